# Optimizing an MI355X kernel written in HIP

```python
import math
import jax
import jax.numpy as jnp
from jax import lax
import numpy as np

D_MODEL = 1024
BATCH = 8
SEQ = 2048
DEPTH = 2

GRID_W = 64
CTX_LEN = 256
A_HEADS = 4
A_HEAD_DIM = 64
A_WIDTH = 2 * A_HEADS * A_HEAD_DIM
ROPE_THETA = 10000.0
Q_BLOCK = 128
B_WIDTH = D_MODEL // 2
B_CONV = 3
C_WIDTH = D_MODEL
C_BLOCKS = 4
C_BLOCK = C_WIDTH // C_BLOCKS
C_CONV = 4
LRU_C = 8.0
N_EXPERTS = 32
TOP_K = 4
EXPERT_FF = D_MODEL
SWIGLU_ALPHA = 1.702
SWIGLU_LIMIT = 7.0
NORM_EPS = 1e-6
N_EVEN = (DEPTH + 1) // 2
N_ODD = DEPTH // 2
EVEN_IN = 3 * A_WIDTH + 3 * B_WIDTH
ODD_IN = 2 * C_WIDTH

kernel_name = "hybrid_diffattn_shortconv_rglru_moe_prefix_trunk"


def rmsnorm(x, g):
    xf = x.astype(jnp.float32)
    y = xf * lax.rsqrt(jnp.mean(xf * xf, axis=-1, keepdims=True) + NORM_EPS)
    return (y * g.astype(jnp.float32)).astype(x.dtype)


def modulate(h, shift, scale):
    return h * (1 + scale) + shift


def adaln(cvec, w_mod, b_mod, n_chunks):
    d = cvec.shape[-1]
    m = jax.nn.silu(cvec) @ w_mod[:, : n_chunks * d] + b_mod[: n_chunks * d]
    return jnp.split(m, n_chunks, axis=-1)


def depthwise_conv(x, w, pad):
    return lax.conv_general_dilated(
        x, w[:, None, :].astype(x.dtype), window_strides=(1,), padding=[pad],
        dimension_numbers=("NWC", "WIO", "NWC"), feature_group_count=x.shape[-1])


def axial_rope_tables(n_tokens, dtype):
    n_rows = n_tokens // GRID_W
    rows, cols = jnp.meshgrid(jnp.arange(n_rows), jnp.arange(GRID_W), indexing="ij")
    pos = jnp.stack([rows.reshape(-1), cols.reshape(-1)], axis=-1).astype(jnp.float32)
    n_freq = A_HEAD_DIM // 4
    inv = ROPE_THETA ** (-jnp.arange(n_freq, dtype=jnp.float32) / n_freq)
    ang = pos[:, :, None] * inv
    return jnp.cos(ang).astype(dtype), jnp.sin(ang).astype(dtype)


def apply_axial_rope(x, cos, sin):
    xs = x.reshape(x.shape[:-1] + (2, 2, A_HEAD_DIM // 4))
    x1, x2 = xs[..., 0, :], xs[..., 1, :]
    out = jnp.stack([x1 * cos - x2 * sin, x2 * cos + x1 * sin], axis=-2)
    return out.reshape(x.shape)


def qk_heads(t):
    b, l, _ = t.shape
    return t.reshape(b, l, A_HEADS, 2, A_HEAD_DIM).transpose(0, 2, 3, 1, 4)


def v_heads(t):
    b, l, _ = t.shape
    return t.reshape(b, l, A_HEADS, 2 * A_HEAD_DIM).transpose(0, 2, 1, 3)


def diff_attend(q, k, v, lam):
    s = jnp.einsum("bhmqd,bhmkd->bhmqk", q, k, preferred_element_type=jnp.float32) * (A_HEAD_DIM ** -0.5)
    p = jax.nn.softmax(s, axis=-1)
    w = p[:, :, 0] - lam * p[:, :, 1]
    return jnp.einsum("bhqk,bhkv->bhqv", w.astype(v.dtype), v)


def merge_heads(o, subln_g, lam_init):
    b, h, l, dv = o.shape
    o = rmsnorm(o, subln_g) * (1.0 - lam_init)
    return o.transpose(0, 2, 1, 3).reshape(b, l, h * dv)


def even_mixer(h_ctx, h_lat, w_in, w_out, lq1, lk1, lq2, lk2, subln_g, conv_w, lam_init, cos, sin, need_ctx):
    f32 = jnp.float32
    lam = (jnp.exp(jnp.sum(lq1.astype(f32) * lk1.astype(f32)))
           - jnp.exp(jnp.sum(lq2.astype(f32) * lk2.astype(f32))) + lam_init)
    splits = (A_WIDTH, 2 * A_WIDTH, 3 * A_WIDTH, 3 * A_WIDTH + B_WIDTH, 3 * A_WIDTH + 2 * B_WIDTH)
    q_l, k_l, v_l, bg_l, cg_l, u_l = jnp.split(h_lat @ w_in, splits, axis=-1)
    if need_ctx:
        q_c, k_c, v_c, bg_c, cg_c, u_c = jnp.split(h_ctx @ w_in, splits, axis=-1)
    else:
        k_c, v_c = jnp.split(h_ctx @ w_in[:, A_WIDTH:3 * A_WIDTH], 2, axis=-1)
    kh_c, vh_c = qk_heads(k_c), v_heads(v_c)
    q_l = apply_axial_rope(qk_heads(q_l), cos, sin)
    k_l = apply_axial_rope(qk_heads(k_l), cos, sin)
    k_all = jnp.concatenate([kh_c, k_l], axis=3)
    v_all = jnp.concatenate([vh_c, v_heads(v_l)], axis=2)
    b, h, _, s_len, d = q_l.shape
    nb = s_len // Q_BLOCK
    q_blocks = jnp.moveaxis(q_l.reshape(b, h, 2, nb, Q_BLOCK, d), 3, 0)
    o = lax.map(lambda qb: diff_attend(qb, k_all, v_all, lam), q_blocks)
    o = jnp.moveaxis(o, 0, 2).reshape(b, h, s_len, 2 * A_HEAD_DIM)
    attn_l = merge_heads(o, subln_g, lam_init)
    pad = (B_CONV // 2, B_CONV // 2)
    conv_l = bg_l * depthwise_conv(cg_l * u_l, conv_w, pad)
    y_lat = jnp.concatenate([attn_l, conv_l], axis=-1) @ w_out
    y_ctx = None
    if need_ctx:
        attn_c = merge_heads(diff_attend(qk_heads(q_c), kh_c, vh_c, lam), subln_g, lam_init)
        conv_c = bg_c * depthwise_conv(cg_c * u_c, conv_w, pad)
        y_ctx = jnp.concatenate([attn_c, conv_c], axis=-1) @ w_out
    return y_ctx, y_lat


def block_diag_linear(x, w, b):
    xb = x.reshape(x.shape[:-1] + (C_BLOCKS, C_BLOCK))
    return jnp.einsum("blgi,gio->blgo", xb, w).reshape(x.shape) + b


def linear_scan(a, u, h0, reverse, emit):
    def step(h, au):
        h = au[0] * h + au[1]
        return h, (h if emit else None)
    h_end, hs = lax.scan(step, h0, (jnp.swapaxes(a, 0, 1), jnp.swapaxes(u, 0, 1)), reverse=reverse)
    return h_end, (jnp.swapaxes(hs, 0, 1) if emit else None)


def rglru_direction(u_ctx, u_lat, conv_w, conv_b, ga_w, ga_b, gx_w, gx_b, lru_lam, reverse, need_ctx):
    f32 = jnp.float32
    pad = (0, C_CONV - 1) if reverse else (C_CONV - 1, 0)

    def gate_inputs(u):
        xc = depthwise_conv(u, conv_w, pad) + conv_b
        r = jax.nn.sigmoid(block_diag_linear(xc, ga_w, ga_b).astype(f32))
        i = jax.nn.sigmoid(block_diag_linear(xc, gx_w, gx_b).astype(f32))
        log_a = -LRU_C * r * jax.nn.softplus(-lru_lam.astype(f32))
        return jnp.exp(log_a), jnp.sqrt(-jnp.expm1(2.0 * log_a)) * (i * xc.astype(f32))

    a_c, b_c = gate_inputs(u_ctx)
    h0 = jnp.zeros((u_ctx.shape[0], C_WIDTH), f32)
    h_ctx_end, hs_c = linear_scan(a_c, b_c, h0, reverse, need_ctx)
    a_l, b_l = gate_inputs(u_lat)
    _, hs_l = linear_scan(a_l, b_l, h_ctx_end, reverse, True)
    return hs_c, hs_l


def odd_mixer(h_ctx, h_lat, w_in, w_out, conv_w, conv_b, ga_w, ga_b, gx_w, gx_b, lru_lam, need_ctx):
    gate_l, u_l = jnp.split(h_lat @ w_in, 2, axis=-1)
    if need_ctx:
        gate_c, u_c = jnp.split(h_ctx @ w_in, 2, axis=-1)
    else:
        u_c = h_ctx @ w_in[:, C_WIDTH:]
    outs = [rglru_direction(u_c, u_l, conv_w[d], conv_b[d], ga_w[d], ga_b[d], gx_w[d], gx_b[d],
                            lru_lam[d], d == 1, need_ctx) for d in range(2)]
    rec_l = outs[0][1] + outs[1][1]
    y_lat = (rec_l.astype(h_lat.dtype) * jax.nn.gelu(gate_l)) @ w_out
    y_ctx = None
    if need_ctx:
        rec_c = outs[0][0] + outs[1][0]
        y_ctx = (rec_c.astype(h_ctx.dtype) * jax.nn.gelu(gate_c)) @ w_out
    return y_ctx, y_lat


def moe_ffn(x, w_r, b_r, w1, b1, w2, b2):
    logits = (x @ w_r + b_r).astype(jnp.float32)
    top_v, top_i = lax.top_k(logits, TOP_K)
    probs = jax.nn.softmax(top_v, axis=-1)
    gates = jnp.sum(jax.nn.one_hot(top_i, N_EXPERTS, dtype=jnp.float32) * probs[..., None], axis=1)

    def expert(acc, ew):
        w1e, b1e, w2e, b2e, ge = ew
        h = x @ w1e + b1e
        glu = jnp.minimum(h[:, :EXPERT_FF], SWIGLU_LIMIT)
        lin = jnp.clip(h[:, EXPERT_FF:], -SWIGLU_LIMIT, SWIGLU_LIMIT)
        act = glu * jax.nn.sigmoid(SWIGLU_ALPHA * glu) * (lin + 1)
        return acc + ge[:, None] * (act @ w2e + b2e), None

    y, _ = lax.scan(expert, jnp.zeros_like(x), (w1, b1, w2, b2, gates.T.astype(x.dtype)))
    return y


def setup_inputs(seed: int = 0) -> dict:
    key = jax.random.key(seed)
    ks = iter(jax.random.split(key, 40))
    D, E, F = D_MODEL, N_EXPERTS, EXPERT_FF

    def nrm(shape, scale):
        return jax.random.normal(next(ks), shape, jnp.float32) * scale

    u = jax.random.uniform(next(ks), (N_ODD, 2, C_WIDTH), jnp.float32, 0.9, 0.999)
    s = u ** (1.0 / LRU_C)
    lru_lambda = jnp.log(s) - jnp.log1p(-s)
    return {
        "x": nrm((BATCH, SEQ, D), 1.0),
        "c": nrm((BATCH, D), 1.0),
        "ctx": nrm((BATCH, CTX_LEN, D), 1.0),
        "c_ctx": nrm((D,), 1.0),
        "w_mod": nrm((DEPTH, D, 6 * D), 0.5 * D ** -0.5),
        "b_mod": nrm((DEPTH, 6 * D), 0.02),
        "norm_mix": 1.0 + nrm((DEPTH, D), 0.05),
        "norm_ffn": 1.0 + nrm((DEPTH, D), 0.05),
        "ev_w_in": nrm((N_EVEN, D, EVEN_IN), D ** -0.5),
        "ev_w_out": nrm((N_EVEN, A_WIDTH + B_WIDTH, D), (A_WIDTH + B_WIDTH) ** -0.5),
        "ev_lambda_q1": nrm((N_EVEN, A_HEAD_DIM), 0.1),
        "ev_lambda_k1": nrm((N_EVEN, A_HEAD_DIM), 0.1),
        "ev_lambda_q2": nrm((N_EVEN, A_HEAD_DIM), 0.1),
        "ev_lambda_k2": nrm((N_EVEN, A_HEAD_DIM), 0.1),
        "ev_subln": 1.0 + nrm((N_EVEN, 2 * A_HEAD_DIM), 0.05),
        "ev_conv_w": nrm((N_EVEN, B_CONV, B_WIDTH), B_CONV ** -0.5),
        "od_w_in": nrm((N_ODD, D, ODD_IN), D ** -0.5),
        "od_w_out": nrm((N_ODD, C_WIDTH, D), C_WIDTH ** -0.5),
        "od_conv_w": nrm((N_ODD, 2, C_CONV, C_WIDTH), C_CONV ** -0.5),
        "od_conv_b": nrm((N_ODD, 2, C_WIDTH), 0.02),
        "od_gate_a_w": nrm((N_ODD, 2, C_BLOCKS, C_BLOCK, C_BLOCK), C_BLOCK ** -0.5),
        "od_gate_a_b": nrm((N_ODD, 2, C_WIDTH), 0.02),
        "od_gate_x_w": nrm((N_ODD, 2, C_BLOCKS, C_BLOCK, C_BLOCK), C_BLOCK ** -0.5),
        "od_gate_x_b": nrm((N_ODD, 2, C_WIDTH), 0.02),
        "od_lru_lambda": lru_lambda,
        "moe_w_router": nrm((DEPTH, D, E), D ** -0.5),
        "moe_b_router": nrm((DEPTH, E), 0.01),
        "moe_w1": nrm((DEPTH, E, D, 2 * F), D ** -0.5),
        "moe_b1": nrm((DEPTH, E, 2 * F), 0.02),
        "moe_w2": nrm((DEPTH, E, F, D), F ** -0.5),
        "moe_b2": nrm((DEPTH, E, D), 0.02),
        "final_norm": 1.0 + nrm((D,), 0.05),
    }


def reference(x, c, ctx, c_ctx, w_mod, b_mod, norm_mix, norm_ffn,
              ev_w_in, ev_w_out, ev_lambda_q1, ev_lambda_k1, ev_lambda_q2, ev_lambda_k2, ev_subln, ev_conv_w,
              od_w_in, od_w_out, od_conv_w, od_conv_b, od_gate_a_w, od_gate_a_b, od_gate_x_w, od_gate_x_b,
              od_lru_lambda, moe_w_router, moe_b_router, moe_w1, moe_b1, moe_w2, moe_b2, final_norm):
    b, s_len, d_model = x.shape
    n_ctx_tok = b * ctx.shape[1]
    cos, sin = axial_rope_tables(s_len, x.dtype)
    for i in range(DEPTH):
        last = i == DEPTH - 1
        need_ctx = not last
        sh1, sc1, g1, sh2, sc2, g2 = [m[:, None, :] for m in adaln(c, w_mod[i], b_mod[i], 6)]
        mc = adaln(c_ctx, w_mod[i], b_mod[i], 2 if last else 6)
        h_lat = modulate(rmsnorm(x, norm_mix[i]), sh1, sc1)
        h_ctx = modulate(rmsnorm(ctx, norm_mix[i]), mc[0], mc[1])
        j = i // 2
        if i % 2 == 0:
            lam_init = 0.8 - 0.6 * math.exp(-0.3 * i)
            y_ctx, y_lat = even_mixer(h_ctx, h_lat, ev_w_in[j], ev_w_out[j], ev_lambda_q1[j], ev_lambda_k1[j],
                                      ev_lambda_q2[j], ev_lambda_k2[j], ev_subln[j], ev_conv_w[j], lam_init,
                                      cos, sin, need_ctx)
        else:
            y_ctx, y_lat = odd_mixer(h_ctx, h_lat, od_w_in[j], od_w_out[j], od_conv_w[j], od_conv_b[j],
                                     od_gate_a_w[j], od_gate_a_b[j], od_gate_x_w[j], od_gate_x_b[j],
                                     od_lru_lambda[j], need_ctx)
        x = x + g1 * y_lat
        h_lat2 = modulate(rmsnorm(x, norm_ffn[i]), sh2, sc2)
        moe_p = (moe_w_router[i], moe_b_router[i], moe_w1[i], moe_b1[i], moe_w2[i], moe_b2[i])
        if last:
            x = x + g2 * moe_ffn(h_lat2.reshape(-1, d_model), *moe_p).reshape(x.shape)
        else:
            ctx = ctx + mc[2] * y_ctx
            h_ctx2 = modulate(rmsnorm(ctx, norm_ffn[i]), mc[3], mc[4])
            tok = jnp.concatenate([h_ctx2.reshape(-1, d_model), h_lat2.reshape(-1, d_model)], axis=0)
            out = moe_ffn(tok, *moe_p)
            ctx = ctx + mc[5] * out[:n_ctx_tok].reshape(ctx.shape)
            x = x + g2 * out[n_ctx_tok:].reshape(x.shape)
    return rmsnorm(x, final_norm)
```

```cpp
#include <hip/hip_runtime.h>
#include <cstdio>
#include <cstdint>
namespace ref {
constexpr int D = 1024, NB = 8, S = 2048, CT = 256, NCTX = NB * CT, NLAT = NB * S, NTOK = NCTX + NLAT;
constexpr int NE = 32, TOPK = 4, NSLOT = NTOK * TOPK;
__device__ __forceinline__ int row_batch(int r) { return r < NCTX ? r / CT : (r - NCTX) / S; }
__device__ __forceinline__ int row_t(int r) { return r < NCTX ? r % CT : (r - NCTX) % S; }
__device__ __forceinline__ int row_seglen(int r) { return r < NCTX ? CT : S; }
__device__ __forceinline__ int row_modrow(int r) { return r < NCTX ? 8 : (r - NCTX) / S; }

__global__ void k_adaln(const float* c, const float* cctx, const float* w_mod, const float* b_mod, float* MOD) {
    const int gid = blockIdx.x * blockDim.x + threadIdx.x; if (gid >= 2 * 6144) return;
    const int layer = gid / 6144, n = gid % 6144;
    float acc[9]; for (int i = 0; i < 9; ++i) acc[i] = 0.f;
    const float* w = w_mod + (size_t)layer * D * 6144 + n;
    for (int k = 0; k < D; ++k) {
        const float wv = w[(size_t)k * 6144];
        for (int b = 0; b < 9; ++b) { const float cv = b < 8 ? c[b * D + k] : cctx[k]; const float s = cv / (1.f + expf(-cv)); acc[b] += s * wv; }
    }
    for (int b = 0; b < 9; ++b) MOD[((size_t)layer * 9 + b) * 6144 + n] = acc[b] + b_mod[layer * 6144 + n];
}
__global__ void k_norm_mod(const float* X, const float* g, const float* MODL, int csh, int csc, float* OUT, int row0, int orow_sub = 0) {
    const int r = row0 + blockIdx.x, tid = threadIdx.x;
    const float* x = X + (size_t)r * D; float v[4]; float ss = 0.f;
    for (int i = 0; i < 4; ++i) { v[i] = x[tid + 256 * i]; ss += v[i] * v[i]; }
    __shared__ float red[256]; red[tid] = ss; __syncthreads();
    for (int o = 128; o > 0; o >>= 1) { if (tid < o) red[tid] += red[tid + o]; __syncthreads(); }
    const float rstd = rsqrtf(red[0] / D + 1e-6f);
    const float* m = MODL + (size_t)row_modrow(r) * 6144;
    for (int i = 0; i < 4; ++i) { const int n = tid + 256 * i; float y = v[i] * rstd * g[n]; if (csh >= 0) y = y * (1.f + m[csc * D + n]) + m[csh * D + n]; OUT[(size_t)(r - orow_sub) * D + n] = y; }
}
struct GDesc { const float* A; const int* gather; const float* B; float* C; int lda, ldb, ldc, M, N, K; };
__global__ void k_set_desc(GDesc* d, const float* A, const int* gather, const float* B, float* C, int lda, int ldb, int ldc, int M, int N, int K) {
    GDesc g; g.A = A; g.gather = gather; g.B = B; g.C = C; g.lda = lda; g.ldb = ldb; g.ldc = ldc; g.M = M; g.N = N; g.K = K; *d = g;
}
__global__ void __launch_bounds__(256) k_gemm(const GDesc* descs) {
    const GDesc g = descs[blockIdx.z];
    const int m0 = blockIdx.y * 64, n0 = blockIdx.x * 64; if (m0 >= g.M || n0 >= g.N) return;
    __shared__ float As[16][68], Bs[16][64];
    const int tid = threadIdx.x, tx = tid & 15, ty = tid >> 4;
    const int ar = tid >> 2, ak = (tid & 3) * 4; int arow = m0 + ar; const bool aok = arow < g.M; if (!aok) arow = g.M - 1;
    const size_t abase = (size_t)(g.gather ? g.gather[arow] : arow) * g.lda;
    const int bk = tid >> 4, bn = (tid & 15) * 4;
    float acc[4][4]; for (int i = 0; i < 4; ++i) for (int j = 0; j < 4; ++j) acc[i][j] = 0.f;
    for (int k0 = 0; k0 < g.K; k0 += 16) {
        const float4 av = *(const float4*)(g.A + abase + k0 + ak);
        As[ak + 0][ar] = av.x; As[ak + 1][ar] = av.y; As[ak + 2][ar] = av.z; As[ak + 3][ar] = av.w;
        *(float4*)&Bs[bk][bn] = *(const float4*)(g.B + (size_t)(k0 + bk) * g.ldb + n0 + bn);
        __syncthreads();
#pragma unroll
        for (int k = 0; k < 16; ++k) { const float4 a = *(const float4*)&As[k][ty * 4]; const float4 b = *(const float4*)&Bs[k][tx * 4];
            const float aa[4] = {a.x, a.y, a.z, a.w}, bb[4] = {b.x, b.y, b.z, b.w};
#pragma unroll
            for (int i = 0; i < 4; ++i)
#pragma unroll
                for (int j = 0; j < 4; ++j) acc[i][j] += aa[i] * bb[j]; }
        __syncthreads();
    }
    for (int i = 0; i < 4; ++i) { const int m = m0 + ty * 4 + i; if (m < g.M) *(float4*)(g.C + (size_t)m * g.ldc + n0 + tx * 4) = make_float4(acc[i][0], acc[i][1], acc[i][2], acc[i][3]); }
}
__global__ void k_rope(float* PROJ) {
    const int gid = blockIdx.x * blockDim.x + threadIdx.x;
    const int lr = gid / 512, p = gid % 512; if (lr >= NLAT) return;
    const int t = lr % S; const int f = p & 15, axis = (p >> 4) & 1, hm = p >> 5;
    const int col = hm * 64 + axis * 32 + f;
    const float pos = axis == 0 ? (float)(t / 64) : (float)(t % 64);
    const float inv = powf(10000.f, -(float)f / 16.f); const float ang = pos * inv; const float cs = cosf(ang), sn = sinf(ang);
    float* x = PROJ + (size_t)(NCTX + lr) * 3072 + col; const float x1 = x[0], x2 = x[16];
    x[0] = x1 * cs - x2 * sn; x[16] = x2 * cs + x1 * sn;
}
__global__ void k_lam(const float* q1, const float* k1, const float* q2, const float* k2, float lam_init, float* out) {
    float a = 0.f, b = 0.f; for (int i = 0; i < 64; ++i) { a += q1[i] * k1[i]; b += q2[i] * k2[i]; } out[0] = expf(a) - expf(b) + lam_init;
}
__global__ void __launch_bounds__(256) k_attn(const float* PROJ, const float* lamp, const float* subln, float lam_init, float* CAT) {
    const int r = blockIdx.x, h = blockIdx.y, tid = threadIdx.x; const int b = row_batch(r); const bool lat = r >= NCTX;
    const int nk = lat ? CT + S : CT;
    __shared__ float q[128]; __shared__ float sc[2][CT + S]; __shared__ float red[256]; __shared__ float o2[256];
    if (tid < 128) q[tid] = PROJ[(size_t)r * 3072 + h * 128 + tid]; __syncthreads();
    float mx[2] = {-1e30f, -1e30f};
    for (int j = tid; j < nk; j += 256) { const int kr = j < CT ? b * CT + j : NCTX + b * S + (j - CT); const float* kp = PROJ + (size_t)kr * 3072 + 512 + h * 128;
        for (int m = 0; m < 2; ++m) { float s = 0.f; for (int d = 0; d < 64; ++d) s += q[m * 64 + d] * kp[m * 64 + d]; s *= 0.125f; sc[m][j] = s; mx[m] = fmaxf(mx[m], s); } }
    float sum[2];
    for (int m = 0; m < 2; ++m) {
        red[tid] = mx[m]; __syncthreads(); for (int o = 128; o > 0; o >>= 1) { if (tid < o) red[tid] = fmaxf(red[tid], red[tid + o]); __syncthreads(); } const float M = red[0]; __syncthreads();
        float s = 0.f; for (int j = tid; j < nk; j += 256) { const float e = expf(sc[m][j] - M); sc[m][j] = e; s += e; }
        red[tid] = s; __syncthreads(); for (int o = 128; o > 0; o >>= 1) { if (tid < o) red[tid] += red[tid + o]; __syncthreads(); } sum[m] = red[0]; __syncthreads();
    }
    const float lam = lamp[0], i0 = 1.f / sum[0], i1 = lam / sum[1];
    const int dv = tid & 127, part = tid >> 7; float acc = 0.f;
    for (int j = part; j < nk; j += 2) { const int kr = j < CT ? b * CT + j : NCTX + b * S + (j - CT); const float w = sc[0][j] * i0 - sc[1][j] * i1; acc += w * PROJ[(size_t)kr * 3072 + 1024 + h * 128 + dv]; }
    o2[tid] = acc; __syncthreads();
    float o = 0.f; if (tid < 128) { o = o2[tid] + o2[tid + 128]; red[tid] = o * o; } else red[tid] = 0.f; __syncthreads();
    for (int st = 128; st > 0; st >>= 1) { if (tid < st) red[tid] += red[tid + st]; __syncthreads(); }
    if (tid < 128) CAT[(size_t)r * D + h * 128 + tid] = o * rsqrtf(red[0] / 128.f + 1e-6f) * subln[tid] * (1.f - lam_init);
}
__global__ void k_conv0(const float* PROJ, const float* cw, float* CAT) {
    const int gid = blockIdx.x * blockDim.x + threadIdx.x; const int r = gid / 512, c = gid % 512; if (r >= NTOK) return;
    const int t = row_t(r), L = row_seglen(r); float acc = 0.f;
    for (int k = 0; k < 3; ++k) { const int tt = t + k - 1; if (tt < 0 || tt >= L) continue; const float* p = PROJ + (size_t)(r + k - 1) * 3072; acc += cw[k * 512 + c] * p[2048 + c] * p[2560 + c]; }
    CAT[(size_t)r * D + 512 + c] = PROJ[(size_t)r * 3072 + 1536 + c] * acc;
}
__global__ void k_resid(float* XS, const float* Y, const float* MODL, int chunk, int row0, int nrows) {
    const size_t gid = (size_t)blockIdx.x * blockDim.x + threadIdx.x; if (gid >= (size_t)nrows * D) return; const int r = row0 + (int)(gid / D), n = (int)(gid % D);
    XS[(size_t)r * D + n] += MODL[(size_t)row_modrow(r) * 6144 + chunk * D + n] * Y[(size_t)r * D + n];
}
__global__ void k_router(const float* H2, const float* wr, const float* br, int row0, int* eidx, float* egate, int* epos, int* counts) {
    const int r = row0 + blockIdx.x, tid = threadIdx.x; __shared__ float lg[32];
    if (tid < 32) { float s = 0.f; const float* x = H2 + (size_t)r * D; for (int k = 0; k < D; ++k) s += x[k] * wr[k * 32 + tid]; lg[tid] = s + br[tid]; } __syncthreads();
    if (tid == 0) { float v[4]; int id[4]; unsigned used = 0u;
        for (int k = 0; k < 4; ++k) { float best = -1e30f; int bi = 0; for (int e = 0; e < 32; ++e) if (!((used >> e) & 1u) && lg[e] > best) { best = lg[e]; bi = e; } used |= 1u << bi; v[k] = best; id[k] = bi; }
        float s = 0.f, p[4]; for (int k = 0; k < 4; ++k) { p[k] = expf(v[k] - v[0]); s += p[k]; }
        for (int k = 0; k < 4; ++k) { eidx[r * 4 + k] = id[k]; egate[r * 4 + k] = p[k] / s; epos[r * 4 + k] = atomicAdd(&counts[id[k]], 1); } }
}
__global__ void k_moe_desc(const int* counts, int* offs, GDesc* d1, GDesc* d2, const float* XIN, const int* slot_row, const float* w1, const float* w2, float* HID, float* ACT, float* Y2) {
    if (threadIdx.x == 0) { int o = 0; for (int e = 0; e < 32; ++e) { offs[e] = o;
        GDesc a; a.A = XIN; a.gather = slot_row + o; a.B = w1 + (size_t)e * D * 2048; a.C = HID + (size_t)o * 2048; a.lda = D; a.ldb = 2048; a.ldc = 2048; a.M = counts[e]; a.N = 2048; a.K = D; d1[e] = a;
        GDesc c; c.A = ACT + (size_t)o * D; c.gather = nullptr; c.B = w2 + (size_t)e * D * D; c.C = Y2 + (size_t)o * D; c.lda = D; c.ldb = D; c.ldc = D; c.M = counts[e]; c.N = D; c.K = D; d2[e] = c;
        o += counts[e]; } }
}
__global__ void k_moe_fill(const int* eidx, const int* epos, const int* offs, int row0, int nrows, int* slot_row, int* slot_exp) {
    const int gid = blockIdx.x * blockDim.x + threadIdx.x; if (gid >= nrows * 4) return; const int r = row0 + gid / 4, k = gid % 4;
    const int e = eidx[r * 4 + k]; const int s = offs[e] + epos[r * 4 + k]; slot_row[s] = r; slot_exp[s] = e;
}
__global__ void k_swiglu(const float* HID, const float* b1, const int* slot_exp, float* ACT, int nslots) {
    const size_t gid = (size_t)blockIdx.x * blockDim.x + threadIdx.x; if (gid >= (size_t)nslots * D) return; const int s = (int)(gid / D), j = (int)(gid % D);
    const float* bb = b1 + (size_t)slot_exp[s] * 2048;
    float glu = HID[(size_t)s * 2048 + j] + bb[j], lin = HID[(size_t)s * 2048 + 1024 + j] + bb[1024 + j];
    glu = fminf(glu, 7.f); lin = fminf(fmaxf(lin, -7.f), 7.f);
    ACT[(size_t)s * D + j] = glu / (1.f + expf(-1.702f * glu)) * (lin + 1.f);
}
__global__ void k_moe_combine(float* XS, const float* Y2, const float* b2, const int* eidx, const float* egate, const int* epos, const int* offs, const float* MODL, int chunk, int row0, int nrows) {
    const size_t gid = (size_t)blockIdx.x * blockDim.x + threadIdx.x; if (gid >= (size_t)nrows * D) return; const int r = row0 + (int)(gid / D), n = (int)(gid % D);
    float acc = 0.f; for (int k = 0; k < 4; ++k) { const int e = eidx[r * 4 + k]; const int s = offs[e] + epos[r * 4 + k]; acc += egate[r * 4 + k] * (Y2[(size_t)s * D + n] + b2[e * D + n]); }
    XS[(size_t)r * D + n] += MODL[(size_t)row_modrow(r) * 6144 + chunk * D + n] * acc;
}
__global__ void k_conv1(const float* PROJ, const float* cw, const float* cb, float* XC) {
    const size_t gid = (size_t)blockIdx.x * blockDim.x + threadIdx.x; if (gid >= (size_t)2 * NTOK * D) return;
    const int d = (int)(gid / ((size_t)NTOK * D)); const int r = (int)((gid / D) % NTOK), c = (int)(gid % D); const int t = row_t(r), L = row_seglen(r);
    float acc = cb[d * D + c];
    for (int k = 0; k < 4; ++k) { const int off = d == 0 ? k - 3 : k; const int tt = t + off; if (tt < 0 || tt >= L) continue; acc += cw[(d * 4 + k) * D + c] * PROJ[(size_t)(r + off) * 2048 + 1024 + c]; }
    XC[gid] = acc;
}
__global__ void k_gates(const float* XC, float* RA, float* IX, const float* gab, const float* gxb, const float* lam) {
    const size_t gid = (size_t)blockIdx.x * blockDim.x + threadIdx.x; if (gid >= (size_t)2 * NTOK * D) return;
    const int d = (int)(gid / ((size_t)NTOK * D)); const int c = (int)(gid % D);
    const float rg = 1.f / (1.f + expf(-(RA[gid] + gab[d * D + c]))), ig = 1.f / (1.f + expf(-(IX[gid] + gxb[d * D + c])));
    const float sp = log1pf(expf(-lam[d * D + c])); const float la = -8.f * rg * sp;
    RA[gid] = expf(la); IX[gid] = sqrtf(-expm1f(2.f * la)) * (ig * XC[gid]);
}
__global__ void k_scan(const float* A, const float* Bv, float* H) {
    const int gid = blockIdx.x * blockDim.x + threadIdx.x; if (gid >= 2 * NB * D) return; const int d = gid / (NB * D), b = (gid / D) % NB, c = gid % D;
    const size_t base = (size_t)d * NTOK * D; float h = 0.f;
    for (int i = 0; i < CT; ++i) { const int t = d == 0 ? i : CT - 1 - i; const size_t o = base + (size_t)(b * CT + t) * D + c; h = A[o] * h + Bv[o]; }
    for (int i = 0; i < S; ++i) { const int t = d == 0 ? i : S - 1 - i; const size_t o = base + (size_t)(NCTX + b * S + t) * D + c; h = A[o] * h + Bv[o]; H[o] = h; }
}
__global__ void k_recgate(const float* H, const float* PROJ, float* CAT) {
    const size_t gid = (size_t)blockIdx.x * blockDim.x + threadIdx.x; if (gid >= (size_t)NLAT * D) return; const int r = NCTX + (int)(gid / D), c = (int)(gid % D);
    const float g = PROJ[(size_t)r * 2048 + c]; const float ge = 0.5f * g * (1.f + tanhf(0.7978845608028654f * (g + 0.044715f * g * g * g)));
    CAT[(size_t)r * D + c] = (H[(size_t)r * D + c] + H[(size_t)NTOK * D + (size_t)r * D + c]) * ge;
}
__global__ void k_copy_rows(const float* x, const float* ctx, float* XS) {
    const size_t gid = (size_t)blockIdx.x * blockDim.x + threadIdx.x; if (gid >= (size_t)NTOK * D) return;
    XS[gid] = gid < (size_t)NCTX * D ? ctx[gid] : x[gid - (size_t)NCTX * D];
}

struct Ws {
    float *MOD, *XS, *XN, *PROJ, *CAT, *Y, *BIG; int *eidx, *epos, *counts, *offs, *slot_row, *slot_exp; float* egate; float* lam; GDesc* desc;
};
inline size_t carve(Ws& w, char* base) {
    size_t o = 0; auto take = [&](size_t bytes) { char* p = base + o; o += (bytes + 255) & ~(size_t)255; return p; };
    w.MOD = (float*)take(2 * 9 * 6144 * 4); w.lam = (float*)take(256); w.counts = (int*)take(256); w.offs = (int*)take(256); w.desc = (GDesc*)take(80 * sizeof(GDesc));
    w.eidx = (int*)take((size_t)NSLOT * 4); w.epos = (int*)take((size_t)NSLOT * 4); w.egate = (float*)take((size_t)NSLOT * 4); w.slot_row = (int*)take((size_t)NSLOT * 4); w.slot_exp = (int*)take((size_t)NSLOT * 4);
    w.XS = (float*)take((size_t)NTOK * D * 4); w.XN = (float*)take((size_t)NTOK * D * 4); w.CAT = (float*)take((size_t)NTOK * D * 4); w.Y = (float*)take((size_t)NTOK * D * 4);
    w.PROJ = (float*)take((size_t)NTOK * 3072 * 4);
    w.BIG = (float*)take((size_t)NSLOT * 3072 * 4);
    return o;
}
inline void gemm1(hipStream_t st, Ws& w, int slot, const float* A, const float* B, float* C, int lda, int ldb, int ldc, int M, int N, int K) {
    k_set_desc<<<1, 1, 0, st>>>(w.desc + slot, A, nullptr, B, C, lda, ldb, ldc, M, N, K);
    k_gemm<<<dim3(N / 64, (M + 63) / 64, 1), 256, 0, st>>>(w.desc + slot);
}
inline void moe(hipStream_t st, Ws& w, int layer, int row0, int nrows, void* const* d_in) {
    const float* wr = (const float*)d_in[25] + (size_t)layer * D * 32; const float* br = (const float*)d_in[26] + layer * 32;
    const float* w1 = (const float*)d_in[27] + (size_t)layer * 32 * D * 2048; const float* b1 = (const float*)d_in[28] + (size_t)layer * 32 * 2048;
    const float* w2 = (const float*)d_in[29] + (size_t)layer * 32 * D * D; const float* b2 = (const float*)d_in[30] + (size_t)layer * 32 * D;
    float* HID = w.BIG; float* ACT = w.BIG + (size_t)NSLOT * 2048; float* Y2 = HID;
    (void)hipMemsetAsync(w.counts, 0, 256, st);
    k_router<<<nrows, 64, 0, st>>>(w.XN, wr, br, row0, w.eidx, w.egate, w.epos, w.counts);
    k_moe_desc<<<1, 64, 0, st>>>(w.counts, w.offs, w.desc + 8, w.desc + 40, w.XN, w.slot_row, w1, w2, HID, ACT, Y2);
    k_moe_fill<<<(nrows * 4 + 255) / 256, 256, 0, st>>>(w.eidx, w.epos, w.offs, row0, nrows, w.slot_row, w.slot_exp);
    k_gemm<<<dim3(2048 / 64, NTOK / 64, 32), 256, 0, st>>>(w.desc + 8);
    k_swiglu<<<(unsigned)(((size_t)nrows * 4 * D + 255) / 256), 256, 0, st>>>(HID, b1, w.slot_exp, ACT, nrows * 4);
    k_gemm<<<dim3(D / 64, NTOK / 64, 32), 256, 0, st>>>(w.desc + 40);
    k_moe_combine<<<(unsigned)(((size_t)nrows * D + 255) / 256), 256, 0, st>>>(w.XS, Y2, b2, w.eidx, w.egate, w.epos, w.offs, w.MOD + (size_t)layer * 9 * 6144, 5, row0, nrows);
}
inline void forward(hipStream_t st, Ws& w, void* const* d_in, float* out) {
    const float* x = (const float*)d_in[0]; const float* c = (const float*)d_in[1]; const float* ctx = (const float*)d_in[2]; const float* cctx = (const float*)d_in[3];
    const float* norm_mix = (const float*)d_in[6]; const float* norm_ffn = (const float*)d_in[7];
    k_adaln<<<(2 * 6144 + 255) / 256, 256, 0, st>>>(c, cctx, (const float*)d_in[4], (const float*)d_in[5], w.MOD);
    k_copy_rows<<<(unsigned)(((size_t)NTOK * D + 255) / 256), 256, 0, st>>>(x, ctx, w.XS);
    const unsigned EW = (unsigned)(((size_t)NTOK * D + 255) / 256);
    {
        const float* M0 = w.MOD;
        k_norm_mod<<<NTOK, 256, 0, st>>>(w.XS, norm_mix, M0, 0, 1, w.XN, 0);
        gemm1(st, w, 0, w.XN, (const float*)d_in[8], w.PROJ, D, 3072, 3072, NTOK, 3072, D);
        k_rope<<<(NLAT * 512 + 255) / 256, 256, 0, st>>>(w.PROJ);
        k_lam<<<1, 1, 0, st>>>((const float*)d_in[10], (const float*)d_in[11], (const float*)d_in[12], (const float*)d_in[13], 0.2f, w.lam);
        k_attn<<<dim3(NTOK, 4), 256, 0, st>>>(w.PROJ, w.lam, (const float*)d_in[14], 0.2f, w.CAT);
        k_conv0<<<(NTOK * 512 + 255) / 256, 256, 0, st>>>(w.PROJ, (const float*)d_in[15], w.CAT);
        gemm1(st, w, 1, w.CAT, (const float*)d_in[9], w.Y, D, D, D, NTOK, D, D);
        k_resid<<<EW, 256, 0, st>>>(w.XS, w.Y, M0, 2, 0, NTOK);
        k_norm_mod<<<NTOK, 256, 0, st>>>(w.XS, norm_ffn, M0, 3, 4, w.XN, 0);
        moe(st, w, 0, 0, NTOK, d_in);
    }
    {
        const float* M1 = w.MOD + (size_t)9 * 6144;
        k_norm_mod<<<NTOK, 256, 0, st>>>(w.XS, norm_mix + D, M1, 0, 1, w.XN, 0);
        gemm1(st, w, 2, w.XN, (const float*)d_in[16], w.PROJ, D, 2048, 2048, NTOK, 2048, D);
        float* XC = w.BIG; float* RA = XC + (size_t)2 * NTOK * D; float* IX = RA + (size_t)2 * NTOK * D; float* H = IX + (size_t)2 * NTOK * D;
        const unsigned EW2 = (unsigned)(((size_t)2 * NTOK * D + 255) / 256);
        k_conv1<<<EW2, 256, 0, st>>>(w.PROJ, (const float*)d_in[18], (const float*)d_in[19], XC);
        for (int d = 0; d < 2; ++d) for (int ty = 0; ty < 2; ++ty) for (int g = 0; g < 4; ++g) {
            const float* W = (const float*)d_in[ty == 0 ? 20 : 22] + (size_t)(d * 4 + g) * 256 * 256; float* O = (ty == 0 ? RA : IX) + (size_t)d * NTOK * D + g * 256;
            gemm1(st, w, 48 + (d * 2 + ty) * 4 + g, XC + (size_t)d * NTOK * D + g * 256, W, O, D, 256, D, NTOK, 256, 256); }
        k_gates<<<EW2, 256, 0, st>>>(XC, RA, IX, (const float*)d_in[21], (const float*)d_in[23], (const float*)d_in[24]);
        k_scan<<<(2 * NB * D + 63) / 64, 64, 0, st>>>(RA, IX, H);
        k_recgate<<<(unsigned)(((size_t)NLAT * D + 255) / 256), 256, 0, st>>>(H, w.PROJ, w.CAT);
        gemm1(st, w, 3, w.CAT + (size_t)NCTX * D, (const float*)d_in[17], w.Y + (size_t)NCTX * D, D, D, D, NLAT, D, D);
        k_resid<<<(unsigned)(((size_t)NLAT * D + 255) / 256), 256, 0, st>>>(w.XS, w.Y, M1, 2, NCTX, NLAT);
        k_norm_mod<<<NLAT, 256, 0, st>>>(w.XS, norm_ffn + D, M1, 3, 4, w.XN, NCTX);
        moe(st, w, 1, NCTX, NLAT, d_in);
    }
    k_norm_mod<<<NLAT, 256, 0, st>>>(w.XS, (const float*)d_in[31], w.MOD, -1, -1, out, NCTX, NCTX);
}
}
extern "C" void kernel_launch(void* const* d_in, const int* in_sizes, int n_in, void* d_out, int out_size, void* d_ws, size_t ws_size, hipStream_t stream) {
    ref::Ws w; const size_t need = ref::carve(w, (char*)d_ws);
    if (need > ws_size) { fprintf(stderr, "kernel_launch: workspace too small: need %zu have %zu\n", need, ws_size); return; }
    ref::forward(stream, w, d_in, (float*)d_out);
}
```

```cpp
#include <hip/hip_runtime.h>
#include <cstdio>
#include <cstdint>
namespace pg8 {
#define PG8_LAS __attribute__((address_space(3)))
typedef unsigned short bf16_t;
typedef short bf16x8 __attribute__((ext_vector_type(8)));
typedef float f32x4 __attribute__((ext_vector_type(4)));
typedef float f32x2 __attribute__((ext_vector_type(2)));
typedef unsigned u32x4 __attribute__((ext_vector_type(4)));
typedef unsigned u32x2 __attribute__((ext_vector_type(2)));
constexpr int BM = 256, BK = 64, HALF = 128, HTB = HALF * BK * 2  , STAGE_BYTES = 8 * HTB, NXCD = 8, WGM = 8;

__host__ __device__ __forceinline__ int lds_byte(int r, int c) { const int st = (r >> 4) * 2 + (c >> 5), rr = r & 15, cc = c & 31, ob = rr * 64 + cc * 2; return st * 1024 + (ob ^ (((ob >> 9) & 1) << 5)); }
__host__ __device__ __forceinline__ void stage_rc(int b, int& R, int& C) { const int st = b / 1024, sb = b % 1024, swz = sb ^ (((sb >> 9) & 1) << 5); R = (st >> 1) * 16 + swz / 64; C = (st & 1) * 32 + (swz % 64) / 2; }
__host__ __device__ __forceinline__ int perm32(int rho) { const int n = rho >> 4, i = rho & 15; return 8 * (i >> 2) + 4 * n + (i & 3); }

struct Unit { int pm, pn; };

struct TileOrder {
    int nM, nN, nwg, G, c;
    __device__ __forceinline__ void init(int nM_, int nN_, int G_, int c_) { nM = nM_; nN = nN_; nwg = nM * nN; G = G_; c = c_; }
    __device__ __forceinline__ bool tile(int i, Unit& u) const { const long L = (long)i * G + c; if (L >= nwg) return false; map((int)L, u); return true; }
    __device__ __forceinline__ void map(int L, Unit& u) const {
        int wgid = L; { const int q = nwg / NXCD, r = nwg % NXCD, xcd = wgid % NXCD, off = wgid / NXCD; wgid = (xcd < r ? xcd * (q + 1) : r * (q + 1) + (xcd - r) * q) + off; }
        const int nig = WGM * nN, gid = wgid / nig, fm = gid * WGM, gsz = (nM - fm) < WGM ? (nM - fm) : WGM;
        u.pm = fm + ((wgid % nig) % gsz); u.pn = (wgid % nig) / gsz;
    }
};

__device__ __forceinline__ unsigned cvt_pk_bf16(float lo, float hi) { unsigned r; asm volatile("v_cvt_pk_bf16_f32 %0, %1, %2" : "=v"(r) : "v"(lo), "v"(hi)); return r; }

template <class Epi, class Sched, bool GATHER>
__device__ __forceinline__ void gemm_phase(PG8_LAS unsigned char* lds, const int K, const Sched& S, const Epi& E) {
    int tid_ = threadIdx.x; asm volatile("" : "+v"(tid_));
    const int tid = tid_, wid = __builtin_amdgcn_readfirstlane(tid >> 6), lane = tid & 63, wr = wid >> 2, wc = wid & 3, fr = lane & 15, fq = lane >> 4;
    const int nt = K / BK;
    int RA[2], CA[2]; unsigned voffB[2];
    unsigned offA[2][2], noffA[2][2];
#pragma unroll
    for (int i = 0; i < 2; ++i) { int R, C; stage_rc(tid * 16 + i * 8192, R, C); const int Rb = Epi::PERM ? ((R & ~31) + perm32(R & 31)) : R;
        RA[i] = R; CA[i] = C; voffB[i] = (unsigned)(Rb * K + C) * 2u;
        offA[0][i] = (unsigned)(R * S.a_pitch + C * 2); offA[1][i] = (unsigned)((R + HALF) * S.a_pitch + C * 2); noffA[0][i] = offA[0][i]; noffA[1][i] = offA[1][i]; }
    const size_t kstep = (size_t)(BK * 2);
    const size_t hstepB = (size_t)HALF * K * 2;
    const unsigned ldsw = (unsigned)wid * 1024u;
    const int aoff = lds_byte(wr * 64 + fr, fq * 8), boff = lds_byte(wc * 32 + fr, fq * 8);
#define PG8_SA(b, h) (((b) * 2 + (h)) * HTB)
#define PG8_SB(b, h) ((4 + (b) * 2 + (h)) * HTB)
#define PG8_STAGE(bufoff, gbase, voff) do { _Pragma("unroll") for (int _i = 0; _i < 2; ++_i) \
        __builtin_amdgcn_global_load_lds((const unsigned*)((const char*)(gbase) + (voff)[_i]), (PG8_LAS unsigned*)(lds + (bufoff) + ldsw + _i * 8192), 16, 0, 0); } while (0)
#define PG8_LDA(dst, b, h) do { _Pragma("unroll") for (int m = 0; m < 4; ++m) _Pragma("unroll") for (int k = 0; k < 2; ++k) dst[m][k] = *(const PG8_LAS bf16x8*)(lds + PG8_SA(b, h) + aoff + m * 2048 + k * 1024); } while (0)
#define PG8_LDB(dst, b, h) do { _Pragma("unroll") for (int n = 0; n < 2; ++n) _Pragma("unroll") for (int k = 0; k < 2; ++k) dst[n][k] = *(const PG8_LAS bf16x8*)(lds + PG8_SB(b, h) + boff + n * 2048 + k * 1024); } while (0)
#define PG8_MMA(ai, bj, At, Bt) do { __builtin_amdgcn_s_setprio(1); _Pragma("unroll") for (int m = 0; m < 4; ++m) _Pragma("unroll") for (int n = 0; n < 2; ++n) _Pragma("unroll") for (int k = 0; k < 2; ++k) \
        acc[ai][bj][m][n] = __builtin_amdgcn_mfma_f32_16x16x32_bf16(Bt[n][k], At[m][k], acc[ai][bj][m][n], 0, 0, 0); __builtin_amdgcn_s_setprio(0); } while (0)
#define PG8_WAIT_V(n) asm volatile("s_waitcnt vmcnt(" #n ")" ::: "memory")
#define PG8_WAIT_L(n) asm volatile("s_waitcnt lgkmcnt(" #n ")" ::: "memory")
#define PG8_BAR __builtin_amdgcn_s_barrier()
#define PG8_SCHED __builtin_amdgcn_sched_barrier(0)
    Unit cur, nxt; int ui = 0;
    if (!S.next(0, cur)) return;
    if constexpr (GATHER) {
#pragma unroll
        for (int i = 0; i < 2; ++i) { offA[0][i] = S.a_rowoff(cur, RA[i]) + (unsigned)(CA[i] * 2); offA[1][i] = S.a_rowoff(cur, RA[i] + HALF) + (unsigned)(CA[i] * 2); }
    }
    f32x4 acc[2][2][4][2];
#pragma unroll
    for (int a = 0; a < 2; ++a)
#pragma unroll
        for (int b = 0; b < 2; ++b)
#pragma unroll
            for (int m = 0; m < 4; ++m)
#pragma unroll
                for (int n = 0; n < 2; ++n) acc[a][b][m][n] = (f32x4){0.f, 0.f, 0.f, 0.f};
    bf16x8 At[4][2], B0[2][2], B1[2][2];
    const char* cA = S.a_base(cur); const char* cB = S.b_base(cur);
    PG8_STAGE(PG8_SB(0, 0), cB, voffB); PG8_STAGE(PG8_SB(0, 1), cB + hstepB, voffB); PG8_STAGE(PG8_SA(0, 0), cA, offA[0]); PG8_STAGE(PG8_SA(0, 1), cA, offA[1]);
    if (wr == 1) PG8_BAR;
    PG8_WAIT_V(2); PG8_BAR;
    PG8_STAGE(PG8_SB(1, 0), cB + kstep, voffB); PG8_STAGE(PG8_SA(1, 0), cA + kstep, offA[0]); PG8_STAGE(PG8_SB(1, 1), cB + hstepB + kstep, voffB);
    PG8_WAIT_V(6); PG8_BAR;
    for (;;) {
        const bool has_next = S.next(ui + 1, nxt);
        const char* nA = has_next ? S.a_base(nxt) : cA; const char* nB = has_next ? S.b_base(nxt) : cB;
        if constexpr (GATHER) {
            if (has_next) {
#pragma unroll
                for (int i = 0; i < 2; ++i) { noffA[0][i] = S.a_rowoff(nxt, RA[i]) + (unsigned)(CA[i] * 2); noffA[1][i] = S.a_rowoff(nxt, RA[i] + HALF) + (unsigned)(CA[i] * 2); }
            } else {
#pragma unroll
                for (int i = 0; i < 2; ++i) { noffA[0][i] = offA[0][i]; noffA[1][i] = offA[1][i]; }
            }
        }
        for (int t = 0; t < nt; t += 2) {
            const bool last = (t == nt - 2);
            const char* a1 = cA + (size_t)(t + 1) * kstep;
            const char* a2 = last ? nA : cA + (size_t)(t + 2) * kstep; const char* b2 = last ? nB : cB + (size_t)(t + 2) * kstep;
            const char* a3 = a2 + kstep; const char* b3 = b2 + kstep;
            unsigned o2[2][2];
#pragma unroll
            for (int h = 0; h < 2; ++h)
#pragma unroll
                for (int i = 0; i < 2; ++i) o2[h][i] = GATHER ? (last ? noffA[h][i] : offA[h][i]) : offA[h][i];
            PG8_LDB(B0, 0, 0); PG8_LDB(B1, 0, 1); PG8_SCHED; PG8_LDA(At, 0, 0); PG8_STAGE(PG8_SA(1, 1), a1, offA[1]);
            PG8_WAIT_V(8); PG8_WAIT_L(0); PG8_BAR; PG8_MMA(0, 0, At, B0); PG8_MMA(0, 1, At, B1); PG8_BAR; PG8_SCHED;
            PG8_LDA(At, 0, 1); PG8_STAGE(PG8_SB(0, 0), b2, voffB); PG8_STAGE(PG8_SB(0, 1), b2 + hstepB, voffB); PG8_STAGE(PG8_SA(0, 0), a2, o2[0]);
            PG8_WAIT_V(8); PG8_WAIT_L(0); PG8_BAR; PG8_MMA(1, 0, At, B0); PG8_MMA(1, 1, At, B1); PG8_BAR; PG8_SCHED;
            PG8_LDB(B0, 1, 0); PG8_LDB(B1, 1, 1); PG8_SCHED; PG8_LDA(At, 1, 0); PG8_STAGE(PG8_SA(0, 1), a2, o2[1]);
            PG8_WAIT_V(8); PG8_WAIT_L(0); PG8_BAR; PG8_MMA(0, 0, At, B0); PG8_MMA(0, 1, At, B1); PG8_BAR; PG8_SCHED;
            PG8_LDA(At, 1, 1); PG8_STAGE(PG8_SB(1, 0), b3, voffB); PG8_STAGE(PG8_SB(1, 1), b3 + hstepB, voffB); PG8_STAGE(PG8_SA(1, 0), a3, o2[0]);
            PG8_WAIT_V(8); PG8_WAIT_L(0); PG8_BAR; PG8_MMA(1, 0, At, B0); PG8_MMA(1, 1, At, B1); PG8_BAR; PG8_SCHED;
        }
        if (wr == 0) PG8_BAR;
        { int l2_ = lane; asm volatile("" : "+v"(l2_)); E(acc, cur, wr, wc, l2_ & 15, l2_ >> 4); }
        if (!has_next) break;
#pragma unroll
        for (int a = 0; a < 2; ++a)
#pragma unroll
            for (int b = 0; b < 2; ++b)
#pragma unroll
                for (int m = 0; m < 4; ++m)
#pragma unroll
                    for (int n = 0; n < 2; ++n) acc[a][b][m][n] = (f32x4){0.f, 0.f, 0.f, 0.f};
        cur = nxt; cA = nA; cB = nB; ++ui;
        if constexpr (GATHER) {
#pragma unroll
            for (int h = 0; h < 2; ++h)
#pragma unroll
                for (int i = 0; i < 2; ++i) offA[h][i] = noffA[h][i];
        }
        if (wr == 1) PG8_BAR;
    }
    PG8_WAIT_V(0);
    PG8_BAR;
#undef PG8_SA
#undef PG8_SB
#undef PG8_STAGE
#undef PG8_LDA
#undef PG8_LDB
#undef PG8_MMA
#undef PG8_WAIT_V
#undef PG8_WAIT_L
#undef PG8_BAR
#undef PG8_SCHED
}
}

#define GAS __attribute__((address_space(1)))
#define LAS __attribute__((address_space(3)))
typedef unsigned short bf16;
typedef unsigned v4u __attribute__((ext_vector_type(4)));
typedef unsigned v2u __attribute__((ext_vector_type(2)));
typedef float f32x4 __attribute__((ext_vector_type(4)));
typedef float f32x2 __attribute__((ext_vector_type(2)));
typedef float f32x16 __attribute__((ext_vector_type(16)));
typedef short bf16x8 __attribute__((ext_vector_type(8)));
typedef short s16x4 __attribute__((ext_vector_type(4)));
typedef GAS unsigned gu32;
#define RLX_AGENT __ATOMIC_RELAXED, __HIP_MEMORY_SCOPE_AGENT
#define LDS_WAIT() asm volatile("s_waitcnt lgkmcnt(0)" ::: "memory")
#define VM_WAIT() asm volatile("s_waitcnt vmcnt(0)" ::: "memory")
__device__ __forceinline__ unsigned f2bf(float f) { unsigned u = __builtin_bit_cast(unsigned, f); return (u + 0x7fffu + ((u >> 16) & 1u)) >> 16; }
__device__ __forceinline__ unsigned pk2(float lo, float hi) { return f2bf(lo) | (f2bf(hi) << 16); }
__device__ __forceinline__ float bf_lo(unsigned w) { return __builtin_bit_cast(float, w << 16); }
__device__ __forceinline__ float bf_hi(unsigned w) { return __builtin_bit_cast(float, w & 0xffff0000u); }
__device__ __forceinline__ float wave_sum(float v) {
#pragma unroll
    for (int o = 1; o < 64; o <<= 1) v += __shfl_xor(v, o);
    return v;
}

#define XB_TMO      128
#define XB_XCNT(j)  (256  + 64 * (j))
#define XB_XSUB(j)  (1280 + 64 * (j))
#define XB_XGEN(j)  (2304 + 64 * (j))
#define XB_TOP      3328
#define XB_TOPGEN   3392
#define XCD_BAR_WORDS 3456
#define XB_SPIN_CAP (1u << 18)
__device__ __forceinline__ unsigned xb_ld(unsigned* p)              { return __hip_atomic_load(p, __ATOMIC_RELAXED, __HIP_MEMORY_SCOPE_AGENT); }
__device__ __forceinline__ unsigned xb_add(unsigned* p, unsigned v) { return __hip_atomic_fetch_add(p, v, __ATOMIC_RELAXED, __HIP_MEMORY_SCOPE_AGENT); }
__device__ __forceinline__ unsigned xb_xcc_id() { return (unsigned)__builtin_amdgcn_s_getreg((3 << 11) | 20) & 0xFu; }
#define XB_SPIN(cond, bar) do { unsigned _sp = 0; while (cond) { __builtin_amdgcn_s_sleep(1); \
    if ((++_sp & 255u) == 0u) { if (xb_ld(&(bar)[XB_TMO])) break; if (_sp > XB_SPIN_CAP) { atomicAdd(&(bar)[XB_TMO], 1u); break; } } } } while (0)
struct XcdBarrier { unsigned* bar; unsigned x; volatile LAS unsigned* st; };
__device__ __forceinline__ XcdBarrier xcd_barrier_post(unsigned* bar, volatile LAS unsigned* st) {
    XcdBarrier b; b.bar = bar; b.x = xb_xcc_id(); b.st = st;
    if (threadIdx.x == 0) (void)xb_add(&bar[XB_XCNT(b.x)], 1u);
    return b;
}
__device__ __forceinline__ void xcd_barrier_complete(unsigned* bar, unsigned x, unsigned& nloc, unsigned& nx) {
    const unsigned G = gridDim.x * gridDim.y * gridDim.z;
    unsigned sum, cnt, mine, sp = 0u;
    for (;;) {
        sum = 0u; cnt = 0u; mine = 0u;
#pragma unroll
        for (unsigned j = 0; j < 16; ++j) { const unsigned c = xb_ld(&bar[XB_XCNT(j)]); sum += c; cnt += (c > 0u) ? 1u : 0u; mine = (j == x) ? c : mine; }
        if (sum == G) break;
        __builtin_amdgcn_s_sleep(1);
        if ((++sp & 255u) == 0u) { if (xb_ld(&bar[XB_TMO])) break; if (sp > XB_SPIN_CAP) { atomicAdd(&bar[XB_TMO], 1u); break; } }
    }
    nloc = mine > 0u ? mine : 1u; nx = cnt > 0u ? cnt : 1u;
}
__device__ __forceinline__ void xcd_barrier(const XcdBarrier& b) {
    asm volatile("s_waitcnt vmcnt(0)" ::: "memory");
    __syncthreads();
    if (threadIdx.x == 0) {
        unsigned* bar = b.bar;
        __builtin_amdgcn_s_waitcnt(0);
        unsigned nloc = b.st[0], nx = b.st[1];
        if (nloc == 0u) { xcd_barrier_complete(bar, b.x, nloc, nx); b.st[0] = nloc; b.st[1] = nx; }
        const unsigned old = xb_add(&bar[XB_XSUB(b.x)], 1u);
        const unsigned gen = old / nloc;
        if (old + 1u == (gen + 1u) * nloc) {
            __builtin_amdgcn_fence(__ATOMIC_RELEASE, "agent");
            asm volatile("s_waitcnt vmcnt(0)" ::: "memory");
            const unsigned og = xb_add(&bar[XB_TOP], 1u);
            const unsigned tg = og / nx;
            if (og + 1u == (tg + 1u) * nx) xb_add(&bar[XB_TOPGEN], 1u);
            else XB_SPIN(xb_ld(&bar[XB_TOPGEN]) == tg, bar);
            __builtin_amdgcn_fence(__ATOMIC_ACQUIRE, "agent");
            xb_add(&bar[XB_XGEN(b.x)], 1u);
            asm volatile("s_waitcnt vmcnt(0)" ::: "memory");
        } else {
            XB_SPIN(xb_ld(&bar[XB_XGEN(b.x)]) == gen, bar);
            __builtin_amdgcn_fence(__ATOMIC_ACQUIRE, "agent");
            asm volatile("s_waitcnt vmcnt(0)" ::: "memory");
        }
    }
    __syncthreads();
}
namespace mk {
constexpr int D = 1024, NB = 8, SEQ = 2048, CT = 256, NCTX = NB * CT, NLAT = NB * SEQ, NTOK = NCTX + NLAT;
constexpr int NE = 32, LCAP = NTOK;
constexpr int NWAVES = 8, NTHR = 512;
#ifndef MK_WRITE_XS_ALWAYS
#define MK_WRITE_XS_ALWAYS 0
#endif
constexpr bool WRITE_XS_ALWAYS = MK_WRITE_XS_ALWAYS != 0;
constexpr int MAXT = NTOK * 4 / 256 + NE;
constexpr int HB_ROWS = MAXT * 256;

constexpr size_t MiB = 1u << 20;
constexpr size_t al(size_t x) { return (x + MiB - 1) / MiB * MiB; }
constexpr size_t WS_CTL = 0, CTL_ZERO_BYTES = 1 * MiB;
constexpr size_t WS_MOD = WS_CTL + CTL_ZERO_BYTES;
constexpr size_t WS_TAB = WS_MOD + al(2 * 9 * 6144 * 4);
constexpr size_t WS_WIN0 = WS_TAB + MiB;
constexpr size_t WS_WOUT0 = WS_WIN0 + al((size_t)3072 * 1024 * 2);
constexpr size_t WS_WIN1 = WS_WOUT0 + al((size_t)1024 * 1024 * 2);
constexpr size_t WS_WOUT1 = WS_WIN1 + al((size_t)2048 * 1024 * 2);
constexpr size_t WS_WGATE = WS_WOUT1 + al((size_t)1024 * 1024 * 2);
constexpr size_t WS_W1 = WS_WGATE + al((size_t)16 * 256 * 256 * 2);
constexpr size_t WS_W2 = WS_W1 + al((size_t)2 * 32 * 2048 * 1024 * 2);
constexpr size_t WS_XS = WS_W2 + al((size_t)2 * 32 * 1024 * 1024 * 2);
constexpr size_t WS_XN = WS_XS + al((size_t)NTOK * D * 4);
constexpr size_t WS_PROJ = WS_XN + al((size_t)NTOK * D * 2);
constexpr size_t WS_CAT = WS_PROJ + al((size_t)NTOK * 3072 * 2);
constexpr size_t WS_ROUTE = WS_CAT + al((size_t)NTOK * D * 2);
constexpr size_t RT_EIDX = 0, RT_EGATE = (size_t)NTOK * 16, RT_EPOS = 2 * (size_t)NTOK * 16, RT_LIST = 3 * (size_t)NTOK * 16;
constexpr size_t WS_HB = WS_ROUTE + al(3 * (size_t)NTOK * 16 + (size_t)NE * LCAP * 4);
constexpr size_t WS_Y2 = WS_HB + al((size_t)HB_ROWS * D * 2);
constexpr size_t WS_END = WS_Y2 + al((size_t)HB_ROWS * D * 2);
constexpr size_t WS_XC = WS_HB;
constexpr size_t WS_AB = WS_XC + al((size_t)2 * NTOK * D * 2);
constexpr size_t WS_SUM = WS_AB + al((size_t)2 * NTOK * D * 4);
static_assert(WS_SUM + (size_t)2 * 288 * 1024 * 8 <= WS_END, "layer-1 mixer overlay");
constexpr int CW_BAR = 4096;
constexpr int CW_CNT = 65536;
static_assert((CW_CNT + 64 * 64) * 4 <= (int)CTL_ZERO_BYTES && CW_BAR + 8 * XCD_BAR_WORDS <= CW_CNT, "CTL map");

constexpr int RING_OFF = 0, RING_BYTES = 131072;
constexpr int MISC_OFF = RING_BYTES;
constexpr int MISC_BAR = 0;
constexpr int MISC_HIST = 64, MISC_BASE = 64 + 128, MISC_CNT = 64 + 256, MISC_PB = 64 + 384, MISC_NT = 64 + 512;
constexpr int MISC_TAB = 1024;
constexpr int MISC_REC = 4096;
constexpr int LDS_BYTES = 147456;
static_assert(MISC_TAB + MAXT * 4 <= MISC_REC && MISC_OFF + MISC_REC + 8192 <= LDS_BYTES, "LDS map");

struct Args { const float* in[32]; float* out; unsigned char* ws; int ph_lo, ph_hi, li, pad; };

struct Frame {
    LAS unsigned char* lds; LAS unsigned char* misc; gu32* ctl;
    int wave, vcu, G;
    unsigned char* ws;
};

__device__ __forceinline__ int tid_now() { int t = threadIdx.x; asm volatile("" : "+v"(t)); return t; }
__device__ __forceinline__ int lane_now() { return tid_now() & 63; }
__device__ __forceinline__ int row_modrow(int r) { return r < NCTX ? 8 : (r - NCTX) >> 11; }

__device__ __forceinline__ void transpose_item(const float* W, int N, int k0, int n0, bf16* dst, int ldd, LAS float* scr, int lane) {
#pragma unroll 8
    for (int i = 0; i < 32; ++i) { const int kk = 2 * i + (lane >> 5); scr[kk * 33 + (lane & 31)] = W[(size_t)(k0 + kk) * N + n0 + (lane & 31)]; }
    LDS_WAIT(); asm volatile("" ::: "memory");
    const int c = lane & 7;
#pragma unroll
    for (int j = 0; j < 4; ++j) { const int n = (lane >> 3) + 8 * j; const LAS float* s = scr + (8 * c) * 33 + n;
        v4u o; o.x = pk2(s[0 * 33], s[1 * 33]); o.y = pk2(s[2 * 33], s[3 * 33]); o.z = pk2(s[4 * 33], s[5 * 33]); o.w = pk2(s[6 * 33], s[7 * 33]);
        *(GAS v4u*)(dst + (size_t)n * ldd + 8 * c) = o; }
    LDS_WAIT(); asm volatile("" ::: "memory");
}
__device__ __forceinline__ void p0_moe_weights(Frame& F, const float* w1, const float* w2, int layer) {
    LAS float* scr = (LAS float*)(F.lds + RING_OFF + F.wave * 16384);
    const int gw = F.vcu * NWAVES + F.wave, NGW = F.G * NWAVES;
    bf16* WT1 = (bf16*)(F.ws + WS_W1) + (size_t)layer * 32 * 2048 * 1024; bf16* WT2 = (bf16*)(F.ws + WS_W2) + (size_t)layer * 32 * 1024 * 1024;
    const float* s1 = w1 + (size_t)layer * 32 * 1024 * 2048; const float* s2 = w2 + (size_t)layer * 32 * 1024 * 1024;
    constexpr int I1 = 16 * 64, I2 = 16 * 32, IT = 32 * (I1 + I2);
    for (int it = gw; it < IT; it += NGW) {
        const int e = it / (I1 + I2); int r = it % (I1 + I2);
        if (r < I1) { const int kb = r / 64, nb = r % 64, n0 = nb * 32; const int nn = n0 & 1023, drow = 256 * (nn >> 7) + (n0 >= 1024 ? 128 : 0) + (nn & 127);
            transpose_item(s1 + (size_t)e * 1024 * 2048, 2048, kb * 64, n0, WT1 + (size_t)e * 2048 * 1024 + (size_t)drow * 1024 + kb * 64, 1024, scr, lane_now()); }
        else { r -= I1; const int kb = r / 32, nb = r % 32;
            transpose_item(s2 + (size_t)e * 1024 * 1024, 1024, kb * 64, nb * 32, WT2 + (size_t)e * 1024 * 1024 + (size_t)(nb * 32) * 1024 + kb * 64, 1024, scr, lane_now()); }
    }
}

__device__ __forceinline__ void moe_table(Frame& F, int layer) {
    LAS int* cntl = (LAS int*)(F.misc + MISC_CNT); LAS int* pb = (LAS int*)(F.misc + MISC_PB); LAS int* tab = (LAS int*)(F.misc + MISC_TAB); LAS int* ntl = (LAS int*)(F.misc + MISC_NT);
    if (tid_now() < 32) cntl[tid_now()] = (int)__hip_atomic_load(F.ctl + CW_CNT + (layer * 32 + tid_now()) * 64, RLX_AGENT);
    __syncthreads();
    if (tid_now() == 0) { int t = 0; for (int e = 0; e < 32; ++e) { pb[e] = t; const int n = (cntl[e] + 255) >> 8; for (int j = 0; j < n; ++j) tab[t + j] = (e << 16) | j; t += n; } ntl[0] = t; }
    __syncthreads();
}

struct MoeSched1 {
    pg8::TileOrder ord; LAS const int* tab; LAS const int* cntl; const char* XN; const char* W; const int* list; int a_pitch;
    __device__ __forceinline__ bool next(int i, pg8::Unit& u) const { return ord.tile(i, u); }
    __device__ __forceinline__ const char* a_base(const pg8::Unit&) const { return XN; }
    __device__ __forceinline__ const char* b_base(const pg8::Unit& u) const { const int e = tab[u.pm] >> 16; return W + ((size_t)e * 2048 + (size_t)u.pn * 256) * 2048; }
    __device__ __forceinline__ unsigned a_rowoff(const pg8::Unit& u, int r) const { const int te = tab[u.pm], e = te >> 16, j = te & 0xffff; int lr = j * 256 + r; const int n = cntl[e]; lr = lr < n ? lr : n - 1;
        return (unsigned)list[(size_t)e * LCAP + lr] * 2048u; }
};
struct MoeSched2 {
    pg8::TileOrder ord; LAS const int* tab; const char* HB; const char* W; int a_pitch;
    __device__ __forceinline__ bool next(int i, pg8::Unit& u) const { return ord.tile(i, u); }
    __device__ __forceinline__ const char* a_base(const pg8::Unit& u) const { return HB + (size_t)u.pm * 256 * 2048; }
    __device__ __forceinline__ const char* b_base(const pg8::Unit& u) const { const int e = tab[u.pm] >> 16; return W + ((size_t)e * 1024 + (size_t)u.pn * 256) * 2048; }
    __device__ __forceinline__ unsigned a_rowoff(const pg8::Unit&, int) const { return 0u; }
};
struct EpiSwiglu {
    static constexpr bool PERM = true;
    bf16* HB; const float* b1; LAS const int* tab;
    __device__ __forceinline__ void operator()(const pg8::f32x4 (&acc)[2][2][4][2], const pg8::Unit& u, int wr, int wc, int fr, int fq) const {
        const int e = tab[u.pm] >> 16; const float* bb = b1 + (size_t)e * 2048 + u.pn * 128 + wc * 32 + 8 * fq;
        pg8::f32x4 bg[2], bl[2];
#pragma unroll
        for (int n = 0; n < 2; ++n) { bg[n] = *(const pg8::f32x4*)(bb + 4 * n); bl[n] = *(const pg8::f32x4*)(bb + 1024 + 4 * n); }
#pragma unroll
        for (int ai = 0; ai < 2; ++ai)
#pragma unroll
            for (int m = 0; m < 4; ++m) { const size_t row = (size_t)u.pm * 256 + ai * 128 + wr * 64 + m * 16 + fr; float o[8];
#pragma unroll
                for (int n = 0; n < 2; ++n)
#pragma unroll
                    for (int i = 0; i < 4; ++i) { float g = acc[ai][0][m][n][i] + bg[n][i], l = acc[ai][1][m][n][i] + bl[n][i];
                        g = fminf(g, 7.f); l = fminf(fmaxf(l, -7.f), 7.f);
                        const float sg = __builtin_amdgcn_rcpf(1.f + __builtin_amdgcn_exp2f(-1.702f * 1.4426950408889634f * g)); o[n * 4 + i] = g * sg * (l + 1.f); }
                pg8::u32x4 w; w.x = pg8::cvt_pk_bf16(o[0], o[1]); w.y = pg8::cvt_pk_bf16(o[2], o[3]); w.z = pg8::cvt_pk_bf16(o[4], o[5]); w.w = pg8::cvt_pk_bf16(o[6], o[7]);
                *(pg8::u32x4*)(HB + row * 1024 + u.pn * 128 + wc * 32 + 8 * fq) = w; }
    }
};
struct EpiBias2 {
    static constexpr bool PERM = true;
    bf16* Y2; const float* b2; LAS const int* tab;
    __device__ __forceinline__ void operator()(const pg8::f32x4 (&acc)[2][2][4][2], const pg8::Unit& u, int wr, int wc, int fr, int fq) const {
        const int e = tab[u.pm] >> 16; const int col0 = u.pn * 256 + wc * 32 + 8 * fq; const float* bb = b2 + (size_t)e * 1024 + col0;
        pg8::f32x4 bv[2][2];
#pragma unroll
        for (int bj = 0; bj < 2; ++bj)
#pragma unroll
            for (int n = 0; n < 2; ++n) bv[bj][n] = *(const pg8::f32x4*)(bb + bj * 128 + 4 * n);
#pragma unroll
        for (int ai = 0; ai < 2; ++ai)
#pragma unroll
            for (int m = 0; m < 4; ++m) { bf16* rowp = Y2 + ((size_t)u.pm * 256 + ai * 128 + wr * 64 + m * 16 + fr) * 1024 + col0;
#pragma unroll
                for (int bj = 0; bj < 2; ++bj) { const pg8::f32x4 v0 = acc[ai][bj][m][0] + bv[bj][0], v1 = acc[ai][bj][m][1] + bv[bj][1];
                    pg8::u32x4 w; w.x = pg8::cvt_pk_bf16(v0[0], v0[1]); w.y = pg8::cvt_pk_bf16(v0[2], v0[3]); w.z = pg8::cvt_pk_bf16(v1[0], v1[1]); w.w = pg8::cvt_pk_bf16(v1[2], v1[3]);
                    *(pg8::u32x4*)(rowp + bj * 128) = w; } }
    }
};

__device__ __forceinline__ void phase_router(Frame& F, int layer, int row0, int nrows, const float* gnorm, const float* wr, const float* br) {
    const float* XS = (const float*)(F.ws + WS_XS); bf16* XN = (bf16*)(F.ws + WS_XN); const float* MODL = (const float*)(F.ws + WS_MOD) + (size_t)layer * 9 * 6144;
    int* eidx = (int*)(F.ws + WS_ROUTE + RT_EIDX); float* egate = (float*)(F.ws + WS_ROUTE + RT_EGATE); int* epos = (int*)(F.ws + WS_ROUTE + RT_EPOS); int* list = (int*)(F.ws + WS_ROUTE + RT_LIST);
    LAS int* hist = (LAS int*)(F.misc + MISC_HIST); LAS int* base = (LAS int*)(F.misc + MISC_BASE); LAS int* rec = (LAS int*)(F.misc + MISC_REC);
    int tid_ = tid_now(); asm volatile("" : "+v"(tid_));
    for (int idx = tid_; idx < 1024 * 8; idx += NTHR) { const int k = idx >> 3, c = idx & 7; const f32x4 v = *(const GAS f32x4*)(wr + (size_t)k * 32 + c * 4);
        *(LAS f32x4*)(F.lds + RING_OFF + k * 128 + ((c ^ ((k >> 1) & 7)) << 4)) = v; }
    if (tid_now() < 32) hist[tid_now()] = 0;
    __syncthreads();
    int lane_ = lane_now(); asm volatile("" : "+v"(lane_)); const int lane = lane_;
    const int nloc = (nrows - F.vcu + F.G - 1) / F.G;
    for (int i = F.wave; i < nloc; i += NWAVES) {
        const int r = row0 + i * F.G + F.vcu; const float* x = XS + (size_t)r * D; const float* m = MODL + (size_t)row_modrow(r) * 6144;
        float h[16]; float ss = 0.f;
#pragma unroll
        for (int j = 0; j < 16; ++j) { h[j] = x[64 * j + lane]; ss += h[j] * h[j]; }
        const float rstd = rsqrtf(wave_sum(ss) * (1.f / D) + 1e-6f);
#pragma unroll
        for (int j = 0; j < 16; ++j) { const int k = 64 * j + lane; h[j] = h[j] * rstd * gnorm[k] * (1.f + m[4 * D + k]) + m[3 * D + k]; XN[(size_t)r * D + k] = (bf16)f2bf(h[j]); if ((j & 3) == 3) asm volatile("" ::: "memory"); }
        float acc[32];
#pragma unroll
        for (int e = 0; e < 32; ++e) acc[e] = 0.f;
        const int sw = (lane >> 1) & 7;
#pragma unroll
        for (int j = 0; j < 16; ++j) { const LAS unsigned char* rowp = F.lds + RING_OFF + (64 * j + lane) * 128;
#pragma unroll
            for (int c = 0; c < 8; ++c) { const f32x4 w = *(const LAS f32x4*)(rowp + ((c ^ sw) << 4));
                acc[4 * c + 0] += h[j] * w[0]; acc[4 * c + 1] += h[j] * w[1]; acc[4 * c + 2] += h[j] * w[2]; acc[4 * c + 3] += h[j] * w[3]; }
            asm volatile("" ::: "memory"); }
#define BFLY(A, B, MSK, UP) do { const float s_ = (UP) ? (A) : (B); const float k_ = (UP) ? (B) : (A); (A) = k_ + __shfl_xor(s_, MSK); } while (0)
        { const bool up = (lane & 32) != 0; BFLY(acc[0], acc[16], 32, up); BFLY(acc[1], acc[17], 32, up); BFLY(acc[2], acc[18], 32, up); BFLY(acc[3], acc[19], 32, up); BFLY(acc[4], acc[20], 32, up); BFLY(acc[5], acc[21], 32, up); BFLY(acc[6], acc[22], 32, up); BFLY(acc[7], acc[23], 32, up); BFLY(acc[8], acc[24], 32, up); BFLY(acc[9], acc[25], 32, up); BFLY(acc[10], acc[26], 32, up); BFLY(acc[11], acc[27], 32, up); BFLY(acc[12], acc[28], 32, up); BFLY(acc[13], acc[29], 32, up); BFLY(acc[14], acc[30], 32, up); BFLY(acc[15], acc[31], 32, up); }
        { const bool up = (lane & 16) != 0; BFLY(acc[0], acc[8], 16, up); BFLY(acc[1], acc[9], 16, up); BFLY(acc[2], acc[10], 16, up); BFLY(acc[3], acc[11], 16, up); BFLY(acc[4], acc[12], 16, up); BFLY(acc[5], acc[13], 16, up); BFLY(acc[6], acc[14], 16, up); BFLY(acc[7], acc[15], 16, up); }
        { const bool up = (lane & 8) != 0; BFLY(acc[0], acc[4], 8, up); BFLY(acc[1], acc[5], 8, up); BFLY(acc[2], acc[6], 8, up); BFLY(acc[3], acc[7], 8, up); }
        { const bool up = (lane & 4) != 0; BFLY(acc[0], acc[2], 4, up); BFLY(acc[1], acc[3], 4, up); }
        { const bool up = (lane & 2) != 0; BFLY(acc[0], acc[1], 2, up); }
#undef BFLY
        float v = acc[0] + __shfl_xor(acc[0], 1); const int me = lane >> 1; v += br[me];
        float tv[4]; int te[4]; float cur = v;
#pragma unroll
        for (int k = 0; k < 4; ++k) { float mx = cur;
#pragma unroll
            for (int o = 1; o < 64; o <<= 1) mx = fmaxf(mx, __shfl_xor(mx, o));
            const unsigned long long bal = __ballot(cur == mx); const int wl = __builtin_ctzll(bal); te[k] = wl >> 1; tv[k] = mx; if (me == te[k]) cur = -3.0e38f; }
        float p[4], ps = 0.f;
#pragma unroll
        for (int k = 0; k < 4; ++k) { p[k] = __expf(tv[k] - tv[0]); ps += p[k]; }
        const float inv = 1.f / ps;
        if (lane < 4) { const int e = lane == 0 ? te[0] : lane == 1 ? te[1] : lane == 2 ? te[2] : te[3]; const float g = (lane == 0 ? p[0] : lane == 1 ? p[1] : lane == 2 ? p[2] : p[3]) * inv;
            const int pl = __hip_atomic_fetch_add(hist + e, 1, __ATOMIC_RELAXED, __HIP_MEMORY_SCOPE_WORKGROUP);
            eidx[r * 4 + lane] = e; egate[r * 4 + lane] = g; rec[(i * 4 + lane) * 2] = e; rec[(i * 4 + lane) * 2 + 1] = pl; }
    }
    __syncthreads();
    if (tid_now() < 32) base[tid_now()] = (int)__hip_atomic_fetch_add(F.ctl + CW_CNT + (layer * 32 + tid_now()) * 64, (unsigned)hist[tid_now()], RLX_AGENT);
    __syncthreads();
    for (int q = tid_now(); q < nloc * 4; q += NTHR) { const int i = q >> 2, k = q & 3; const int r = row0 + i * F.G + F.vcu; const int e = rec[q * 2], pos = base[e] + rec[q * 2 + 1];
        epos[r * 4 + k] = pos; list[(size_t)e * LCAP + pos] = r; }
}

__device__ __forceinline__ void phase_combine(Frame& F, int layer, int row0, int nrows, int mode, const float* gnext, const float* MODN, float* out) {
    float* XS = (float*)(F.ws + WS_XS); bf16* XN = (bf16*)(F.ws + WS_XN); const bf16* Y2 = (const bf16*)(F.ws + WS_Y2); const float* MODL = (const float*)(F.ws + WS_MOD) + (size_t)layer * 9 * 6144;
    const int* eidx = (const int*)(F.ws + WS_ROUTE + RT_EIDX); const float* egate = (const float*)(F.ws + WS_ROUTE + RT_EGATE); const int* epos = (const int*)(F.ws + WS_ROUTE + RT_EPOS);
    LAS const int* pb = (LAS const int*)(F.misc + MISC_PB);
    int lane_ = lane_now(); asm volatile("" : "+v"(lane_)); const int lane = lane_; const int nloc = (nrows - F.vcu + F.G - 1) / F.G;
    for (int i = F.wave; i < nloc; i += NWAVES) {
        const int r = row0 + i * F.G + F.vcu; const float* g2 = MODL + (size_t)row_modrow(r) * 6144 + 5 * D;
        f32x4 a[2][2];
#pragma unroll
        for (int h = 0; h < 2; ++h) { a[h][0] = (f32x4){0.f, 0.f, 0.f, 0.f}; a[h][1] = a[h][0]; }
#pragma unroll
        for (int k = 0; k < 4; ++k) { const int e = eidx[r * 4 + k]; const float p = egate[r * 4 + k]; const size_t slot = (size_t)pb[e] * 256 + epos[r * 4 + k]; const bf16* y = Y2 + slot * D;
#pragma unroll
            for (int h = 0; h < 2; ++h) { const v4u w = *(const GAS v4u*)(y + 512 * h + 8 * lane);
                a[h][0] += p * (f32x4){bf_lo(w.x), bf_hi(w.x), bf_lo(w.y), bf_hi(w.y)}; a[h][1] += p * (f32x4){bf_lo(w.z), bf_hi(w.z), bf_lo(w.w), bf_hi(w.w)}; } }
        float ss = 0.f; f32x4 xv[2][2];
#pragma unroll
        for (int h = 0; h < 2; ++h)
#pragma unroll
            for (int q = 0; q < 2; ++q) { const int c = 512 * h + 8 * lane + 4 * q; const f32x4 xo = *(const GAS f32x4*)(XS + (size_t)r * D + c); const f32x4 gg = *(const GAS f32x4*)(g2 + c);
                const f32x4 xn = xo + gg * a[h][q]; xv[h][q] = xn; if (mode == 0 || WRITE_XS_ALWAYS) *(GAS f32x4*)(XS + (size_t)r * D + c) = xn; ss += (xn[0] * xn[0] + xn[1] * xn[1]) + (xn[2] * xn[2] + xn[3] * xn[3]); }
        const float rstd = rsqrtf(wave_sum(ss) * (1.f / D) + 1e-6f);
        if (mode == 0) { const float* m = MODN + (size_t)row_modrow(r) * 6144;
#pragma unroll
            for (int h = 0; h < 2; ++h) { float o[8];
#pragma unroll
                for (int q = 0; q < 2; ++q) { const int c = 512 * h + 8 * lane + 4 * q; const f32x4 gn = *(const GAS f32x4*)(gnext + c), sc = *(const GAS f32x4*)(m + D + c), sh = *(const GAS f32x4*)(m + c);
                    const f32x4 y = xv[h][q] * rstd * gn * (1.f + sc) + sh; o[4 * q] = y[0]; o[4 * q + 1] = y[1]; o[4 * q + 2] = y[2]; o[4 * q + 3] = y[3]; }
                v4u w; w.x = pk2(o[0], o[1]); w.y = pk2(o[2], o[3]); w.z = pk2(o[4], o[5]); w.w = pk2(o[6], o[7]);
                *(GAS v4u*)(XN + (size_t)r * D + 512 * h + 8 * lane) = w; }
        } else {
#pragma unroll
            for (int h = 0; h < 2; ++h)
#pragma unroll
                for (int q = 0; q < 2; ++q) { const int c = 512 * h + 8 * lane + 4 * q; const f32x4 gn = *(const GAS f32x4*)(gnext + c);
                    *(GAS f32x4*)(out + (size_t)(r - NCTX) * D + c) = xv[h][q] * rstd * gn; }
        }
    }
}
}
namespace mk {
__device__ __forceinline__ void p0_dense_weight(Frame& F, const float* W, int K, int N, bf16* WT, int rot) {
    LAS float* scr = (LAS float*)(F.lds + RING_OFF + F.wave * 16384);
    const int NGW = F.G * NWAVES; const int gw = (F.vcu * NWAVES + F.wave + rot) % NGW;
    const int nb = N / 32, items = (K / 64) * nb;
    for (int it = gw; it < items; it += NGW) { const int kb = it / nb, n0 = (it % nb) * 32; transpose_item(W, N, kb * 64, n0, WT + (size_t)n0 * K + kb * 64, K, scr, lane_now()); }
}
__device__ __forceinline__ void p0_gate_weights(Frame& F, const float* ga, const float* gx, int rot) {
    LAS float* scr = (LAS float*)(F.lds + RING_OFF + F.wave * 16384);
    const int NGW = F.G * NWAVES; const int gw = (F.vcu * NWAVES + F.wave + rot) % NGW;
    bf16* WG = (bf16*)(F.ws + WS_WGATE);
    for (int it = gw; it < 16 * 32; it += NGW) { const int mat = it >> 5, r = it & 31, kb = r >> 3, nbk = r & 7, n0 = nbk * 32; const int ty = mat & 1, dg = mat >> 1;
        const float* W = (ty ? gx : ga) + (size_t)dg * 65536; const int jt = n0 >> 7, rr = (n0 & 127) + (ty ? 128 : 0);
        transpose_item(W, 256, kb * 64, n0, WG + ((size_t)(dg * 2 + jt) * 256 + rr) * 256 + kb * 64, 256, scr, lane_now()); }
}
__device__ __forceinline__ void p0_adaln(Frame& F, const float* c, const float* cctx, const float* w_mod, const float* b_mod) {
    LAS float* sil = (LAS float*)(F.lds + RING_OFF);
    LAS float* part = (LAS float*)(F.lds + RING_OFF + 40960);
    float* MOD = (float*)(F.ws + WS_MOD);
    if (F.vcu >= 192 && F.G >= 256) return;
    for (int idx = tid_now(); idx < 9 * 1024; idx += NTHR) { const float v = idx < 8192 ? c[idx] : cctx[idx - 8192]; sil[idx] = v / (1.f + __expf(-v)); }
    __syncthreads();
    for (int item = F.vcu; item < 192; item += F.G) {
        const int layer = item / 96, n0 = (item % 96) * 64; const float* w = w_mod + (size_t)layer * 1024 * 6144 + n0 + lane_now(); const int k0 = F.wave * 128;
        float acc[9];
#pragma unroll
        for (int b = 0; b < 9; ++b) acc[b] = 0.f;
        for (int kk = 0; kk < 128; kk += 4) { float wv[4];
#pragma unroll
            for (int j = 0; j < 4; ++j) wv[j] = w[(size_t)(k0 + kk + j) * 6144];
#pragma unroll
            for (int b = 0; b < 9; ++b) { const f32x4 s = *(const LAS f32x4*)(sil + b * 1024 + k0 + kk); acc[b] += s[0] * wv[0] + s[1] * wv[1] + s[2] * wv[2] + s[3] * wv[3]; } }
#pragma unroll
        for (int b = 0; b < 9; ++b) part[(F.wave * 9 + b) * 64 + lane_now()] = acc[b];
        __syncthreads();
        for (int q = tid_now(); q < 9 * 64; q += NTHR) { const int b = q >> 6, l = q & 63; float s = 0.f;
#pragma unroll
            for (int wv = 0; wv < 8; ++wv) s += part[(wv * 9 + b) * 64 + l];
            MOD[((size_t)layer * 9 + b) * 6144 + n0 + l] = s + b_mod[layer * 6144 + n0 + l]; }
        __syncthreads();
    }
}
constexpr int TAB_COS = 0, TAB_SIN = 1024, TAB_SP = 2048, TAB_LAM = 4096;
__device__ __forceinline__ void p0_tables(Frame& F, const float* lq1, const float* lk1, const float* lq2, const float* lk2, const float* lru) {
    if (F.vcu != (F.G > 200 ? 200 : 0)) return;
    float* T = (float*)(F.ws + WS_TAB);
    for (int i = tid_now(); i < 1024; i += NTHR) { const int pos = i >> 4, f = i & 15; const float inv = powf(10000.f, -(float)f / 16.f); const float ang = (float)pos * inv; T[TAB_COS + i] = cosf(ang); T[TAB_SIN + i] = sinf(ang); }
    for (int i = tid_now(); i < 2048; i += NTHR) T[TAB_SP + i] = log1pf(expf(-lru[i]));
    if (tid_now() == 0) { float a = 0.f, b = 0.f; for (int i = 0; i < 64; ++i) { a += lq1[i] * lk1[i]; b += lq2[i] * lk2[i]; } T[TAB_LAM] = expf(a) - expf(b) + 0.2f; }
}

__device__ __forceinline__ void phase_norm1_l0(Frame& F, const float* x, const float* ctx, const float* g) {
    bf16* XN = (bf16*)(F.ws + WS_XN); const float* MODL = (const float*)(F.ws + WS_MOD);
    int lane_ = lane_now(); asm volatile("" : "+v"(lane_)); const int lane = lane_;
    const int gw = F.vcu * NWAVES + F.wave, NGW = F.G * NWAVES;
    for (int r = gw; r < NTOK; r += NGW) {
        const float* src = r < NCTX ? ctx + (size_t)r * D : x + (size_t)(r - NCTX) * D; const float* m = MODL + (size_t)row_modrow(r) * 6144;
        f32x4 v[2][2]; float ss = 0.f;
#pragma unroll
        for (int h = 0; h < 2; ++h)
#pragma unroll
            for (int q = 0; q < 2; ++q) { v[h][q] = *(const GAS f32x4*)(src + 512 * h + 8 * lane + 4 * q); ss += (v[h][q][0] * v[h][q][0] + v[h][q][1] * v[h][q][1]) + (v[h][q][2] * v[h][q][2] + v[h][q][3] * v[h][q][3]); }
        const float rstd = rsqrtf(wave_sum(ss) * (1.f / D) + 1e-6f);
#pragma unroll
        for (int h = 0; h < 2; ++h) { float o[8];
#pragma unroll
            for (int q = 0; q < 2; ++q) { const int c = 512 * h + 8 * lane + 4 * q; const f32x4 gn = *(const GAS f32x4*)(g + c), sc = *(const GAS f32x4*)(m + D + c), sh = *(const GAS f32x4*)(m + c);
                const f32x4 y = v[h][q] * rstd * gn * (1.f + sc) + sh; o[4 * q] = y[0]; o[4 * q + 1] = y[1]; o[4 * q + 2] = y[2]; o[4 * q + 3] = y[3]; }
            v4u w; w.x = pk2(o[0], o[1]); w.y = pk2(o[2], o[3]); w.z = pk2(o[4], o[5]); w.w = pk2(o[6], o[7]);
            *(GAS v4u*)(XN + (size_t)r * D + 512 * h + 8 * lane) = w; }
    }
}

struct DenseSched {
    pg8::TileOrder ord; const char* A; const char* W; int a_pitch; int K2;
    __device__ __forceinline__ bool next(int i, pg8::Unit& u) const { return ord.tile(i, u); }
    __device__ __forceinline__ const char* a_base(const pg8::Unit& u) const { return A + (size_t)u.pm * 256 * a_pitch; }
    __device__ __forceinline__ const char* b_base(const pg8::Unit& u) const { return W + (size_t)u.pn * 256 * K2; }
    __device__ __forceinline__ unsigned a_rowoff(const pg8::Unit&, int) const { return 0u; }
};
constexpr float ATT_C2 = 0.125f * 1.4426950408889634f;
struct EpiInProj0 {
    static constexpr bool PERM = false;
    bf16* PROJ; const float* TAB;
    __device__ __forceinline__ void operator()(const pg8::f32x4 (&acc)[2][2][4][2], const pg8::Unit& u, int wr, int wc, int fr, int fq) const {
        const bool rope = u.pn < 4 && u.pm >= 8; const float sc = u.pn < 2 ? ATT_C2 : 1.f; const int axis = wc & 1;
#pragma unroll
        for (int ai = 0; ai < 2; ++ai)
#pragma unroll
            for (int m = 0; m < 4; ++m) { const int r = u.pm * 256 + ai * 128 + wr * 64 + m * 16 + fr;
                pg8::f32x4 cs = (pg8::f32x4){1.f, 1.f, 1.f, 1.f}, sn = (pg8::f32x4){0.f, 0.f, 0.f, 0.f};
                if (rope) { const int t = (r - NCTX) & 2047; const int pos = axis ? (t & 63) : (t >> 6); cs = *(const pg8::f32x4*)(TAB + TAB_COS + pos * 16 + 4 * fq); sn = *(const pg8::f32x4*)(TAB + TAB_SIN + pos * 16 + 4 * fq); }
                bf16* rowp = PROJ + (size_t)r * 3072 + u.pn * 256 + wc * 32 + 4 * fq;
#pragma unroll
                for (int bj = 0; bj < 2; ++bj) { const pg8::f32x4 x1 = acc[ai][bj][m][0], x2 = acc[ai][bj][m][1];
                    const pg8::f32x4 o1 = (x1 * cs - x2 * sn) * sc, o2 = (x2 * cs + x1 * sn) * sc;
                    pg8::u32x2 w1, w2; w1.x = pg8::cvt_pk_bf16(o1[0], o1[1]); w1.y = pg8::cvt_pk_bf16(o1[2], o1[3]); w2.x = pg8::cvt_pk_bf16(o2[0], o2[1]); w2.y = pg8::cvt_pk_bf16(o2[2], o2[3]);
                    *(pg8::u32x2*)(rowp + bj * 128) = w1; *(pg8::u32x2*)(rowp + bj * 128 + 16) = w2; } }
    }
};
struct EpiResid {
    static constexpr bool PERM = false;
    float* XS; const float* x_in; const float* ctx_in; const float* gate;
    int row0;
    __device__ __forceinline__ void operator()(const pg8::f32x4 (&acc)[2][2][4][2], const pg8::Unit& u, int wr, int wc, int fr, int fq) const {
        const int col0 = u.pn * 256 + wc * 32 + 4 * fq;
#pragma unroll
        for (int ai = 0; ai < 2; ++ai)
#pragma unroll
            for (int m = 0; m < 4; ++m) { const int r = row0 + u.pm * 256 + ai * 128 + wr * 64 + m * 16 + fr; const float* g = gate + (size_t)row_modrow(r) * 6144 + col0;
                const float* bp = x_in ? (r < NCTX ? ctx_in + (size_t)r * D : x_in + (size_t)(r - NCTX) * D) : XS + (size_t)r * D; float* op = XS + (size_t)r * D + col0; bp += col0;
#pragma unroll
                for (int bj = 0; bj < 2; ++bj)
#pragma unroll
                    for (int n = 0; n < 2; ++n) { const int o = bj * 128 + n * 16; const pg8::f32x4 gg = *(const pg8::f32x4*)(g + o), bb = *(const pg8::f32x4*)(bp + o);
                        *(pg8::f32x4*)(op + o) = bb + gg * acc[ai][bj][m][n]; }
                if (m & 1) asm volatile("" ::: "memory"); }
    }
};
}
namespace mk {
namespace att {
constexpr int PITCH = 3072;
constexpr int SLOT = 32768, NSL = 3;
constexpr int LDS_SCR = NSL * SLOT;
constexpr int LDS_END = LDS_SCR + 8 * 512;
static_assert(LDS_END <= RING_BYTES, "attention LDS");
__device__ __forceinline__ int crow(int r, int hi) { return (r & 3) + 8 * (r >> 2) + 4 * hi; }
#define ATT_WAIT_BAR(N) asm volatile("s_waitcnt vmcnt(" #N ") lgkmcnt(0)\n\ts_barrier" ::: "memory")
typedef short v4i16_t __attribute__((ext_vector_type(4)));
__device__ __forceinline__ s16x4 vtr(LAS const unsigned char* p) { return __builtin_bit_cast(s16x4, __builtin_amdgcn_ds_read_tr16_b64_v4i16((LAS v4i16_t*)p)); }
__device__ __forceinline__ unsigned cvtpk(float lo, float hi) { typedef float f2 __attribute__((ext_vector_type(2))); typedef __bf16 b2 __attribute__((ext_vector_type(2))); f2 v = {lo, hi}; b2 b = __builtin_convertvector(v, b2); return __builtin_bit_cast(unsigned, b); }
__device__ __forceinline__ float half_swap_max(float m) { auto rr = __builtin_amdgcn_permlane32_swap(__float_as_uint(m), __float_as_uint(m), false, false); return fmaxf(__uint_as_float(rr[0]), __uint_as_float(rr[1])); }
__device__ __forceinline__ float half_swap_sum(float m) { auto rr = __builtin_amdgcn_permlane32_swap(__float_as_uint(m), __float_as_uint(m), false, false); return __uint_as_float(rr[0]) + __uint_as_float(rr[1]); }

__device__ __forceinline__ void attn_unit(LAS unsigned char* lds, const bf16* PROJ, bf16* CAT, const int qrow0, const int krow_ctx, const int krow_lat, const int NT, const int h, const float lam, const float* subln, const int tid) {
    const int lane = tid & 63, r32 = lane & 31, hi = lane >> 5; const int wid = __builtin_amdgcn_readfirstlane(tid >> 6); const int mh = wid >> 2, wq = wid & 3;
    LAS float* wsf = (LAS float*)(lds + LDS_SCR) + wid * 128;
    const bf16* kbase = PROJ + 512 + h * 128 + wid * 8 + (size_t)lane * PITCH;
    const bf16* vbase0 = PROJ + 1024 + h * 128 + ((wid >> 2) * 32) + (lane & 3) * 8 + (size_t)(16 * (wid & 3) + (lane >> 2)) * PITCH;
    const bf16* vbase1 = vbase0 + 64;
#define ATT_DMA(t, slot) do { const size_t kr_ = (size_t)((t) < 4 ? krow_ctx + 64 * (t) : krow_lat + 64 * ((t) - 4)) * PITCH; \
        __builtin_amdgcn_global_load_lds((const unsigned*)(kbase + kr_), (LAS unsigned*)(lds + (slot) * SLOT + wid * 1024), 16, 0, 0); \
        __builtin_amdgcn_global_load_lds((const unsigned*)(kbase + kr_ + 64), (LAS unsigned*)(lds + (slot) * SLOT + 8192 + wid * 1024), 16, 0, 0); \
        __builtin_amdgcn_global_load_lds((const unsigned*)(vbase0 + kr_), (LAS unsigned*)(lds + (slot) * SLOT + 16384 + wid * 1024), 16, 0, 0); \
        __builtin_amdgcn_global_load_lds((const unsigned*)(vbase1 + kr_), (LAS unsigned*)(lds + (slot) * SLOT + 16384 + 8192 + wid * 1024), 16, 0, 0); } while (0)
    ATT_DMA(0, 0); if (NT > 1) ATT_DMA(1, 1);
    const bf16* Qw = PROJ + (size_t)(qrow0 + wq * 32 + r32) * PITCH + h * 128 + mh * 64 + hi * 8;
    bf16x8 qr[4];
#pragma unroll
    for (int d0 = 0; d0 < 4; ++d0) qr[d0] = *(const GAS bf16x8*)(Qw + d0 * 16);
    float mrow = 0.f, l_reg = 0.f; f32x16 o[4]; f32x16 negm;
#pragma unroll
    for (int d0 = 0; d0 < 4; ++d0)
#pragma unroll
        for (int r = 0; r < 16; ++r) o[d0][r] = 0.f;
#pragma unroll
    for (int r = 0; r < 16; ++r) negm[r] = 0.f;
    const int koff = mh * 8192 + hi * 1024 + r32 * 16;
    const int voff = 16384 + ((lane >> 4) & 1) * 32 + (lane & 3) * 8 + (4 * hi + ((lane & 15) >> 2)) * 64;
    int sl = 0;
    for (int t = 0; t < NT; ++t) {
        if (t + 1 < NT) { ATT_WAIT_BAR(4); } else { ATT_WAIT_BAR(0); }
        if (t + 2 < NT) { const int s2 = sl >= 1 ? sl - 1 : 2; ATT_DMA(t + 2, s2); }
        LAS const unsigned char* kp = lds + sl * SLOT + koff; LAS const unsigned char* vp = lds + sl * SLOT + voff;
        f32x16 p0 = negm, p1 = negm;
#pragma unroll
        for (int d0 = 0; d0 < 4; ++d0) { const bf16x8 b0 = *(const LAS bf16x8*)(kp + d0 * 2048), b1 = *(const LAS bf16x8*)(kp + d0 * 2048 + 512);
            p0 = __builtin_amdgcn_mfma_f32_32x32x16_bf16(b0, qr[d0], p0, 0, 0, 0); p1 = __builtin_amdgcn_mfma_f32_32x32x16_bf16(b1, qr[d0], p1, 0, 0, 0); }
        float rm = fmaxf(p0[0], p1[0]);
#pragma unroll
        for (int r = 1; r < 16; ++r) rm = fmaxf(rm, fmaxf(p0[r], p1[r]));
        rm = half_swap_max(rm);
        if (t == 0 || __any(rm > 0.f)) {
            const float dl = t == 0 ? rm : fmaxf(rm, 0.f); mrow += dl;
#pragma unroll
            for (int r = 0; r < 16; ++r) { p0[r] -= dl; p1[r] -= dl; negm[r] = -mrow; }
            if (t > 0) { const float f = __builtin_amdgcn_exp2f(-dl); l_reg *= f; if (hi == 0) wsf[r32] = f; LDS_WAIT();
                float fr_[16];
#pragma unroll
                for (int r = 0; r < 16; ++r) fr_[r] = wsf[crow(r, hi)];
#pragma unroll
                for (int d0 = 0; d0 < 4; ++d0)
#pragma unroll
                    for (int r = 0; r < 16; ++r) o[d0][r] *= fr_[r]; }
        }
        float sacc = 0.f;
#pragma unroll
        for (int r = 0; r < 16; ++r) { p0[r] = __builtin_amdgcn_exp2f(p0[r]); p1[r] = __builtin_amdgcn_exp2f(p1[r]); sacc += p0[r] + p1[r]; }
        l_reg += sacc;
        v4u pw[4];
        pw[0] = (v4u){cvtpk(p0[0], p0[1]), cvtpk(p0[2], p0[3]), cvtpk(p0[4], p0[5]), cvtpk(p0[6], p0[7])};
        pw[1] = (v4u){cvtpk(p0[8], p0[9]), cvtpk(p0[10], p0[11]), cvtpk(p0[12], p0[13]), cvtpk(p0[14], p0[15])};
        pw[2] = (v4u){cvtpk(p1[0], p1[1]), cvtpk(p1[2], p1[3]), cvtpk(p1[4], p1[5]), cvtpk(p1[6], p1[7])};
        pw[3] = (v4u){cvtpk(p1[8], p1[9]), cvtpk(p1[10], p1[11]), cvtpk(p1[12], p1[13]), cvtpk(p1[14], p1[15])};
#pragma unroll
        for (int d0 = 0; d0 < 4; ++d0) {
            s16x4 lo[4], hh[4];
#pragma unroll
            for (int ks = 0; ks < 4; ++ks) { lo[ks] = vtr(vp + d0 * 4096 + ks * 1024); hh[ks] = vtr(vp + d0 * 4096 + ks * 1024 + 512); }
#pragma unroll
            for (int ks = 0; ks < 4; ++ks) { const bf16x8 vf = (bf16x8){lo[ks][0], lo[ks][1], lo[ks][2], lo[ks][3], hh[ks][0], hh[ks][1], hh[ks][2], hh[ks][3]};
                o[d0] = __builtin_amdgcn_mfma_f32_32x32x16_bf16(__builtin_bit_cast(bf16x8, pw[ks]), vf, o[d0], 0, 0, 0); }
        }
        sl = sl == 2 ? 0 : sl + 1;
    }
    l_reg = half_swap_sum(l_reg);
    const float coef = (mh == 0 ? 1.f : -lam) / l_reg;
    if (hi == 0) wsf[64 + r32] = coef;
    ATT_WAIT_BAR(0);
    float cf[16];
#pragma unroll
    for (int r = 0; r < 16; ++r) cf[r] = wsf[64 + crow(r, hi)];
    LAS float* X = (LAS float*)lds + wq * 4096;
    if (mh == 1) {
#pragma unroll
        for (int d0 = 0; d0 < 4; ++d0)
#pragma unroll
            for (int r = 0; r < 16; ++r) X[crow(r, hi) * 128 + d0 * 32 + r32] = o[d0][r] * cf[r];
    }
    ATT_WAIT_BAR(0);
    if (mh == 0) {
        float ssq[16];
#pragma unroll
        for (int r = 0; r < 16; ++r) ssq[r] = 0.f;
#pragma unroll
        for (int d0 = 0; d0 < 4; ++d0)
#pragma unroll
            for (int r = 0; r < 16; ++r) { const float v = o[d0][r] * cf[r] + X[crow(r, hi) * 128 + d0 * 32 + r32]; o[d0][r] = v; ssq[r] += v * v; }
#pragma unroll
        for (int r = 0; r < 16; ++r) { float s = ssq[r]; s += __shfl_xor(s, 1); s += __shfl_xor(s, 2); s += __shfl_xor(s, 4); s += __shfl_xor(s, 8); s += __shfl_xor(s, 16); ssq[r] = rsqrtf(s * (1.f / 128.f) + 1e-6f) * 0.8f; }
        LDS_WAIT();
        LAS bf16* stg = (LAS bf16*)(lds + wq * 16384);
#pragma unroll
        for (int d0 = 0; d0 < 4; ++d0) { const float g = subln[d0 * 32 + r32];
#pragma unroll
            for (int r = 0; r < 16; ++r) stg[crow(r, hi) * 128 + d0 * 32 + r32] = (bf16)f2bf(o[d0][r] * ssq[r] * g); }
        LDS_WAIT();
        bf16* Ow = CAT + (size_t)(qrow0 + wq * 32) * D + h * 128;
#pragma unroll
        for (int i = 0; i < 8; ++i) { const int row = i * 4 + (lane >> 4), ch = lane & 15; const v4u v = *(const LAS v4u*)(stg + row * 128 + ch * 8); *(GAS v4u*)(Ow + (size_t)row * D + ch * 8) = v; }
    }
    ATT_WAIT_BAR(0);
#undef ATT_DMA
}
__device__ __forceinline__ void conv_items(Frame& F, const bf16* PROJ, bf16* CAT, const float* cw) {
    int lane_ = lane_now(); asm volatile("" : "+v"(lane_)); const int lane = lane_;
    const int gw = F.vcu * NWAVES + F.wave, NGW = F.G * NWAVES; const int c0 = 8 * lane;
    float w0[8], w1[8], w2[8];
#pragma unroll
    for (int j = 0; j < 8; ++j) { w0[j] = cw[c0 + j]; w1[j] = cw[512 + c0 + j]; w2[j] = cw[1024 + c0 + j]; }
    for (int it = gw; it < NTOK / 16; it += NGW) {
        const int r0 = it * 16; const int seg0 = r0 < NCTX ? (r0 & ~255) : NCTX + ((r0 - NCTX) & ~2047); const int seg1 = r0 < NCTX ? seg0 + 256 : seg0 + 2048;
        float pm1[8], pc[8], pn[8];
        auto prod = [&](int r, float (&dst)[8]) { if (r < seg0 || r >= seg1) {
#pragma unroll
                for (int j = 0; j < 8; ++j) dst[j] = 0.f; return; }
            const v4u a = *(const GAS v4u*)(PROJ + (size_t)r * att::PITCH + 2048 + c0), b = *(const GAS v4u*)(PROJ + (size_t)r * att::PITCH + 2560 + c0);
            dst[0] = bf_lo(a.x) * bf_lo(b.x); dst[1] = bf_hi(a.x) * bf_hi(b.x); dst[2] = bf_lo(a.y) * bf_lo(b.y); dst[3] = bf_hi(a.y) * bf_hi(b.y);
            dst[4] = bf_lo(a.z) * bf_lo(b.z); dst[5] = bf_hi(a.z) * bf_hi(b.z); dst[6] = bf_lo(a.w) * bf_lo(b.w); dst[7] = bf_hi(a.w) * bf_hi(b.w); };
        prod(r0 - 1, pm1); prod(r0, pc);
        for (int i = 0; i < 16; ++i) { const int r = r0 + i; prod(r + 1, pn);
            const v4u g = *(const GAS v4u*)(PROJ + (size_t)r * att::PITCH + 1536 + c0); const float bg[8] = {bf_lo(g.x), bf_hi(g.x), bf_lo(g.y), bf_hi(g.y), bf_lo(g.z), bf_hi(g.z), bf_lo(g.w), bf_hi(g.w)};
            float o[8];
#pragma unroll
            for (int j = 0; j < 8; ++j) { o[j] = bg[j] * (w0[j] * pm1[j] + w1[j] * pc[j] + w2[j] * pn[j]); pm1[j] = pc[j]; pc[j] = pn[j]; }
            v4u w; w.x = pk2(o[0], o[1]); w.y = pk2(o[2], o[3]); w.z = pk2(o[4], o[5]); w.w = pk2(o[6], o[7]);
            *(GAS v4u*)(CAT + (size_t)r * D + 512 + c0) = w; }
    }
}
}
__device__ __forceinline__ void phase_attn(Frame& F, const float* subln, const float* cw) {
    const bf16* PROJ = (const bf16*)(F.ws + WS_PROJ); bf16* CAT = (bf16*)(F.ws + WS_CAT); const float lam = ((const float*)(F.ws + WS_TAB))[TAB_LAM];
    int tid_ = tid_now(); asm volatile("" : "+v"(tid_));
    for (int u = 2 * F.vcu; u < 512; u += 2 * F.G)
        for (int j = 0; j < 2; ++j) { const int uu = u + j; const int bh = uu >> 4, qb = uu & 15, b = bh >> 2, h = bh & 3;
            att::attn_unit(F.lds + RING_OFF, PROJ, CAT, NCTX + b * SEQ + qb * 128, b * CT, NCTX + b * SEQ, 36, h, lam, subln, tid_); }
    for (int u = F.vcu; u < 64; u += F.G) { const int bh = u >> 1, qb = u & 1, b = bh >> 2, h = bh & 3;
        att::attn_unit(F.lds + RING_OFF, PROJ, CAT, b * CT + qb * 128, b * CT, NCTX + b * SEQ, 4, h, lam, subln, tid_); }
    att::conv_items(F, PROJ, CAT, cw);
}
}
namespace mk {
struct EpiBf16 {
    static constexpr bool PERM = true;
    bf16* O; int ldc;
    __device__ __forceinline__ void operator()(const pg8::f32x4 (&acc)[2][2][4][2], const pg8::Unit& u, int wr, int wc, int fr, int fq) const {
        const int col0 = u.pn * 256 + wc * 32 + 8 * fq;
#pragma unroll
        for (int ai = 0; ai < 2; ++ai)
#pragma unroll
            for (int m = 0; m < 4; ++m) { bf16* rowp = O + (size_t)(u.pm * 256 + ai * 128 + wr * 64 + m * 16 + fr) * ldc + col0;
#pragma unroll
                for (int bj = 0; bj < 2; ++bj) { const pg8::f32x4 v0 = acc[ai][bj][m][0], v1 = acc[ai][bj][m][1];
                    pg8::u32x4 w; w.x = pg8::cvt_pk_bf16(v0[0], v0[1]); w.y = pg8::cvt_pk_bf16(v0[2], v0[3]); w.z = pg8::cvt_pk_bf16(v1[0], v1[1]); w.w = pg8::cvt_pk_bf16(v1[2], v1[3]);
                    *(pg8::u32x4*)(rowp + bj * 128) = w; } }
    }
};
struct InProj1Sched {
    pg8::TileOrder ord; int G, c; const char* A; const char* W; int a_pitch;
    __device__ __forceinline__ bool next(int i, pg8::Unit& u) const { const int L = i * G + c; if (L >= 544) return false;
        if (L < 512) { ord.map(L, u); u.pm += 8; } else { const int q = L - 512; u.pm = q >> 2; u.pn = 4 + (q & 3); } return true; }
    __device__ __forceinline__ const char* a_base(const pg8::Unit& u) const { return A + (size_t)u.pm * 256 * 2048; }
    __device__ __forceinline__ const char* b_base(const pg8::Unit& u) const { return W + (size_t)u.pn * 256 * 2048; }
    __device__ __forceinline__ unsigned a_rowoff(const pg8::Unit&, int) const { return 0u; }
};
__device__ __forceinline__ void phase_conv1(Frame& F, const float* cw, const float* cb) {
    const bf16* GU = (const bf16*)(F.ws + WS_PROJ); bf16* XC = (bf16*)(F.ws + WS_XC);
    int lane_ = lane_now(); asm volatile("" : "+v"(lane_)); const int lane = lane_;
    const int gw = F.vcu * NWAVES + F.wave, NGW = F.G * NWAVES;
    for (int it = gw; it < (NTOK / 16) * 2; it += NGW) {
        const int r0 = (it >> 1) * 16, c0 = (it & 1) * 512 + 8 * lane; const int seg0 = r0 < NCTX ? (r0 & ~255) : NCTX + ((r0 - NCTX) & ~2047); const int seg1 = r0 < NCTX ? seg0 + 256 : seg0 + 2048;
        float wf[4][8], wb[4][8], bf_[8], bb_[8];
#pragma unroll
        for (int j = 0; j < 8; ++j) { bf_[j] = cb[c0 + j]; bb_[j] = cb[1024 + c0 + j];
#pragma unroll
            for (int k = 0; k < 4; ++k) { wf[k][j] = cw[k * 1024 + c0 + j]; wb[k][j] = cw[(4 + k) * 1024 + c0 + j]; } }
        float win[7][8];
        auto ld = [&](int r, float (&dst)[8]) { if (r < seg0 || r >= seg1) {
#pragma unroll
                for (int j = 0; j < 8; ++j) dst[j] = 0.f; return; }
            const v4u a = *(const GAS v4u*)(GU + (size_t)r * 2048 + 1024 + c0);
            dst[0] = bf_lo(a.x); dst[1] = bf_hi(a.x); dst[2] = bf_lo(a.y); dst[3] = bf_hi(a.y); dst[4] = bf_lo(a.z); dst[5] = bf_hi(a.z); dst[6] = bf_lo(a.w); dst[7] = bf_hi(a.w); };
#pragma unroll
        for (int q = 0; q < 6; ++q) ld(r0 - 3 + q, win[q + 1]);
#pragma unroll 4
        for (int i = 0; i < 16; ++i) { const int r = r0 + i;
#pragma unroll
            for (int q = 0; q < 6; ++q)
#pragma unroll
                for (int j = 0; j < 8; ++j) win[q][j] = win[q + 1][j];
            ld(r + 3, win[6]);
            float of[8], ob[8];
#pragma unroll
            for (int j = 0; j < 8; ++j) { of[j] = bf_[j] + wf[0][j] * win[0][j] + wf[1][j] * win[1][j] + wf[2][j] * win[2][j] + wf[3][j] * win[3][j];
                ob[j] = bb_[j] + wb[0][j] * win[3][j] + wb[1][j] * win[4][j] + wb[2][j] * win[5][j] + wb[3][j] * win[6][j]; }
            v4u w; w.x = pk2(of[0], of[1]); w.y = pk2(of[2], of[3]); w.z = pk2(of[4], of[5]); w.w = pk2(of[6], of[7]);
            *(GAS v4u*)(XC + (size_t)r * D + c0) = w;
            w.x = pk2(ob[0], ob[1]); w.y = pk2(ob[2], ob[3]); w.z = pk2(ob[4], ob[5]); w.w = pk2(ob[6], ob[7]);
            *(GAS v4u*)(XC + ((size_t)NTOK + r) * D + c0) = w; }
    }
}
struct GateSched {
    pg8::TileOrder ord; const char* XC; const char* W; int a_pitch;
    __device__ __forceinline__ bool next(int i, pg8::Unit& u) const { return ord.tile(i, u); }
    __device__ __forceinline__ const char* a_base(const pg8::Unit& u) const { const int d = u.pm >= 72 ? 1 : 0, rt = u.pm - 72 * d; return XC + ((size_t)d * NTOK + (size_t)rt * 256) * 2048 + (u.pn >> 1) * 512; }
    __device__ __forceinline__ const char* b_base(const pg8::Unit& u) const { const int d = u.pm >= 72 ? 1 : 0; return W + (size_t)(d * 8 + u.pn) * 256 * 512; }
    __device__ __forceinline__ unsigned a_rowoff(const pg8::Unit&, int) const { return 0u; }
};
struct EpiGate {
    static constexpr bool PERM = true;
    const bf16* XC; unsigned* AB; const float* gab; const float* gxb; const float* SP;
    __device__ __forceinline__ void operator()(const pg8::f32x4 (&acc)[2][2][4][2], const pg8::Unit& u, int wr, int wc, int fr, int fq) const {
        const int d = u.pm >= 72 ? 1 : 0, rt = u.pm - 72 * d; const int ch0 = (u.pn >> 1) * 256 + (u.pn & 1) * 128 + wc * 32 + 8 * fq;
#pragma unroll
        for (int ai = 0; ai < 2; ++ai)
#pragma unroll
            for (int m = 0; m < 4; ++m) { const size_t row = (size_t)d * NTOK + rt * 256 + ai * 128 + wr * 64 + m * 16 + fr;
#pragma unroll
                for (int n = 0; n < 2; ++n) {
                    asm volatile("" ::: "memory");
                    const int ch = ch0 + 4 * n; const pg8::f32x4 ba = *(const pg8::f32x4*)(gab + d * 1024 + ch), bx = *(const pg8::f32x4*)(gxb + d * 1024 + ch), sp = *(const pg8::f32x4*)(SP + d * 1024 + ch);
                    const v2u xw = *(const GAS v2u*)(XC + row * D + ch); const float xc[4] = {bf_lo(xw.x), bf_hi(xw.x), bf_lo(xw.y), bf_hi(xw.y)};
                    unsigned o[4];
#pragma unroll
                    for (int i = 0; i < 4; ++i) { const float rp = acc[ai][0][m][n][i] + ba[i], ip = acc[ai][1][m][n][i] + bx[i];
                        const float rg = __builtin_amdgcn_rcpf(1.f + __builtin_amdgcn_exp2f(-1.4426950408889634f * rp)), ig = __builtin_amdgcn_rcpf(1.f + __builtin_amdgcn_exp2f(-1.4426950408889634f * ip));
                        const float la2 = rg * sp[i] * (-8.f * 1.4426950408889634f); const float a = __builtin_amdgcn_exp2f(la2); const float bv = __builtin_amdgcn_sqrtf(fmaxf(1.f - a * a, 0.f)) * ig * xc[i];
                        o[i] = (f2bf(la2) << 16) | f2bf(bv); }
                    *(GAS v4u*)(AB + row * D + ch) = (v4u){o[0], o[1], o[2], o[3]}; } }
    }
};
__device__ __forceinline__ void phase_scan1(Frame& F) {
    const unsigned* AB = (const unsigned*)(F.ws + WS_AB); f32x2* SUM = (f32x2*)(F.ws + WS_SUM);
    int lane_ = lane_now(); asm volatile("" : "+v"(lane_)); const int lane = lane_;
    const int gw = F.vcu * NWAVES + F.wave, NGW = F.G * NWAVES;
    for (int it = gw; it < 2 * 288 * 16; it += NGW) {
        const int cg = it & 15, sc = (it >> 4) % 288, d = it / (288 * 16); const int c = cg * 64 + lane;
        const unsigned* p = AB + ((size_t)d * NTOK + sc * 64) * D + c; float h = 0.f, la = 0.f;
#pragma unroll
        for (int blk = 0; blk < 4; ++blk) { unsigned w[16];
#pragma unroll
            for (int i = 0; i < 16; ++i) { const int row = d == 0 ? blk * 16 + i : 63 - (blk * 16 + i); w[i] = p[(size_t)row * D]; }
#pragma unroll
            for (int i = 0; i < 16; ++i) { const float l2 = bf_hi(w[i]), b = bf_lo(w[i]); la += l2; h = __builtin_amdgcn_exp2f(l2) * h + b; } }
        SUM[((size_t)d * 288 + sc) * D + c] = (f32x2){la, h};
    }
}
__device__ __forceinline__ void phase_scan2(Frame& F) {
    const unsigned* AB = (const unsigned*)(F.ws + WS_AB); const f32x2* SUM = (const f32x2*)(F.ws + WS_SUM); const bf16* GU = (const bf16*)(F.ws + WS_PROJ); bf16* CAT = (bf16*)(F.ws + WS_CAT);
    int lane_ = lane_now(); asm volatile("" : "+v"(lane_)); const int lane = lane_;
    const int gw = F.vcu * NWAVES + F.wave, NGW = F.G * NWAVES;
    for (int it = gw; it < 8 * 32 * 16; it += NGW) {
        const int cg = it & 15, s = (it >> 4) & 31, b = it >> 9; const int c = cg * 64 + lane;
        float hf = 0.f, hb = 0.f;
        for (int q = 0; q < 4 + s; ++q) { const int sc = q < 4 ? b * 4 + q : 32 + b * 32 + (q - 4); const f32x2 v = SUM[(size_t)sc * D + c]; hf = __builtin_amdgcn_exp2f(v[0]) * hf + v[1]; }
        for (int q = 0; q < 4 + (31 - s); ++q) { const int sc = q < 4 ? b * 4 + (3 - q) : 32 + b * 32 + (31 - (q - 4)); const f32x2 v = SUM[((size_t)288 + sc) * D + c]; hb = __builtin_amdgcn_exp2f(v[0]) * hb + v[1]; }
        const size_t row0 = (size_t)NCTX + (size_t)b * SEQ + s * 64;
        float hfv[64];
#pragma unroll
        for (int blk = 0; blk < 4; ++blk) { unsigned w[16];
#pragma unroll
            for (int i = 0; i < 16; ++i) w[i] = AB[(row0 + blk * 16 + i) * D + c];
#pragma unroll
            for (int i = 0; i < 16; ++i) { hf = __builtin_amdgcn_exp2f(bf_hi(w[i])) * hf + bf_lo(w[i]); hfv[blk * 16 + i] = hf; } }
#pragma unroll
        for (int blk = 3; blk >= 0; --blk) { unsigned w[16]; unsigned short gt[16];
#pragma unroll
            for (int i = 0; i < 16; ++i) { const size_t row = row0 + blk * 16 + 15 - i; w[i] = AB[((size_t)NTOK + row) * D + c]; gt[i] = GU[row * 2048 + c]; }
#pragma unroll
            for (int i = 0; i < 16; ++i) { const int ri = blk * 16 + 15 - i; hb = __builtin_amdgcn_exp2f(bf_hi(w[i])) * hb + bf_lo(w[i]);
                const float g = bf_lo((unsigned)gt[i]); const float z = 0.7978845608028654f * (g + 0.044715f * g * g * g);
                const float th = 1.f - 2.f * __builtin_amdgcn_rcpf(__builtin_amdgcn_exp2f(2.f * 1.4426950408889634f * z) + 1.f);
                CAT[(row0 + ri) * D + c] = (bf16)f2bf((hfv[ri] + hb) * (0.5f * g * (1.f + th))); } }
    }
}
}
namespace mk {
#define IN(k) (lo <= (k) && (k) < hi)
#define SEAM(k) do { if (IN(k) && IN((k) + 1)) xcd_barrier(bar); } while (0)
template <int LAYER> __device__ __forceinline__ void moe_section(Frame& F, const Args& args, const XcdBarrier& bar, const int lo, const int hi) {
        constexpr int layer = LAYER; constexpr int mb = layer == 0 ? 5 : 15;
        constexpr int row0 = layer == 0 ? 0 : NCTX, nrows = layer == 0 ? NTOK : NLAT;
        if (IN(mb)) phase_router(F, layer, row0, nrows, args.in[7] + layer * D, args.in[25] + (size_t)layer * D * 32, args.in[26] + layer * 32);
        SEAM(mb);
        if (IN(mb + 1)) {
            moe_table(F, layer);
            LAS const int* tab = (LAS const int*)(F.misc + MISC_TAB); const int T = *(LAS const int*)(F.misc + MISC_NT);
            MoeSched1 S; S.ord.init(T, 8, F.G, (int)blockIdx.x); S.tab = tab; S.cntl = (LAS const int*)(F.misc + MISC_CNT); S.XN = (const char*)(F.ws + WS_XN);
            S.W = (const char*)(F.ws + WS_W1) + (size_t)layer * 32 * 2048 * 2048; S.list = (const int*)(F.ws + WS_ROUTE + RT_LIST); S.a_pitch = 2048;
            EpiSwiglu E{(bf16*)(F.ws + WS_HB), args.in[28] + (size_t)layer * 32 * 2048, tab};
            pg8::gemm_phase<EpiSwiglu, MoeSched1, true>(F.lds + RING_OFF, 1024, S, E);
        }
        SEAM(mb + 1);
        if (IN(mb + 2)) {
            moe_table(F, layer);
            LAS const int* tab = (LAS const int*)(F.misc + MISC_TAB); const int T = *(LAS const int*)(F.misc + MISC_NT);
            MoeSched2 S; S.ord.init(T, 4, F.G, (int)blockIdx.x); S.tab = tab; S.HB = (const char*)(F.ws + WS_HB); S.W = (const char*)(F.ws + WS_W2) + (size_t)layer * 32 * 1024 * 2048; S.a_pitch = 2048;
            EpiBias2 E{(bf16*)(F.ws + WS_Y2), args.in[30] + (size_t)layer * 32 * 1024, tab};
            pg8::gemm_phase<EpiBias2, MoeSched2, false>(F.lds + RING_OFF, 1024, S, E);
        }
        SEAM(mb + 2);
        if (IN(mb + 3)) {
            moe_table(F, layer);
            if (layer == 0) phase_combine(F, 0, row0, nrows, 0, args.in[6] + D, (const float*)(F.ws + WS_MOD) + (size_t)9 * 6144, args.out);
            else phase_combine(F, 1, row0, nrows, 1, args.in[31], nullptr, args.out);
        }
        SEAM(mb + 3);
}
#undef IN
#undef SEAM
constexpr int NPHASE = 19;
__global__ void __launch_bounds__(NTHR, 2) mk_fwd(Args args) {
    extern __shared__ __attribute__((aligned(16))) unsigned char lds_raw[];
    Frame F;
    F.lds = (LAS unsigned char*)lds_raw; F.misc = F.lds + MISC_OFF;
    F.wave = __builtin_amdgcn_readfirstlane(tid_now() >> 6);
    F.G = gridDim.x; { const int bx = blockIdx.x; F.vcu = (F.G % 8 == 0) ? (bx % 8) * (F.G / 8) + bx / 8 : bx; }
    F.ws = args.ws; F.ctl = (gu32*)(args.ws + WS_CTL);
    for (int u = tid_now(); u < (LDS_BYTES - MISC_OFF) / 4; u += NTHR) ((LAS unsigned*)F.misc)[u] = 0u;
    __syncthreads();
    const int lo = args.ph_lo, hi = args.ph_hi;
    XcdBarrier bar = xcd_barrier_post((unsigned*)(F.ctl + CW_BAR) + args.li * XCD_BAR_WORDS, (volatile LAS unsigned*)(F.misc + MISC_BAR));
#define IN(k) (lo <= (k) && (k) < hi)
#define SEAM(k) do { if (IN(k) && IN((k) + 1)) xcd_barrier(bar); } while (0)

    if (IN(0)) {
        p0_adaln(F, args.in[1], args.in[3], args.in[4], args.in[5]);
        p0_tables(F, args.in[10], args.in[11], args.in[12], args.in[13], args.in[24]);
        __syncthreads();
        p0_dense_weight(F, args.in[8], 1024, 3072, (bf16*)(F.ws + WS_WIN0), 0);
        p0_dense_weight(F, args.in[9], 1024, 1024, (bf16*)(F.ws + WS_WOUT0), 1536);
        p0_dense_weight(F, args.in[16], 1024, 2048, (bf16*)(F.ws + WS_WIN1), 0);
        p0_dense_weight(F, args.in[17], 1024, 1024, (bf16*)(F.ws + WS_WOUT1), 1024);
        p0_gate_weights(F, args.in[20], args.in[22], 1536);
        p0_moe_weights(F, args.in[27], args.in[29], 0);
        p0_moe_weights(F, args.in[27], args.in[29], 1);
    }
    SEAM(0);
    if (IN(1)) phase_norm1_l0(F, args.in[0], args.in[2], args.in[6]);
    SEAM(1);
    if (IN(2)) {
        DenseSched S; S.ord.init(NTOK / 256, 12, F.G, (int)blockIdx.x); S.A = (const char*)(F.ws + WS_XN); S.W = (const char*)(F.ws + WS_WIN0); S.a_pitch = 2048; S.K2 = 2048;
        EpiInProj0 E{(bf16*)(F.ws + WS_PROJ), (const float*)(F.ws + WS_TAB)};
        pg8::gemm_phase<EpiInProj0, DenseSched, false>(F.lds + RING_OFF, 1024, S, E);
    }
    SEAM(2);
    if (IN(3)) phase_attn(F, args.in[14], args.in[15]);
    SEAM(3);
    if (IN(4)) {
        DenseSched S; S.ord.init(NTOK / 256, 4, F.G, (int)blockIdx.x); S.A = (const char*)(F.ws + WS_CAT); S.W = (const char*)(F.ws + WS_WOUT0); S.a_pitch = 2048; S.K2 = 2048;
        EpiResid E{(float*)(F.ws + WS_XS), args.in[0], args.in[2], (const float*)(F.ws + WS_MOD) + 2 * D, 0};
        pg8::gemm_phase<EpiResid, DenseSched, false>(F.lds + RING_OFF, 1024, S, E);
    }
    SEAM(4);

    moe_section<0>(F, args, bar, lo, hi);
    if (IN(9)) {
        InProj1Sched S; S.ord.init(64, 8, F.G, (int)blockIdx.x); S.G = F.G; S.c = (int)blockIdx.x; S.A = (const char*)(F.ws + WS_XN); S.W = (const char*)(F.ws + WS_WIN1); S.a_pitch = 2048;
        EpiBf16 E{(bf16*)(F.ws + WS_PROJ), 2048};
        pg8::gemm_phase<EpiBf16, InProj1Sched, false>(F.lds + RING_OFF, 1024, S, E);
    }
    SEAM(9);
    if (IN(10)) phase_conv1(F, args.in[18], args.in[19]);
    SEAM(10);
    if (IN(11)) {
        GateSched S; S.ord.init(144, 8, F.G, (int)blockIdx.x); S.XC = (const char*)(F.ws + WS_XC); S.W = (const char*)(F.ws + WS_WGATE); S.a_pitch = 2048;
        EpiGate E{(const bf16*)(F.ws + WS_XC), (unsigned*)(F.ws + WS_AB), args.in[21], args.in[23], (const float*)(F.ws + WS_TAB) + TAB_SP};
        pg8::gemm_phase<EpiGate, GateSched, false>(F.lds + RING_OFF, 256, S, E);
    }
    SEAM(11);
    if (IN(12)) phase_scan1(F);
    SEAM(12);
    if (IN(13)) phase_scan2(F);
    SEAM(13);
    if (IN(14)) {
        DenseSched S; S.ord.init(NLAT / 256, 4, F.G, (int)blockIdx.x); S.A = (const char*)(F.ws + WS_CAT) + (size_t)NCTX * 2048; S.W = (const char*)(F.ws + WS_WOUT1); S.a_pitch = 2048; S.K2 = 2048;
        EpiResid E{(float*)(F.ws + WS_XS), nullptr, nullptr, (const float*)(F.ws + WS_MOD) + (size_t)9 * 6144 + 2 * D, NCTX};
        pg8::gemm_phase<EpiResid, DenseSched, false>(F.lds + RING_OFF, 1024, S, E);
    }
    SEAM(14);
    moe_section<1>(F, args, bar, lo, hi);
#undef IN
#undef SEAM
}

struct Launcher { int grid; bool ok; };
inline Launcher& launcher() {
    static Launcher L{0, false};
    if (L.grid == 0) {
        int dev = 0, cus = 0, per_cu = 0;
        if (hipGetDevice(&dev) != hipSuccess || hipDeviceGetAttribute(&cus, hipDeviceAttributeMultiprocessorCount, dev) != hipSuccess) { fprintf(stderr, "mk: device query failed\n"); L.grid = -1; return L; }
        if (hipFuncSetAttribute((const void*)mk_fwd, hipFuncAttributeMaxDynamicSharedMemorySize, LDS_BYTES) != hipSuccess) { fprintf(stderr, "mk: hipFuncSetAttribute failed\n"); L.grid = -1; return L; }
        if (hipOccupancyMaxActiveBlocksPerMultiprocessor(&per_cu, (const void*)mk_fwd, NTHR, LDS_BYTES) != hipSuccess || per_cu < 1) fprintf(stderr, "mk: note: occupancy query reports %d\n", per_cu);
        (void)hipGetLastError();
        L.grid = cus; L.ok = true;
    }
    return L;
}
inline void launch(hipStream_t st, void* const* d_in, float* out, unsigned char* ws, int ph_lo, int ph_hi, int li) {
    Launcher& L = launcher(); if (L.grid <= 0) return;
    Args a{}; for (int i = 0; i < 32; ++i) a.in[i] = (const float*)d_in[i];
    a.out = out; a.ws = ws; a.ph_lo = ph_lo; a.ph_hi = ph_hi; a.li = li; a.pad = 0;
    hipLaunchKernelGGL(mk_fwd, dim3(L.grid), dim3(NTHR), LDS_BYTES, st, a);
}
}
extern "C" void kernel_launch(void* const* d_in, const int* in_sizes, int n_in, void* d_out, int out_size, void* d_ws, size_t ws_size, hipStream_t stream) {
    unsigned char* ws = (unsigned char*)d_ws;
    if (mk::WS_END > ws_size) { fprintf(stderr, "kernel_launch: workspace too small: need %zu have %zu\n", (size_t)mk::WS_END, ws_size); return; }
    (void)hipMemsetAsync(ws + mk::WS_CTL, 0, mk::CTL_ZERO_BYTES, stream);
    mk::launch(stream, d_in, (float*)d_out, ws, 0, 19, 0);
}
```

```cpp
#define MK_FP8_G1 1
#define MK_FP8_G2 1
#include <hip/hip_runtime.h>
#include <cstdio>
#include <cstdint>
namespace pg8 {
#define PG8_LAS __attribute__((address_space(3)))
typedef unsigned short bf16_t;
typedef short bf16x8 __attribute__((ext_vector_type(8)));
typedef float f32x4 __attribute__((ext_vector_type(4)));
typedef float f32x2 __attribute__((ext_vector_type(2)));
typedef unsigned u32x4 __attribute__((ext_vector_type(4)));
typedef unsigned u32x2 __attribute__((ext_vector_type(2)));
constexpr int BM = 256, BK = 64, HALF = 128, HTB = HALF * BK * 2  , STAGE_BYTES = 8 * HTB, NXCD = 8, WGM = 8;

__host__ __device__ __forceinline__ int lds_byte(int r, int c) { const int st = (r >> 4) * 2 + (c >> 5), rr = r & 15, cc = c & 31, ob = rr * 64 + cc * 2; return st * 1024 + (ob ^ (((ob >> 9) & 1) << 5)); }
__host__ __device__ __forceinline__ void stage_rc(int b, int& R, int& C) { const int st = b / 1024, sb = b % 1024, swz = sb ^ (((sb >> 9) & 1) << 5); R = (st >> 1) * 16 + swz / 64; C = (st & 1) * 32 + (swz % 64) / 2; }
__host__ __device__ __forceinline__ int perm32(int rho) { const int n = rho >> 4, i = rho & 15; return 8 * (i >> 2) + 4 * n + (i & 3); }

struct Unit { int pm, pn; };

struct TileOrder {
    int nM, nN, nwg, G, c;
    __device__ __forceinline__ void init(int nM_, int nN_, int G_, int c_) { nM = nM_; nN = nN_; nwg = nM * nN; G = G_; c = c_; }
    __device__ __forceinline__ bool tile(int i, Unit& u) const { const long L = (long)i * G + c; if (L >= nwg) return false; map((int)L, u); return true; }
    __device__ __forceinline__ void map(int L, Unit& u) const {
        int wgid = L; { const int q = nwg / NXCD, r = nwg % NXCD, xcd = wgid % NXCD, off = wgid / NXCD; wgid = (xcd < r ? xcd * (q + 1) : r * (q + 1) + (xcd - r) * q) + off; }
        const int nig = WGM * nN, gid = wgid / nig, fm = gid * WGM, gsz = (nM - fm) < WGM ? (nM - fm) : WGM;
        u.pm = fm + ((wgid % nig) % gsz); u.pn = (wgid % nig) / gsz;
    }
};

__device__ __forceinline__ unsigned cvt_pk_bf16(float lo, float hi) { unsigned r; asm volatile("v_cvt_pk_bf16_f32 %0, %1, %2" : "=v"(r) : "v"(lo), "v"(hi)); return r; }

template <class Epi, class Sched, bool GATHER, bool FP8 = false, int SCALE_W = 127>
__device__ __forceinline__ void gemm_phase(PG8_LAS unsigned char* lds, const int Kb, const Sched& S, const Epi& E) {
    int tid_ = threadIdx.x; asm volatile("" : "+v"(tid_));
    const int tid = tid_, wid = __builtin_amdgcn_readfirstlane(tid >> 6), lane = tid & 63, wr = wid >> 2, wc = wid & 3, fr = lane & 15, fq = lane >> 4;
    const int nt = Kb / 128;
    unsigned voffB[2];
    unsigned offA[2][2], noffA[2][2];
#pragma unroll
    for (int i = 0; i < 2; ++i) { int R, C; stage_rc(tid * 16 + i * 8192, R, C); const int Rb = Epi::PERM ? ((R & ~31) + perm32(R & 31)) : R;
        voffB[i] = (unsigned)(Rb * Kb + C * 2);
        offA[0][i] = (unsigned)(R * S.a_pitch + C * 2); offA[1][i] = (unsigned)((R + HALF) * S.a_pitch + C * 2); noffA[0][i] = offA[0][i]; noffA[1][i] = offA[1][i]; }
    const size_t kstep = (size_t)(BK * 2);
    const size_t hstepB = (size_t)HALF * Kb;
    const unsigned ldsw = (unsigned)wid * 1024u;
    const int aoff = lds_byte(wr * 64 + fr, fq * 8), boff = lds_byte(wc * 32 + fr, fq * 8);
#define PG8_SA(b, h) (((b) * 2 + (h)) * HTB)
#define PG8_SB(b, h) ((4 + (b) * 2 + (h)) * HTB)
#define PG8_STAGE(bufoff, gbase, voff) do { const char* gb_ = (const char*)(gbase); asm volatile("" : "+s"(gb_));     \
        _Pragma("unroll") for (int _i = 0; _i < 2; ++_i) \
        __builtin_amdgcn_global_load_lds((const unsigned*)(gb_ + (voff)[_i]), (PG8_LAS unsigned*)(lds + (bufoff) + ldsw + _i * 8192), 16, 0, 0); } while (0)
    typedef int v4i_ __attribute__((ext_vector_type(4))); typedef int v8i_ __attribute__((ext_vector_type(8)));
#define PG8_LDA(dst, b, h) do { _Pragma("unroll") for (int m = 0; m < 4; ++m) { if constexpr (FP8) { const v4i_ lo_ = *(const PG8_LAS v4i_*)(lds + PG8_SA(b, h) + aoff + m * 2048), hi_ = *(const PG8_LAS v4i_*)(lds + PG8_SA(b, h) + aoff + m * 2048 + 1024); \
            dst##8[m] = __builtin_shufflevector(lo_, hi_, 0, 1, 2, 3, 4, 5, 6, 7); } else { _Pragma("unroll") for (int k = 0; k < 2; ++k) dst[m][k] = *(const PG8_LAS bf16x8*)(lds + PG8_SA(b, h) + aoff + m * 2048 + k * 1024); } } } while (0)
#define PG8_LDB(dst, b, h) do { _Pragma("unroll") for (int n = 0; n < 2; ++n) { if constexpr (FP8) { const v4i_ lo_ = *(const PG8_LAS v4i_*)(lds + PG8_SB(b, h) + boff + n * 2048), hi_ = *(const PG8_LAS v4i_*)(lds + PG8_SB(b, h) + boff + n * 2048 + 1024); \
            dst##8[n] = __builtin_shufflevector(lo_, hi_, 0, 1, 2, 3, 4, 5, 6, 7); } else { _Pragma("unroll") for (int k = 0; k < 2; ++k) dst[n][k] = *(const PG8_LAS bf16x8*)(lds + PG8_SB(b, h) + boff + n * 2048 + k * 1024); } } } while (0)
#define PG8_MMA(ai, bj, At, Bt) do { __builtin_amdgcn_s_setprio(1); _Pragma("unroll") for (int m = 0; m < 4; ++m) _Pragma("unroll") for (int n = 0; n < 2; ++n) { \
        if constexpr (FP8) { asm volatile("v_mfma_scale_f32_16x16x128_f8f6f4 %0, %1, %2, %0, %3, %4 op_sel_hi:[0,0,0]" : "+v"(acc[ai][bj][m][n]) : "v"(Bt##8[n]), "v"(At##8[m]), "v"(sclw_), "v"(scla_)); } \
        else { _Pragma("unroll") for (int k = 0; k < 2; ++k) acc[ai][bj][m][n] = __builtin_amdgcn_mfma_f32_16x16x32_bf16(Bt[n][k], At[m][k], acc[ai][bj][m][n], 0, 0, 0); } } \
        __builtin_amdgcn_s_setprio(0); } while (0)
#define PG8_WAIT_V(n) asm volatile("s_waitcnt vmcnt(" #n ")" ::: "memory")
#define PG8_WAIT_L(n) asm volatile("s_waitcnt lgkmcnt(" #n ")" ::: "memory")
#define PG8_BAR __builtin_amdgcn_s_barrier()
#define PG8_SCHED __builtin_amdgcn_sched_barrier(0)
    int sclw_ = SCALE_W, scla_ = 127; asm volatile("" : "+v"(sclw_), "+v"(scla_));
    Unit cur, nxt; int ui = 0;
    if (!S.next(0, cur)) return;
    if constexpr (GATHER) {
#pragma unroll
        for (int i = 0; i < 2; ++i) { int R, C; stage_rc(tid * 16 + i * 8192, R, C); offA[0][i] = S.a_rowoff(cur, R) + (unsigned)(C * 2); offA[1][i] = S.a_rowoff(cur, R + HALF) + (unsigned)(C * 2); }
    }
    f32x4 acc[2][2][4][2];
#pragma unroll
    for (int a = 0; a < 2; ++a)
#pragma unroll
        for (int b = 0; b < 2; ++b)
#pragma unroll
            for (int m = 0; m < 4; ++m)
#pragma unroll
                for (int n = 0; n < 2; ++n) acc[a][b][m][n] = (f32x4){0.f, 0.f, 0.f, 0.f};
    bf16x8 At[4][2], B0[2][2], B1[2][2]; v8i_ At8[4], B08[2], B18[2];
    const char* cA = S.a_base(cur); const char* cB = S.b_base(cur);
    PG8_STAGE(PG8_SB(0, 0), cB, voffB); PG8_STAGE(PG8_SB(0, 1), cB + hstepB, voffB); PG8_STAGE(PG8_SA(0, 0), cA, offA[0]); PG8_STAGE(PG8_SA(0, 1), cA, offA[1]);
    if (wr == 1) PG8_BAR;
    PG8_WAIT_V(2); PG8_BAR;
    PG8_STAGE(PG8_SB(1, 0), cB + kstep, voffB); PG8_STAGE(PG8_SA(1, 0), cA + kstep, offA[0]); PG8_STAGE(PG8_SB(1, 1), cB + hstepB + kstep, voffB);
    PG8_WAIT_V(6); PG8_BAR;
    for (;;) {
        const bool has_next = S.next(ui + 1, nxt);
        const char* nA = has_next ? S.a_base(nxt) : cA; const char* nB = has_next ? S.b_base(nxt) : cB;
        if constexpr (GATHER) {
            if (has_next) {
#pragma unroll
                for (int i = 0; i < 2; ++i) { int t2_ = tid; asm volatile("" : "+v"(t2_)); int R, C; stage_rc(t2_ * 16 + i * 8192, R, C);
                    noffA[0][i] = S.a_rowoff(nxt, R) + (unsigned)(C * 2); noffA[1][i] = S.a_rowoff(nxt, R + HALF) + (unsigned)(C * 2); }
            } else {
#pragma unroll
                for (int i = 0; i < 2; ++i) { noffA[0][i] = offA[0][i]; noffA[1][i] = offA[1][i]; }
            }
        }
#pragma unroll 1
        for (int t = 0; t < nt; t += 2) {
            const bool last = (t == nt - 2);
            const char* a1 = cA + (size_t)(t + 1) * kstep;
            const char* a2 = last ? nA : cA + (size_t)(t + 2) * kstep; const char* b2 = last ? nB : cB + (size_t)(t + 2) * kstep;
            const char* a3 = a2 + kstep; const char* b3 = b2 + kstep;
            unsigned o2[2][2];
#pragma unroll
            for (int h = 0; h < 2; ++h)
#pragma unroll
                for (int i = 0; i < 2; ++i) o2[h][i] = GATHER ? (last ? noffA[h][i] : offA[h][i]) : offA[h][i];
            PG8_LDB(B0, 0, 0); PG8_LDB(B1, 0, 1); PG8_SCHED; PG8_LDA(At, 0, 0); PG8_STAGE(PG8_SA(1, 1), a1, offA[1]);
            PG8_WAIT_V(8); PG8_WAIT_L(0); PG8_BAR; PG8_MMA(0, 0, At, B0); PG8_MMA(0, 1, At, B1); PG8_BAR; PG8_SCHED;
            PG8_LDA(At, 0, 1); PG8_STAGE(PG8_SB(0, 0), b2, voffB); PG8_STAGE(PG8_SB(0, 1), b2 + hstepB, voffB); PG8_STAGE(PG8_SA(0, 0), a2, o2[0]);
            PG8_WAIT_V(8); PG8_WAIT_L(0); PG8_BAR; PG8_MMA(1, 0, At, B0); PG8_MMA(1, 1, At, B1); PG8_BAR; PG8_SCHED;
            PG8_LDB(B0, 1, 0); PG8_LDB(B1, 1, 1); PG8_SCHED; PG8_LDA(At, 1, 0); PG8_STAGE(PG8_SA(0, 1), a2, o2[1]);
            PG8_WAIT_V(8); PG8_WAIT_L(0); PG8_BAR; PG8_MMA(0, 0, At, B0); PG8_MMA(0, 1, At, B1); PG8_BAR; PG8_SCHED;
            PG8_LDA(At, 1, 1); PG8_STAGE(PG8_SB(1, 0), b3, voffB); PG8_STAGE(PG8_SB(1, 1), b3 + hstepB, voffB); PG8_STAGE(PG8_SA(1, 0), a3, o2[0]);
            PG8_WAIT_V(8); PG8_WAIT_L(0); PG8_BAR; PG8_MMA(1, 0, At, B0); PG8_MMA(1, 1, At, B1); PG8_BAR; PG8_SCHED;
        }
        if (wr == 0) PG8_BAR;
        if constexpr (FP8) asm volatile("s_nop 15\n\ts_nop 3" ::: "memory");
        { int l2_ = lane; asm volatile("" : "+v"(l2_)); E(acc, cur, wr, wc, l2_ & 15, l2_ >> 4); }
        if (!has_next) break;
#pragma unroll
        for (int a = 0; a < 2; ++a)
#pragma unroll
            for (int b = 0; b < 2; ++b)
#pragma unroll
                for (int m = 0; m < 4; ++m)
#pragma unroll
                    for (int n = 0; n < 2; ++n) acc[a][b][m][n] = (f32x4){0.f, 0.f, 0.f, 0.f};
        cur = nxt; cA = nA; cB = nB; ++ui;
        if constexpr (GATHER) {
#pragma unroll
            for (int h = 0; h < 2; ++h)
#pragma unroll
                for (int i = 0; i < 2; ++i) offA[h][i] = noffA[h][i];
        }
        if (wr == 1) PG8_BAR;
    }
    PG8_WAIT_V(0);
    PG8_BAR;
#undef PG8_SA
#undef PG8_SB
#undef PG8_STAGE
#undef PG8_LDA
#undef PG8_LDB
#undef PG8_MMA
#undef PG8_WAIT_V
#undef PG8_WAIT_L
#undef PG8_BAR
#undef PG8_SCHED
}
}

#define GAS __attribute__((address_space(1)))
#define LAS __attribute__((address_space(3)))
typedef unsigned short bf16;
typedef unsigned v4u __attribute__((ext_vector_type(4)));
typedef unsigned v2u __attribute__((ext_vector_type(2)));
typedef float f32x4 __attribute__((ext_vector_type(4)));
typedef float f32x2 __attribute__((ext_vector_type(2)));
typedef float f32x16 __attribute__((ext_vector_type(16)));
typedef short bf16x8 __attribute__((ext_vector_type(8)));
typedef short s16x4 __attribute__((ext_vector_type(4)));
typedef GAS unsigned gu32;
#define RLX_AGENT __ATOMIC_RELAXED, __HIP_MEMORY_SCOPE_AGENT
#define LDS_WAIT() asm volatile("s_waitcnt lgkmcnt(0)" ::: "memory")
#define VM_WAIT() asm volatile("s_waitcnt vmcnt(0)" ::: "memory")
__device__ __forceinline__ unsigned f2bf(float f) { unsigned u = __builtin_bit_cast(unsigned, f); return (u + 0x7fffu + ((u >> 16) & 1u)) >> 16; }
__device__ __forceinline__ unsigned pk2(float lo, float hi) { return f2bf(lo) | (f2bf(hi) << 16); }
__device__ __forceinline__ float bf_lo(unsigned w) { return __builtin_bit_cast(float, w << 16); }
__device__ __forceinline__ float bf_hi(unsigned w) { return __builtin_bit_cast(float, w & 0xffff0000u); }
__device__ __forceinline__ float wave_sum(float v) {
#pragma unroll
    for (int o = 1; o < 64; o <<= 1) v += __shfl_xor(v, o);
    return v;
}

#define XB_TMO      128
#define XB_XCNT(j)  (256  + 64 * (j))
#define XB_XSUB(j)  (1280 + 64 * (j))
#define XB_XGEN(j)  (2304 + 64 * (j))
#define XB_TOP      3328
#define XB_TOPGEN   3392
#define XCD_BAR_WORDS 3456
#define XB_SPIN_CAP (1u << 18)
__device__ __forceinline__ unsigned xb_ld(unsigned* p)              { return __hip_atomic_load(p, __ATOMIC_RELAXED, __HIP_MEMORY_SCOPE_AGENT); }
__device__ __forceinline__ unsigned xb_add(unsigned* p, unsigned v) { return __hip_atomic_fetch_add(p, v, __ATOMIC_RELAXED, __HIP_MEMORY_SCOPE_AGENT); }
__device__ __forceinline__ unsigned xb_xcc_id() { return (unsigned)__builtin_amdgcn_s_getreg((3 << 11) | 20) & 0xFu; }
#define XB_SPIN(cond, bar) do { unsigned _sp = 0; while (cond) { __builtin_amdgcn_s_sleep(1); \
    if ((++_sp & 255u) == 0u) { if (xb_ld(&(bar)[XB_TMO])) break; if (_sp > XB_SPIN_CAP) { atomicAdd(&(bar)[XB_TMO], 1u); break; } } } } while (0)
struct XcdBarrier { unsigned* bar; unsigned x; volatile LAS unsigned* st; };
__device__ __forceinline__ XcdBarrier xcd_barrier_post(unsigned* bar, volatile LAS unsigned* st) {
    XcdBarrier b; b.bar = bar; b.x = xb_xcc_id(); b.st = st;
    if (threadIdx.x == 0) (void)xb_add(&bar[XB_XCNT(b.x)], 1u);
    return b;
}
__device__ __forceinline__ void xcd_barrier_complete(unsigned* bar, unsigned x, unsigned& nloc, unsigned& nx) {
    const unsigned G = gridDim.x * gridDim.y * gridDim.z;
    unsigned sum, cnt, mine, sp = 0u;
    for (;;) {
        sum = 0u; cnt = 0u; mine = 0u;
#pragma unroll
        for (unsigned j = 0; j < 16; ++j) { const unsigned c = xb_ld(&bar[XB_XCNT(j)]); sum += c; cnt += (c > 0u) ? 1u : 0u; mine = (j == x) ? c : mine; }
        if (sum == G) break;
        __builtin_amdgcn_s_sleep(1);
        if ((++sp & 255u) == 0u) { if (xb_ld(&bar[XB_TMO])) break; if (sp > XB_SPIN_CAP) { atomicAdd(&bar[XB_TMO], 1u); break; } }
    }
    nloc = mine > 0u ? mine : 1u; nx = cnt > 0u ? cnt : 1u;
}
__device__ __forceinline__ void xcd_barrier(const XcdBarrier& b) {
    asm volatile("s_waitcnt vmcnt(0)" ::: "memory");
    __syncthreads();
    if (threadIdx.x == 0) {
        unsigned* bar = b.bar;
        __builtin_amdgcn_s_waitcnt(0);
        unsigned nloc = b.st[0], nx = b.st[1];
        if (nloc == 0u) { xcd_barrier_complete(bar, b.x, nloc, nx); b.st[0] = nloc; b.st[1] = nx; }
        const unsigned old = xb_add(&bar[XB_XSUB(b.x)], 1u);
        const unsigned gen = old / nloc;
        if (old + 1u == (gen + 1u) * nloc) {
            __builtin_amdgcn_fence(__ATOMIC_RELEASE, "agent");
            asm volatile("s_waitcnt vmcnt(0)" ::: "memory");
            const unsigned og = xb_add(&bar[XB_TOP], 1u);
            const unsigned tg = og / nx;
            if (og + 1u == (tg + 1u) * nx) xb_add(&bar[XB_TOPGEN], 1u);
            else XB_SPIN(xb_ld(&bar[XB_TOPGEN]) == tg, bar);
            __builtin_amdgcn_fence(__ATOMIC_ACQUIRE, "agent");
            xb_add(&bar[XB_XGEN(b.x)], 1u);
            asm volatile("s_waitcnt vmcnt(0)" ::: "memory");
        } else {
            XB_SPIN(xb_ld(&bar[XB_XGEN(b.x)]) == gen, bar);
            __builtin_amdgcn_fence(__ATOMIC_ACQUIRE, "agent");
            asm volatile("s_waitcnt vmcnt(0)" ::: "memory");
        }
    }
    __syncthreads();
}
namespace mk {
constexpr int D = 1024, NB = 8, SEQ = 2048, CT = 256, NCTX = NB * CT, NLAT = NB * SEQ, NTOK = NCTX + NLAT;
constexpr int NE = 32, LCAP = NTOK;
constexpr int NWAVES = 8, NTHR = 512;
#ifndef MK_WRITE_XS_ALWAYS
#define MK_WRITE_XS_ALWAYS 0
#endif
constexpr bool WRITE_XS_ALWAYS = MK_WRITE_XS_ALWAYS != 0;
#ifndef MK_FP8_G1
#define MK_FP8_G1 0
#endif
#ifndef MK_FP8_G2
#define MK_FP8_G2 0
#endif
constexpr bool FP8_G1 = MK_FP8_G1 != 0, FP8_G2 = MK_FP8_G2 != 0;
constexpr int W1_KB = FP8_G1 ? 1024 : 2048, W2_KB = FP8_G2 ? 1024 : 2048;
constexpr int MAXT = NTOK * 4 / 256 + NE;
constexpr int HB_ROWS = MAXT * 256;

constexpr size_t MiB = 1u << 20;
constexpr size_t al(size_t x) { return (x + MiB - 1) / MiB * MiB; }
constexpr size_t WS_CTL = 0, CTL_ZERO_BYTES = 1 * MiB;
constexpr size_t WS_MOD = WS_CTL + CTL_ZERO_BYTES;
constexpr size_t WS_TAB = WS_MOD + al(2 * 9 * 6144 * 4);
constexpr size_t WS_WIN0 = WS_TAB + MiB;
constexpr size_t WS_WOUT0 = WS_WIN0 + al((size_t)3072 * 1024 * 2);
constexpr size_t WS_WIN1 = WS_WOUT0 + al((size_t)1024 * 1024 * 2);
constexpr size_t WS_WOUT1 = WS_WIN1 + al((size_t)2048 * 1024 * 2);
constexpr size_t WS_WGATE = WS_WOUT1 + al((size_t)1024 * 1024 * 2);
constexpr size_t WS_W1 = WS_WGATE + al((size_t)16 * 256 * 256 * 2);
constexpr size_t WS_W2 = WS_W1 + al((size_t)2 * 32 * 2048 * 1024 * 2);
constexpr size_t WS_XS = WS_W2 + al((size_t)2 * 32 * 1024 * 1024 * 2);
constexpr size_t WS_XN = WS_XS + al((size_t)NTOK * D * 4);
constexpr size_t WS_PROJ = WS_XN + al((size_t)NTOK * D * 2);
constexpr size_t WS_CAT = WS_PROJ + al((size_t)NTOK * 3072 * 2);
constexpr size_t WS_ROUTE = WS_CAT + al((size_t)NTOK * D * 2);
constexpr size_t RT_EIDX = 0, RT_EGATE = (size_t)NTOK * 16, RT_EPOS = 2 * (size_t)NTOK * 16, RT_LIST = 3 * (size_t)NTOK * 16;
constexpr size_t WS_HB = WS_ROUTE + al(3 * (size_t)NTOK * 16 + (size_t)NE * LCAP * 4);
constexpr size_t WS_Y2 = WS_HB + al((size_t)HB_ROWS * D * 2);
constexpr size_t WS_END = WS_Y2 + al((size_t)HB_ROWS * D * 2);
constexpr size_t WS_XC = WS_HB;
constexpr size_t WS_AB = WS_XC + al((size_t)2 * NTOK * D * 2);
constexpr size_t WS_SUM = WS_AB + al((size_t)2 * NTOK * D * 4);
static_assert(WS_SUM + (size_t)2 * 288 * 1024 * 8 <= WS_END, "layer-1 mixer overlay");
constexpr int CW_BAR = 4096;
constexpr int CW_CNT = 65536;
static_assert((CW_CNT + 64 * 64) * 4 <= (int)CTL_ZERO_BYTES && CW_BAR + 8 * XCD_BAR_WORDS <= CW_CNT, "CTL map");

constexpr int RING_OFF = 0, RING_BYTES = 131072;
constexpr int MISC_OFF = RING_BYTES;
constexpr int MISC_BAR = 0;
constexpr int MISC_HIST = 64, MISC_BASE = 64 + 128, MISC_CNT = 64 + 256, MISC_PB = 64 + 384, MISC_NT = 64 + 512;
constexpr int MISC_TAB = 1024;
constexpr int MISC_REC = 4096;
constexpr int LDS_BYTES = 147456;
static_assert(MISC_TAB + MAXT * 4 <= MISC_REC && MISC_OFF + MISC_REC + 8192 <= LDS_BYTES, "LDS map");

struct Args { const float* in[32]; float* out; unsigned char* ws; int ph_lo, ph_hi, li, pad; };

struct Frame {
    LAS unsigned char* lds; LAS unsigned char* misc; gu32* ctl;
    int wave, vcu, G;
    unsigned char* ws;
};

__device__ __forceinline__ int tid_now() { int t = threadIdx.x; asm volatile("" : "+v"(t)); return t; }
__device__ __forceinline__ int lane_now() { return tid_now() & 63; }
__device__ __forceinline__ int row_modrow(int r) { return r < NCTX ? 8 : (r - NCTX) >> 11; }

__device__ __forceinline__ unsigned pk4_fp8(float a, float b, float c, float d) { int p = __builtin_amdgcn_cvt_pk_fp8_f32(a, b, 0, false); p = __builtin_amdgcn_cvt_pk_fp8_f32(c, d, p, true); return (unsigned)p; }
#ifdef MK_EMU_FP8
__device__ __forceinline__ float q8(float x) { const int p = __builtin_amdgcn_cvt_pk_fp8_f32(x, x, 0, false); return __builtin_amdgcn_cvt_f32_fp8(p, 0); }
#define Q8W(x) (q8((x) * 32.f) * 0.03125f)
#define Q8A(x) q8(x)
#else
#define Q8W(x) (x)
#define Q8A(x) (x)
#endif
template <bool QW = false> __device__ __forceinline__ void transpose_item(const float* W, int N, int k0, int n0, bf16* dst, int ldd, LAS float* scr, int lane) {
#pragma unroll 8
    for (int i = 0; i < 32; ++i) { const int kk = 2 * i + (lane >> 5); const float wv_ = W[(size_t)(k0 + kk) * N + n0 + (lane & 31)]; scr[kk * 33 + (lane & 31)] = QW ? Q8W(wv_) : wv_; }
    LDS_WAIT(); asm volatile("" ::: "memory");
    const int c = lane & 7;
#pragma unroll
    for (int j = 0; j < 4; ++j) { const int n = (lane >> 3) + 8 * j; const LAS float* s = scr + (8 * c) * 33 + n;
        v4u o; o.x = pk2(s[0 * 33], s[1 * 33]); o.y = pk2(s[2 * 33], s[3 * 33]); o.z = pk2(s[4 * 33], s[5 * 33]); o.w = pk2(s[6 * 33], s[7 * 33]);
        *(GAS v4u*)(dst + (size_t)n * ldd + 8 * c) = o; }
    LDS_WAIT(); asm volatile("" ::: "memory");
}
__device__ __forceinline__ void transpose_item_fp8(const float* W, int N, int k0, int n0, unsigned char* dst, int ldd, LAS float* scr, int lane) {
#pragma unroll 8
    for (int i = 0; i < 32; ++i) { const int kk = 2 * i + (lane >> 5); scr[kk * 33 + (lane & 31)] = W[(size_t)(k0 + kk) * N + n0 + (lane & 31)] * 32.f; }
    LDS_WAIT(); asm volatile("" ::: "memory");
    const int c = lane & 7;
#pragma unroll
    for (int j = 0; j < 4; ++j) { const int n = (lane >> 3) + 8 * j; const LAS float* s = scr + (8 * c) * 33 + n;
        v2u o; o.x = pk4_fp8(s[0 * 33], s[1 * 33], s[2 * 33], s[3 * 33]); o.y = pk4_fp8(s[4 * 33], s[5 * 33], s[6 * 33], s[7 * 33]);
        *(GAS v2u*)(dst + (size_t)n * ldd + 8 * c) = o; }
    LDS_WAIT(); asm volatile("" ::: "memory");
}
__device__ __forceinline__ void p0_moe_weights(Frame& F, const float* w1, const float* w2, int layer) {
    LAS float* scr = (LAS float*)(F.lds + RING_OFF + F.wave * 16384);
    const int gw = F.vcu * NWAVES + F.wave, NGW = F.G * NWAVES;
    bf16* WT1 = (bf16*)(F.ws + WS_W1) + (size_t)layer * 32 * 2048 * 1024; bf16* WT2 = (bf16*)(F.ws + WS_W2) + (size_t)layer * 32 * 1024 * 1024;
    unsigned char* W81 = F.ws + WS_W1 + (size_t)layer * 32 * 2048 * 1024; unsigned char* W82 = F.ws + WS_W2 + (size_t)layer * 32 * 1024 * 1024;
    const float* s1 = w1 + (size_t)layer * 32 * 1024 * 2048; const float* s2 = w2 + (size_t)layer * 32 * 1024 * 1024;
    constexpr int I1 = 16 * 64, I2 = 16 * 32, IT = 32 * (I1 + I2);
    for (int it = gw; it < IT; it += NGW) {
        const int e = it / (I1 + I2); int r = it % (I1 + I2);
        if (r < I1) { const int kb = r / 64, nb = r % 64, n0 = nb * 32; const int nn = n0 & 1023, drow = 256 * (nn >> 7) + (n0 >= 1024 ? 128 : 0) + (nn & 127);
            if constexpr (FP8_G1) transpose_item_fp8(s1 + (size_t)e * 1024 * 2048, 2048, kb * 64, n0, W81 + (size_t)e * 2048 * 1024 + (size_t)drow * 1024 + kb * 64, 1024, scr, lane_now());
            else transpose_item<true>(s1 + (size_t)e * 1024 * 2048, 2048, kb * 64, n0, WT1 + (size_t)e * 2048 * 1024 + (size_t)drow * 1024 + kb * 64, 1024, scr, lane_now()); }
        else { r -= I1; const int kb = r / 32, nb = r % 32;
            if constexpr (FP8_G2) transpose_item_fp8(s2 + (size_t)e * 1024 * 1024, 1024, kb * 64, nb * 32, W82 + (size_t)e * 1024 * 1024 + (size_t)(nb * 32) * 1024 + kb * 64, 1024, scr, lane_now());
            else transpose_item<true>(s2 + (size_t)e * 1024 * 1024, 1024, kb * 64, nb * 32, WT2 + (size_t)e * 1024 * 1024 + (size_t)(nb * 32) * 1024 + kb * 64, 1024, scr, lane_now()); }
    }
}

__device__ __forceinline__ void moe_table(Frame& F, int layer) {
    LAS int* cntl = (LAS int*)(F.misc + MISC_CNT); LAS int* pb = (LAS int*)(F.misc + MISC_PB); LAS int* tab = (LAS int*)(F.misc + MISC_TAB); LAS int* ntl = (LAS int*)(F.misc + MISC_NT);
    if (tid_now() < 32) cntl[tid_now()] = (int)__hip_atomic_load(F.ctl + CW_CNT + (layer * 32 + tid_now()) * 64, RLX_AGENT);
    __syncthreads();
    if (tid_now() == 0) { int t = 0; for (int e = 0; e < 32; ++e) { pb[e] = t; const int n = (cntl[e] + 255) >> 8; for (int j = 0; j < n; ++j) tab[t + j] = (e << 16) | j; t += n; } ntl[0] = t; }
    __syncthreads();
}

struct MoeSched1 {
    pg8::TileOrder ord; LAS const int* tab; LAS const int* cntl; const char* XN; const char* W; const int* list; int a_pitch; int wb;
    __device__ __forceinline__ bool next(int i, pg8::Unit& u) const { return ord.tile(i, u); }
    __device__ __forceinline__ const char* a_base(const pg8::Unit&) const { return XN; }
    __device__ __forceinline__ const char* b_base(const pg8::Unit& u) const { const int e = __builtin_amdgcn_readfirstlane(tab[u.pm]) >> 16; return W + ((size_t)e * 2048 + (size_t)u.pn * 256) * wb; }
    __device__ __forceinline__ unsigned a_rowoff(const pg8::Unit& u, int r) const { const int te = __builtin_amdgcn_readfirstlane(tab[u.pm]), e = te >> 16, j = te & 0xffff; int lr = j * 256 + r; const int n = __builtin_amdgcn_readfirstlane(cntl[e]); lr = lr < n ? lr : n - 1;
        return (unsigned)list[(size_t)e * LCAP + lr] * (unsigned)a_pitch; }
};
struct MoeSched2 {
    pg8::TileOrder ord; LAS const int* tab; const char* HB; const char* W; int a_pitch; int wb;
    __device__ __forceinline__ bool next(int i, pg8::Unit& u) const { return ord.tile(i, u); }
    __device__ __forceinline__ const char* a_base(const pg8::Unit& u) const { return HB + (size_t)u.pm * 256 * a_pitch; }
    __device__ __forceinline__ const char* b_base(const pg8::Unit& u) const { const int e = __builtin_amdgcn_readfirstlane(tab[u.pm]) >> 16; return W + ((size_t)e * 1024 + (size_t)u.pn * 256) * wb; }
    __device__ __forceinline__ unsigned a_rowoff(const pg8::Unit&, int) const { return 0u; }
};
struct EpiSwiglu {
    static constexpr bool PERM = true;
    bf16* HB; const float* b1; LAS const int* tab;
    __device__ __forceinline__ void operator()(const pg8::f32x4 (&acc)[2][2][4][2], const pg8::Unit& u, int wr, int wc, int fr, int fq) const {
        const int e = __builtin_amdgcn_readfirstlane(tab[u.pm]) >> 16; const float* bb = b1 + (size_t)e * 2048 + u.pn * 128 + wc * 32 + 8 * fq;
#pragma unroll
        for (int ai = 0; ai < 2; ++ai)
#pragma unroll
            for (int m = 0; m < 4; ++m) { const size_t row = (size_t)u.pm * 256 + ai * 128 + wr * 64 + m * 16 + fr; float o[8];
                asm volatile("" ::: "memory");
                pg8::f32x4 bg[2], bl[2];
#pragma unroll
                for (int n = 0; n < 2; ++n) { bg[n] = *(const pg8::f32x4*)(bb + 4 * n); bl[n] = *(const pg8::f32x4*)(bb + 1024 + 4 * n); }
#pragma unroll
                for (int n = 0; n < 2; ++n)
#pragma unroll
                    for (int i = 0; i < 4; ++i) { float g = acc[ai][0][m][n][i] + bg[n][i], l = acc[ai][1][m][n][i] + bl[n][i];
                        g = fminf(g, 7.f); l = fminf(fmaxf(l, -7.f), 7.f);
                        const float sg = __builtin_amdgcn_rcpf(1.f + __builtin_amdgcn_exp2f(-1.702f * 1.4426950408889634f * g)); o[n * 4 + i] = Q8A(g * sg * (l + 1.f)); }
                if constexpr (FP8_G2) { pg8::u32x2 w; w.x = pk4_fp8(o[0], o[1], o[2], o[3]); w.y = pk4_fp8(o[4], o[5], o[6], o[7]); *(pg8::u32x2*)((unsigned char*)HB + row * 1024 + u.pn * 128 + wc * 32 + 8 * fq) = w; }
                else { pg8::u32x4 w; w.x = pg8::cvt_pk_bf16(o[0], o[1]); w.y = pg8::cvt_pk_bf16(o[2], o[3]); w.z = pg8::cvt_pk_bf16(o[4], o[5]); w.w = pg8::cvt_pk_bf16(o[6], o[7]);
                    *(pg8::u32x4*)(HB + row * 1024 + u.pn * 128 + wc * 32 + 8 * fq) = w; } }
    }
};
struct EpiBias2 {
    static constexpr bool PERM = true;
    bf16* Y2; const float* b2; LAS const int* tab;
    __device__ __forceinline__ void operator()(const pg8::f32x4 (&acc)[2][2][4][2], const pg8::Unit& u, int wr, int wc, int fr, int fq) const {
        const int e = __builtin_amdgcn_readfirstlane(tab[u.pm]) >> 16; const int col0 = u.pn * 256 + wc * 32 + 8 * fq; const float* bb = b2 + (size_t)e * 1024 + col0;
        pg8::f32x4 bv[2][2];
#pragma unroll
        for (int bj = 0; bj < 2; ++bj)
#pragma unroll
            for (int n = 0; n < 2; ++n) bv[bj][n] = *(const pg8::f32x4*)(bb + bj * 128 + 4 * n);
#pragma unroll
        for (int ai = 0; ai < 2; ++ai)
#pragma unroll
            for (int m = 0; m < 4; ++m) { bf16* rowp = Y2 + ((size_t)u.pm * 256 + ai * 128 + wr * 64 + m * 16 + fr) * 1024 + col0;
#pragma unroll
                for (int bj = 0; bj < 2; ++bj) { const pg8::f32x4 v0 = acc[ai][bj][m][0] + bv[bj][0], v1 = acc[ai][bj][m][1] + bv[bj][1];
                    pg8::u32x4 w; w.x = pg8::cvt_pk_bf16(v0[0], v0[1]); w.y = pg8::cvt_pk_bf16(v0[2], v0[3]); w.z = pg8::cvt_pk_bf16(v1[0], v1[1]); w.w = pg8::cvt_pk_bf16(v1[2], v1[3]);
                    *(pg8::u32x4*)(rowp + bj * 128) = w; } }
    }
};

__device__ __forceinline__ void phase_router(Frame& F, int layer, int row0, int nrows, const float* gnorm, const float* wr, const float* br) {
    const float* XS = (const float*)(F.ws + WS_XS); bf16* XN = (bf16*)(F.ws + WS_XN); const float* MODL = (const float*)(F.ws + WS_MOD) + (size_t)layer * 9 * 6144;
    int* eidx = (int*)(F.ws + WS_ROUTE + RT_EIDX); float* egate = (float*)(F.ws + WS_ROUTE + RT_EGATE); int* epos = (int*)(F.ws + WS_ROUTE + RT_EPOS); int* list = (int*)(F.ws + WS_ROUTE + RT_LIST);
    LAS int* hist = (LAS int*)(F.misc + MISC_HIST); LAS int* base = (LAS int*)(F.misc + MISC_BASE); LAS int* rec = (LAS int*)(F.misc + MISC_REC);
    int tid_ = tid_now(); asm volatile("" : "+v"(tid_));
    for (int idx = tid_; idx < 1024 * 8; idx += NTHR) { const int k = idx >> 3, c = idx & 7; const f32x4 v = *(const GAS f32x4*)(wr + (size_t)k * 32 + c * 4);
        *(LAS f32x4*)(F.lds + RING_OFF + k * 128 + ((c ^ ((k >> 1) & 7)) << 4)) = v; }
    if (tid_now() < 32) hist[tid_now()] = 0;
    __syncthreads();
    int lane_ = lane_now();
    const int nloc = (nrows - F.vcu + F.G - 1) / F.G;
    for (int i0 = F.wave; i0 < nloc; i0 += NWAVES * 2) {
        int lane = lane_; asm volatile("" : "+v"(lane));
        const int i1 = i0 + 8; const bool ok1 = i1 < nloc; const int r0 = row0 + i0 * F.G + F.vcu, r1 = row0 + (ok1 ? i1 : i0) * F.G + F.vcu;
        float h0[16], h1[16]; float ss0 = 0.f, ss1 = 0.f;
        { const float* x0 = XS + (size_t)r0 * D; const float* x1 = XS + (size_t)r1 * D;
#pragma unroll
            for (int j = 0; j < 16; ++j) { h0[j] = x0[64 * j + lane]; h1[j] = x1[64 * j + lane]; }
#pragma unroll
            for (int j = 0; j < 16; ++j) { ss0 += h0[j] * h0[j]; ss1 += h1[j] * h1[j]; } }
#pragma unroll
        for (int o = 1; o < 64; o <<= 1) { ss0 += __shfl_xor(ss0, o); ss1 += __shfl_xor(ss1, o); }
        { const float rs0 = rsqrtf(ss0 * (1.f / D) + 1e-6f), rs1 = rsqrtf(ss1 * (1.f / D) + 1e-6f);
            const float* m0 = MODL + (size_t)row_modrow(r0) * 6144; const float* m1 = MODL + (size_t)row_modrow(r1) * 6144;
#pragma unroll
            for (int j = 0; j < 16; ++j) { const int k = 64 * j + lane; const float gk = gnorm[k];
                h0[j] = h0[j] * rs0 * gk * (1.f + m0[4 * D + k]) + m0[3 * D + k]; h1[j] = h1[j] * rs1 * gk * (1.f + m1[4 * D + k]) + m1[3 * D + k];
                if constexpr (FP8_G1) { unsigned char* X8 = (unsigned char*)XN; X8[(size_t)r0 * D + k] = (unsigned char)(__builtin_amdgcn_cvt_pk_fp8_f32(h0[j], h0[j], 0, false) & 0xff); if (ok1) X8[(size_t)r1 * D + k] = (unsigned char)(__builtin_amdgcn_cvt_pk_fp8_f32(h1[j], h1[j], 0, false) & 0xff); }
                else { XN[(size_t)r0 * D + k] = (bf16)f2bf(Q8A(h0[j])); if (ok1) XN[(size_t)r1 * D + k] = (bf16)f2bf(Q8A(h1[j])); }
                if ((j & 3) == 3) asm volatile("" ::: "memory"); } }
        float a0[32], a1[32];
#pragma unroll
        for (int e = 0; e < 32; ++e) { a0[e] = 0.f; a1[e] = 0.f; }
        const int sw = (lane >> 1) & 7;
#pragma unroll
        for (int j = 0; j < 16; ++j) { const LAS unsigned char* rowp = F.lds + RING_OFF + (64 * j + lane) * 128;
#pragma unroll
            for (int c = 0; c < 8; ++c) { const f32x4 w = *(const LAS f32x4*)(rowp + ((c ^ sw) << 4));
                a0[4 * c + 0] += h0[j] * w[0]; a0[4 * c + 1] += h0[j] * w[1]; a0[4 * c + 2] += h0[j] * w[2]; a0[4 * c + 3] += h0[j] * w[3];
                a1[4 * c + 0] += h1[j] * w[0]; a1[4 * c + 1] += h1[j] * w[1]; a1[4 * c + 2] += h1[j] * w[2]; a1[4 * c + 3] += h1[j] * w[3]; }
            asm volatile("" ::: "memory"); }
#define BFLY(A, B, MSK, UP) do { const float s_ = (UP) ? (A) : (B); const float k_ = (UP) ? (B) : (A); (A) = k_ + __shfl_xor(s_, MSK); } while (0)
        { const bool up = (lane & 32) != 0; BFLY(a0[0], a0[16], 32, up); BFLY(a0[1], a0[17], 32, up); BFLY(a0[2], a0[18], 32, up); BFLY(a0[3], a0[19], 32, up); BFLY(a0[4], a0[20], 32, up); BFLY(a0[5], a0[21], 32, up); BFLY(a0[6], a0[22], 32, up); BFLY(a0[7], a0[23], 32, up); BFLY(a0[8], a0[24], 32, up); BFLY(a0[9], a0[25], 32, up); BFLY(a0[10], a0[26], 32, up); BFLY(a0[11], a0[27], 32, up); BFLY(a0[12], a0[28], 32, up); BFLY(a0[13], a0[29], 32, up); BFLY(a0[14], a0[30], 32, up); BFLY(a0[15], a0[31], 32, up); }
        { const bool up = (lane & 16) != 0; BFLY(a0[0], a0[8], 16, up); BFLY(a0[1], a0[9], 16, up); BFLY(a0[2], a0[10], 16, up); BFLY(a0[3], a0[11], 16, up); BFLY(a0[4], a0[12], 16, up); BFLY(a0[5], a0[13], 16, up); BFLY(a0[6], a0[14], 16, up); BFLY(a0[7], a0[15], 16, up); }
        { const bool up = (lane & 8) != 0; BFLY(a0[0], a0[4], 8, up); BFLY(a0[1], a0[5], 8, up); BFLY(a0[2], a0[6], 8, up); BFLY(a0[3], a0[7], 8, up); }
        { const bool up = (lane & 4) != 0; BFLY(a0[0], a0[2], 4, up); BFLY(a0[1], a0[3], 4, up); }
        { const bool up = (lane & 2) != 0; BFLY(a0[0], a0[1], 2, up); }
        { const bool up = (lane & 32) != 0; BFLY(a1[0], a1[16], 32, up); BFLY(a1[1], a1[17], 32, up); BFLY(a1[2], a1[18], 32, up); BFLY(a1[3], a1[19], 32, up); BFLY(a1[4], a1[20], 32, up); BFLY(a1[5], a1[21], 32, up); BFLY(a1[6], a1[22], 32, up); BFLY(a1[7], a1[23], 32, up); BFLY(a1[8], a1[24], 32, up); BFLY(a1[9], a1[25], 32, up); BFLY(a1[10], a1[26], 32, up); BFLY(a1[11], a1[27], 32, up); BFLY(a1[12], a1[28], 32, up); BFLY(a1[13], a1[29], 32, up); BFLY(a1[14], a1[30], 32, up); BFLY(a1[15], a1[31], 32, up); }
        { const bool up = (lane & 16) != 0; BFLY(a1[0], a1[8], 16, up); BFLY(a1[1], a1[9], 16, up); BFLY(a1[2], a1[10], 16, up); BFLY(a1[3], a1[11], 16, up); BFLY(a1[4], a1[12], 16, up); BFLY(a1[5], a1[13], 16, up); BFLY(a1[6], a1[14], 16, up); BFLY(a1[7], a1[15], 16, up); }
        { const bool up = (lane & 8) != 0; BFLY(a1[0], a1[4], 8, up); BFLY(a1[1], a1[5], 8, up); BFLY(a1[2], a1[6], 8, up); BFLY(a1[3], a1[7], 8, up); }
        { const bool up = (lane & 4) != 0; BFLY(a1[0], a1[2], 4, up); BFLY(a1[1], a1[3], 4, up); }
        { const bool up = (lane & 2) != 0; BFLY(a1[0], a1[1], 2, up); }
#undef BFLY
        const int me = lane >> 1; const float brv = br[me];
        float c0 = a0[0] + __shfl_xor(a0[0], 1) + brv, c1 = a1[0] + __shfl_xor(a1[0], 1) + brv;
        float tv0[4], tv1[4]; int te0[4], te1[4];
#pragma unroll
        for (int k = 0; k < 4; ++k) { float mx0 = c0, mx1 = c1;
#pragma unroll
            for (int o = 1; o < 64; o <<= 1) { mx0 = fmaxf(mx0, __shfl_xor(mx0, o)); mx1 = fmaxf(mx1, __shfl_xor(mx1, o)); }
            const unsigned long long b0 = __ballot(c0 == mx0), b1 = __ballot(c1 == mx1);
            te0[k] = __builtin_ctzll(b0) >> 1; te1[k] = __builtin_ctzll(b1) >> 1; tv0[k] = mx0; tv1[k] = mx1;
            if (me == te0[k]) c0 = -3.0e38f; if (me == te1[k]) c1 = -3.0e38f; }
        float p0[4], p1[4], ps0 = 0.f, ps1 = 0.f;
#pragma unroll
        for (int k = 0; k < 4; ++k) { p0[k] = __expf(tv0[k] - tv0[0]); ps0 += p0[k]; p1[k] = __expf(tv1[k] - tv1[0]); ps1 += p1[k]; }
        if (lane < 4) { { const int e = lane == 0 ? te0[0] : lane == 1 ? te0[1] : lane == 2 ? te0[2] : te0[3]; const float g = (lane == 0 ? p0[0] : lane == 1 ? p0[1] : lane == 2 ? p0[2] : p0[3]) / ps0;
                const int pl = __hip_atomic_fetch_add(hist + e, 1, __ATOMIC_RELAXED, __HIP_MEMORY_SCOPE_WORKGROUP);
                eidx[r0 * 4 + lane] = e; egate[r0 * 4 + lane] = g; rec[(i0 * 4 + lane) * 2] = e; rec[(i0 * 4 + lane) * 2 + 1] = pl; }
            if (ok1) { const int e = lane == 0 ? te1[0] : lane == 1 ? te1[1] : lane == 2 ? te1[2] : te1[3]; const float g = (lane == 0 ? p1[0] : lane == 1 ? p1[1] : lane == 2 ? p1[2] : p1[3]) / ps1;
                const int pl = __hip_atomic_fetch_add(hist + e, 1, __ATOMIC_RELAXED, __HIP_MEMORY_SCOPE_WORKGROUP);
                eidx[r1 * 4 + lane] = e; egate[r1 * 4 + lane] = g; rec[(i1 * 4 + lane) * 2] = e; rec[(i1 * 4 + lane) * 2 + 1] = pl; } }
    }
    __syncthreads();
    if (tid_now() < 32) base[tid_now()] = (int)__hip_atomic_fetch_add(F.ctl + CW_CNT + (layer * 32 + tid_now()) * 64, (unsigned)hist[tid_now()], RLX_AGENT);
    __syncthreads();
    for (int q = tid_now(); q < nloc * 4; q += NTHR) { const int i = q >> 2, k = q & 3; const int r = row0 + i * F.G + F.vcu; const int e = rec[q * 2], pos = base[e] + rec[q * 2 + 1];
        epos[r * 4 + k] = pos; list[(size_t)e * LCAP + pos] = r; }
}

__device__ __forceinline__ void phase_combine(Frame& F, int layer, int row0, int nrows, int mode, const float* gnext, const float* MODN, float* out) {
    float* XS = (float*)(F.ws + WS_XS); bf16* XN = (bf16*)(F.ws + WS_XN); const bf16* Y2 = (const bf16*)(F.ws + WS_Y2); const float* MODL = (const float*)(F.ws + WS_MOD) + (size_t)layer * 9 * 6144;
    const int* eidx = (const int*)(F.ws + WS_ROUTE + RT_EIDX); const float* egate = (const float*)(F.ws + WS_ROUTE + RT_EGATE); const int* epos = (const int*)(F.ws + WS_ROUTE + RT_EPOS);
    LAS const int* pb = (LAS const int*)(F.misc + MISC_PB);
    const int lane_ = lane_now(); const int nloc = (nrows - F.vcu + F.G - 1) / F.G;
    for (int i0 = F.wave; i0 < nloc; i0 += NWAVES * 2) {
        int lane = lane_; asm volatile("" : "+v"(lane));
        const int i1 = i0 + 8; const bool ok1 = i1 < nloc; const int rA = row0 + i0 * F.G + F.vcu, rB = row0 + (ok1 ? i1 : i0) * F.G + F.vcu;
        int eA[4], eB[4], sA[4], sB[4]; float pA[4], pB[4];
#pragma unroll
        for (int k = 0; k < 4; ++k) { eA[k] = eidx[rA * 4 + k]; eB[k] = eidx[rB * 4 + k]; pA[k] = egate[rA * 4 + k]; pB[k] = egate[rB * 4 + k]; sA[k] = epos[rA * 4 + k]; sB[k] = epos[rB * 4 + k]; }
#pragma unroll
        for (int k = 0; k < 4; ++k) { sA[k] += pb[eA[k]] * 256; sB[k] += pb[eB[k]] * 256; }
        v4u yA[4][2], yB[4][2];
#pragma unroll
        for (int k = 0; k < 4; ++k)
#pragma unroll
            for (int h = 0; h < 2; ++h) { yA[k][h] = *(const GAS v4u*)(Y2 + (size_t)sA[k] * D + 512 * h + 8 * lane); yB[k][h] = *(const GAS v4u*)(Y2 + (size_t)sB[k] * D + 512 * h + 8 * lane); }
        const float* gA = MODL + (size_t)row_modrow(rA) * 6144 + 5 * D; const float* gB = MODL + (size_t)row_modrow(rB) * 6144 + 5 * D;
        f32x4 xA[2][2], xB[2][2]; float ssA = 0.f, ssB = 0.f;
#pragma unroll
        for (int h = 0; h < 2; ++h)
#pragma unroll
            for (int q = 0; q < 2; ++q) { const int c = 512 * h + 8 * lane + 4 * q;
                f32x4 aA = (f32x4){0.f, 0.f, 0.f, 0.f}, aB = aA;
#pragma unroll
                for (int k = 0; k < 4; ++k) { const unsigned wa0 = q ? yA[k][h].z : yA[k][h].x, wa1 = q ? yA[k][h].w : yA[k][h].y, wb0 = q ? yB[k][h].z : yB[k][h].x, wb1 = q ? yB[k][h].w : yB[k][h].y;
                    aA += pA[k] * (f32x4){bf_lo(wa0), bf_hi(wa0), bf_lo(wa1), bf_hi(wa1)}; aB += pB[k] * (f32x4){bf_lo(wb0), bf_hi(wb0), bf_lo(wb1), bf_hi(wb1)}; }
                const f32x4 xoA = *(const GAS f32x4*)(XS + (size_t)rA * D + c), xoB = *(const GAS f32x4*)(XS + (size_t)rB * D + c); const f32x4 ggA = *(const GAS f32x4*)(gA + c), ggB = *(const GAS f32x4*)(gB + c);
                const f32x4 nA = xoA + ggA * aA, nB = xoB + ggB * aB; xA[h][q] = nA; xB[h][q] = nB;
                if (mode == 0 || WRITE_XS_ALWAYS) { *(GAS f32x4*)(XS + (size_t)rA * D + c) = nA; if (ok1) *(GAS f32x4*)(XS + (size_t)rB * D + c) = nB; }
                ssA += (nA[0] * nA[0] + nA[1] * nA[1]) + (nA[2] * nA[2] + nA[3] * nA[3]); ssB += (nB[0] * nB[0] + nB[1] * nB[1]) + (nB[2] * nB[2] + nB[3] * nB[3]); }
#pragma unroll
        for (int o = 1; o < 64; o <<= 1) { ssA += __shfl_xor(ssA, o); ssB += __shfl_xor(ssB, o); }
        const float rsA = rsqrtf(ssA * (1.f / D) + 1e-6f), rsB = rsqrtf(ssB * (1.f / D) + 1e-6f);
        if (mode == 0) { const float* mA = MODN + (size_t)row_modrow(rA) * 6144; const float* mB = MODN + (size_t)row_modrow(rB) * 6144;
#pragma unroll
            for (int h = 0; h < 2; ++h) { float oA[8], oB[8];
#pragma unroll
                for (int q = 0; q < 2; ++q) { const int c = 512 * h + 8 * lane + 4 * q; const f32x4 gn = *(const GAS f32x4*)(gnext + c);
                    const f32x4 yA_ = xA[h][q] * rsA * gn * (1.f + *(const GAS f32x4*)(mA + D + c)) + *(const GAS f32x4*)(mA + c), yB_ = xB[h][q] * rsB * gn * (1.f + *(const GAS f32x4*)(mB + D + c)) + *(const GAS f32x4*)(mB + c);
                    oA[4 * q] = yA_[0]; oA[4 * q + 1] = yA_[1]; oA[4 * q + 2] = yA_[2]; oA[4 * q + 3] = yA_[3]; oB[4 * q] = yB_[0]; oB[4 * q + 1] = yB_[1]; oB[4 * q + 2] = yB_[2]; oB[4 * q + 3] = yB_[3]; }
                v4u w; w.x = pk2(oA[0], oA[1]); w.y = pk2(oA[2], oA[3]); w.z = pk2(oA[4], oA[5]); w.w = pk2(oA[6], oA[7]);
                *(GAS v4u*)(XN + (size_t)rA * D + 512 * h + 8 * lane) = w;
                if (ok1) { w.x = pk2(oB[0], oB[1]); w.y = pk2(oB[2], oB[3]); w.z = pk2(oB[4], oB[5]); w.w = pk2(oB[6], oB[7]); *(GAS v4u*)(XN + (size_t)rB * D + 512 * h + 8 * lane) = w; } }
        } else {
#pragma unroll
            for (int h = 0; h < 2; ++h)
#pragma unroll
                for (int q = 0; q < 2; ++q) { const int c = 512 * h + 8 * lane + 4 * q; const f32x4 gn = *(const GAS f32x4*)(gnext + c);
                    *(GAS f32x4*)(out + (size_t)(rA - NCTX) * D + c) = xA[h][q] * rsA * gn; if (ok1) *(GAS f32x4*)(out + (size_t)(rB - NCTX) * D + c) = xB[h][q] * rsB * gn; }
        }
    }
}
}
namespace mk {
__device__ __forceinline__ void p0_dense_weight(Frame& F, const float* W, int K, int N, bf16* WT, int rot) {
    LAS float* scr = (LAS float*)(F.lds + RING_OFF + F.wave * 16384);
    const int NGW = F.G * NWAVES; const int gw = (F.vcu * NWAVES + F.wave + rot) % NGW;
    const int nb = N / 32, items = (K / 64) * nb;
    for (int it = gw; it < items; it += NGW) { const int kb = it / nb, n0 = (it % nb) * 32; transpose_item(W, N, kb * 64, n0, WT + (size_t)n0 * K + kb * 64, K, scr, lane_now()); }
}
__device__ __forceinline__ void p0_gate_weights(Frame& F, const float* ga, const float* gx, int rot) {
    LAS float* scr = (LAS float*)(F.lds + RING_OFF + F.wave * 16384);
    const int NGW = F.G * NWAVES; const int gw = (F.vcu * NWAVES + F.wave + rot) % NGW;
    bf16* WG = (bf16*)(F.ws + WS_WGATE);
    for (int it = gw; it < 16 * 32; it += NGW) { const int mat = it >> 5, r = it & 31, kb = r >> 3, nbk = r & 7, n0 = nbk * 32; const int ty = mat & 1, dg = mat >> 1;
        const float* W = (ty ? gx : ga) + (size_t)dg * 65536; const int jt = n0 >> 7, rr = (n0 & 127) + (ty ? 128 : 0);
        transpose_item(W, 256, kb * 64, n0, WG + ((size_t)(dg * 2 + jt) * 256 + rr) * 256 + kb * 64, 256, scr, lane_now()); }
}
__device__ __forceinline__ void p0_adaln(Frame& F, const float* c, const float* cctx, const float* w_mod, const float* b_mod) {
    LAS float* sil = (LAS float*)(F.lds + RING_OFF);
    LAS float* part = (LAS float*)(F.lds + RING_OFF + 40960);
    float* MOD = (float*)(F.ws + WS_MOD);
    if (F.vcu >= 192 && F.G >= 256) return;
    for (int idx = tid_now(); idx < 9 * 1024; idx += NTHR) { const float v = idx < 8192 ? c[idx] : cctx[idx - 8192]; sil[idx] = v / (1.f + __expf(-v)); }
    __syncthreads();
    for (int item = F.vcu; item < 192; item += F.G) {
        const int layer = item / 96, n0 = (item % 96) * 64; const float* w = w_mod + (size_t)layer * 1024 * 6144 + n0 + lane_now(); const int k0 = F.wave * 128;
        float acc[9];
#pragma unroll
        for (int b = 0; b < 9; ++b) acc[b] = 0.f;
        for (int kk = 0; kk < 128; kk += 4) { float wv[4];
#pragma unroll
            for (int j = 0; j < 4; ++j) wv[j] = w[(size_t)(k0 + kk + j) * 6144];
#pragma unroll
            for (int b = 0; b < 9; ++b) { const f32x4 s = *(const LAS f32x4*)(sil + b * 1024 + k0 + kk); acc[b] += s[0] * wv[0] + s[1] * wv[1] + s[2] * wv[2] + s[3] * wv[3]; } }
#pragma unroll
        for (int b = 0; b < 9; ++b) part[(F.wave * 9 + b) * 64 + lane_now()] = acc[b];
        __syncthreads();
        for (int q = tid_now(); q < 9 * 64; q += NTHR) { const int b = q >> 6, l = q & 63; float s = 0.f;
#pragma unroll
            for (int wv = 0; wv < 8; ++wv) s += part[(wv * 9 + b) * 64 + l];
            MOD[((size_t)layer * 9 + b) * 6144 + n0 + l] = s + b_mod[layer * 6144 + n0 + l]; }
        __syncthreads();
    }
}
constexpr int TAB_COS = 0, TAB_SIN = 1024, TAB_SP = 2048, TAB_LAM = 4096;
__device__ __forceinline__ void p0_tables(Frame& F, const float* lq1, const float* lk1, const float* lq2, const float* lk2, const float* lru) {
    if (F.vcu != (F.G > 200 ? 200 : 0)) return;
    float* T = (float*)(F.ws + WS_TAB);
    for (int i = tid_now(); i < 1024; i += NTHR) { const int pos = i >> 4, f = i & 15; const float inv = powf(10000.f, -(float)f / 16.f); const float ang = (float)pos * inv; T[TAB_COS + i] = cosf(ang); T[TAB_SIN + i] = sinf(ang); }
    for (int i = tid_now(); i < 2048; i += NTHR) T[TAB_SP + i] = log1pf(expf(-lru[i]));
    if (tid_now() == 0) { float a = 0.f, b = 0.f; for (int i = 0; i < 64; ++i) { a += lq1[i] * lk1[i]; b += lq2[i] * lk2[i]; } T[TAB_LAM] = expf(a) - expf(b) + 0.2f; }
}

__device__ __forceinline__ void phase_norm1_l0(Frame& F, const float* x, const float* ctx, const float* g) {
    bf16* XN = (bf16*)(F.ws + WS_XN); const float* MODL = (const float*)(F.ws + WS_MOD);
    int lane_ = lane_now(); asm volatile("" : "+v"(lane_)); const int lane = lane_;
    const int gw = F.vcu * NWAVES + F.wave, NGW = F.G * NWAVES;
    for (int r = gw; r < NTOK; r += NGW) {
        const float* src = r < NCTX ? ctx + (size_t)r * D : x + (size_t)(r - NCTX) * D; const float* m = MODL + (size_t)row_modrow(r) * 6144;
        f32x4 v[2][2]; float ss = 0.f;
#pragma unroll
        for (int h = 0; h < 2; ++h)
#pragma unroll
            for (int q = 0; q < 2; ++q) { v[h][q] = *(const GAS f32x4*)(src + 512 * h + 8 * lane + 4 * q); ss += (v[h][q][0] * v[h][q][0] + v[h][q][1] * v[h][q][1]) + (v[h][q][2] * v[h][q][2] + v[h][q][3] * v[h][q][3]); }
        const float rstd = rsqrtf(wave_sum(ss) * (1.f / D) + 1e-6f);
#pragma unroll
        for (int h = 0; h < 2; ++h) { float o[8];
#pragma unroll
            for (int q = 0; q < 2; ++q) { const int c = 512 * h + 8 * lane + 4 * q; const f32x4 gn = *(const GAS f32x4*)(g + c), sc = *(const GAS f32x4*)(m + D + c), sh = *(const GAS f32x4*)(m + c);
                const f32x4 y = v[h][q] * rstd * gn * (1.f + sc) + sh; o[4 * q] = y[0]; o[4 * q + 1] = y[1]; o[4 * q + 2] = y[2]; o[4 * q + 3] = y[3]; }
            v4u w; w.x = pk2(o[0], o[1]); w.y = pk2(o[2], o[3]); w.z = pk2(o[4], o[5]); w.w = pk2(o[6], o[7]);
            *(GAS v4u*)(XN + (size_t)r * D + 512 * h + 8 * lane) = w; }
    }
}

struct DenseSched {
    pg8::TileOrder ord; const char* A; const char* W; int a_pitch; int K2;
    __device__ __forceinline__ bool next(int i, pg8::Unit& u) const { return ord.tile(i, u); }
    __device__ __forceinline__ const char* a_base(const pg8::Unit& u) const { return A + (size_t)u.pm * 256 * a_pitch; }
    __device__ __forceinline__ const char* b_base(const pg8::Unit& u) const { return W + (size_t)u.pn * 256 * K2; }
    __device__ __forceinline__ unsigned a_rowoff(const pg8::Unit&, int) const { return 0u; }
};
constexpr float ATT_C2 = 0.125f * 1.4426950408889634f;
struct EpiInProj0 {
    static constexpr bool PERM = false;
    bf16* PROJ; const float* TAB;
    __device__ __forceinline__ void operator()(const pg8::f32x4 (&acc)[2][2][4][2], const pg8::Unit& u, int wr, int wc, int fr, int fq) const {
        const bool rope = u.pn < 4 && u.pm >= 8; const float sc = u.pn < 2 ? ATT_C2 : 1.f; const int axis = wc & 1;
#pragma unroll
        for (int ai = 0; ai < 2; ++ai)
#pragma unroll
            for (int m = 0; m < 4; ++m) { const int r = u.pm * 256 + ai * 128 + wr * 64 + m * 16 + fr;
                pg8::f32x4 cs = (pg8::f32x4){1.f, 1.f, 1.f, 1.f}, sn = (pg8::f32x4){0.f, 0.f, 0.f, 0.f};
                if (rope) { const int t = (r - NCTX) & 2047; const int pos = axis ? (t & 63) : (t >> 6); cs = *(const pg8::f32x4*)(TAB + TAB_COS + pos * 16 + 4 * fq); sn = *(const pg8::f32x4*)(TAB + TAB_SIN + pos * 16 + 4 * fq); }
                bf16* rowp = PROJ + (size_t)r * 3072 + u.pn * 256 + wc * 32 + 4 * fq;
#pragma unroll
                for (int bj = 0; bj < 2; ++bj) { const pg8::f32x4 x1 = acc[ai][bj][m][0], x2 = acc[ai][bj][m][1];
                    const pg8::f32x4 o1 = (x1 * cs - x2 * sn) * sc, o2 = (x2 * cs + x1 * sn) * sc;
                    pg8::u32x2 w1, w2; w1.x = pg8::cvt_pk_bf16(o1[0], o1[1]); w1.y = pg8::cvt_pk_bf16(o1[2], o1[3]); w2.x = pg8::cvt_pk_bf16(o2[0], o2[1]); w2.y = pg8::cvt_pk_bf16(o2[2], o2[3]);
                    *(pg8::u32x2*)(rowp + bj * 128) = w1; *(pg8::u32x2*)(rowp + bj * 128 + 16) = w2; } }
    }
};
struct EpiResid {
    static constexpr bool PERM = false;
    float* XS; const float* x_in; const float* ctx_in; const float* gate;
    int row0;
    __device__ __forceinline__ void operator()(const pg8::f32x4 (&acc)[2][2][4][2], const pg8::Unit& u, int wr, int wc, int fr, int fq) const {
        const int col0 = u.pn * 256 + wc * 32 + 4 * fq;
#pragma unroll
        for (int ai = 0; ai < 2; ++ai)
#pragma unroll
            for (int m = 0; m < 4; ++m) { const int r = row0 + u.pm * 256 + ai * 128 + wr * 64 + m * 16 + fr; const float* g = gate + (size_t)row_modrow(r) * 6144 + col0;
                const float* bp = x_in ? (r < NCTX ? ctx_in + (size_t)r * D : x_in + (size_t)(r - NCTX) * D) : XS + (size_t)r * D; float* op = XS + (size_t)r * D + col0; bp += col0;
#pragma unroll
                for (int bj = 0; bj < 2; ++bj)
#pragma unroll
                    for (int n = 0; n < 2; ++n) { const int o = bj * 128 + n * 16; const pg8::f32x4 gg = *(const pg8::f32x4*)(g + o), bb = *(const pg8::f32x4*)(bp + o);
                        *(pg8::f32x4*)(op + o) = bb + gg * acc[ai][bj][m][n]; }
                if (m & 1) asm volatile("" ::: "memory"); }
    }
};
}
namespace mk {
namespace att {
constexpr int PITCH = 3072;
constexpr int SLOT = 32768, NSL = 3;
constexpr int LDS_SCR = NSL * SLOT;
constexpr int LDS_END = LDS_SCR + 8 * 512;
static_assert(LDS_END <= RING_BYTES, "attention LDS");
__device__ __forceinline__ int crow(int r, int hi) { return (r & 3) + 8 * (r >> 2) + 4 * hi; }
#define ATT_WAIT_BAR(N) asm volatile("s_waitcnt vmcnt(" #N ") lgkmcnt(0)\n\ts_barrier" ::: "memory")
typedef short v4i16_t __attribute__((ext_vector_type(4)));
__device__ __forceinline__ s16x4 vtr(LAS const unsigned char* p) { return __builtin_bit_cast(s16x4, __builtin_amdgcn_ds_read_tr16_b64_v4i16((LAS v4i16_t*)p)); }
__device__ __forceinline__ unsigned cvtpk(float lo, float hi) { typedef float f2 __attribute__((ext_vector_type(2))); typedef __bf16 b2 __attribute__((ext_vector_type(2))); f2 v = {lo, hi}; b2 b = __builtin_convertvector(v, b2); return __builtin_bit_cast(unsigned, b); }
__device__ __forceinline__ float half_swap_max(float m) { auto rr = __builtin_amdgcn_permlane32_swap(__float_as_uint(m), __float_as_uint(m), false, false); return fmaxf(__uint_as_float(rr[0]), __uint_as_float(rr[1])); }
__device__ __forceinline__ float half_swap_sum(float m) { auto rr = __builtin_amdgcn_permlane32_swap(__float_as_uint(m), __float_as_uint(m), false, false); return __uint_as_float(rr[0]) + __uint_as_float(rr[1]); }

__device__ __forceinline__ void attn_unit(LAS unsigned char* lds, const bf16* PROJ, bf16* CAT, const int qrow0, const int krow_ctx, const int krow_lat, const int NT, const int h, const float lam, const float* subln, const int tid) {
    const int lane = tid & 63, r32 = lane & 31, hi = lane >> 5; const int wid = __builtin_amdgcn_readfirstlane(tid >> 6); const int mh = wid >> 2, wq = wid & 3;
    LAS float* wsf = (LAS float*)(lds + LDS_SCR) + wid * 128;
    const bf16* kbase = PROJ + 512 + h * 128 + wid * 8 + (size_t)lane * PITCH;
    const bf16* vbase0 = PROJ + 1024 + h * 128 + ((wid >> 2) * 32) + (lane & 3) * 8 + (size_t)(16 * (wid & 3) + (lane >> 2)) * PITCH;
    const bf16* vbase1 = vbase0 + 64;
#define ATT_DMA(t, slot) do { const size_t kr_ = (size_t)((t) < 4 ? krow_ctx + 64 * (t) : krow_lat + 64 * ((t) - 4)) * PITCH; \
        __builtin_amdgcn_global_load_lds((const unsigned*)(kbase + kr_), (LAS unsigned*)(lds + (slot) * SLOT + wid * 1024), 16, 0, 0); \
        __builtin_amdgcn_global_load_lds((const unsigned*)(kbase + kr_ + 64), (LAS unsigned*)(lds + (slot) * SLOT + 8192 + wid * 1024), 16, 0, 0); \
        __builtin_amdgcn_global_load_lds((const unsigned*)(vbase0 + kr_), (LAS unsigned*)(lds + (slot) * SLOT + 16384 + wid * 1024), 16, 0, 0); \
        __builtin_amdgcn_global_load_lds((const unsigned*)(vbase1 + kr_), (LAS unsigned*)(lds + (slot) * SLOT + 16384 + 8192 + wid * 1024), 16, 0, 0); } while (0)
    ATT_DMA(0, 0); if (NT > 1) ATT_DMA(1, 1);
    const bf16* Qw = PROJ + (size_t)(qrow0 + wq * 32 + r32) * PITCH + h * 128 + mh * 64 + hi * 8;
    bf16x8 qr[4];
#pragma unroll
    for (int d0 = 0; d0 < 4; ++d0) qr[d0] = *(const GAS bf16x8*)(Qw + d0 * 16);
    float mrow = 0.f, l_reg = 0.f; f32x16 o[4]; f32x16 negm;
#pragma unroll
    for (int d0 = 0; d0 < 4; ++d0)
#pragma unroll
        for (int r = 0; r < 16; ++r) o[d0][r] = 0.f;
#pragma unroll
    for (int r = 0; r < 16; ++r) negm[r] = 0.f;
    const int koff = mh * 8192 + hi * 1024 + r32 * 16;
    const int voff = 16384 + ((lane >> 4) & 1) * 32 + (lane & 3) * 8 + (4 * hi + ((lane & 15) >> 2)) * 64;
    int sl = 0;
    for (int t = 0; t < NT; ++t) {
        if (t + 1 < NT) { ATT_WAIT_BAR(4); } else { ATT_WAIT_BAR(0); }
        if (t + 2 < NT) { const int s2 = sl >= 1 ? sl - 1 : 2; ATT_DMA(t + 2, s2); }
        LAS const unsigned char* kp = lds + sl * SLOT + koff; LAS const unsigned char* vp = lds + sl * SLOT + voff;
        f32x16 p0 = negm, p1 = negm;
#pragma unroll
        for (int d0 = 0; d0 < 4; ++d0) { const bf16x8 b0 = *(const LAS bf16x8*)(kp + d0 * 2048), b1 = *(const LAS bf16x8*)(kp + d0 * 2048 + 512);
            p0 = __builtin_amdgcn_mfma_f32_32x32x16_bf16(b0, qr[d0], p0, 0, 0, 0); p1 = __builtin_amdgcn_mfma_f32_32x32x16_bf16(b1, qr[d0], p1, 0, 0, 0); }
        float rm = fmaxf(p0[0], p1[0]);
#pragma unroll
        for (int r = 1; r < 16; ++r) rm = fmaxf(rm, fmaxf(p0[r], p1[r]));
        rm = half_swap_max(rm);
        if (t == 0 || __any(rm > 0.f)) {
            const float dl = t == 0 ? rm : fmaxf(rm, 0.f); mrow += dl;
#pragma unroll
            for (int r = 0; r < 16; ++r) { p0[r] -= dl; p1[r] -= dl; negm[r] = -mrow; }
            if (t > 0) { const float f = __builtin_amdgcn_exp2f(-dl); l_reg *= f; if (hi == 0) wsf[r32] = f; LDS_WAIT();
                float fr_[16];
#pragma unroll
                for (int r = 0; r < 16; ++r) fr_[r] = wsf[crow(r, hi)];
#pragma unroll
                for (int d0 = 0; d0 < 4; ++d0)
#pragma unroll
                    for (int r = 0; r < 16; ++r) o[d0][r] *= fr_[r]; }
        }
        float sacc = 0.f;
#pragma unroll
        for (int r = 0; r < 16; ++r) { p0[r] = __builtin_amdgcn_exp2f(p0[r]); p1[r] = __builtin_amdgcn_exp2f(p1[r]); sacc += p0[r] + p1[r]; }
        l_reg += sacc;
        v4u pw[4];
        pw[0] = (v4u){cvtpk(p0[0], p0[1]), cvtpk(p0[2], p0[3]), cvtpk(p0[4], p0[5]), cvtpk(p0[6], p0[7])};
        pw[1] = (v4u){cvtpk(p0[8], p0[9]), cvtpk(p0[10], p0[11]), cvtpk(p0[12], p0[13]), cvtpk(p0[14], p0[15])};
        pw[2] = (v4u){cvtpk(p1[0], p1[1]), cvtpk(p1[2], p1[3]), cvtpk(p1[4], p1[5]), cvtpk(p1[6], p1[7])};
        pw[3] = (v4u){cvtpk(p1[8], p1[9]), cvtpk(p1[10], p1[11]), cvtpk(p1[12], p1[13]), cvtpk(p1[14], p1[15])};
#pragma unroll
        for (int d0 = 0; d0 < 4; ++d0) {
            s16x4 lo[4], hh[4];
#pragma unroll
            for (int ks = 0; ks < 4; ++ks) { lo[ks] = vtr(vp + d0 * 4096 + ks * 1024); hh[ks] = vtr(vp + d0 * 4096 + ks * 1024 + 512); }
#pragma unroll
            for (int ks = 0; ks < 4; ++ks) { const bf16x8 vf = (bf16x8){lo[ks][0], lo[ks][1], lo[ks][2], lo[ks][3], hh[ks][0], hh[ks][1], hh[ks][2], hh[ks][3]};
                o[d0] = __builtin_amdgcn_mfma_f32_32x32x16_bf16(__builtin_bit_cast(bf16x8, pw[ks]), vf, o[d0], 0, 0, 0); }
        }
        sl = sl == 2 ? 0 : sl + 1;
    }
    l_reg = half_swap_sum(l_reg);
    const float coef = (mh == 0 ? 1.f : -lam) / l_reg;
    if (hi == 0) wsf[64 + r32] = coef;
    ATT_WAIT_BAR(0);
    float cf[16];
#pragma unroll
    for (int r = 0; r < 16; ++r) cf[r] = wsf[64 + crow(r, hi)];
    LAS float* X = (LAS float*)lds + wq * 4096;
    if (mh == 1) {
#pragma unroll
        for (int d0 = 0; d0 < 4; ++d0)
#pragma unroll
            for (int r = 0; r < 16; ++r) X[crow(r, hi) * 128 + d0 * 32 + r32] = o[d0][r] * cf[r];
    }
    ATT_WAIT_BAR(0);
    if (mh == 0) {
        float ssq[16];
#pragma unroll
        for (int r = 0; r < 16; ++r) ssq[r] = 0.f;
#pragma unroll
        for (int d0 = 0; d0 < 4; ++d0)
#pragma unroll
            for (int r = 0; r < 16; ++r) { const float v = o[d0][r] * cf[r] + X[crow(r, hi) * 128 + d0 * 32 + r32]; o[d0][r] = v; ssq[r] += v * v; }
#pragma unroll
        for (int r = 0; r < 16; ++r) { float s = ssq[r]; s += __shfl_xor(s, 1); s += __shfl_xor(s, 2); s += __shfl_xor(s, 4); s += __shfl_xor(s, 8); s += __shfl_xor(s, 16); ssq[r] = rsqrtf(s * (1.f / 128.f) + 1e-6f) * 0.8f; }
        LDS_WAIT();
        LAS bf16* stg = (LAS bf16*)(lds + wq * 16384);
#pragma unroll
        for (int d0 = 0; d0 < 4; ++d0) { const float g = subln[d0 * 32 + r32];
#pragma unroll
            for (int r = 0; r < 16; ++r) stg[crow(r, hi) * 128 + d0 * 32 + r32] = (bf16)f2bf(o[d0][r] * ssq[r] * g); }
        LDS_WAIT();
        bf16* Ow = CAT + (size_t)(qrow0 + wq * 32) * D + h * 128;
#pragma unroll
        for (int i = 0; i < 8; ++i) { const int row = i * 4 + (lane >> 4), ch = lane & 15; const v4u v = *(const LAS v4u*)(stg + row * 128 + ch * 8); *(GAS v4u*)(Ow + (size_t)row * D + ch * 8) = v; }
    }
    ATT_WAIT_BAR(0);
#undef ATT_DMA
}
__device__ __forceinline__ void conv_items(Frame& F, const bf16* PROJ, bf16* CAT, const float* cw) {
    int lane_ = lane_now(); asm volatile("" : "+v"(lane_)); const int lane = lane_;
    const int gw = F.vcu * NWAVES + F.wave, NGW = F.G * NWAVES; const int c0 = 8 * lane;
    float w0[8], w1[8], w2[8];
#pragma unroll
    for (int j = 0; j < 8; ++j) { w0[j] = cw[c0 + j]; w1[j] = cw[512 + c0 + j]; w2[j] = cw[1024 + c0 + j]; }
    for (int it = gw; it < NTOK / 16; it += NGW) {
        const int r0 = it * 16; const int seg0 = r0 < NCTX ? (r0 & ~255) : NCTX + ((r0 - NCTX) & ~2047); const int seg1 = r0 < NCTX ? seg0 + 256 : seg0 + 2048;
        float pm1[8], pc[8], pn[8];
        auto prod = [&](int r, float (&dst)[8]) { if (r < seg0 || r >= seg1) {
#pragma unroll
                for (int j = 0; j < 8; ++j) dst[j] = 0.f; return; }
            const v4u a = *(const GAS v4u*)(PROJ + (size_t)r * att::PITCH + 2048 + c0), b = *(const GAS v4u*)(PROJ + (size_t)r * att::PITCH + 2560 + c0);
            dst[0] = bf_lo(a.x) * bf_lo(b.x); dst[1] = bf_hi(a.x) * bf_hi(b.x); dst[2] = bf_lo(a.y) * bf_lo(b.y); dst[3] = bf_hi(a.y) * bf_hi(b.y);
            dst[4] = bf_lo(a.z) * bf_lo(b.z); dst[5] = bf_hi(a.z) * bf_hi(b.z); dst[6] = bf_lo(a.w) * bf_lo(b.w); dst[7] = bf_hi(a.w) * bf_hi(b.w); };
        prod(r0 - 1, pm1); prod(r0, pc);
        for (int i = 0; i < 16; ++i) { const int r = r0 + i; prod(r + 1, pn);
            const v4u g = *(const GAS v4u*)(PROJ + (size_t)r * att::PITCH + 1536 + c0); const float bg[8] = {bf_lo(g.x), bf_hi(g.x), bf_lo(g.y), bf_hi(g.y), bf_lo(g.z), bf_hi(g.z), bf_lo(g.w), bf_hi(g.w)};
            float o[8];
#pragma unroll
            for (int j = 0; j < 8; ++j) { o[j] = bg[j] * (w0[j] * pm1[j] + w1[j] * pc[j] + w2[j] * pn[j]); pm1[j] = pc[j]; pc[j] = pn[j]; }
            v4u w; w.x = pk2(o[0], o[1]); w.y = pk2(o[2], o[3]); w.z = pk2(o[4], o[5]); w.w = pk2(o[6], o[7]);
            *(GAS v4u*)(CAT + (size_t)r * D + 512 + c0) = w; }
    }
}
}
__device__ __forceinline__ void phase_attn(Frame& F, const float* subln, const float* cw) {
    const bf16* PROJ = (const bf16*)(F.ws + WS_PROJ); bf16* CAT = (bf16*)(F.ws + WS_CAT); const float lam = ((const float*)(F.ws + WS_TAB))[TAB_LAM];
    int tid_ = tid_now(); asm volatile("" : "+v"(tid_));
    for (int u = 2 * F.vcu; u < 512; u += 2 * F.G)
        for (int j = 0; j < 2; ++j) { const int uu = u + j; const int bh = uu >> 4, qb = uu & 15, b = bh >> 2, h = bh & 3;
            att::attn_unit(F.lds + RING_OFF, PROJ, CAT, NCTX + b * SEQ + qb * 128, b * CT, NCTX + b * SEQ, 36, h, lam, subln, tid_); }
    for (int u = F.vcu; u < 64; u += F.G) { const int bh = u >> 1, qb = u & 1, b = bh >> 2, h = bh & 3;
        att::attn_unit(F.lds + RING_OFF, PROJ, CAT, b * CT + qb * 128, b * CT, NCTX + b * SEQ, 4, h, lam, subln, tid_); }
    att::conv_items(F, PROJ, CAT, cw);
}
}
namespace mk {
struct EpiBf16 {
    static constexpr bool PERM = true;
    bf16* O; int ldc;
    __device__ __forceinline__ void operator()(const pg8::f32x4 (&acc)[2][2][4][2], const pg8::Unit& u, int wr, int wc, int fr, int fq) const {
        const int col0 = u.pn * 256 + wc * 32 + 8 * fq;
#pragma unroll
        for (int ai = 0; ai < 2; ++ai)
#pragma unroll
            for (int m = 0; m < 4; ++m) { bf16* rowp = O + (size_t)(u.pm * 256 + ai * 128 + wr * 64 + m * 16 + fr) * ldc + col0;
#pragma unroll
                for (int bj = 0; bj < 2; ++bj) { const pg8::f32x4 v0 = acc[ai][bj][m][0], v1 = acc[ai][bj][m][1];
                    pg8::u32x4 w; w.x = pg8::cvt_pk_bf16(v0[0], v0[1]); w.y = pg8::cvt_pk_bf16(v0[2], v0[3]); w.z = pg8::cvt_pk_bf16(v1[0], v1[1]); w.w = pg8::cvt_pk_bf16(v1[2], v1[3]);
                    *(pg8::u32x4*)(rowp + bj * 128) = w; } }
    }
};
struct InProj1Sched {
    pg8::TileOrder ord; int G, c; const char* A; const char* W; int a_pitch;
    __device__ __forceinline__ bool next(int i, pg8::Unit& u) const { const int L = i * G + c; if (L >= 544) return false;
        if (L < 512) { ord.map(L, u); u.pm += 8; } else { const int q = L - 512; u.pm = q >> 2; u.pn = 4 + (q & 3); } return true; }
    __device__ __forceinline__ const char* a_base(const pg8::Unit& u) const { return A + (size_t)u.pm * 256 * 2048; }
    __device__ __forceinline__ const char* b_base(const pg8::Unit& u) const { return W + (size_t)u.pn * 256 * 2048; }
    __device__ __forceinline__ unsigned a_rowoff(const pg8::Unit&, int) const { return 0u; }
};
__device__ __forceinline__ void phase_conv1(Frame& F, const float* cw, const float* cb) {
    const bf16* GU = (const bf16*)(F.ws + WS_PROJ); bf16* XC = (bf16*)(F.ws + WS_XC);
    int lane_ = lane_now(); asm volatile("" : "+v"(lane_)); const int lane = lane_;
    const int gw = F.vcu * NWAVES + F.wave, NGW = F.G * NWAVES;
    for (int it = gw; it < (NTOK / 16) * 2; it += NGW) {
        const int r0 = (it >> 1) * 16, c0 = (it & 1) * 512 + 8 * lane; const int seg0 = r0 < NCTX ? (r0 & ~255) : NCTX + ((r0 - NCTX) & ~2047); const int seg1 = r0 < NCTX ? seg0 + 256 : seg0 + 2048;
        float wf[4][8], wb[4][8], bf_[8], bb_[8];
#pragma unroll
        for (int j = 0; j < 8; ++j) { bf_[j] = cb[c0 + j]; bb_[j] = cb[1024 + c0 + j];
#pragma unroll
            for (int k = 0; k < 4; ++k) { wf[k][j] = cw[k * 1024 + c0 + j]; wb[k][j] = cw[(4 + k) * 1024 + c0 + j]; } }
        float win[7][8];
        auto ld = [&](int r, float (&dst)[8]) { if (r < seg0 || r >= seg1) {
#pragma unroll
                for (int j = 0; j < 8; ++j) dst[j] = 0.f; return; }
            const v4u a = *(const GAS v4u*)(GU + (size_t)r * 2048 + 1024 + c0);
            dst[0] = bf_lo(a.x); dst[1] = bf_hi(a.x); dst[2] = bf_lo(a.y); dst[3] = bf_hi(a.y); dst[4] = bf_lo(a.z); dst[5] = bf_hi(a.z); dst[6] = bf_lo(a.w); dst[7] = bf_hi(a.w); };
#pragma unroll
        for (int q = 0; q < 6; ++q) ld(r0 - 3 + q, win[q + 1]);
#pragma unroll 4
        for (int i = 0; i < 16; ++i) { const int r = r0 + i;
#pragma unroll
            for (int q = 0; q < 6; ++q)
#pragma unroll
                for (int j = 0; j < 8; ++j) win[q][j] = win[q + 1][j];
            ld(r + 3, win[6]);
            float of[8], ob[8];
#pragma unroll
            for (int j = 0; j < 8; ++j) { of[j] = bf_[j] + wf[0][j] * win[0][j] + wf[1][j] * win[1][j] + wf[2][j] * win[2][j] + wf[3][j] * win[3][j];
                ob[j] = bb_[j] + wb[0][j] * win[3][j] + wb[1][j] * win[4][j] + wb[2][j] * win[5][j] + wb[3][j] * win[6][j]; }
            v4u w; w.x = pk2(of[0], of[1]); w.y = pk2(of[2], of[3]); w.z = pk2(of[4], of[5]); w.w = pk2(of[6], of[7]);
            *(GAS v4u*)(XC + (size_t)r * D + c0) = w;
            w.x = pk2(ob[0], ob[1]); w.y = pk2(ob[2], ob[3]); w.z = pk2(ob[4], ob[5]); w.w = pk2(ob[6], ob[7]);
            *(GAS v4u*)(XC + ((size_t)NTOK + r) * D + c0) = w; }
    }
}
struct GateSched {
    pg8::TileOrder ord; const char* XC; const char* W; int a_pitch;
    __device__ __forceinline__ bool next(int i, pg8::Unit& u) const { return ord.tile(i, u); }
    __device__ __forceinline__ const char* a_base(const pg8::Unit& u) const { const int d = u.pm >= 72 ? 1 : 0, rt = u.pm - 72 * d; return XC + ((size_t)d * NTOK + (size_t)rt * 256) * 2048 + (u.pn >> 1) * 512; }
    __device__ __forceinline__ const char* b_base(const pg8::Unit& u) const { const int d = u.pm >= 72 ? 1 : 0; return W + (size_t)(d * 8 + u.pn) * 256 * 512; }
    __device__ __forceinline__ unsigned a_rowoff(const pg8::Unit&, int) const { return 0u; }
};
struct EpiGate {
    static constexpr bool PERM = true;
    const bf16* XC; unsigned* AB; const float* gab; const float* gxb; const float* SP;
    __device__ __forceinline__ void operator()(const pg8::f32x4 (&acc)[2][2][4][2], const pg8::Unit& u, int wr, int wc, int fr, int fq) const {
        const int d = u.pm >= 72 ? 1 : 0, rt = u.pm - 72 * d; const int ch0 = (u.pn >> 1) * 256 + (u.pn & 1) * 128 + wc * 32 + 8 * fq;
#pragma unroll
        for (int ai = 0; ai < 2; ++ai)
#pragma unroll
            for (int m = 0; m < 4; ++m) { const size_t row = (size_t)d * NTOK + rt * 256 + ai * 128 + wr * 64 + m * 16 + fr;
#pragma unroll
                for (int n = 0; n < 2; ++n) {
                    asm volatile("" ::: "memory");
                    const int ch = ch0 + 4 * n; const pg8::f32x4 ba = *(const pg8::f32x4*)(gab + d * 1024 + ch), bx = *(const pg8::f32x4*)(gxb + d * 1024 + ch), sp = *(const pg8::f32x4*)(SP + d * 1024 + ch);
                    const v2u xw = *(const GAS v2u*)(XC + row * D + ch); const float xc[4] = {bf_lo(xw.x), bf_hi(xw.x), bf_lo(xw.y), bf_hi(xw.y)};
                    unsigned o[4];
#pragma unroll
                    for (int i = 0; i < 4; ++i) { const float rp = acc[ai][0][m][n][i] + ba[i], ip = acc[ai][1][m][n][i] + bx[i];
                        const float rg = __builtin_amdgcn_rcpf(1.f + __builtin_amdgcn_exp2f(-1.4426950408889634f * rp)), ig = __builtin_amdgcn_rcpf(1.f + __builtin_amdgcn_exp2f(-1.4426950408889634f * ip));
                        const float la2 = rg * sp[i] * (-8.f * 1.4426950408889634f); const float a = __builtin_amdgcn_exp2f(la2); const float bv = __builtin_amdgcn_sqrtf(fmaxf(1.f - a * a, 0.f)) * ig * xc[i];
                        o[i] = (f2bf(la2) << 16) | f2bf(bv); }
                    *(GAS v4u*)(AB + row * D + ch) = (v4u){o[0], o[1], o[2], o[3]}; } }
    }
};
__device__ __forceinline__ void phase_scan1(Frame& F) {
    const unsigned* AB = (const unsigned*)(F.ws + WS_AB); f32x2* SUM = (f32x2*)(F.ws + WS_SUM);
    int lane_ = lane_now(); asm volatile("" : "+v"(lane_)); const int lane = lane_;
    const int gw = F.vcu * NWAVES + F.wave, NGW = F.G * NWAVES;
    for (int it = gw; it < 2 * 288 * 16; it += NGW) {
        const int cg = it & 15, sc = (it >> 4) % 288, d = it / (288 * 16); const int c = cg * 64 + lane;
        const unsigned* p = AB + ((size_t)d * NTOK + sc * 64) * D + c; float h = 0.f, la = 0.f;
#pragma unroll
        for (int blk = 0; blk < 4; ++blk) { unsigned w[16];
#pragma unroll
            for (int i = 0; i < 16; ++i) { const int row = d == 0 ? blk * 16 + i : 63 - (blk * 16 + i); w[i] = p[(size_t)row * D]; }
#pragma unroll
            for (int i = 0; i < 16; ++i) { const float l2 = bf_hi(w[i]), b = bf_lo(w[i]); la += l2; h = __builtin_amdgcn_exp2f(l2) * h + b; } }
        SUM[((size_t)d * 288 + sc) * D + c] = (f32x2){la, h};
    }
}
__device__ __forceinline__ void phase_scan2(Frame& F) {
    const unsigned* AB = (const unsigned*)(F.ws + WS_AB); const f32x2* SUM = (const f32x2*)(F.ws + WS_SUM); const bf16* GU = (const bf16*)(F.ws + WS_PROJ); bf16* CAT = (bf16*)(F.ws + WS_CAT);
    int lane_ = lane_now(); asm volatile("" : "+v"(lane_)); const int lane = lane_;
    const int gw = F.vcu * NWAVES + F.wave, NGW = F.G * NWAVES;
    for (int it = gw; it < 8 * 32 * 16; it += NGW) {
        const int cg = it & 15, s = (it >> 4) & 31, b = it >> 9; const int c = cg * 64 + lane;
        float hf = 0.f, hb = 0.f;
        for (int q = 0; q < 4 + s; ++q) { const int sc = q < 4 ? b * 4 + q : 32 + b * 32 + (q - 4); const f32x2 v = SUM[(size_t)sc * D + c]; hf = __builtin_amdgcn_exp2f(v[0]) * hf + v[1]; }
        for (int q = 0; q < 4 + (31 - s); ++q) { const int sc = q < 4 ? b * 4 + (3 - q) : 32 + b * 32 + (31 - (q - 4)); const f32x2 v = SUM[((size_t)288 + sc) * D + c]; hb = __builtin_amdgcn_exp2f(v[0]) * hb + v[1]; }
        const size_t row0 = (size_t)NCTX + (size_t)b * SEQ + s * 64;
        float hfv[64];
#pragma unroll
        for (int blk = 0; blk < 4; ++blk) { unsigned w[16];
#pragma unroll
            for (int i = 0; i < 16; ++i) w[i] = AB[(row0 + blk * 16 + i) * D + c];
#pragma unroll
            for (int i = 0; i < 16; ++i) { hf = __builtin_amdgcn_exp2f(bf_hi(w[i])) * hf + bf_lo(w[i]); hfv[blk * 16 + i] = hf; } }
#pragma unroll
        for (int blk = 3; blk >= 0; --blk) { unsigned w[16]; unsigned short gt[16];
#pragma unroll
            for (int i = 0; i < 16; ++i) { const size_t row = row0 + blk * 16 + 15 - i; w[i] = AB[((size_t)NTOK + row) * D + c]; gt[i] = GU[row * 2048 + c]; }
#pragma unroll
            for (int i = 0; i < 16; ++i) { const int ri = blk * 16 + 15 - i; hb = __builtin_amdgcn_exp2f(bf_hi(w[i])) * hb + bf_lo(w[i]);
                const float g = bf_lo((unsigned)gt[i]); const float z = 0.7978845608028654f * (g + 0.044715f * g * g * g);
                const float th = 1.f - 2.f * __builtin_amdgcn_rcpf(__builtin_amdgcn_exp2f(2.f * 1.4426950408889634f * z) + 1.f);
                CAT[(row0 + ri) * D + c] = (bf16)f2bf((hfv[ri] + hb) * (0.5f * g * (1.f + th))); } }
    }
}
}
namespace mk {
#define IN(k) (lo <= (k) && (k) < hi)
#define SEAM(k) do { if (IN(k) && IN((k) + 1)) xcd_barrier(bar); } while (0)
template <int LAYER> __device__ __forceinline__ void moe_section(Frame& F, const Args& args, const XcdBarrier& bar, const int lo, const int hi) {
        constexpr int layer = LAYER; constexpr int mb = layer == 0 ? 5 : 15;
        constexpr int row0 = layer == 0 ? 0 : NCTX, nrows = layer == 0 ? NTOK : NLAT;
        if (IN(mb)) phase_router(F, layer, row0, nrows, args.in[7] + layer * D, args.in[25] + (size_t)layer * D * 32, args.in[26] + layer * 32);
        SEAM(mb);
        if (IN(mb + 1)) {
            moe_table(F, layer);
            LAS const int* tab = (LAS const int*)(F.misc + MISC_TAB); const int T = *(LAS const int*)(F.misc + MISC_NT);
            MoeSched1 S; S.ord.init(T, 8, F.G, (int)blockIdx.x); S.tab = tab; S.cntl = (LAS const int*)(F.misc + MISC_CNT); S.XN = (const char*)(F.ws + WS_XN);
            S.W = (const char*)(F.ws + WS_W1) + (size_t)layer * 32 * 2048 * (size_t)W1_KB; S.list = (const int*)(F.ws + WS_ROUTE + RT_LIST); S.a_pitch = W1_KB; S.wb = W1_KB;
            EpiSwiglu E{(bf16*)(F.ws + WS_HB), args.in[28] + (size_t)layer * 32 * 2048, tab};
            pg8::gemm_phase<EpiSwiglu, MoeSched1, true, FP8_G1, 122>(F.lds + RING_OFF, W1_KB, S, E);
        }
        SEAM(mb + 1);
        if (IN(mb + 2)) {
            moe_table(F, layer);
            LAS const int* tab = (LAS const int*)(F.misc + MISC_TAB); const int T = *(LAS const int*)(F.misc + MISC_NT);
            MoeSched2 S; S.ord.init(T, 4, F.G, (int)blockIdx.x); S.tab = tab; S.HB = (const char*)(F.ws + WS_HB); S.W = (const char*)(F.ws + WS_W2) + (size_t)layer * 32 * 1024 * (size_t)W2_KB; S.a_pitch = W2_KB; S.wb = W2_KB;
            EpiBias2 E{(bf16*)(F.ws + WS_Y2), args.in[30] + (size_t)layer * 32 * 1024, tab};
            pg8::gemm_phase<EpiBias2, MoeSched2, false, FP8_G2, 122>(F.lds + RING_OFF, W2_KB, S, E);
        }
        SEAM(mb + 2);
        if (IN(mb + 3)) {
            moe_table(F, layer);
            if (layer == 0) phase_combine(F, 0, row0, nrows, 0, args.in[6] + D, (const float*)(F.ws + WS_MOD) + (size_t)9 * 6144, args.out);
            else phase_combine(F, 1, row0, nrows, 1, args.in[31], nullptr, args.out);
        }
        SEAM(mb + 3);
}
#undef IN
#undef SEAM
constexpr int NPHASE = 19;
__global__ void __launch_bounds__(NTHR, 2) mk_fwd(Args args) {
    extern __shared__ __attribute__((aligned(16))) unsigned char lds_raw[];
    Frame F;
    F.lds = (LAS unsigned char*)lds_raw; F.misc = F.lds + MISC_OFF;
    F.wave = __builtin_amdgcn_readfirstlane(tid_now() >> 6);
    F.G = gridDim.x; { const int bx = blockIdx.x; F.vcu = (F.G % 8 == 0) ? (bx % 8) * (F.G / 8) + bx / 8 : bx; }
    F.ws = args.ws; F.ctl = (gu32*)(args.ws + WS_CTL);
    for (int u = tid_now(); u < (LDS_BYTES - MISC_OFF) / 4; u += NTHR) ((LAS unsigned*)F.misc)[u] = 0u;
    __syncthreads();
    const int lo = args.ph_lo, hi = args.ph_hi;
    XcdBarrier bar = xcd_barrier_post((unsigned*)(F.ctl + CW_BAR) + args.li * XCD_BAR_WORDS, (volatile LAS unsigned*)(F.misc + MISC_BAR));
#define IN(k) (lo <= (k) && (k) < hi)
#define SEAM(k) do { if (IN(k) && IN((k) + 1)) xcd_barrier(bar); } while (0)

    if (IN(0)) {
        p0_adaln(F, args.in[1], args.in[3], args.in[4], args.in[5]);
        p0_tables(F, args.in[10], args.in[11], args.in[12], args.in[13], args.in[24]);
        __syncthreads();
        p0_dense_weight(F, args.in[8], 1024, 3072, (bf16*)(F.ws + WS_WIN0), 0);
        p0_dense_weight(F, args.in[9], 1024, 1024, (bf16*)(F.ws + WS_WOUT0), 1536);
        p0_dense_weight(F, args.in[16], 1024, 2048, (bf16*)(F.ws + WS_WIN1), 0);
        p0_dense_weight(F, args.in[17], 1024, 1024, (bf16*)(F.ws + WS_WOUT1), 1024);
        p0_gate_weights(F, args.in[20], args.in[22], 1536);
        p0_moe_weights(F, args.in[27], args.in[29], 0);
        p0_moe_weights(F, args.in[27], args.in[29], 1);
    }
    SEAM(0);
    if (IN(1)) phase_norm1_l0(F, args.in[0], args.in[2], args.in[6]);
    SEAM(1);
    if (IN(2)) {
        DenseSched S; S.ord.init(NTOK / 256, 12, F.G, (int)blockIdx.x); S.A = (const char*)(F.ws + WS_XN); S.W = (const char*)(F.ws + WS_WIN0); S.a_pitch = 2048; S.K2 = 2048;
        EpiInProj0 E{(bf16*)(F.ws + WS_PROJ), (const float*)(F.ws + WS_TAB)};
        pg8::gemm_phase<EpiInProj0, DenseSched, false>(F.lds + RING_OFF, 2048, S, E);
    }
    SEAM(2);
    if (IN(3)) phase_attn(F, args.in[14], args.in[15]);
    SEAM(3);
    if (IN(4)) {
        DenseSched S; S.ord.init(NTOK / 256, 4, F.G, (int)blockIdx.x); S.A = (const char*)(F.ws + WS_CAT); S.W = (const char*)(F.ws + WS_WOUT0); S.a_pitch = 2048; S.K2 = 2048;
        EpiResid E{(float*)(F.ws + WS_XS), args.in[0], args.in[2], (const float*)(F.ws + WS_MOD) + 2 * D, 0};
        pg8::gemm_phase<EpiResid, DenseSched, false>(F.lds + RING_OFF, 2048, S, E);
    }
    SEAM(4);

    moe_section<0>(F, args, bar, lo, hi);
    if (IN(9)) {
        InProj1Sched S; S.ord.init(64, 8, F.G, (int)blockIdx.x); S.G = F.G; S.c = (int)blockIdx.x; S.A = (const char*)(F.ws + WS_XN); S.W = (const char*)(F.ws + WS_WIN1); S.a_pitch = 2048;
        EpiBf16 E{(bf16*)(F.ws + WS_PROJ), 2048};
        pg8::gemm_phase<EpiBf16, InProj1Sched, false>(F.lds + RING_OFF, 2048, S, E);
    }
    SEAM(9);
    if (IN(10)) phase_conv1(F, args.in[18], args.in[19]);
    SEAM(10);
    if (IN(11)) {
        GateSched S; S.ord.init(144, 8, F.G, (int)blockIdx.x); S.XC = (const char*)(F.ws + WS_XC); S.W = (const char*)(F.ws + WS_WGATE); S.a_pitch = 2048;
        EpiGate E{(const bf16*)(F.ws + WS_XC), (unsigned*)(F.ws + WS_AB), args.in[21], args.in[23], (const float*)(F.ws + WS_TAB) + TAB_SP};
        pg8::gemm_phase<EpiGate, GateSched, false>(F.lds + RING_OFF, 512, S, E);
    }
    SEAM(11);
    if (IN(12)) phase_scan1(F);
    SEAM(12);
    if (IN(13)) phase_scan2(F);
    SEAM(13);
    if (IN(14)) {
        DenseSched S; S.ord.init(NLAT / 256, 4, F.G, (int)blockIdx.x); S.A = (const char*)(F.ws + WS_CAT) + (size_t)NCTX * 2048; S.W = (const char*)(F.ws + WS_WOUT1); S.a_pitch = 2048; S.K2 = 2048;
        EpiResid E{(float*)(F.ws + WS_XS), nullptr, nullptr, (const float*)(F.ws + WS_MOD) + (size_t)9 * 6144 + 2 * D, NCTX};
        pg8::gemm_phase<EpiResid, DenseSched, false>(F.lds + RING_OFF, 2048, S, E);
    }
    SEAM(14);
    moe_section<1>(F, args, bar, lo, hi);
#undef IN
#undef SEAM
}

struct Launcher { int grid; bool ok; };
inline Launcher& launcher() {
    static Launcher L{0, false};
    if (L.grid == 0) {
        int dev = 0, cus = 0, per_cu = 0;
        if (hipGetDevice(&dev) != hipSuccess || hipDeviceGetAttribute(&cus, hipDeviceAttributeMultiprocessorCount, dev) != hipSuccess) { fprintf(stderr, "mk: device query failed\n"); L.grid = -1; return L; }
        if (hipFuncSetAttribute((const void*)mk_fwd, hipFuncAttributeMaxDynamicSharedMemorySize, LDS_BYTES) != hipSuccess) { fprintf(stderr, "mk: hipFuncSetAttribute failed\n"); L.grid = -1; return L; }
        if (hipOccupancyMaxActiveBlocksPerMultiprocessor(&per_cu, (const void*)mk_fwd, NTHR, LDS_BYTES) != hipSuccess || per_cu < 1) fprintf(stderr, "mk: note: occupancy query reports %d\n", per_cu);
        (void)hipGetLastError();
        L.grid = cus; L.ok = true;
    }
    return L;
}
inline void launch(hipStream_t st, void* const* d_in, float* out, unsigned char* ws, int ph_lo, int ph_hi, int li) {
    Launcher& L = launcher(); if (L.grid <= 0) return;
    Args a{}; for (int i = 0; i < 32; ++i) a.in[i] = (const float*)d_in[i];
    a.out = out; a.ws = ws; a.ph_lo = ph_lo; a.ph_hi = ph_hi; a.li = li; a.pad = 0;
    hipLaunchKernelGGL(mk_fwd, dim3(L.grid), dim3(NTHR), LDS_BYTES, st, a);
}
}
extern "C" void kernel_launch(void* const* d_in, const int* in_sizes, int n_in, void* d_out, int out_size, void* d_ws, size_t ws_size, hipStream_t stream) {
    unsigned char* ws = (unsigned char*)d_ws;
    if (mk::WS_END > ws_size) { fprintf(stderr, "kernel_launch: workspace too small: need %zu have %zu\n", (size_t)mk::WS_END, ws_size); return; }
    (void)hipMemsetAsync(ws + mk::WS_CTL, 0, mk::CTL_ZERO_BYTES, stream);
    mk::launch(stream, d_in, (float*)d_out, ws, 0, 19, 0);
}
```

```cpp
#define MK_FP8_G1 1
#define MK_FP8_G2 1
#include <hip/hip_runtime.h>
#include <cstdio>
#include <cstdint>
__device__ __forceinline__ int lane_now() { int l = (int)__builtin_amdgcn_mbcnt_hi(~0u, __builtin_amdgcn_mbcnt_lo(~0u, 0u)); asm volatile("" : "+v"(l)); return l; }
namespace pg8 {
#define PG8_LAS __attribute__((address_space(3)))
typedef unsigned short bf16_t;
typedef short bf16x8 __attribute__((ext_vector_type(8)));
typedef float f32x4 __attribute__((ext_vector_type(4)));
typedef float f32x2 __attribute__((ext_vector_type(2)));
typedef unsigned u32x4 __attribute__((ext_vector_type(4)));
typedef unsigned u32x2 __attribute__((ext_vector_type(2)));
constexpr int BM = 256, BK = 64, HALF = 128, HTB = HALF * BK * 2  , STAGE_BYTES = 8 * HTB, NXCD = 8, WGM = 8;

__host__ __device__ __forceinline__ int lds_byte(int r, int c) { const int st = (r >> 4) * 2 + (c >> 5), rr = r & 15, cc = c & 31, ob = rr * 64 + cc * 2; return st * 1024 + (ob ^ (((ob >> 9) & 1) << 5)); }
__host__ __device__ __forceinline__ void stage_rc(int b, int& R, int& C) { const int st = b / 1024, sb = b % 1024, swz = sb ^ (((sb >> 9) & 1) << 5); R = (st >> 1) * 16 + swz / 64; C = (st & 1) * 32 + (swz % 64) / 2; }
__host__ __device__ __forceinline__ int perm32(int rho) { const int n = rho >> 4, i = rho & 15; return 8 * (i >> 2) + 4 * n + (i & 3); }

struct Unit { int pm, pn; };

struct TileOrder {
    int nM, nN, nwg, G, c;
    __device__ __forceinline__ void init(int nM_, int nN_, int G_, int c_) { nM = nM_; nN = nN_; nwg = nM * nN; G = G_; c = c_; }
    __device__ __forceinline__ bool tile(int i, Unit& u) const { const long L = (long)i * G + c; if (L >= nwg) return false; map((int)L, u); return true; }
    __device__ __forceinline__ bool early() const { const int mine = nwg > c ? (nwg - 1 - c) / G + 1 : 0; return mine < (nwg + G - 1) / G; }
    __device__ __forceinline__ void map(int L, Unit& u) const {
        int wgid = L; { const int q = nwg / NXCD, r = nwg % NXCD, xcd = wgid % NXCD, off = wgid / NXCD; wgid = (xcd < r ? xcd * (q + 1) : r * (q + 1) + (xcd - r) * q) + off; }
        const int nig = WGM * nN, gid = wgid / nig, fm = gid * WGM, gsz = (nM - fm) < WGM ? (nM - fm) : WGM;
        u.pm = fm + ((wgid % nig) % gsz); u.pn = (wgid % nig) / gsz;
    }
};

__device__ __forceinline__ unsigned cvt_pk_bf16(float lo, float hi) { unsigned r; asm volatile("v_cvt_pk_bf16_f32 %0, %1, %2" : "=v"(r) : "v"(lo), "v"(hi)); return r; }

template <class Epi, class Sched, bool GATHER, bool FP8 = false, int SCALE_W = 127>
__device__ __forceinline__ void gemm_phase(PG8_LAS unsigned char* lds, const int Kb, const Sched& S, const Epi& E, const int wave_id) {
    int tid_ = wave_id * 64 + lane_now(); asm volatile("" : "+v"(tid_));
    const int tid = tid_, wid = __builtin_amdgcn_readfirstlane(tid >> 6), lane = tid & 63, wr = wid >> 2, wc = wid & 3, fr = lane & 15, fq = lane >> 4;
    const int nt = Kb / 128;
    unsigned voffB[2];
    unsigned offA[2][2], noffA[2][2];
#pragma unroll
    for (int i = 0; i < 2; ++i) { int R, C; stage_rc(tid * 16 + i * 8192, R, C); const int Rb = Epi::PERM ? ((R & ~31) + perm32(R & 31)) : R;
        voffB[i] = (unsigned)(Rb * Kb + C * 2);
        offA[0][i] = (unsigned)(R * S.a_pitch + C * 2); offA[1][i] = (unsigned)((R + HALF) * S.a_pitch + C * 2); noffA[0][i] = offA[0][i]; noffA[1][i] = offA[1][i]; }
    const size_t kstep = (size_t)(BK * 2);
    const size_t hstepB = (size_t)HALF * Kb;
    const unsigned ldsw = (unsigned)wid * 1024u;
    const int aoff = lds_byte(wr * 64 + fr, fq * 8), boff = lds_byte(wc * 32 + fr, fq * 8);
#define PG8_SA(b, h) (((b) * 2 + (h)) * HTB)
#define PG8_SB(b, h) ((4 + (b) * 2 + (h)) * HTB)
#define PG8_STAGE(bufoff, gbase, voff) do { const char* gb_ = (const char*)(gbase); asm volatile("" : "+s"(gb_));     \
        _Pragma("unroll") for (int _i = 0; _i < 2; ++_i) \
        __builtin_amdgcn_global_load_lds((const unsigned*)(gb_ + (voff)[_i]), (PG8_LAS unsigned*)(lds + (bufoff) + ldsw + _i * 8192), 16, 0, 0); } while (0)
    typedef int v4i_ __attribute__((ext_vector_type(4))); typedef int v8i_ __attribute__((ext_vector_type(8)));
#define PG8_LDA(dst, b, h) do { _Pragma("unroll") for (int m = 0; m < 4; ++m) { if constexpr (FP8) { const v4i_ lo_ = *(const PG8_LAS v4i_*)(lds + PG8_SA(b, h) + aoff + m * 2048), hi_ = *(const PG8_LAS v4i_*)(lds + PG8_SA(b, h) + aoff + m * 2048 + 1024); \
            dst##8[m] = __builtin_shufflevector(lo_, hi_, 0, 1, 2, 3, 4, 5, 6, 7); } else { _Pragma("unroll") for (int k = 0; k < 2; ++k) dst[m][k] = *(const PG8_LAS bf16x8*)(lds + PG8_SA(b, h) + aoff + m * 2048 + k * 1024); } } } while (0)
#define PG8_LDB(dst, b, h) do { _Pragma("unroll") for (int n = 0; n < 2; ++n) { if constexpr (FP8) { const v4i_ lo_ = *(const PG8_LAS v4i_*)(lds + PG8_SB(b, h) + boff + n * 2048), hi_ = *(const PG8_LAS v4i_*)(lds + PG8_SB(b, h) + boff + n * 2048 + 1024); \
            dst##8[n] = __builtin_shufflevector(lo_, hi_, 0, 1, 2, 3, 4, 5, 6, 7); } else { _Pragma("unroll") for (int k = 0; k < 2; ++k) dst[n][k] = *(const PG8_LAS bf16x8*)(lds + PG8_SB(b, h) + boff + n * 2048 + k * 1024); } } } while (0)
#define PG8_MMA(ai, bj, At, Bt) do { __builtin_amdgcn_s_setprio(1); _Pragma("unroll") for (int m = 0; m < 4; ++m) _Pragma("unroll") for (int n = 0; n < 2; ++n) { \
        if constexpr (FP8) { asm volatile("v_mfma_scale_f32_16x16x128_f8f6f4 %0, %1, %2, %0, %3, %4 op_sel_hi:[0,0,0]" : "+v"(acc[ai][bj][m][n]) : "v"(Bt##8[n]), "v"(At##8[m]), "v"(sclw_), "v"(scla_)); } \
        else { _Pragma("unroll") for (int k = 0; k < 2; ++k) acc[ai][bj][m][n] = __builtin_amdgcn_mfma_f32_16x16x32_bf16(Bt[n][k], At[m][k], acc[ai][bj][m][n], 0, 0, 0); } } \
        __builtin_amdgcn_s_setprio(0); } while (0)
#define PG8_WAIT_V(n) asm volatile("s_waitcnt vmcnt(" #n ")" ::: "memory")
#define PG8_WAIT_L(n) asm volatile("s_waitcnt lgkmcnt(" #n ")" ::: "memory")
#define PG8_BAR __builtin_amdgcn_s_barrier()
#define PG8_SCHED __builtin_amdgcn_sched_barrier(0)
    int sclw_ = SCALE_W, scla_ = 127; asm volatile("" : "+v"(sclw_), "+v"(scla_));
    Unit cur, nxt; int ui = 0;
    if (!S.next(0, cur)) return;
    if constexpr (GATHER) {
#pragma unroll
        for (int i = 0; i < 2; ++i) { int R, C; stage_rc(tid * 16 + i * 8192, R, C); offA[0][i] = S.a_rowoff(cur, R) + (unsigned)(C * 2); offA[1][i] = S.a_rowoff(cur, R + HALF) + (unsigned)(C * 2); }
    }
    f32x4 acc[2][2][4][2];
#pragma unroll
    for (int a = 0; a < 2; ++a)
#pragma unroll
        for (int b = 0; b < 2; ++b)
#pragma unroll
            for (int m = 0; m < 4; ++m)
#pragma unroll
                for (int n = 0; n < 2; ++n) acc[a][b][m][n] = (f32x4){0.f, 0.f, 0.f, 0.f};
    bf16x8 At[4][2], B0[2][2], B1[2][2]; v8i_ At8[4], B08[2], B18[2];
    const char* cA = S.a_base(cur); const char* cB = S.b_base(cur);
    PG8_STAGE(PG8_SB(0, 0), cB, voffB); PG8_STAGE(PG8_SB(0, 1), cB + hstepB, voffB); PG8_STAGE(PG8_SA(0, 0), cA, offA[0]); PG8_STAGE(PG8_SA(0, 1), cA, offA[1]);
    if (wr == 1) PG8_BAR;
    PG8_WAIT_V(2); PG8_BAR;
    PG8_STAGE(PG8_SB(1, 0), cB + kstep, voffB); PG8_STAGE(PG8_SA(1, 0), cA + kstep, offA[0]); PG8_STAGE(PG8_SB(1, 1), cB + hstepB + kstep, voffB);
    PG8_WAIT_V(6); PG8_BAR;
    for (;;) {
        const bool has_next = S.next(ui + 1, nxt);
        const char* nA = has_next ? S.a_base(nxt) : cA; const char* nB = has_next ? S.b_base(nxt) : cB;
        if constexpr (GATHER) {
            if (has_next) {
#pragma unroll
                for (int i = 0; i < 2; ++i) { int t2_ = tid; asm volatile("" : "+v"(t2_)); int R, C; stage_rc(t2_ * 16 + i * 8192, R, C);
                    noffA[0][i] = S.a_rowoff(nxt, R) + (unsigned)(C * 2); noffA[1][i] = S.a_rowoff(nxt, R + HALF) + (unsigned)(C * 2); }
            } else {
#pragma unroll
                for (int i = 0; i < 2; ++i) { noffA[0][i] = offA[0][i]; noffA[1][i] = offA[1][i]; }
            }
        }
#pragma unroll 1
        for (int t = 0; t < nt; t += 2) {
            const bool last = (t == nt - 2);
            const char* a1 = cA + (size_t)(t + 1) * kstep;
            const char* a2 = last ? nA : cA + (size_t)(t + 2) * kstep; const char* b2 = last ? nB : cB + (size_t)(t + 2) * kstep;
            const char* a3 = a2 + kstep; const char* b3 = b2 + kstep;
            unsigned o2[2][2];
#pragma unroll
            for (int h = 0; h < 2; ++h)
#pragma unroll
                for (int i = 0; i < 2; ++i) o2[h][i] = GATHER ? (last ? noffA[h][i] : offA[h][i]) : offA[h][i];
            PG8_LDB(B0, 0, 0); PG8_LDB(B1, 0, 1); PG8_SCHED; PG8_LDA(At, 0, 0); PG8_STAGE(PG8_SA(1, 1), a1, offA[1]);
            PG8_WAIT_V(8); PG8_WAIT_L(0); PG8_BAR; PG8_MMA(0, 0, At, B0); PG8_MMA(0, 1, At, B1); PG8_BAR; PG8_SCHED;
            PG8_LDA(At, 0, 1); PG8_STAGE(PG8_SB(0, 0), b2, voffB); PG8_STAGE(PG8_SB(0, 1), b2 + hstepB, voffB); PG8_STAGE(PG8_SA(0, 0), a2, o2[0]);
            PG8_WAIT_V(8); PG8_WAIT_L(0); PG8_BAR; PG8_MMA(1, 0, At, B0); PG8_MMA(1, 1, At, B1); PG8_BAR; PG8_SCHED;
            PG8_LDB(B0, 1, 0); PG8_LDB(B1, 1, 1); PG8_SCHED; PG8_LDA(At, 1, 0); PG8_STAGE(PG8_SA(0, 1), a2, o2[1]);
            PG8_WAIT_V(8); PG8_WAIT_L(0); PG8_BAR; PG8_MMA(0, 0, At, B0); PG8_MMA(0, 1, At, B1); PG8_BAR; PG8_SCHED;
            PG8_LDA(At, 1, 1); PG8_STAGE(PG8_SB(1, 0), b3, voffB); PG8_STAGE(PG8_SB(1, 1), b3 + hstepB, voffB); PG8_STAGE(PG8_SA(1, 0), a3, o2[0]);
            PG8_WAIT_V(8); PG8_WAIT_L(0); PG8_BAR; PG8_MMA(1, 0, At, B0); PG8_MMA(1, 1, At, B1); PG8_BAR; PG8_SCHED;
        }
        if (wr == 0) PG8_BAR;
        if constexpr (FP8) asm volatile("s_nop 15\n\ts_nop 3" ::: "memory");
        { int l2_ = lane; asm volatile("" : "+v"(l2_)); E(acc, cur, wr, wc, l2_ & 15, l2_ >> 4); }
        if (!has_next) break;
#pragma unroll
        for (int a = 0; a < 2; ++a)
#pragma unroll
            for (int b = 0; b < 2; ++b)
#pragma unroll
                for (int m = 0; m < 4; ++m)
#pragma unroll
                    for (int n = 0; n < 2; ++n) acc[a][b][m][n] = (f32x4){0.f, 0.f, 0.f, 0.f};
        cur = nxt; cA = nA; cB = nB; ++ui;
        if constexpr (GATHER) {
#pragma unroll
            for (int h = 0; h < 2; ++h)
#pragma unroll
                for (int i = 0; i < 2; ++i) offA[h][i] = noffA[h][i];
        }
        if (wr == 1) PG8_BAR;
    }
    PG8_WAIT_V(0);
    PG8_BAR;
#undef PG8_SA
#undef PG8_SB
#undef PG8_STAGE
#undef PG8_LDA
#undef PG8_LDB
#undef PG8_MMA
#undef PG8_WAIT_V
#undef PG8_WAIT_L
#undef PG8_BAR
#undef PG8_SCHED
}
}

#define GAS __attribute__((address_space(1)))
#define LAS __attribute__((address_space(3)))
typedef unsigned short bf16;
typedef unsigned v4u __attribute__((ext_vector_type(4)));
typedef unsigned v2u __attribute__((ext_vector_type(2)));
typedef float f32x4 __attribute__((ext_vector_type(4)));
typedef float f32x2 __attribute__((ext_vector_type(2)));
typedef float f32x16 __attribute__((ext_vector_type(16)));
typedef short bf16x8 __attribute__((ext_vector_type(8)));
typedef short s16x4 __attribute__((ext_vector_type(4)));
typedef GAS unsigned gu32;
#define RLX_AGENT __ATOMIC_RELAXED, __HIP_MEMORY_SCOPE_AGENT
#define LDS_WAIT() asm volatile("s_waitcnt lgkmcnt(0)" ::: "memory")
#define VM_WAIT() asm volatile("s_waitcnt vmcnt(0)" ::: "memory")
__device__ __forceinline__ unsigned f2bf(float f) { unsigned u = __builtin_bit_cast(unsigned, f); return (u + 0x7fffu + ((u >> 16) & 1u)) >> 16; }
__device__ __forceinline__ unsigned pk2(float lo, float hi) { return f2bf(lo) | (f2bf(hi) << 16); }
__device__ __forceinline__ float bf_lo(unsigned w) { return __builtin_bit_cast(float, w << 16); }
__device__ __forceinline__ float bf_hi(unsigned w) { return __builtin_bit_cast(float, w & 0xffff0000u); }
__device__ __forceinline__ float wave_sum(float v) {
#pragma unroll
    for (int o = 1; o < 64; o <<= 1) v += __shfl_xor(v, o);
    return v;
}

#define XB_TMO      128
#define XB_XCNT(j)  (256  + 64 * (j))
#define XB_XSUB(j)  (1280 + 64 * (j))
#define XB_XGEN(j)  (2304 + 64 * (j))
#define XB_TOP      3328
#define XB_TOPGEN   3392
#define XCD_BAR_WORDS 3456
#define XB_SPIN_CAP (1u << 18)
__device__ __forceinline__ unsigned xb_ld(unsigned* p)              { return __hip_atomic_load(p, __ATOMIC_RELAXED, __HIP_MEMORY_SCOPE_AGENT); }
__device__ __forceinline__ unsigned xb_add(unsigned* p, unsigned v) { return __hip_atomic_fetch_add(p, v, __ATOMIC_RELAXED, __HIP_MEMORY_SCOPE_AGENT); }
__device__ __forceinline__ unsigned xb_xcc_id() { return (unsigned)__builtin_amdgcn_s_getreg((3 << 11) | 20) & 0xFu; }
#define XB_SPIN(cond, bar) do { unsigned _sp = 0; while (cond) { __builtin_amdgcn_s_sleep(1); \
    if ((++_sp & 255u) == 0u) { if (xb_ld(&(bar)[XB_TMO])) break; if (_sp > XB_SPIN_CAP) { atomicAdd(&(bar)[XB_TMO], 1u); break; } } } } while (0)
struct XcdBarrier { unsigned* bar; unsigned x; volatile LAS unsigned* st; int wave; };
__device__ __forceinline__ XcdBarrier xcd_barrier_post(unsigned* bar, volatile LAS unsigned* st, int wave) {
    XcdBarrier b; b.bar = bar; b.x = xb_xcc_id(); b.st = st; b.wave = wave;
    if (wave == 0 && lane_now() == 0) (void)xb_add(&bar[XB_XCNT(b.x)], 1u);
    return b;
}
__device__ __forceinline__ void xcd_barrier_complete(unsigned* bar, unsigned x, unsigned& nloc, unsigned& nx) {
    const unsigned G = gridDim.x * gridDim.y * gridDim.z;
    unsigned sum, cnt, mine, sp = 0u;
    for (;;) {
        sum = 0u; cnt = 0u; mine = 0u;
#pragma unroll
        for (unsigned j = 0; j < 16; ++j) { const unsigned c = xb_ld(&bar[XB_XCNT(j)]); sum += c; cnt += (c > 0u) ? 1u : 0u; mine = (j == x) ? c : mine; }
        if (sum == G) break;
        __builtin_amdgcn_s_sleep(1);
        if ((++sp & 255u) == 0u) { if (xb_ld(&bar[XB_TMO])) break; if (sp > XB_SPIN_CAP) { atomicAdd(&bar[XB_TMO], 1u); break; } }
    }
    nloc = mine > 0u ? mine : 1u; nx = cnt > 0u ? cnt : 1u;
}
__device__ __forceinline__ void xcd_barrier(const XcdBarrier& b) {
    asm volatile("s_waitcnt vmcnt(0)" ::: "memory");
    __syncthreads();
    if (b.wave == 0 && lane_now() == 0) {
        unsigned* bar = b.bar;
        __builtin_amdgcn_s_waitcnt(0);
        unsigned nloc = b.st[0], nx = b.st[1];
        if (nloc == 0u) { xcd_barrier_complete(bar, b.x, nloc, nx); b.st[0] = nloc; b.st[1] = nx; }
        const unsigned old = xb_add(&bar[XB_XSUB(b.x)], 1u);
        const unsigned gen = old / nloc;
        if (old + 1u == (gen + 1u) * nloc) {
            __builtin_amdgcn_fence(__ATOMIC_RELEASE, "agent");
            asm volatile("s_waitcnt vmcnt(0)" ::: "memory");
            const unsigned og = xb_add(&bar[XB_TOP], 1u);
            const unsigned tg = og / nx;
            if (og + 1u == (tg + 1u) * nx) xb_add(&bar[XB_TOPGEN], 1u);
            else XB_SPIN(xb_ld(&bar[XB_TOPGEN]) == tg, bar);
            __builtin_amdgcn_fence(__ATOMIC_ACQUIRE, "agent");
            xb_add(&bar[XB_XGEN(b.x)], 1u);
            asm volatile("s_waitcnt vmcnt(0)" ::: "memory");
        } else {
            XB_SPIN(xb_ld(&bar[XB_XGEN(b.x)]) == gen, bar);
            __builtin_amdgcn_fence(__ATOMIC_ACQUIRE, "agent");
            asm volatile("s_waitcnt vmcnt(0)" ::: "memory");
        }
    }
    __syncthreads();
}
namespace mk {
constexpr int D = 1024, NB = 8, SEQ = 2048, CT = 256, NCTX = NB * CT, NLAT = NB * SEQ, NTOK = NCTX + NLAT;
constexpr int NE = 32, LCAP = NTOK;
constexpr int NWAVES = 8, NTHR = 512;
#ifndef MK_WRITE_XS_ALWAYS
#define MK_WRITE_XS_ALWAYS 0
#endif
constexpr bool WRITE_XS_ALWAYS = MK_WRITE_XS_ALWAYS != 0;
#ifndef MK_FP8_G1
#define MK_FP8_G1 0
#endif
#ifndef MK_FP8_G2
#define MK_FP8_G2 0
#endif
constexpr bool FP8_G1 = MK_FP8_G1 != 0, FP8_G2 = MK_FP8_G2 != 0;
constexpr int W1_KB = FP8_G1 ? 1024 : 2048, W2_KB = FP8_G2 ? 1024 : 2048;
constexpr int MAXT = NTOK * 4 / 256 + NE;
constexpr int HB_ROWS = MAXT * 256;

constexpr size_t MiB = 1u << 20;
constexpr size_t al(size_t x) { return (x + MiB - 1) / MiB * MiB; }
constexpr size_t WS_CTL = 0, CTL_ZERO_BYTES = 1 * MiB;
constexpr size_t WS_MOD = WS_CTL + CTL_ZERO_BYTES;
constexpr size_t WS_TAB = WS_MOD + al(2 * 9 * 6144 * 4);
constexpr size_t WS_WIN0 = WS_TAB + MiB;
constexpr size_t WS_WOUT0 = WS_WIN0 + al((size_t)3072 * 1024 * 2);
constexpr size_t WS_WIN1 = WS_WOUT0 + al((size_t)1024 * 1024 * 2);
constexpr size_t WS_WOUT1 = WS_WIN1 + al((size_t)2048 * 1024 * 2);
constexpr size_t WS_WGATE = WS_WOUT1 + al((size_t)1024 * 1024 * 2);
constexpr size_t WS_W1 = WS_WGATE + al((size_t)16 * 256 * 256 * 2);
constexpr size_t WS_W2 = WS_W1 + al((size_t)2 * 32 * 2048 * 1024 * 2);
constexpr size_t WS_XS = WS_W2 + al((size_t)2 * 32 * 1024 * 1024 * 2);
constexpr size_t WS_XN = WS_XS + al((size_t)NTOK * D * 4);
constexpr size_t WS_PROJ = WS_XN + al((size_t)NTOK * D * 2);
constexpr size_t WS_CAT = WS_PROJ + al((size_t)NTOK * 3072 * 2);
constexpr size_t WS_ROUTE = WS_CAT + al((size_t)NTOK * D * 2);
constexpr size_t RT_EIDX = 0, RT_EGATE = (size_t)NTOK * 16, RT_EPOS = 2 * (size_t)NTOK * 16, RT_LIST = 3 * (size_t)NTOK * 16;
constexpr size_t WS_HB = WS_ROUTE + al(3 * (size_t)NTOK * 16 + (size_t)NE * LCAP * 4);
constexpr size_t WS_Y2 = WS_HB + al((size_t)HB_ROWS * D * 2);
constexpr size_t WS_END = WS_Y2 + al((size_t)HB_ROWS * D * 2);
constexpr size_t WS_XC = WS_HB;
constexpr size_t WS_AB = WS_XC + al((size_t)2 * NTOK * D * 2);
constexpr size_t WS_SUM = WS_AB + al((size_t)2 * NTOK * D * 4);
static_assert(WS_SUM + (size_t)2 * 288 * 1024 * 8 <= WS_END, "layer-1 mixer overlay");
constexpr int CW_BAR = 4096;
constexpr int CW_FILL = 32768;
constexpr int CW_CNT = 65536;
static_assert((CW_CNT + 64 * 64) * 4 <= (int)CTL_ZERO_BYTES && CW_BAR + 8 * XCD_BAR_WORDS <= CW_CNT, "CTL map");

constexpr int RING_OFF = 0, RING_BYTES = 131072;
constexpr int MISC_OFF = RING_BYTES;
constexpr int MISC_BAR = 0;
constexpr int MISC_HIST = 64, MISC_BASE = 64 + 128, MISC_CNT = 64 + 256, MISC_PB = 64 + 384, MISC_NT = 64 + 512;
constexpr int MISC_TAB = 1024;
constexpr int MISC_REC = 4096;
constexpr int LDS_BYTES = 147456;
static_assert(MISC_TAB + MAXT * 4 <= MISC_REC && MISC_OFF + MISC_REC + 8192 <= LDS_BYTES, "LDS map");

struct Args { const float* in[32]; float* out; unsigned char* ws; int ph_lo, ph_hi, li, pad; };

struct Frame {
    LAS unsigned char* lds; LAS unsigned char* misc; gu32* ctl;
    int wave, vcu, G;
    unsigned char* ws;
};

__device__ __forceinline__ int tid_now(const Frame& F) { return F.wave * 64 + lane_now(); }
__device__ __forceinline__ int row_modrow(int r) { return r < NCTX ? 8 : (r - NCTX) >> 11; }

__device__ __forceinline__ unsigned pk4_fp8(float a, float b, float c, float d) { int p = __builtin_amdgcn_cvt_pk_fp8_f32(a, b, 0, false); p = __builtin_amdgcn_cvt_pk_fp8_f32(c, d, p, true); return (unsigned)p; }
#ifdef MK_EMU_FP8
__device__ __forceinline__ float q8(float x) { const int p = __builtin_amdgcn_cvt_pk_fp8_f32(x, x, 0, false); return __builtin_amdgcn_cvt_f32_fp8(p, 0); }
#define Q8W(x) (q8((x) * 32.f) * 0.03125f)
#define Q8A(x) q8(x)
#else
#define Q8W(x) (x)
#define Q8A(x) (x)
#endif
template <bool QW = false> __device__ __forceinline__ void transpose_item(const float* W, int N, int k0, int n0, bf16* dst, int ldd, LAS float* scr, int lane) {
#pragma unroll 8
    for (int i = 0; i < 32; ++i) { const int kk = 2 * i + (lane >> 5); const float wv_ = W[(size_t)(k0 + kk) * N + n0 + (lane & 31)]; scr[kk * 33 + (lane & 31)] = QW ? Q8W(wv_) : wv_; }
    LDS_WAIT(); asm volatile("" ::: "memory");
    const int c = lane & 7;
#pragma unroll
    for (int j = 0; j < 4; ++j) { const int n = (lane >> 3) + 8 * j; const LAS float* s = scr + (8 * c) * 33 + n;
        v4u o; o.x = pk2(s[0 * 33], s[1 * 33]); o.y = pk2(s[2 * 33], s[3 * 33]); o.z = pk2(s[4 * 33], s[5 * 33]); o.w = pk2(s[6 * 33], s[7 * 33]);
        *(GAS v4u*)(dst + (size_t)n * ldd + 8 * c) = o; }
    LDS_WAIT(); asm volatile("" ::: "memory");
}
__device__ __forceinline__ void transpose_item_fp8(const float* W, int N, int k0, int n0, unsigned char* dst, int ldd, int lane) {
    const float* src = W + (size_t)k0 * N + n0 + lane; float v[64];
#pragma unroll
    for (int kk = 0; kk < 64; ++kk) v[kk] = src[(size_t)kk * N];
    unsigned char* o = dst + (size_t)lane * ldd;
#pragma unroll
    for (int q = 0; q < 4; ++q) { v4u w;
        w.x = pk4_fp8(v[16 * q + 0] * 32.f, v[16 * q + 1] * 32.f, v[16 * q + 2] * 32.f, v[16 * q + 3] * 32.f); w.y = pk4_fp8(v[16 * q + 4] * 32.f, v[16 * q + 5] * 32.f, v[16 * q + 6] * 32.f, v[16 * q + 7] * 32.f);
        w.z = pk4_fp8(v[16 * q + 8] * 32.f, v[16 * q + 9] * 32.f, v[16 * q + 10] * 32.f, v[16 * q + 11] * 32.f); w.w = pk4_fp8(v[16 * q + 12] * 32.f, v[16 * q + 13] * 32.f, v[16 * q + 14] * 32.f, v[16 * q + 15] * 32.f);
        *(GAS v4u*)(o + 16 * q) = w; }
}
constexpr int MOE_ITEMS = 32 * (16 * 32 + 16 * 16);
__device__ __forceinline__ void moe_item_fp8(unsigned char* ws, const float* w1, const float* w2, int layer, int it) {
    constexpr int J1 = 16 * 32, J2 = 16 * 16;
    unsigned char* W81 = ws + WS_W1 + (size_t)layer * 32 * 2048 * 1024; unsigned char* W82 = ws + WS_W2 + (size_t)layer * 32 * 1024 * 1024;
    const float* s1 = w1 + (size_t)layer * 32 * 1024 * 2048; const float* s2 = w2 + (size_t)layer * 32 * 1024 * 1024;
    const int e = it / (J1 + J2); int r = it % (J1 + J2);
    if (r < J1) { const int kb = r / 32, n0 = (r % 32) * 64; const int nn = n0 & 1023, drow = 256 * (nn >> 7) + (n0 >= 1024 ? 128 : 0) + (nn & 127);
        transpose_item_fp8(s1 + (size_t)e * 1024 * 2048, 2048, kb * 64, n0, W81 + (size_t)e * 2048 * 1024 + (size_t)drow * 1024 + kb * 64, 1024, lane_now()); }
    else { r -= J1; const int kb = r / 16, n0 = (r % 16) * 64;
        transpose_item_fp8(s2 + (size_t)e * 1024 * 1024, 1024, kb * 64, n0, W82 + (size_t)e * 1024 * 1024 + (size_t)n0 * 1024 + kb * 64, 1024, lane_now()); }
}
#ifndef MK_FILL_MAX
#define MK_FILL_MAX 1000000
#endif
#ifndef MK_FILLER
#define MK_FILLER 0
#endif
constexpr bool FILLER_ON = (MK_FILLER != 0) && FP8_G1 && FP8_G2;
__device__ __forceinline__ void filler(Frame& F, const float* w1, const float* w2, int budget) {
    if constexpr (!FILLER_ON) return;
    if (budget < 1000 && budget > MK_FILL_MAX) budget = MK_FILL_MAX;
    while (budget > 0) {
        const int chunk = budget < 8 ? budget : 8; budget -= chunk;
        int it0 = 0; if (lane_now() == 0) it0 = (int)__hip_atomic_fetch_add(F.ctl + CW_FILL, (unsigned)chunk, RLX_AGENT);
        it0 = __builtin_amdgcn_readfirstlane(it0);
        if (it0 >= MOE_ITEMS) break;
        for (int it = it0; it < it0 + chunk && it < MOE_ITEMS; ++it) moe_item_fp8(F.ws, w1, w2, 1, it);
    }
}
__device__ __forceinline__ void p0_moe_weights(Frame& F, const float* w1, const float* w2, int layer) {
    LAS float* scr = (LAS float*)(F.lds + RING_OFF + F.wave * 16384);
    const int gw = F.vcu * NWAVES + F.wave, NGW = F.G * NWAVES;
    bf16* WT1 = (bf16*)(F.ws + WS_W1) + (size_t)layer * 32 * 2048 * 1024; bf16* WT2 = (bf16*)(F.ws + WS_W2) + (size_t)layer * 32 * 1024 * 1024;
    unsigned char* W81 = F.ws + WS_W1 + (size_t)layer * 32 * 2048 * 1024; unsigned char* W82 = F.ws + WS_W2 + (size_t)layer * 32 * 1024 * 1024;
    const float* s1 = w1 + (size_t)layer * 32 * 1024 * 2048; const float* s2 = w2 + (size_t)layer * 32 * 1024 * 1024;
    if constexpr (FP8_G1 && FP8_G2) {
        for (int it = gw; it < MOE_ITEMS; it += NGW) moe_item_fp8(F.ws, w1, w2, layer, it);
        return;
    }
    constexpr int I1 = 16 * 64, I2 = 16 * 32, IT = 32 * (I1 + I2);
    for (int it = gw; it < IT; it += NGW) {
        const int e = it / (I1 + I2); int r = it % (I1 + I2);
        if (r < I1) { const int kb = r / 64, nb = r % 64, n0 = nb * 32; const int nn = n0 & 1023, drow = 256 * (nn >> 7) + (n0 >= 1024 ? 128 : 0) + (nn & 127);
            transpose_item<true>(s1 + (size_t)e * 1024 * 2048, 2048, kb * 64, n0, WT1 + (size_t)e * 2048 * 1024 + (size_t)drow * 1024 + kb * 64, 1024, scr, lane_now()); }
        else { r -= I1; const int kb = r / 32, nb = r % 32;
            transpose_item<true>(s2 + (size_t)e * 1024 * 1024, 1024, kb * 64, nb * 32, WT2 + (size_t)e * 1024 * 1024 + (size_t)(nb * 32) * 1024 + kb * 64, 1024, scr, lane_now()); }
    }
}

__device__ __forceinline__ void moe_table(Frame& F, int layer) {
    LAS int* cntl = (LAS int*)(F.misc + MISC_CNT); LAS int* pb = (LAS int*)(F.misc + MISC_PB); LAS int* tab = (LAS int*)(F.misc + MISC_TAB); LAS int* ntl = (LAS int*)(F.misc + MISC_NT);
    if (tid_now(F) < 32) cntl[tid_now(F)] = (int)__hip_atomic_load(F.ctl + CW_CNT + (layer * 32 + tid_now(F)) * 64, RLX_AGENT);
    __syncthreads();
    if (tid_now(F) == 0) { int t = 0; for (int e = 0; e < 32; ++e) { pb[e] = t; const int n = (cntl[e] + 255) >> 8; for (int j = 0; j < n; ++j) tab[t + j] = (e << 16) | j; t += n; } ntl[0] = t; }
    __syncthreads();
}

struct MoeSched1 {
    pg8::TileOrder ord; LAS const int* tab; LAS const int* cntl; const char* XN; const char* W; const int* list; int a_pitch; int wb;
    __device__ __forceinline__ bool next(int i, pg8::Unit& u) const { return ord.tile(i, u); }
    __device__ __forceinline__ const char* a_base(const pg8::Unit&) const { return XN; }
    __device__ __forceinline__ const char* b_base(const pg8::Unit& u) const { const int e = __builtin_amdgcn_readfirstlane(tab[u.pm]) >> 16; return W + ((size_t)e * 2048 + (size_t)u.pn * 256) * wb; }
    __device__ __forceinline__ unsigned a_rowoff(const pg8::Unit& u, int r) const { const int te = __builtin_amdgcn_readfirstlane(tab[u.pm]), e = te >> 16, j = te & 0xffff; int lr = j * 256 + r; const int n = __builtin_amdgcn_readfirstlane(cntl[e]); lr = lr < n ? lr : n - 1;
        return (unsigned)list[(size_t)e * LCAP + lr] * (unsigned)a_pitch; }
};
struct MoeSched2 {
    pg8::TileOrder ord; LAS const int* tab; const char* HB; const char* W; int a_pitch; int wb;
    __device__ __forceinline__ bool next(int i, pg8::Unit& u) const { return ord.tile(i, u); }
    __device__ __forceinline__ const char* a_base(const pg8::Unit& u) const { return HB + (size_t)u.pm * 256 * a_pitch; }
    __device__ __forceinline__ const char* b_base(const pg8::Unit& u) const { const int e = __builtin_amdgcn_readfirstlane(tab[u.pm]) >> 16; return W + ((size_t)e * 1024 + (size_t)u.pn * 256) * wb; }
    __device__ __forceinline__ unsigned a_rowoff(const pg8::Unit&, int) const { return 0u; }
};
struct EpiSwiglu {
    static constexpr bool PERM = true;
    bf16* HB; const float* b1; LAS const int* tab;
    __device__ __forceinline__ void operator()(const pg8::f32x4 (&acc)[2][2][4][2], const pg8::Unit& u, int wr, int wc, int fr, int fq) const {
        const int e = __builtin_amdgcn_readfirstlane(tab[u.pm]) >> 16; const float* bb = b1 + (size_t)e * 2048 + u.pn * 128 + wc * 32 + 8 * fq;
#pragma unroll
        for (int ai = 0; ai < 2; ++ai)
#pragma unroll
            for (int m = 0; m < 4; ++m) { const size_t row = (size_t)u.pm * 256 + ai * 128 + wr * 64 + m * 16 + fr; float o[8];
                asm volatile("" ::: "memory");
                pg8::f32x4 bg[2], bl[2];
#pragma unroll
                for (int n = 0; n < 2; ++n) { bg[n] = *(const pg8::f32x4*)(bb + 4 * n); bl[n] = *(const pg8::f32x4*)(bb + 1024 + 4 * n); }
#pragma unroll
                for (int n = 0; n < 2; ++n)
#pragma unroll
                    for (int i = 0; i < 4; ++i) { float g = acc[ai][0][m][n][i] + bg[n][i], l = acc[ai][1][m][n][i] + bl[n][i];
                        g = fminf(g, 7.f); l = fminf(fmaxf(l, -7.f), 7.f);
                        const float sg = __builtin_amdgcn_rcpf(1.f + __builtin_amdgcn_exp2f(-1.702f * 1.4426950408889634f * g)); o[n * 4 + i] = Q8A(g * sg * (l + 1.f)); }
                if constexpr (FP8_G2) { pg8::u32x2 w; w.x = pk4_fp8(o[0], o[1], o[2], o[3]); w.y = pk4_fp8(o[4], o[5], o[6], o[7]); *(pg8::u32x2*)((unsigned char*)HB + row * 1024 + u.pn * 128 + wc * 32 + 8 * fq) = w; }
                else { pg8::u32x4 w; w.x = pg8::cvt_pk_bf16(o[0], o[1]); w.y = pg8::cvt_pk_bf16(o[2], o[3]); w.z = pg8::cvt_pk_bf16(o[4], o[5]); w.w = pg8::cvt_pk_bf16(o[6], o[7]);
                    *(pg8::u32x4*)(HB + row * 1024 + u.pn * 128 + wc * 32 + 8 * fq) = w; } }
    }
};
struct EpiBias2 {
    static constexpr bool PERM = true;
    bf16* Y2; const float* b2; LAS const int* tab;
    __device__ __forceinline__ void operator()(const pg8::f32x4 (&acc)[2][2][4][2], const pg8::Unit& u, int wr, int wc, int fr, int fq) const {
        const int e = __builtin_amdgcn_readfirstlane(tab[u.pm]) >> 16; const int col0 = u.pn * 256 + wc * 32 + 8 * fq; const float* bb = b2 + (size_t)e * 1024 + col0;
        pg8::f32x4 bv[2][2];
#pragma unroll
        for (int bj = 0; bj < 2; ++bj)
#pragma unroll
            for (int n = 0; n < 2; ++n) bv[bj][n] = *(const pg8::f32x4*)(bb + bj * 128 + 4 * n);
#pragma unroll
        for (int ai = 0; ai < 2; ++ai)
#pragma unroll
            for (int m = 0; m < 4; ++m) { bf16* rowp = Y2 + ((size_t)u.pm * 256 + ai * 128 + wr * 64 + m * 16 + fr) * 1024 + col0;
#pragma unroll
                for (int bj = 0; bj < 2; ++bj) { const pg8::f32x4 v0 = acc[ai][bj][m][0] + bv[bj][0], v1 = acc[ai][bj][m][1] + bv[bj][1];
                    pg8::u32x4 w; w.x = pg8::cvt_pk_bf16(v0[0], v0[1]); w.y = pg8::cvt_pk_bf16(v0[2], v0[3]); w.z = pg8::cvt_pk_bf16(v1[0], v1[1]); w.w = pg8::cvt_pk_bf16(v1[2], v1[3]);
                    *(pg8::u32x4*)(rowp + bj * 128) = w; } }
    }
};

template <int M> __device__ __forceinline__ float xshfl(float x) {
    const int xi = __float_as_int(x);
    if constexpr (M == 1) return __int_as_float(__builtin_amdgcn_update_dpp(xi, xi, 0xB1, 0xF, 0xF, true));
    else if constexpr (M == 2) return __int_as_float(__builtin_amdgcn_update_dpp(xi, xi, 0x4E, 0xF, 0xF, true));
    else if constexpr (M == 32) { auto rr = __builtin_amdgcn_permlane32_swap((unsigned)xi, (unsigned)xi, false, false); return __uint_as_float((lane_now() & 32) ? rr[0] : rr[1]); }
    else return __int_as_float(__builtin_amdgcn_ds_swizzle(xi, (M << 10) | 0x1f));
}
constexpr size_t TAB_WRIMG = 65536;
__device__ __forceinline__ void p0_wr_image(Frame& F, const float* wr_all) {
    unsigned short* img = (unsigned short*)(F.ws + WS_TAB + TAB_WRIMG);
    const int gid0 = (F.vcu * NWAVES + F.wave) * 64 + lane_now(), NG = F.G * NTHR;
    for (int gid = gid0; gid < 2 * 32768; gid += NG) { const int layer = gid >> 15, k = (gid & 32767) >> 5, e = gid & 31; const float w = wr_all[(size_t)layer * 32768 + k * 32 + e];
        const unsigned hi = f2bf(w); const float rem = w - __builtin_bit_cast(float, hi << 16); const unsigned lo = f2bf(rem);
        const size_t o = (size_t)layer * 65536 + e * 1024 + ((((k >> 3) ^ (e & 15)) << 3) + (k & 7));
        img[o] = (unsigned short)hi; img[o + 32768] = (unsigned short)lo; }
}
__device__ __forceinline__ float rowmax16(float v) {
    v = fmaxf(v, __int_as_float(__builtin_amdgcn_update_dpp(0, __float_as_int(v), 0xB1, 0xF, 0xF, true)));
    v = fmaxf(v, __int_as_float(__builtin_amdgcn_update_dpp(0, __float_as_int(v), 0x4E, 0xF, 0xF, true)));
    v = fmaxf(v, __int_as_float(__builtin_amdgcn_update_dpp(0, __float_as_int(v), 0x124, 0xF, 0xF, true)));
    v = fmaxf(v, __int_as_float(__builtin_amdgcn_update_dpp(0, __float_as_int(v), 0x128, 0xF, 0xF, true)));
    return v;
}
__device__ __forceinline__ void phase_router(Frame& F, int layer, int row0, int nrows, const float* gnorm, const float* wr, const float* br) {
    const float* XS = (const float*)(F.ws + WS_XS); bf16* XN = (bf16*)(F.ws + WS_XN); const float* MODL = (const float*)(F.ws + WS_MOD) + (size_t)layer * 9 * 6144;
    int* eidx = (int*)(F.ws + WS_ROUTE + RT_EIDX); float* egate = (float*)(F.ws + WS_ROUTE + RT_EGATE); int* epos = (int*)(F.ws + WS_ROUTE + RT_EPOS); int* list = (int*)(F.ws + WS_ROUTE + RT_LIST);
    LAS int* hist = (LAS int*)(F.misc + MISC_HIST); LAS int* base = (LAS int*)(F.misc + MISC_BASE); LAS int* rec = (LAS int*)(F.misc + MISC_REC);
    (void)wr;
    { const v4u* img = (const v4u*)(F.ws + WS_TAB + TAB_WRIMG + (size_t)layer * 131072); const int t0 = tid_now(F);
#pragma unroll 4
        for (int i = t0; i < 8192; i += NTHR) *(LAS v4u*)(F.lds + RING_OFF + i * 16) = img[i];
        if (t0 < 32) hist[t0] = 0; }
    __syncthreads();
    const int ntiles = nrows >> 4; const int tile = F.wave * F.G + F.vcu; const bool have = tile < ntiles;
    if (have) {
        int lane = lane_now(); const int fr = lane & 15, fq = lane >> 4;
        const int rbase = row0 + tile * 16; const int row = rbase + fr; const float* x = XS + (size_t)row * D + 8 * fq; const float* m = MODL + (size_t)row_modrow(rbase) * 6144 + 8 * fq; const float* gp = gnorm + 8 * fq;
        float ss = 0.f;
#pragma unroll 1
        for (int s0 = 0; s0 < 32; s0 += 8) { f32x4 v[16];
#pragma unroll
            for (int q = 0; q < 8; ++q) { v[2 * q] = *(const GAS f32x4*)(x + 32 * (s0 + q)); v[2 * q + 1] = *(const GAS f32x4*)(x + 32 * (s0 + q) + 4); }
#pragma unroll
            for (int q = 0; q < 16; ++q) ss += (v[q][0] * v[q][0] + v[q][1] * v[q][1]) + (v[q][2] * v[q][2] + v[q][3] * v[q][3]); }
        ss += xshfl<16>(ss); ss += xshfl<32>(ss);
        const float rstd = rsqrtf(ss * (1.f / D) + 1e-6f);
        f32x4 acc0 = (f32x4){0.f, 0.f, 0.f, 0.f}, acc1 = acc0;
        LAS const unsigned char* bb = F.lds + RING_OFF + fr * 2048;
#pragma unroll 2
        for (int s = 0; s < 32; ++s) {
            const f32x4 xa = *(const GAS f32x4*)(x + 32 * s), xb = *(const GAS f32x4*)(x + 32 * s + 4);
            const f32x4 ga = *(const GAS f32x4*)(gp + 32 * s), gb = *(const GAS f32x4*)(gp + 32 * s + 4);
            const f32x4 sca = *(const GAS f32x4*)(m + 4 * D + 32 * s), scb = *(const GAS f32x4*)(m + 4 * D + 32 * s + 4), sha = *(const GAS f32x4*)(m + 3 * D + 32 * s), shb = *(const GAS f32x4*)(m + 3 * D + 32 * s + 4);
            const f32x4 ha = xa * rstd * ga * (1.f + sca) + sha, hb = xb * rstd * gb * (1.f + scb) + shb;
            if constexpr (FP8_G1) { v2u w; w.x = pk4_fp8(ha[0], ha[1], ha[2], ha[3]); w.y = pk4_fp8(hb[0], hb[1], hb[2], hb[3]); *(GAS v2u*)((unsigned char*)XN + (size_t)row * D + 32 * s + 8 * fq) = w; }
            else { v4u w; w.x = pk2(Q8A(ha[0]), Q8A(ha[1])); w.y = pk2(Q8A(ha[2]), Q8A(ha[3])); w.z = pk2(Q8A(hb[0]), Q8A(hb[1])); w.w = pk2(Q8A(hb[2]), Q8A(hb[3])); *(GAS v4u*)(XN + (size_t)row * D + 32 * s + 8 * fq) = w; }
            unsigned hh[4], hl[4];
#pragma unroll
            for (int j = 0; j < 2; ++j) { const unsigned a0 = f2bf(ha[2 * j]), a1 = f2bf(ha[2 * j + 1]), b0 = f2bf(hb[2 * j]), b1 = f2bf(hb[2 * j + 1]);
                hh[j] = a0 | (a1 << 16); hh[2 + j] = b0 | (b1 << 16);
                hl[j] = pk2(ha[2 * j] - __builtin_bit_cast(float, a0 << 16), ha[2 * j + 1] - __builtin_bit_cast(float, a1 << 16)); hl[2 + j] = pk2(hb[2 * j] - __builtin_bit_cast(float, b0 << 16), hb[2 * j + 1] - __builtin_bit_cast(float, b1 << 16)); }
            const bf16x8 Ah = __builtin_bit_cast(bf16x8, (v4u){hh[0], hh[1], hh[2], hh[3]}), Al = __builtin_bit_cast(bf16x8, (v4u){hl[0], hl[1], hl[2], hl[3]});
            const int co = ((4 * s + fq) ^ fr) << 4;
            const bf16x8 B0h = *(const LAS bf16x8*)(bb + co), B1h = *(const LAS bf16x8*)(bb + 32768 + co), B0l = *(const LAS bf16x8*)(bb + 65536 + co), B1l = *(const LAS bf16x8*)(bb + 65536 + 32768 + co);
            acc0 = __builtin_amdgcn_mfma_f32_16x16x32_bf16(Ah, B0h, acc0, 0, 0, 0); acc1 = __builtin_amdgcn_mfma_f32_16x16x32_bf16(Ah, B1h, acc1, 0, 0, 0);
            acc0 = __builtin_amdgcn_mfma_f32_16x16x32_bf16(Ah, B0l, acc0, 0, 0, 0); acc1 = __builtin_amdgcn_mfma_f32_16x16x32_bf16(Ah, B1l, acc1, 0, 0, 0);
            acc0 = __builtin_amdgcn_mfma_f32_16x16x32_bf16(Al, B0h, acc0, 0, 0, 0); acc1 = __builtin_amdgcn_mfma_f32_16x16x32_bf16(Al, B1h, acc1, 0, 0, 0);
        }
        const float b0v = br[fr], b1v = br[fr + 16];
        float k0[4], k1[4];
#pragma unroll
        for (int i = 0; i < 4; ++i) { k0[i] = __int_as_float((__float_as_int(acc0[i] + b0v) & ~31) | (31 - fr)); k1[i] = __int_as_float((__float_as_int(acc1[i] + b1v) & ~31) | (15 - fr)); }
        float tv[4][4]; int te[4][4];
#pragma unroll
        for (int kk = 0; kk < 4; ++kk) {
#pragma unroll
            for (int i = 0; i < 4; ++i) { const float w = rowmax16(fmaxf(k0[i], k1[i])); const int wb = __float_as_int(w); te[i][kk] = 31 - (wb & 31); tv[i][kk] = __int_as_float(wb & ~31);
                k0[i] = (k0[i] == w) ? -3.0e38f : k0[i]; k1[i] = (k1[i] == w) ? -3.0e38f : k1[i]; } }
#pragma unroll
        for (int i = 0; i < 4; ++i) { float p[4], ps = 0.f;
#pragma unroll
            for (int kk = 0; kk < 4; ++kk) { p[kk] = __expf(tv[i][kk] - tv[i][0]); ps += p[kk]; }
            if (fr < 4) { const int e = fr == 0 ? te[i][0] : fr == 1 ? te[i][1] : fr == 2 ? te[i][2] : te[i][3]; const float g = (fr == 0 ? p[0] : fr == 1 ? p[1] : fr == 2 ? p[2] : p[3]) / ps;
                const int r = rbase + 4 * fq + i; const int li = F.wave * 16 + 4 * fq + i;
                const int pl = __hip_atomic_fetch_add(hist + e, 1, __ATOMIC_RELAXED, __HIP_MEMORY_SCOPE_WORKGROUP);
                eidx[r * 4 + fr] = e; egate[r * 4 + fr] = g; rec[(li * 4 + fr) * 2] = e; rec[(li * 4 + fr) * 2 + 1] = pl; } }
    }
    __syncthreads();
    if (tid_now(F) < 32) base[tid_now(F)] = (int)__hip_atomic_fetch_add(F.ctl + CW_CNT + (layer * 32 + tid_now(F)) * 64, (unsigned)hist[tid_now(F)], RLX_AGENT);
    __syncthreads();
    { const int q = tid_now(F); const int w = q >> 6, rit = (q >> 2) & 15, k = q & 3; const int t2 = w * F.G + F.vcu;
        if (t2 < ntiles) { const int r = row0 + t2 * 16 + rit; const int e = rec[q * 2], pos = base[e] + rec[q * 2 + 1]; epos[r * 4 + k] = pos; list[(size_t)e * LCAP + pos] = r; } }
}

__device__ __forceinline__ void phase_combine(Frame& F, int layer, int row0, int nrows, int mode, const float* gnext, const float* MODN, float* out) {
    float* XS = (float*)(F.ws + WS_XS); bf16* XN = (bf16*)(F.ws + WS_XN); const bf16* Y2 = (const bf16*)(F.ws + WS_Y2); const float* MODL = (const float*)(F.ws + WS_MOD) + (size_t)layer * 9 * 6144;
    const int* eidx = (const int*)(F.ws + WS_ROUTE + RT_EIDX); const float* egate = (const float*)(F.ws + WS_ROUTE + RT_EGATE); const int* epos = (const int*)(F.ws + WS_ROUTE + RT_EPOS);
    LAS const int* pb = (LAS const int*)(F.misc + MISC_PB);
    const int lane_ = lane_now(); const int nloc = (nrows - F.vcu + F.G - 1) / F.G;
    for (int i0 = F.wave; i0 < nloc; i0 += NWAVES * 2) {
        int lane = lane_; asm volatile("" : "+v"(lane));
        const int i1 = i0 + 8; const bool ok1 = i1 < nloc; const int rA = row0 + i0 * F.G + F.vcu, rB = row0 + (ok1 ? i1 : i0) * F.G + F.vcu;
        int eA[4], eB[4], sA[4], sB[4]; float pA[4], pB[4];
#pragma unroll
        for (int k = 0; k < 4; ++k) { eA[k] = eidx[rA * 4 + k]; eB[k] = eidx[rB * 4 + k]; pA[k] = egate[rA * 4 + k]; pB[k] = egate[rB * 4 + k]; sA[k] = epos[rA * 4 + k]; sB[k] = epos[rB * 4 + k]; }
#pragma unroll
        for (int k = 0; k < 4; ++k) { sA[k] += pb[eA[k]] * 256; sB[k] += pb[eB[k]] * 256; }
        v4u yA[4][2], yB[4][2];
#pragma unroll
        for (int k = 0; k < 4; ++k)
#pragma unroll
            for (int h = 0; h < 2; ++h) { yA[k][h] = *(const GAS v4u*)(Y2 + (size_t)sA[k] * D + 512 * h + 8 * lane); yB[k][h] = *(const GAS v4u*)(Y2 + (size_t)sB[k] * D + 512 * h + 8 * lane); }
        const float* gA = MODL + (size_t)row_modrow(rA) * 6144 + 5 * D; const float* gB = MODL + (size_t)row_modrow(rB) * 6144 + 5 * D;
        f32x4 xA[2][2], xB[2][2]; float ssA = 0.f, ssB = 0.f;
#pragma unroll
        for (int h = 0; h < 2; ++h)
#pragma unroll
            for (int q = 0; q < 2; ++q) { const int c = 512 * h + 8 * lane + 4 * q;
                f32x4 aA = (f32x4){0.f, 0.f, 0.f, 0.f}, aB = aA;
#pragma unroll
                for (int k = 0; k < 4; ++k) { const unsigned wa0 = q ? yA[k][h].z : yA[k][h].x, wa1 = q ? yA[k][h].w : yA[k][h].y, wb0 = q ? yB[k][h].z : yB[k][h].x, wb1 = q ? yB[k][h].w : yB[k][h].y;
                    aA += pA[k] * (f32x4){bf_lo(wa0), bf_hi(wa0), bf_lo(wa1), bf_hi(wa1)}; aB += pB[k] * (f32x4){bf_lo(wb0), bf_hi(wb0), bf_lo(wb1), bf_hi(wb1)}; }
                const f32x4 xoA = *(const GAS f32x4*)(XS + (size_t)rA * D + c), xoB = *(const GAS f32x4*)(XS + (size_t)rB * D + c); const f32x4 ggA = *(const GAS f32x4*)(gA + c), ggB = *(const GAS f32x4*)(gB + c);
                const f32x4 nA = xoA + ggA * aA, nB = xoB + ggB * aB; xA[h][q] = nA; xB[h][q] = nB;
                if (mode == 0 || WRITE_XS_ALWAYS) { *(GAS f32x4*)(XS + (size_t)rA * D + c) = nA; if (ok1) *(GAS f32x4*)(XS + (size_t)rB * D + c) = nB; }
                ssA += (nA[0] * nA[0] + nA[1] * nA[1]) + (nA[2] * nA[2] + nA[3] * nA[3]); ssB += (nB[0] * nB[0] + nB[1] * nB[1]) + (nB[2] * nB[2] + nB[3] * nB[3]); }
#pragma unroll
        for (int o = 1; o < 64; o <<= 1) { ssA += __shfl_xor(ssA, o); ssB += __shfl_xor(ssB, o); }
        const float rsA = rsqrtf(ssA * (1.f / D) + 1e-6f), rsB = rsqrtf(ssB * (1.f / D) + 1e-6f);
        if (mode == 0) { const float* mA = MODN + (size_t)row_modrow(rA) * 6144; const float* mB = MODN + (size_t)row_modrow(rB) * 6144;
#pragma unroll
            for (int h = 0; h < 2; ++h) { float oA[8], oB[8];
#pragma unroll
                for (int q = 0; q < 2; ++q) { const int c = 512 * h + 8 * lane + 4 * q; const f32x4 gn = *(const GAS f32x4*)(gnext + c);
                    const f32x4 yA_ = xA[h][q] * rsA * gn * (1.f + *(const GAS f32x4*)(mA + D + c)) + *(const GAS f32x4*)(mA + c), yB_ = xB[h][q] * rsB * gn * (1.f + *(const GAS f32x4*)(mB + D + c)) + *(const GAS f32x4*)(mB + c);
                    oA[4 * q] = yA_[0]; oA[4 * q + 1] = yA_[1]; oA[4 * q + 2] = yA_[2]; oA[4 * q + 3] = yA_[3]; oB[4 * q] = yB_[0]; oB[4 * q + 1] = yB_[1]; oB[4 * q + 2] = yB_[2]; oB[4 * q + 3] = yB_[3]; }
                v4u w; w.x = pk2(oA[0], oA[1]); w.y = pk2(oA[2], oA[3]); w.z = pk2(oA[4], oA[5]); w.w = pk2(oA[6], oA[7]);
                *(GAS v4u*)(XN + (size_t)rA * D + 512 * h + 8 * lane) = w;
                if (ok1) { w.x = pk2(oB[0], oB[1]); w.y = pk2(oB[2], oB[3]); w.z = pk2(oB[4], oB[5]); w.w = pk2(oB[6], oB[7]); *(GAS v4u*)(XN + (size_t)rB * D + 512 * h + 8 * lane) = w; } }
        } else {
#pragma unroll
            for (int h = 0; h < 2; ++h)
#pragma unroll
                for (int q = 0; q < 2; ++q) { const int c = 512 * h + 8 * lane + 4 * q; const f32x4 gn = *(const GAS f32x4*)(gnext + c);
                    *(GAS f32x4*)(out + (size_t)(rA - NCTX) * D + c) = xA[h][q] * rsA * gn; if (ok1) *(GAS f32x4*)(out + (size_t)(rB - NCTX) * D + c) = xB[h][q] * rsB * gn; }
        }
    }
}
}
namespace mk {
__device__ __forceinline__ void p0_dense_weight(Frame& F, const float* W, int K, int N, bf16* WT, int rot) {
    LAS float* scr = (LAS float*)(F.lds + RING_OFF + F.wave * 16384);
    const int NGW = F.G * NWAVES; const int gw = (F.vcu * NWAVES + F.wave + rot) % NGW;
    const int nb = N / 32, items = (K / 64) * nb;
    for (int it = gw; it < items; it += NGW) { const int kb = it / nb, n0 = (it % nb) * 32; transpose_item(W, N, kb * 64, n0, WT + (size_t)n0 * K + kb * 64, K, scr, lane_now()); }
}
__device__ __forceinline__ void p0_gate_weights(Frame& F, const float* ga, const float* gx, int rot) {
    LAS float* scr = (LAS float*)(F.lds + RING_OFF + F.wave * 16384);
    const int NGW = F.G * NWAVES; const int gw = (F.vcu * NWAVES + F.wave + rot) % NGW;
    bf16* WG = (bf16*)(F.ws + WS_WGATE);
    for (int it = gw; it < 16 * 32; it += NGW) { const int mat = it >> 5, r = it & 31, kb = r >> 3, nbk = r & 7, n0 = nbk * 32; const int ty = mat & 1, dg = mat >> 1;
        const float* W = (ty ? gx : ga) + (size_t)dg * 65536; const int jt = n0 >> 7, rr = (n0 & 127) + (ty ? 128 : 0);
        transpose_item(W, 256, kb * 64, n0, WG + ((size_t)(dg * 2 + jt) * 256 + rr) * 256 + kb * 64, 256, scr, lane_now()); }
}
__device__ __forceinline__ void p0_adaln(Frame& F, const float* c, const float* cctx, const float* w_mod, const float* b_mod) {
    LAS float* sil = (LAS float*)(F.lds + RING_OFF);
    LAS float* part = (LAS float*)(F.lds + RING_OFF + 40960);
    float* MOD = (float*)(F.ws + WS_MOD);
    if (F.vcu >= 192 && F.G >= 256) return;
    for (int idx = tid_now(F); idx < 9 * 1024; idx += NTHR) { const float v = idx < 8192 ? c[idx] : cctx[idx - 8192]; sil[idx] = v / (1.f + __expf(-v)); }
    __syncthreads();
    for (int item = F.vcu; item < 192; item += F.G) {
        const int layer = item / 96, n0 = (item % 96) * 64; const float* w = w_mod + (size_t)layer * 1024 * 6144 + n0 + lane_now(); const int k0 = F.wave * 128;
        float acc[9];
#pragma unroll
        for (int b = 0; b < 9; ++b) acc[b] = 0.f;
        for (int kk = 0; kk < 128; kk += 16) { float wv[16];
#pragma unroll
            for (int j = 0; j < 16; ++j) wv[j] = w[(size_t)(k0 + kk + j) * 6144];
#pragma unroll
            for (int q = 0; q < 4; ++q)
#pragma unroll
                for (int b = 0; b < 9; ++b) { const f32x4 s = *(const LAS f32x4*)(sil + b * 1024 + k0 + kk + 4 * q); acc[b] += s[0] * wv[4 * q] + s[1] * wv[4 * q + 1] + s[2] * wv[4 * q + 2] + s[3] * wv[4 * q + 3]; } }
#pragma unroll
        for (int b = 0; b < 9; ++b) part[(F.wave * 9 + b) * 64 + lane_now()] = acc[b];
        __syncthreads();
        for (int q = tid_now(F); q < 9 * 64; q += NTHR) { const int b = q >> 6, l = q & 63; float s = 0.f;
#pragma unroll
            for (int wv = 0; wv < 8; ++wv) s += part[(wv * 9 + b) * 64 + l];
            MOD[((size_t)layer * 9 + b) * 6144 + n0 + l] = s + b_mod[layer * 6144 + n0 + l]; }
        __syncthreads();
    }
}
constexpr int TAB_COS = 0, TAB_SIN = 1024, TAB_SP = 2048, TAB_LAM = 4096;
__device__ __forceinline__ void p0_tables(Frame& F, const float* lq1, const float* lk1, const float* lq2, const float* lk2, const float* lru) {
    if (F.vcu != (F.G > 200 ? 200 : 0)) return;
    float* T = (float*)(F.ws + WS_TAB);
    for (int i = tid_now(F); i < 1024; i += NTHR) { const int pos = i >> 4, f = i & 15; const float inv = powf(10000.f, -(float)f / 16.f); const float ang = (float)pos * inv; T[TAB_COS + i] = cosf(ang); T[TAB_SIN + i] = sinf(ang); }
    for (int i = tid_now(F); i < 2048; i += NTHR) T[TAB_SP + i] = log1pf(expf(-lru[i]));
    if (tid_now(F) == 0) { float a = 0.f, b = 0.f; for (int i = 0; i < 64; ++i) { a += lq1[i] * lk1[i]; b += lq2[i] * lk2[i]; } T[TAB_LAM] = expf(a) - expf(b) + 0.2f; }
}

__device__ __forceinline__ void phase_norm1_l0(Frame& F, const float* x, const float* ctx, const float* g) {
    bf16* XN = (bf16*)(F.ws + WS_XN); const float* MODL = (const float*)(F.ws + WS_MOD);
    int lane_ = lane_now(); asm volatile("" : "+v"(lane_)); const int lane = lane_;
    const int gw = F.vcu * NWAVES + F.wave, NGW = F.G * NWAVES;
    for (int r = gw; r < NTOK; r += NGW) {
        const float* src = r < NCTX ? ctx + (size_t)r * D : x + (size_t)(r - NCTX) * D; const float* m = MODL + (size_t)row_modrow(r) * 6144;
        f32x4 v[2][2]; float ss = 0.f;
#pragma unroll
        for (int h = 0; h < 2; ++h)
#pragma unroll
            for (int q = 0; q < 2; ++q) { v[h][q] = *(const GAS f32x4*)(src + 512 * h + 8 * lane + 4 * q); ss += (v[h][q][0] * v[h][q][0] + v[h][q][1] * v[h][q][1]) + (v[h][q][2] * v[h][q][2] + v[h][q][3] * v[h][q][3]); }
        const float rstd = rsqrtf(wave_sum(ss) * (1.f / D) + 1e-6f);
#pragma unroll
        for (int h = 0; h < 2; ++h) { float o[8];
#pragma unroll
            for (int q = 0; q < 2; ++q) { const int c = 512 * h + 8 * lane + 4 * q; const f32x4 gn = *(const GAS f32x4*)(g + c), sc = *(const GAS f32x4*)(m + D + c), sh = *(const GAS f32x4*)(m + c);
                const f32x4 y = v[h][q] * rstd * gn * (1.f + sc) + sh; o[4 * q] = y[0]; o[4 * q + 1] = y[1]; o[4 * q + 2] = y[2]; o[4 * q + 3] = y[3]; }
            v4u w; w.x = pk2(o[0], o[1]); w.y = pk2(o[2], o[3]); w.z = pk2(o[4], o[5]); w.w = pk2(o[6], o[7]);
            *(GAS v4u*)(XN + (size_t)r * D + 512 * h + 8 * lane) = w; }
    }
}

struct DenseSched {
    pg8::TileOrder ord; const char* A; const char* W; int a_pitch; int K2;
    __device__ __forceinline__ bool next(int i, pg8::Unit& u) const { return ord.tile(i, u); }
    __device__ __forceinline__ const char* a_base(const pg8::Unit& u) const { return A + (size_t)u.pm * 256 * a_pitch; }
    __device__ __forceinline__ const char* b_base(const pg8::Unit& u) const { return W + (size_t)u.pn * 256 * K2; }
    __device__ __forceinline__ unsigned a_rowoff(const pg8::Unit&, int) const { return 0u; }
};
constexpr float ATT_C2 = 0.125f * 1.4426950408889634f;
struct EpiInProj0 {
    static constexpr bool PERM = false;
    bf16* PROJ; const float* TAB;
    __device__ __forceinline__ void operator()(const pg8::f32x4 (&acc)[2][2][4][2], const pg8::Unit& u, int wr, int wc, int fr, int fq) const {
        const bool rope = u.pn < 4 && u.pm >= 8; const float sc = u.pn < 2 ? ATT_C2 : 1.f; const int axis = wc & 1;
#pragma unroll
        for (int ai = 0; ai < 2; ++ai)
#pragma unroll
            for (int m = 0; m < 4; ++m) { const int r = u.pm * 256 + ai * 128 + wr * 64 + m * 16 + fr;
                pg8::f32x4 cs = (pg8::f32x4){1.f, 1.f, 1.f, 1.f}, sn = (pg8::f32x4){0.f, 0.f, 0.f, 0.f};
                if (rope) { const int t = (r - NCTX) & 2047; const int pos = axis ? (t & 63) : (t >> 6); cs = *(const pg8::f32x4*)(TAB + TAB_COS + pos * 16 + 4 * fq); sn = *(const pg8::f32x4*)(TAB + TAB_SIN + pos * 16 + 4 * fq); }
                bf16* rowp = PROJ + (size_t)r * 3072 + u.pn * 256 + wc * 32 + 4 * fq;
#pragma unroll
                for (int bj = 0; bj < 2; ++bj) { const pg8::f32x4 x1 = acc[ai][bj][m][0], x2 = acc[ai][bj][m][1];
                    const pg8::f32x4 o1 = (x1 * cs - x2 * sn) * sc, o2 = (x2 * cs + x1 * sn) * sc;
                    pg8::u32x2 w1, w2; w1.x = pg8::cvt_pk_bf16(o1[0], o1[1]); w1.y = pg8::cvt_pk_bf16(o1[2], o1[3]); w2.x = pg8::cvt_pk_bf16(o2[0], o2[1]); w2.y = pg8::cvt_pk_bf16(o2[2], o2[3]);
                    *(pg8::u32x2*)(rowp + bj * 128) = w1; *(pg8::u32x2*)(rowp + bj * 128 + 16) = w2; } }
    }
};
struct EpiResid {
    static constexpr bool PERM = true;
    float* XS; const float* x_in; const float* ctx_in; const float* gate;
    int row0;
    __device__ __forceinline__ void operator()(const pg8::f32x4 (&acc)[2][2][4][2], const pg8::Unit& u, int wr, int wc, int fr, int fq) const {
        const int col0 = u.pn * 256 + wc * 32 + 8 * fq;
#pragma unroll
        for (int ai = 0; ai < 2; ++ai)
#pragma unroll
            for (int m = 0; m < 4; ++m) { const int r = row0 + u.pm * 256 + ai * 128 + wr * 64 + m * 16 + fr; const float* g = gate + (size_t)row_modrow(r) * 6144 + col0;
                const float* bp = x_in ? (r < NCTX ? ctx_in + (size_t)r * D : x_in + (size_t)(r - NCTX) * D) : XS + (size_t)r * D; float* op = XS + (size_t)r * D + col0; bp += col0;
#pragma unroll
                for (int bj = 0; bj < 2; ++bj)
#pragma unroll
                    for (int n = 0; n < 2; ++n) { const int o = bj * 128 + n * 4; const pg8::f32x4 gg = *(const pg8::f32x4*)(g + o), bb = *(const pg8::f32x4*)(bp + o);
                        *(pg8::f32x4*)(op + o) = bb + gg * acc[ai][bj][m][n]; }
                if (m & 1) asm volatile("" ::: "memory"); }
    }
};
}
namespace mk {
namespace att {
constexpr int PITCH = 3072;
constexpr int SLOT = 32768, NSL = 4;
static_assert(NSL * SLOT <= RING_BYTES && MISC_REC + 8 * 512 <= LDS_BYTES - MISC_OFF, "attention LDS: four K/V slots fill the ring; the per-wave f32 scratch [8][128] lives in the MISC area");
__device__ __forceinline__ int crow(int r, int hi) { return (r & 3) + 8 * (r >> 2) + 4 * hi; }
#define ATT_WAIT_BAR(N) asm volatile("s_waitcnt vmcnt(" #N ") lgkmcnt(0)\n\ts_barrier" ::: "memory")
typedef short v4i16_t __attribute__((ext_vector_type(4)));
__device__ __forceinline__ s16x4 vtr(LAS const unsigned char* p) { return __builtin_bit_cast(s16x4, __builtin_amdgcn_ds_read_tr16_b64_v4i16((LAS v4i16_t*)p)); }
__device__ __forceinline__ unsigned cvtpk(float lo, float hi) { typedef float f2 __attribute__((ext_vector_type(2))); typedef __bf16 b2 __attribute__((ext_vector_type(2))); f2 v = {lo, hi}; b2 b = __builtin_convertvector(v, b2); return __builtin_bit_cast(unsigned, b); }
__device__ __forceinline__ float half_swap_max(float m) { auto rr = __builtin_amdgcn_permlane32_swap(__float_as_uint(m), __float_as_uint(m), false, false); return fmaxf(__uint_as_float(rr[0]), __uint_as_float(rr[1])); }
__device__ __forceinline__ float half_swap_sum(float m) { auto rr = __builtin_amdgcn_permlane32_swap(__float_as_uint(m), __float_as_uint(m), false, false); return __uint_as_float(rr[0]) + __uint_as_float(rr[1]); }

template <int ABL = 0> __device__ __forceinline__ void attn_unit(LAS unsigned char* lds, LAS float* scr, const bf16* PROJ, bf16* CAT, const int qrow0, const int krow_ctx, const int krow_lat, const int NT, const int h, const float lam, const float* subln, const int tid_in) {
    int tid = tid_in; asm volatile("" : "+v"(tid));
    const int lane = tid & 63, r32 = lane & 31, hi = lane >> 5; const int wid = __builtin_amdgcn_readfirstlane(tid >> 6); const int mh = wid >> 2, wq = wid & 3;
    LAS float* wsf = scr + wid * 128; LAS float* wsfh = wsf + 4 * hi;
#define CR(r) (((r) & 3) + 8 * ((r) >> 2))
    const int krow_ = 8 * wid + (lane >> 3);
    const bf16* kbase = PROJ + 512 + h * 128 + (size_t)krow_ * PITCH + (((lane & 7) ^ ((krow_ >> 1) & 7)) * 8);
    const bf16* vbase0 = PROJ + 1024 + h * 128 + ((wid >> 2) * 32) + (lane & 3) * 8 + (size_t)(16 * (wid & 3) + (lane >> 2)) * PITCH;
    const bf16* vbase1 = vbase0 + 64;
    const unsigned lds0 = (unsigned)__builtin_amdgcn_readfirstlane((int)(unsigned)(uintptr_t)lds) + (unsigned)wid * 1024u;
#define ATT_GLDS(gsrc, dst) do { unsigned keep_; asm volatile("s_mov_b32 %0, m0\n\ts_mov_b32 m0, %2\n\ts_nop 0\n\tglobal_load_lds_dwordx4 %1, off\n\ts_mov_b32 m0, %0" : "=&s"(keep_) : "v"(gsrc), "s"(dst) : "memory"); } while (0)
#define ATT_DMA(t, slot) do { const size_t kr_ = (size_t)((t) < 4 ? krow_ctx + 64 * (t) : krow_lat + 64 * ((t) - 4)) * PITCH; const unsigned d_ = lds0 + (unsigned)(slot) * SLOT; \
        ATT_GLDS(kbase + kr_, d_); ATT_GLDS(kbase + kr_ + 64, d_ + 8192u); ATT_GLDS(vbase0 + kr_, d_ + 16384u); ATT_GLDS(vbase1 + kr_, d_ + 24576u); } while (0)
    ATT_DMA(0, 0); ATT_DMA(1, 1); ATT_DMA(2, 2);
    const bf16* Qw = PROJ + (size_t)(qrow0 + wq * 32 + r32) * PITCH + h * 128 + mh * 64 + hi * 8;
    bf16x8 qr[4];
#pragma unroll
    for (int d0 = 0; d0 < 4; ++d0) qr[d0] = *(const GAS bf16x8*)(Qw + d0 * 16);
    asm volatile("" : "+v"(qr[0]), "+v"(qr[1]), "+v"(qr[2]), "+v"(qr[3]));
    float mrow = 0.f, l_reg = 0.f; f32x16 o[4]; f32x16 negm;
#pragma unroll
    for (int d0 = 0; d0 < 4; ++d0)
#pragma unroll
        for (int r = 0; r < 16; ++r) o[d0][r] = 0.f;
#pragma unroll
    for (int r = 0; r < 16; ++r) negm[r] = 0.f;
    int koffs[4];
#pragma unroll
    for (int d0 = 0; d0 < 4; ++d0) koffs[d0] = mh * 8192 + r32 * 128 + (((2 * d0 + hi) ^ ((r32 >> 1) & 7)) << 4);
    const int voff = 16384 + ((lane >> 4) & 1) * 32 + (lane & 3) * 8 + (4 * hi + ((lane & 15) >> 2)) * 64;
#define SBAR() __builtin_amdgcn_sched_barrier(0)
    for (int t = 0; t < NT; ++t) {
        if (t + 2 < NT) { ATT_WAIT_BAR(8); } else if (t + 1 < NT) { ATT_WAIT_BAR(4); } else { ATT_WAIT_BAR(0); }
        if (t + 3 < NT && ABL != 3) ATT_DMA(t + 3, (t + 3) & 3);
        LAS const unsigned char* kp = lds + (t & 3) * SLOT; LAS const unsigned char* vp = lds + (t & 3) * SLOT + voff;
        bf16x8 kf[8];
#pragma unroll
        for (int d0 = 0; d0 < 4; ++d0) { kf[2 * d0] = *(const LAS bf16x8*)(kp + koffs[d0]); kf[2 * d0 + 1] = *(const LAS bf16x8*)(kp + koffs[d0] + 4096); }
        SBAR();
        f32x16 p0 = negm, p1 = negm;
#pragma unroll
        for (int d0 = 0; d0 < 4; ++d0) { if (ABL == 5 || ABL == 6) { asm volatile("" :: "v"(kf[2 * d0]), "v"(kf[2 * d0 + 1])); continue; } p0 = __builtin_amdgcn_mfma_f32_32x32x16_bf16(kf[2 * d0], qr[d0], p0, 0, 0, 0); p1 = __builtin_amdgcn_mfma_f32_32x32x16_bf16(kf[2 * d0 + 1], qr[d0], p1, 0, 0, 0); }
        SBAR();
        s16x4 va[16];
#pragma unroll
        for (int i = 0; i < 8; ++i) { va[2 * i] = vtr(vp + (i >> 2) * 4096 + (i & 3) * 1024); va[2 * i + 1] = vtr(vp + (i >> 2) * 4096 + (i & 3) * 1024 + 512); }
        SBAR();
        float rm = __builtin_fmaxf(p0[0], p1[0]);
#pragma unroll
        for (int r = 1; r < 16; ++r) rm = __builtin_fmaxf(rm, __builtin_fmaxf(p0[r], p1[r]));
        rm = half_swap_max(rm);
        if (ABL != 6 && ABL != 1 && (t == 0 || __any(rm > 8.f))) {
            const float dl = t == 0 ? rm : __builtin_fmaxf(rm, 0.f); mrow += dl;
#pragma unroll
            for (int r = 0; r < 16; ++r) { p0[r] -= dl; p1[r] -= dl; negm[r] = -mrow; }
            if (t > 0) { const float f = __builtin_amdgcn_exp2f(-dl); l_reg *= f; if (hi == 0) wsf[r32] = f; LDS_WAIT();
                float fr_[16];
#pragma unroll
                for (int r = 0; r < 16; ++r) fr_[r] = wsfh[CR(r)];
#pragma unroll
                for (int d0 = 0; d0 < 4; ++d0)
#pragma unroll
                    for (int r = 0; r < 16; ++r) o[d0][r] *= fr_[r]; }
        }
        float sacc = 0.f;
#pragma unroll
        for (int r = 0; r < 16; ++r) { if (ABL != 6 && ABL != 1) { p0[r] = __builtin_amdgcn_exp2f(p0[r]); p1[r] = __builtin_amdgcn_exp2f(p1[r]); } sacc += p0[r] + p1[r]; }
        l_reg += sacc;
        v4u pw[4];
        pw[0] = (v4u){cvtpk(p0[0], p0[1]), cvtpk(p0[2], p0[3]), cvtpk(p0[4], p0[5]), cvtpk(p0[6], p0[7])};
        pw[1] = (v4u){cvtpk(p0[8], p0[9]), cvtpk(p0[10], p0[11]), cvtpk(p0[12], p0[13]), cvtpk(p0[14], p0[15])};
        pw[2] = (v4u){cvtpk(p1[0], p1[1]), cvtpk(p1[2], p1[3]), cvtpk(p1[4], p1[5]), cvtpk(p1[6], p1[7])};
        pw[3] = (v4u){cvtpk(p1[8], p1[9]), cvtpk(p1[10], p1[11]), cvtpk(p1[12], p1[13]), cvtpk(p1[14], p1[15])};
        SBAR();
#define ATT_VF(arr, i) ((bf16x8){arr[2 * (i)][0], arr[2 * (i)][1], arr[2 * (i)][2], arr[2 * (i)][3], arr[2 * (i) + 1][0], arr[2 * (i) + 1][1], arr[2 * (i) + 1][2], arr[2 * (i) + 1][3]})
        if (ABL != 2 && ABL != 6) {
#pragma unroll
        for (int ks = 0; ks < 4; ++ks) o[0] = __builtin_amdgcn_mfma_f32_32x32x16_bf16(__builtin_bit_cast(bf16x8, pw[ks]), ATT_VF(va, ks), o[0], 0, 0, 0);
        SBAR();
        s16x4 vb[8];
#pragma unroll
        for (int i = 0; i < 4; ++i) { vb[2 * i] = vtr(vp + 2 * 4096 + i * 1024); vb[2 * i + 1] = vtr(vp + 2 * 4096 + i * 1024 + 512); }
        SBAR();
#pragma unroll
        for (int ks = 0; ks < 4; ++ks) o[1] = __builtin_amdgcn_mfma_f32_32x32x16_bf16(__builtin_bit_cast(bf16x8, pw[ks]), ATT_VF(va, 4 + ks), o[1], 0, 0, 0);
        SBAR();
        s16x4 vc[8];
#pragma unroll
        for (int i = 0; i < 4; ++i) { vc[2 * i] = vtr(vp + 3 * 4096 + i * 1024); vc[2 * i + 1] = vtr(vp + 3 * 4096 + i * 1024 + 512); }
        SBAR();
#pragma unroll
        for (int ks = 0; ks < 4; ++ks) o[2] = __builtin_amdgcn_mfma_f32_32x32x16_bf16(__builtin_bit_cast(bf16x8, pw[ks]), ATT_VF(vb, ks), o[2], 0, 0, 0);
        SBAR();
#pragma unroll
        for (int ks = 0; ks < 4; ++ks) o[3] = __builtin_amdgcn_mfma_f32_32x32x16_bf16(__builtin_bit_cast(bf16x8, pw[ks]), ATT_VF(vc, ks), o[3], 0, 0, 0);
        }
        SBAR();
    }
#undef ATT_VF
#undef SBAR
    l_reg = half_swap_sum(l_reg);
    const float coef = (mh == 0 ? 1.f : -lam) / l_reg;
    if (hi == 0) wsf[64 + r32] = coef;
    ATT_WAIT_BAR(0);
    float cf[16];
#pragma unroll
    for (int r = 0; r < 16; ++r) cf[r] = wsfh[64 + CR(r)];
    LAS float* X = (LAS float*)lds + wq * 4096 + 4 * hi * 128 + r32;
    if (mh == 1) {
#pragma unroll
        for (int d0 = 0; d0 < 4; ++d0)
#pragma unroll
            for (int r = 0; r < 16; ++r) X[CR(r) * 128 + d0 * 32] = o[d0][r] * cf[r];
    }
    ATT_WAIT_BAR(0);
    if (mh == 0) {
        float ssq[16];
#pragma unroll
        for (int r = 0; r < 16; ++r) ssq[r] = 0.f;
#pragma unroll
        for (int d0 = 0; d0 < 4; ++d0)
#pragma unroll
            for (int r = 0; r < 16; ++r) { const float v = o[d0][r] * cf[r] + X[CR(r) * 128 + d0 * 32]; o[d0][r] = v; ssq[r] += v * v; }
#pragma unroll
        for (int r = 0; r < 16; ++r) { float s = ssq[r]; s += __shfl_xor(s, 1); s += __shfl_xor(s, 2); s += __shfl_xor(s, 4); s += __shfl_xor(s, 8); s += __shfl_xor(s, 16); ssq[r] = rsqrtf(s * (1.f / 128.f) + 1e-6f) * 0.8f; }
        LDS_WAIT();
        LAS bf16* stg = (LAS bf16*)(lds + wq * 16384);
        LAS bf16* stgh = stg + 4 * hi * 128 + r32;
#pragma unroll
        for (int d0 = 0; d0 < 4; ++d0) { const float g = subln[d0 * 32 + r32];
#pragma unroll
            for (int r = 0; r < 16; ++r) stgh[CR(r) * 128 + d0 * 32] = (bf16)f2bf(o[d0][r] * ssq[r] * g); }
        LDS_WAIT();
        bf16* Ow = CAT + (size_t)(qrow0 + wq * 32) * D + h * 128;
        int le = lane; asm volatile("" : "+v"(le));
#pragma unroll
        for (int i = 0; i < 8; ++i) { const int row = i * 4 + (le >> 4), ch = le & 15; const v4u v = *(const LAS v4u*)(stg + row * 128 + ch * 8); *(GAS v4u*)(Ow + (size_t)row * D + ch * 8) = v; }
    }
    ATT_WAIT_BAR(0);
#undef ATT_DMA
#undef ATT_GLDS
#undef CR
}
__device__ __forceinline__ void conv_items(Frame& F, const bf16* PROJ, bf16* CAT, const float* cw) {
    int lane_ = lane_now(); asm volatile("" : "+v"(lane_)); const int lane = lane_;
    const int gw = F.vcu * NWAVES + F.wave, NGW = F.G * NWAVES; const int c0 = 8 * lane;
    float w0[8], w1[8], w2[8];
#pragma unroll
    for (int j = 0; j < 8; ++j) { w0[j] = cw[c0 + j]; w1[j] = cw[512 + c0 + j]; w2[j] = cw[1024 + c0 + j]; }
    for (int it = gw; it < NTOK / 16; it += NGW) {
        const int r0 = it * 16; const int seg0 = r0 < NCTX ? (r0 & ~255) : NCTX + ((r0 - NCTX) & ~2047); const int seg1 = r0 < NCTX ? seg0 + 256 : seg0 + 2048;
        float pm1[8], pc[8], pn[8];
        auto prod = [&](int r, float (&dst)[8]) { if (r < seg0 || r >= seg1) {
#pragma unroll
                for (int j = 0; j < 8; ++j) dst[j] = 0.f; return; }
            const v4u a = *(const GAS v4u*)(PROJ + (size_t)r * att::PITCH + 2048 + c0), b = *(const GAS v4u*)(PROJ + (size_t)r * att::PITCH + 2560 + c0);
            dst[0] = bf_lo(a.x) * bf_lo(b.x); dst[1] = bf_hi(a.x) * bf_hi(b.x); dst[2] = bf_lo(a.y) * bf_lo(b.y); dst[3] = bf_hi(a.y) * bf_hi(b.y);
            dst[4] = bf_lo(a.z) * bf_lo(b.z); dst[5] = bf_hi(a.z) * bf_hi(b.z); dst[6] = bf_lo(a.w) * bf_lo(b.w); dst[7] = bf_hi(a.w) * bf_hi(b.w); };
        prod(r0 - 1, pm1); prod(r0, pc);
        for (int i = 0; i < 16; ++i) { const int r = r0 + i; prod(r + 1, pn);
            const v4u g = *(const GAS v4u*)(PROJ + (size_t)r * att::PITCH + 1536 + c0); const float bg[8] = {bf_lo(g.x), bf_hi(g.x), bf_lo(g.y), bf_hi(g.y), bf_lo(g.z), bf_hi(g.z), bf_lo(g.w), bf_hi(g.w)};
            float o[8];
#pragma unroll
            for (int j = 0; j < 8; ++j) { o[j] = bg[j] * (w0[j] * pm1[j] + w1[j] * pc[j] + w2[j] * pn[j]); pm1[j] = pc[j]; pc[j] = pn[j]; }
            v4u w; w.x = pk2(o[0], o[1]); w.y = pk2(o[2], o[3]); w.z = pk2(o[4], o[5]); w.w = pk2(o[6], o[7]);
            *(GAS v4u*)(CAT + (size_t)r * D + 512 + c0) = w; }
    }
}
}
template <int ABL = 0> __device__ __forceinline__ void phase_attn(Frame& F, const float* subln, const float* cw, const float* fw1 = nullptr, const float* fw2 = nullptr) {
    const bf16* PROJ = (const bf16*)(F.ws + WS_PROJ); bf16* CAT = (bf16*)(F.ws + WS_CAT); const float lam = ((const float*)(F.ws + WS_TAB))[TAB_LAM];
    int tid_ = tid_now(F); asm volatile("" : "+v"(tid_));
    if (F.G == 256) {
        const int xq = F.vcu >> 5, j = F.vcu & 31;
        for (int pass = 0; pass < 2; ++pass) { const int bh = 4 * xq + 2 * pass + (j >> 4), qb = j & 15, b = bh >> 2, h = bh & 3;
            att::attn_unit<ABL>(F.lds + RING_OFF, (LAS float*)(F.misc + MISC_REC), PROJ, CAT, NCTX + b * SEQ + qb * 128, b * CT, NCTX + b * SEQ, 36, h, lam, subln, tid_); }
    } else {
        for (int u = F.vcu; u < 512; u += F.G) { const int bh = u >> 4, qb = u & 15, b = bh >> 2, h = bh & 3;
            att::attn_unit<ABL>(F.lds + RING_OFF, (LAS float*)(F.misc + MISC_REC), PROJ, CAT, NCTX + b * SEQ + qb * 128, b * CT, NCTX + b * SEQ, 36, h, lam, subln, tid_); }
    }
    for (int u = F.vcu; u < 64; u += F.G) { const int bh = u >> 1, qb = u & 1, b = bh >> 2, h = bh & 3;
        att::attn_unit<ABL>(F.lds + RING_OFF, (LAS float*)(F.misc + MISC_REC), PROJ, CAT, b * CT + qb * 128, b * CT, NCTX + b * SEQ, 4, h, lam, subln, tid_); }
    if (ABL == 0) att::conv_items(F, PROJ, CAT, cw);
    if (ABL == 0 && fw1 && F.vcu >= 64) filler(F, fw1, fw2, 1);
}
}
namespace mk {
struct EpiBf16 {
    static constexpr bool PERM = true;
    bf16* O; int ldc;
    __device__ __forceinline__ void operator()(const pg8::f32x4 (&acc)[2][2][4][2], const pg8::Unit& u, int wr, int wc, int fr, int fq) const {
        const int col0 = u.pn * 256 + wc * 32 + 8 * fq;
#pragma unroll
        for (int ai = 0; ai < 2; ++ai)
#pragma unroll
            for (int m = 0; m < 4; ++m) { bf16* rowp = O + (size_t)(u.pm * 256 + ai * 128 + wr * 64 + m * 16 + fr) * ldc + col0;
#pragma unroll
                for (int bj = 0; bj < 2; ++bj) { const pg8::f32x4 v0 = acc[ai][bj][m][0], v1 = acc[ai][bj][m][1];
                    pg8::u32x4 w; w.x = pg8::cvt_pk_bf16(v0[0], v0[1]); w.y = pg8::cvt_pk_bf16(v0[2], v0[3]); w.z = pg8::cvt_pk_bf16(v1[0], v1[1]); w.w = pg8::cvt_pk_bf16(v1[2], v1[3]);
                    *(pg8::u32x4*)(rowp + bj * 128) = w; } }
    }
};
struct InProj1Sched {
    pg8::TileOrder ord; int G, c; const char* A; const char* W; int a_pitch;
    __device__ __forceinline__ bool next(int i, pg8::Unit& u) const { const int L = i * G + c; if (L >= 544) return false;
        if (L < 512) { ord.map(L, u); u.pm += 8; } else { const int q = L - 512; u.pm = q >> 2; u.pn = 4 + (q & 3); } return true; }
    __device__ __forceinline__ const char* a_base(const pg8::Unit& u) const { return A + (size_t)u.pm * 256 * 2048; }
    __device__ __forceinline__ const char* b_base(const pg8::Unit& u) const { return W + (size_t)u.pn * 256 * 2048; }
    __device__ __forceinline__ unsigned a_rowoff(const pg8::Unit&, int) const { return 0u; }
};
__device__ __forceinline__ void phase_conv1(Frame& F, const float* cw, const float* cb) {
    const bf16* GU = (const bf16*)(F.ws + WS_PROJ); bf16* XC = (bf16*)(F.ws + WS_XC);
    int lane_ = lane_now(); asm volatile("" : "+v"(lane_)); const int lane = lane_;
    const int gw = F.vcu * NWAVES + F.wave, NGW = F.G * NWAVES;
    for (int it = gw; it < (NTOK / 16) * 2; it += NGW) {
        const int r0 = (it >> 1) * 16, c0 = (it & 1) * 512 + 8 * lane; const int seg0 = r0 < NCTX ? (r0 & ~255) : NCTX + ((r0 - NCTX) & ~2047); const int seg1 = r0 < NCTX ? seg0 + 256 : seg0 + 2048;
        float wf[4][8], wb[4][8], bf_[8], bb_[8];
#pragma unroll
        for (int j = 0; j < 8; ++j) { bf_[j] = cb[c0 + j]; bb_[j] = cb[1024 + c0 + j];
#pragma unroll
            for (int k = 0; k < 4; ++k) { wf[k][j] = cw[k * 1024 + c0 + j]; wb[k][j] = cw[(4 + k) * 1024 + c0 + j]; } }
        float win[7][8];
        auto ld = [&](int r, float (&dst)[8]) { if (r < seg0 || r >= seg1) {
#pragma unroll
                for (int j = 0; j < 8; ++j) dst[j] = 0.f; return; }
            const v4u a = *(const GAS v4u*)(GU + (size_t)r * 2048 + 1024 + c0);
            dst[0] = bf_lo(a.x); dst[1] = bf_hi(a.x); dst[2] = bf_lo(a.y); dst[3] = bf_hi(a.y); dst[4] = bf_lo(a.z); dst[5] = bf_hi(a.z); dst[6] = bf_lo(a.w); dst[7] = bf_hi(a.w); };
#pragma unroll
        for (int q = 0; q < 6; ++q) ld(r0 - 3 + q, win[q + 1]);
#pragma unroll 4
        for (int i = 0; i < 16; ++i) { const int r = r0 + i;
#pragma unroll
            for (int q = 0; q < 6; ++q)
#pragma unroll
                for (int j = 0; j < 8; ++j) win[q][j] = win[q + 1][j];
            ld(r + 3, win[6]);
            float of[8], ob[8];
#pragma unroll
            for (int j = 0; j < 8; ++j) { of[j] = bf_[j] + wf[0][j] * win[0][j] + wf[1][j] * win[1][j] + wf[2][j] * win[2][j] + wf[3][j] * win[3][j];
                ob[j] = bb_[j] + wb[0][j] * win[3][j] + wb[1][j] * win[4][j] + wb[2][j] * win[5][j] + wb[3][j] * win[6][j]; }
            v4u w; w.x = pk2(of[0], of[1]); w.y = pk2(of[2], of[3]); w.z = pk2(of[4], of[5]); w.w = pk2(of[6], of[7]);
            *(GAS v4u*)(XC + (size_t)r * D + c0) = w;
            w.x = pk2(ob[0], ob[1]); w.y = pk2(ob[2], ob[3]); w.z = pk2(ob[4], ob[5]); w.w = pk2(ob[6], ob[7]);
            *(GAS v4u*)(XC + ((size_t)NTOK + r) * D + c0) = w; }
    }
}
struct GateSched {
    pg8::TileOrder ord; const char* XC; const char* W; int a_pitch;
    __device__ __forceinline__ bool next(int i, pg8::Unit& u) const { return ord.tile(i, u); }
    __device__ __forceinline__ const char* a_base(const pg8::Unit& u) const { const int d = u.pm >= 72 ? 1 : 0, rt = u.pm - 72 * d; return XC + ((size_t)d * NTOK + (size_t)rt * 256) * 2048 + (u.pn >> 1) * 512; }
    __device__ __forceinline__ const char* b_base(const pg8::Unit& u) const { const int d = u.pm >= 72 ? 1 : 0; return W + (size_t)(d * 8 + u.pn) * 256 * 512; }
    __device__ __forceinline__ unsigned a_rowoff(const pg8::Unit&, int) const { return 0u; }
};
struct EpiGate {
    static constexpr bool PERM = true;
    const bf16* XC; unsigned* AB; const float* gab; const float* gxb; const float* SP;
    __device__ __forceinline__ void operator()(const pg8::f32x4 (&acc)[2][2][4][2], const pg8::Unit& u, int wr, int wc, int fr, int fq) const {
        const int d = u.pm >= 72 ? 1 : 0, rt = u.pm - 72 * d; const int ch0 = (u.pn >> 1) * 256 + (u.pn & 1) * 128 + wc * 32 + 8 * fq;
#pragma unroll
        for (int ai = 0; ai < 2; ++ai)
#pragma unroll
            for (int m = 0; m < 4; ++m) { const size_t row = (size_t)d * NTOK + rt * 256 + ai * 128 + wr * 64 + m * 16 + fr;
#pragma unroll
                for (int n = 0; n < 2; ++n) {
                    asm volatile("" ::: "memory");
                    const int ch = ch0 + 4 * n; const pg8::f32x4 ba = *(const pg8::f32x4*)(gab + d * 1024 + ch), bx = *(const pg8::f32x4*)(gxb + d * 1024 + ch), sp = *(const pg8::f32x4*)(SP + d * 1024 + ch);
                    const v2u xw = *(const GAS v2u*)(XC + row * D + ch); const float xc[4] = {bf_lo(xw.x), bf_hi(xw.x), bf_lo(xw.y), bf_hi(xw.y)};
                    unsigned o[4];
#pragma unroll
                    for (int i = 0; i < 4; ++i) { const float rp = acc[ai][0][m][n][i] + ba[i], ip = acc[ai][1][m][n][i] + bx[i];
                        const float rg = __builtin_amdgcn_rcpf(1.f + __builtin_amdgcn_exp2f(-1.4426950408889634f * rp)), ig = __builtin_amdgcn_rcpf(1.f + __builtin_amdgcn_exp2f(-1.4426950408889634f * ip));
                        const float la2 = rg * sp[i] * (-8.f * 1.4426950408889634f); const float a = __builtin_amdgcn_exp2f(la2); const float bv = __builtin_amdgcn_sqrtf(fmaxf(1.f - a * a, 0.f)) * ig * xc[i];
                        o[i] = (f2bf(la2) << 16) | f2bf(bv); }
                    *(GAS v4u*)(AB + row * D + ch) = (v4u){o[0], o[1], o[2], o[3]}; } }
    }
};
__device__ __forceinline__ void phase_scan1(Frame& F) {
    const unsigned* AB = (const unsigned*)(F.ws + WS_AB); f32x2* SUM = (f32x2*)(F.ws + WS_SUM);
    int lane_ = lane_now(); asm volatile("" : "+v"(lane_)); const int lane = lane_;
    const int gw = F.vcu * NWAVES + F.wave, NGW = F.G * NWAVES;
    for (int it = gw; it < 2 * 288 * 16; it += NGW) {
        const int cg = it & 15, sc = (it >> 4) % 288, d = it / (288 * 16); const int c = cg * 64 + lane;
        const unsigned* p = AB + ((size_t)d * NTOK + sc * 64) * D + c; float h = 0.f, la = 0.f;
#pragma unroll
        for (int blk = 0; blk < 4; ++blk) { unsigned w[16];
#pragma unroll
            for (int i = 0; i < 16; ++i) { const int row = d == 0 ? blk * 16 + i : 63 - (blk * 16 + i); w[i] = p[(size_t)row * D]; }
#pragma unroll
            for (int i = 0; i < 16; ++i) { const float l2 = bf_hi(w[i]), b = bf_lo(w[i]); la += l2; h = __builtin_amdgcn_exp2f(l2) * h + b; } }
        SUM[((size_t)d * 288 + sc) * D + c] = (f32x2){la, h};
    }
}
__device__ __forceinline__ void phase_scan2(Frame& F) {
    const unsigned* AB = (const unsigned*)(F.ws + WS_AB); const f32x2* SUM = (const f32x2*)(F.ws + WS_SUM); const bf16* GU = (const bf16*)(F.ws + WS_PROJ); bf16* CAT = (bf16*)(F.ws + WS_CAT);
    int lane_ = lane_now(); asm volatile("" : "+v"(lane_)); const int lane = lane_;
    const int gw = F.vcu * NWAVES + F.wave, NGW = F.G * NWAVES;
    for (int it = gw; it < 8 * 32 * 16; it += NGW) {
        const int cg = it & 15, s = (it >> 4) & 31, b = it >> 9; const int c = cg * 64 + lane;
        float hf = 0.f, hb = 0.f;
        for (int q = 0; q < 4 + s; ++q) { const int sc = q < 4 ? b * 4 + q : 32 + b * 32 + (q - 4); const f32x2 v = SUM[(size_t)sc * D + c]; hf = __builtin_amdgcn_exp2f(v[0]) * hf + v[1]; }
        for (int q = 0; q < 4 + (31 - s); ++q) { const int sc = q < 4 ? b * 4 + (3 - q) : 32 + b * 32 + (31 - (q - 4)); const f32x2 v = SUM[((size_t)288 + sc) * D + c]; hb = __builtin_amdgcn_exp2f(v[0]) * hb + v[1]; }
        const size_t row0 = (size_t)NCTX + (size_t)b * SEQ + s * 64;
        float hfv[64];
#pragma unroll
        for (int blk = 0; blk < 4; ++blk) { unsigned w[16];
#pragma unroll
            for (int i = 0; i < 16; ++i) w[i] = AB[(row0 + blk * 16 + i) * D + c];
#pragma unroll
            for (int i = 0; i < 16; ++i) { hf = __builtin_amdgcn_exp2f(bf_hi(w[i])) * hf + bf_lo(w[i]); hfv[blk * 16 + i] = hf; } }
#pragma unroll
        for (int blk = 3; blk >= 0; --blk) { unsigned w[16]; unsigned short gt[16];
#pragma unroll
            for (int i = 0; i < 16; ++i) { const size_t row = row0 + blk * 16 + 15 - i; w[i] = AB[((size_t)NTOK + row) * D + c]; gt[i] = GU[row * 2048 + c]; }
#pragma unroll
            for (int i = 0; i < 16; ++i) { const int ri = blk * 16 + 15 - i; hb = __builtin_amdgcn_exp2f(bf_hi(w[i])) * hb + bf_lo(w[i]);
                const float g = bf_lo((unsigned)gt[i]); const float z = 0.7978845608028654f * (g + 0.044715f * g * g * g);
                const float th = 1.f - 2.f * __builtin_amdgcn_rcpf(__builtin_amdgcn_exp2f(2.f * 1.4426950408889634f * z) + 1.f);
                CAT[(row0 + ri) * D + c] = (bf16)f2bf((hfv[ri] + hb) * (0.5f * g * (1.f + th))); } }
    }
}
}
namespace mk {
#define IN(k) (lo <= (k) && (k) < hi)
#define SEAM(k) do { if (IN(k) && IN((k) + 1)) xcd_barrier(bar); } while (0)
template <int LAYER> __device__ __forceinline__ void moe_section(Frame& F, const Args& args, const XcdBarrier& bar, const int lo, const int hi) {
        constexpr int layer = LAYER; constexpr int mb = layer == 0 ? 5 : 15;
        constexpr int row0 = layer == 0 ? 0 : NCTX, nrows = layer == 0 ? NTOK : NLAT;
        if (IN(mb)) { phase_router(F, layer, row0, nrows, args.in[7] + layer * D, args.in[25] + (size_t)layer * D * 32, args.in[26] + layer * 32);
            if (layer == 1) filler(F, args.in[27], args.in[29], 1 << 20); }
        SEAM(mb);
        if (IN(mb + 1)) {
            moe_table(F, layer);
            LAS const int* tab = (LAS const int*)(F.misc + MISC_TAB); const int T = *(LAS const int*)(F.misc + MISC_NT);
            MoeSched1 S; S.ord.init(T, 8, F.G, (int)blockIdx.x); S.tab = tab; S.cntl = (LAS const int*)(F.misc + MISC_CNT); S.XN = (const char*)(F.ws + WS_XN);
            S.W = (const char*)(F.ws + WS_W1) + (size_t)layer * 32 * 2048 * (size_t)W1_KB; S.list = (const int*)(F.ws + WS_ROUTE + RT_LIST); S.a_pitch = W1_KB; S.wb = W1_KB;
            EpiSwiglu E{(bf16*)(F.ws + WS_HB), args.in[28] + (size_t)layer * 32 * 2048, tab};
            pg8::gemm_phase<EpiSwiglu, MoeSched1, true, FP8_G1, 122>(F.lds + RING_OFF, W1_KB, S, E, F.wave);
            if (layer == 0 && S.ord.early()) filler(F, args.in[27], args.in[29], 2);
        }
        SEAM(mb + 1);
        if (IN(mb + 2)) {
            moe_table(F, layer);
            LAS const int* tab = (LAS const int*)(F.misc + MISC_TAB); const int T = *(LAS const int*)(F.misc + MISC_NT);
            MoeSched2 S; S.ord.init(T, 4, F.G, (int)blockIdx.x); S.tab = tab; S.HB = (const char*)(F.ws + WS_HB); S.W = (const char*)(F.ws + WS_W2) + (size_t)layer * 32 * 1024 * (size_t)W2_KB; S.a_pitch = W2_KB; S.wb = W2_KB;
            EpiBias2 E{(bf16*)(F.ws + WS_Y2), args.in[30] + (size_t)layer * 32 * 1024, tab};
            pg8::gemm_phase<EpiBias2, MoeSched2, false, FP8_G2, 122>(F.lds + RING_OFF, W2_KB, S, E, F.wave);
            if (layer == 0 && S.ord.early()) filler(F, args.in[27], args.in[29], 2);
        }
        SEAM(mb + 2);
        if (IN(mb + 3)) {
            moe_table(F, layer);
            if (layer == 0) phase_combine(F, 0, row0, nrows, 0, args.in[6] + D, (const float*)(F.ws + WS_MOD) + (size_t)9 * 6144, args.out);
            else phase_combine(F, 1, row0, nrows, 1, args.in[31], nullptr, args.out);
        }
        SEAM(mb + 3);
}
#undef IN
#undef SEAM
constexpr int NPHASE = 19;
__global__ void __launch_bounds__(NTHR, 2) mk_fwd(Args args) {
    extern __shared__ __attribute__((aligned(16))) unsigned char lds_raw[];
    Frame F;
    F.lds = (LAS unsigned char*)lds_raw; F.misc = F.lds + MISC_OFF;
    F.wave = __builtin_amdgcn_readfirstlane((int)threadIdx.x >> 6);
    F.G = gridDim.x; { const int bx = blockIdx.x; F.vcu = (F.G % 8 == 0) ? (bx % 8) * (F.G / 8) + bx / 8 : bx; }
    F.ws = args.ws; F.ctl = (gu32*)(args.ws + WS_CTL);
    for (int u = tid_now(F); u < (LDS_BYTES - MISC_OFF) / 4; u += NTHR) ((LAS unsigned*)F.misc)[u] = 0u;
    __syncthreads();
    const int lo = args.ph_lo, hi = args.ph_hi;
    XcdBarrier bar = xcd_barrier_post((unsigned*)(F.ctl + CW_BAR) + args.li * XCD_BAR_WORDS, (volatile LAS unsigned*)(F.misc + MISC_BAR), F.wave);
#define IN(k) (lo <= (k) && (k) < hi)
#define SEAM(k) do { if (IN(k) && IN((k) + 1)) xcd_barrier(bar); } while (0)

    if (IN(0)) {
        p0_adaln(F, args.in[1], args.in[3], args.in[4], args.in[5]);
        p0_tables(F, args.in[10], args.in[11], args.in[12], args.in[13], args.in[24]);
        p0_wr_image(F, args.in[25]);
        __syncthreads();
        p0_dense_weight(F, args.in[8], 1024, 3072, (bf16*)(F.ws + WS_WIN0), 0);
        p0_dense_weight(F, args.in[9], 1024, 1024, (bf16*)(F.ws + WS_WOUT0), 1536);
        p0_dense_weight(F, args.in[16], 1024, 2048, (bf16*)(F.ws + WS_WIN1), 0);
        p0_dense_weight(F, args.in[17], 1024, 1024, (bf16*)(F.ws + WS_WOUT1), 1024);
        p0_gate_weights(F, args.in[20], args.in[22], 1536);
        p0_moe_weights(F, args.in[27], args.in[29], 0);
        if constexpr (!FILLER_ON) p0_moe_weights(F, args.in[27], args.in[29], 1);
    }
    SEAM(0);
    if (IN(1)) phase_norm1_l0(F, args.in[0], args.in[2], args.in[6]);
    SEAM(1);
    if (IN(2)) {
        DenseSched S; S.ord.init(NTOK / 256, 12, F.G, (int)blockIdx.x); S.A = (const char*)(F.ws + WS_XN); S.W = (const char*)(F.ws + WS_WIN0); S.a_pitch = 2048; S.K2 = 2048;
        EpiInProj0 E{(bf16*)(F.ws + WS_PROJ), (const float*)(F.ws + WS_TAB)};
        pg8::gemm_phase<EpiInProj0, DenseSched, false>(F.lds + RING_OFF, 2048, S, E, F.wave);
        if (S.ord.early()) filler(F, args.in[27], args.in[29], 3);
    }
    SEAM(2);
    if (IN(3)) phase_attn(F, args.in[14], args.in[15], args.in[27], args.in[29]);
    SEAM(3);
    if (IN(4)) {
        DenseSched S; S.ord.init(NTOK / 256, 4, F.G, (int)blockIdx.x); S.A = (const char*)(F.ws + WS_CAT); S.W = (const char*)(F.ws + WS_WOUT0); S.a_pitch = 2048; S.K2 = 2048;
        EpiResid E{(float*)(F.ws + WS_XS), args.in[0], args.in[2], (const float*)(F.ws + WS_MOD) + 2 * D, 0};
        pg8::gemm_phase<EpiResid, DenseSched, false>(F.lds + RING_OFF, 2048, S, E, F.wave);
        if (S.ord.early()) filler(F, args.in[27], args.in[29], 3);
    }
    SEAM(4);

    moe_section<0>(F, args, bar, lo, hi);
    if (IN(9)) {
        InProj1Sched S; S.ord.init(64, 8, F.G, (int)blockIdx.x); S.G = F.G; S.c = (int)blockIdx.x; S.A = (const char*)(F.ws + WS_XN); S.W = (const char*)(F.ws + WS_WIN1); S.a_pitch = 2048;
        EpiBf16 E{(bf16*)(F.ws + WS_PROJ), 2048};
        pg8::gemm_phase<EpiBf16, InProj1Sched, false>(F.lds + RING_OFF, 2048, S, E, F.wave);
        if (2 * F.G + (int)blockIdx.x >= 544) filler(F, args.in[27], args.in[29], 3);
    }
    SEAM(9);
    if (IN(10)) phase_conv1(F, args.in[18], args.in[19]);
    SEAM(10);
    if (IN(11)) {
        GateSched S; S.ord.init(144, 8, F.G, (int)blockIdx.x); S.XC = (const char*)(F.ws + WS_XC); S.W = (const char*)(F.ws + WS_WGATE); S.a_pitch = 2048;
        EpiGate E{(const bf16*)(F.ws + WS_XC), (unsigned*)(F.ws + WS_AB), args.in[21], args.in[23], (const float*)(F.ws + WS_TAB) + TAB_SP};
        pg8::gemm_phase<EpiGate, GateSched, false>(F.lds + RING_OFF, 512, S, E, F.wave);
        if (S.ord.early()) filler(F, args.in[27], args.in[29], 1);
    }
    SEAM(11);
    if (IN(12)) phase_scan1(F);
    SEAM(12);
    if (IN(13)) phase_scan2(F);
    SEAM(13);
    if (IN(14)) {
        DenseSched S; S.ord.init(NLAT / 256, 4, F.G, (int)blockIdx.x); S.A = (const char*)(F.ws + WS_CAT) + (size_t)NCTX * 2048; S.W = (const char*)(F.ws + WS_WOUT1); S.a_pitch = 2048; S.K2 = 2048;
        EpiResid E{(float*)(F.ws + WS_XS), nullptr, nullptr, (const float*)(F.ws + WS_MOD) + (size_t)9 * 6144 + 2 * D, NCTX};
        pg8::gemm_phase<EpiResid, DenseSched, false>(F.lds + RING_OFF, 2048, S, E, F.wave);
    }
    SEAM(14);
    moe_section<1>(F, args, bar, lo, hi);
#ifdef MK_ABLATION_PHASES
    if (IN(20)) phase_attn<MK_ABLATION_PHASES>(F, args.in[14], args.in[15]);
    if (IN(21)) { for (int i = 0; i < 10; ++i) xcd_barrier(bar); }
#endif
#undef IN
#undef SEAM
}

struct Launcher { int grid; bool ok; };
inline Launcher& launcher() {
    static Launcher L{0, false};
    if (L.grid == 0) {
        int dev = 0, cus = 0, per_cu = 0;
        if (hipGetDevice(&dev) != hipSuccess || hipDeviceGetAttribute(&cus, hipDeviceAttributeMultiprocessorCount, dev) != hipSuccess) { fprintf(stderr, "mk: device query failed\n"); L.grid = -1; return L; }
        if (hipFuncSetAttribute((const void*)mk_fwd, hipFuncAttributeMaxDynamicSharedMemorySize, LDS_BYTES) != hipSuccess) { fprintf(stderr, "mk: hipFuncSetAttribute failed\n"); L.grid = -1; return L; }
        if (hipOccupancyMaxActiveBlocksPerMultiprocessor(&per_cu, (const void*)mk_fwd, NTHR, LDS_BYTES) != hipSuccess || per_cu < 1) fprintf(stderr, "mk: note: occupancy query reports %d\n", per_cu);
        (void)hipGetLastError();
        L.grid = cus; L.ok = true;
    }
    return L;
}
inline void launch(hipStream_t st, void* const* d_in, float* out, unsigned char* ws, int ph_lo, int ph_hi, int li) {
    Launcher& L = launcher(); if (L.grid <= 0) return;
    Args a{}; for (int i = 0; i < 32; ++i) a.in[i] = (const float*)d_in[i];
    a.out = out; a.ws = ws; a.ph_lo = ph_lo; a.ph_hi = ph_hi; a.li = li; a.pad = 0;
    hipLaunchKernelGGL(mk_fwd, dim3(L.grid), dim3(NTHR), LDS_BYTES, st, a);
}
}
extern "C" void kernel_launch(void* const* d_in, const int* in_sizes, int n_in, void* d_out, int out_size, void* d_ws, size_t ws_size, hipStream_t stream) {
    unsigned char* ws = (unsigned char*)d_ws;
    if (mk::WS_END > ws_size) { fprintf(stderr, "kernel_launch: workspace too small: need %zu have %zu\n", (size_t)mk::WS_END, ws_size); return; }
    (void)hipMemsetAsync(ws + mk::WS_CTL, 0, mk::CTL_ZERO_BYTES, stream);
    mk::launch(stream, d_in, (float*)d_out, ws, 0, 19, 0);
}
```

```cpp
#define MK_FP8_G1 1
#define MK_FP8_G2 1
#include <hip/hip_runtime.h>
#include <cstdio>
#include <cstdint>
__device__ __forceinline__ int lane_now() { int l = (int)__builtin_amdgcn_mbcnt_hi(~0u, __builtin_amdgcn_mbcnt_lo(~0u, 0u)); asm volatile("" : "+v"(l)); return l; }
namespace pg8 {
#define PG8_LAS __attribute__((address_space(3)))
typedef unsigned short bf16_t;
typedef short bf16x8 __attribute__((ext_vector_type(8)));
typedef float f32x4 __attribute__((ext_vector_type(4)));
typedef float f32x2 __attribute__((ext_vector_type(2)));
typedef unsigned u32x4 __attribute__((ext_vector_type(4)));
typedef unsigned u32x2 __attribute__((ext_vector_type(2)));
constexpr int BM = 256, BK = 64, HALF = 128, HTB = HALF * BK * 2  , STAGE_BYTES = 8 * HTB, NXCD = 8, WGM = 8;

__host__ __device__ __forceinline__ int lds_byte(int r, int c) { const int st = (r >> 4) * 2 + (c >> 5), rr = r & 15, cc = c & 31, ob = rr * 64 + cc * 2; return st * 1024 + (ob ^ (((ob >> 9) & 1) << 5)); }
__host__ __device__ __forceinline__ void stage_rc(int b, int& R, int& C) { const int st = b / 1024, sb = b % 1024, swz = sb ^ (((sb >> 9) & 1) << 5); R = (st >> 1) * 16 + swz / 64; C = (st & 1) * 32 + (swz % 64) / 2; }
__host__ __device__ __forceinline__ int perm32(int rho) { const int n = rho >> 4, i = rho & 15; return 8 * (i >> 2) + 4 * n + (i & 3); }

struct Unit { int pm, pn; };

struct TileOrder {
    int nM, nN, nwg, G, c;
    __device__ __forceinline__ void init(int nM_, int nN_, int G_, int c_) { nM = nM_; nN = nN_; nwg = nM * nN; G = G_; c = c_; }
    __device__ __forceinline__ bool tile(int i, Unit& u) const { const long L = (long)i * G + c; if (L >= nwg) return false; map((int)L, u); return true; }
    __device__ __forceinline__ bool early() const { const int mine = nwg > c ? (nwg - 1 - c) / G + 1 : 0; return mine < (nwg + G - 1) / G; }
    __device__ __forceinline__ void map(int L, Unit& u) const {
        int wgid = L; { const int q = nwg / NXCD, r = nwg % NXCD, xcd = wgid % NXCD, off = wgid / NXCD; wgid = (xcd < r ? xcd * (q + 1) : r * (q + 1) + (xcd - r) * q) + off; }
        const int nig = WGM * nN, gid = wgid / nig, fm = gid * WGM, gsz = (nM - fm) < WGM ? (nM - fm) : WGM;
        u.pm = fm + ((wgid % nig) % gsz); u.pn = (wgid % nig) / gsz;
    }
};

__device__ __forceinline__ unsigned cvt_pk_bf16(float lo, float hi) { unsigned r; asm volatile("v_cvt_pk_bf16_f32 %0, %1, %2" : "=v"(r) : "v"(lo), "v"(hi)); return r; }

template <class Epi, class Sched, bool GATHER, bool FP8 = false, int SCALE_W = 127>
__device__ __forceinline__ void gemm_phase(PG8_LAS unsigned char* lds, const int Kb, const Sched& S, const Epi& E, const int wave_id) {
    int tid_ = wave_id * 64 + lane_now(); asm volatile("" : "+v"(tid_));
    const int tid = tid_, wid = __builtin_amdgcn_readfirstlane(tid >> 6), lane = tid & 63, wr = wid >> 2, wc = wid & 3, fr = lane & 15, fq = lane >> 4;
    const int nt = Kb / 128;
    unsigned voffB[2];
    unsigned offA[2][2], noffA[2][2];
#pragma unroll
    for (int i = 0; i < 2; ++i) { int R, C; stage_rc(tid * 16 + i * 8192, R, C); const int Rb = Epi::PERM ? ((R & ~31) + perm32(R & 31)) : R;
        voffB[i] = (unsigned)(Rb * Kb + C * 2);
        offA[0][i] = (unsigned)(R * S.a_pitch + C * 2); offA[1][i] = (unsigned)((R + HALF) * S.a_pitch + C * 2); noffA[0][i] = offA[0][i]; noffA[1][i] = offA[1][i]; }
    const size_t kstep = (size_t)(BK * 2);
    const size_t hstepB = (size_t)HALF * Kb;
    const unsigned ldsw = (unsigned)wid * 1024u;
    const int aoff = lds_byte(wr * 64 + fr, fq * 8), boff = lds_byte(wc * 32 + fr, fq * 8);
#define PG8_SA(b, h) (((b) * 2 + (h)) * HTB)
#define PG8_SB(b, h) ((4 + (b) * 2 + (h)) * HTB)
#define PG8_STAGE(bufoff, gbase, voff) do { const char* gb_ = (const char*)(gbase); asm volatile("" : "+s"(gb_));     \
        _Pragma("unroll") for (int _i = 0; _i < 2; ++_i) \
        __builtin_amdgcn_global_load_lds((const unsigned*)(gb_ + (voff)[_i]), (PG8_LAS unsigned*)(lds + (bufoff) + ldsw + _i * 8192), 16, 0, 0); } while (0)
    typedef int v4i_ __attribute__((ext_vector_type(4))); typedef int v8i_ __attribute__((ext_vector_type(8)));
#define PG8_LDA(dst, b, h) do { _Pragma("unroll") for (int m = 0; m < 4; ++m) { if constexpr (FP8) { const v4i_ lo_ = *(const PG8_LAS v4i_*)(lds + PG8_SA(b, h) + aoff + m * 2048), hi_ = *(const PG8_LAS v4i_*)(lds + PG8_SA(b, h) + aoff + m * 2048 + 1024); \
            dst##8[m] = __builtin_shufflevector(lo_, hi_, 0, 1, 2, 3, 4, 5, 6, 7); } else { _Pragma("unroll") for (int k = 0; k < 2; ++k) dst[m][k] = *(const PG8_LAS bf16x8*)(lds + PG8_SA(b, h) + aoff + m * 2048 + k * 1024); } } } while (0)
#define PG8_LDB(dst, b, h) do { _Pragma("unroll") for (int n = 0; n < 2; ++n) { if constexpr (FP8) { const v4i_ lo_ = *(const PG8_LAS v4i_*)(lds + PG8_SB(b, h) + boff + n * 2048), hi_ = *(const PG8_LAS v4i_*)(lds + PG8_SB(b, h) + boff + n * 2048 + 1024); \
            dst##8[n] = __builtin_shufflevector(lo_, hi_, 0, 1, 2, 3, 4, 5, 6, 7); } else { _Pragma("unroll") for (int k = 0; k < 2; ++k) dst[n][k] = *(const PG8_LAS bf16x8*)(lds + PG8_SB(b, h) + boff + n * 2048 + k * 1024); } } } while (0)
#define PG8_MMA(ai, bj, At, Bt) do { __builtin_amdgcn_s_setprio(1); _Pragma("unroll") for (int m = 0; m < 4; ++m) _Pragma("unroll") for (int n = 0; n < 2; ++n) { \
        if constexpr (FP8) { asm volatile("v_mfma_scale_f32_16x16x128_f8f6f4 %0, %1, %2, %0, %3, %4 op_sel_hi:[0,0,0]" : "+v"(acc[ai][bj][m][n]) : "v"(Bt##8[n]), "v"(At##8[m]), "v"(sclw_), "v"(scla_)); } \
        else { _Pragma("unroll") for (int k = 0; k < 2; ++k) acc[ai][bj][m][n] = __builtin_amdgcn_mfma_f32_16x16x32_bf16(Bt[n][k], At[m][k], acc[ai][bj][m][n], 0, 0, 0); } } \
        __builtin_amdgcn_s_setprio(0); } while (0)
#define PG8_WAIT_V(n) asm volatile("s_waitcnt vmcnt(" #n ")" ::: "memory")
#define PG8_WAIT_L(n) asm volatile("s_waitcnt lgkmcnt(" #n ")" ::: "memory")
#define PG8_BAR __builtin_amdgcn_s_barrier()
#define PG8_SCHED __builtin_amdgcn_sched_barrier(0)
    int sclw_ = SCALE_W, scla_ = 127; asm volatile("" : "+v"(sclw_), "+v"(scla_));
    Unit cur, nxt; int ui = 0;
    if (!S.next(0, cur)) return;
    if constexpr (GATHER) {
#pragma unroll
        for (int i = 0; i < 2; ++i) { int R, C; stage_rc(tid * 16 + i * 8192, R, C); offA[0][i] = S.a_rowoff(cur, R) + (unsigned)(C * 2); offA[1][i] = S.a_rowoff(cur, R + HALF) + (unsigned)(C * 2); }
    }
    f32x4 acc[2][2][4][2];
#pragma unroll
    for (int a = 0; a < 2; ++a)
#pragma unroll
        for (int b = 0; b < 2; ++b)
#pragma unroll
            for (int m = 0; m < 4; ++m)
#pragma unroll
                for (int n = 0; n < 2; ++n) acc[a][b][m][n] = (f32x4){0.f, 0.f, 0.f, 0.f};
    bf16x8 At[4][2], B0[2][2], B1[2][2]; v8i_ At8[4], B08[2], B18[2];
    const char* cA = S.a_base(cur); const char* cB = S.b_base(cur);
    PG8_STAGE(PG8_SB(0, 0), cB, voffB); PG8_STAGE(PG8_SB(0, 1), cB + hstepB, voffB); PG8_STAGE(PG8_SA(0, 0), cA, offA[0]); PG8_STAGE(PG8_SA(0, 1), cA, offA[1]);
    if (wr == 1) PG8_BAR;
    PG8_WAIT_V(2); PG8_BAR;
    PG8_STAGE(PG8_SB(1, 0), cB + kstep, voffB); PG8_STAGE(PG8_SA(1, 0), cA + kstep, offA[0]); PG8_STAGE(PG8_SB(1, 1), cB + hstepB + kstep, voffB);
    PG8_WAIT_V(6); PG8_BAR;
    for (;;) {
        const bool has_next = S.next(ui + 1, nxt);
        const char* nA = has_next ? S.a_base(nxt) : cA; const char* nB = has_next ? S.b_base(nxt) : cB;
        if constexpr (GATHER) {
            if (has_next) {
#pragma unroll
                for (int i = 0; i < 2; ++i) { int t2_ = tid; asm volatile("" : "+v"(t2_)); int R, C; stage_rc(t2_ * 16 + i * 8192, R, C);
                    noffA[0][i] = S.a_rowoff(nxt, R) + (unsigned)(C * 2); noffA[1][i] = S.a_rowoff(nxt, R + HALF) + (unsigned)(C * 2); }
            } else {
#pragma unroll
                for (int i = 0; i < 2; ++i) { noffA[0][i] = offA[0][i]; noffA[1][i] = offA[1][i]; }
            }
        }
#pragma unroll 1
        for (int t = 0; t < nt; t += 2) {
            const bool last = (t == nt - 2);
            const char* a1 = cA + (size_t)(t + 1) * kstep;
            const char* a2 = last ? nA : cA + (size_t)(t + 2) * kstep; const char* b2 = last ? nB : cB + (size_t)(t + 2) * kstep;
            const char* a3 = a2 + kstep; const char* b3 = b2 + kstep;
            unsigned o2[2][2];
#pragma unroll
            for (int h = 0; h < 2; ++h)
#pragma unroll
                for (int i = 0; i < 2; ++i) o2[h][i] = GATHER ? (last ? noffA[h][i] : offA[h][i]) : offA[h][i];
            PG8_LDB(B0, 0, 0); PG8_LDB(B1, 0, 1); PG8_SCHED; PG8_LDA(At, 0, 0); PG8_STAGE(PG8_SA(1, 1), a1, offA[1]);
            PG8_WAIT_V(8); PG8_WAIT_L(0); PG8_BAR; PG8_MMA(0, 0, At, B0); PG8_MMA(0, 1, At, B1); PG8_BAR; PG8_SCHED;
            PG8_LDA(At, 0, 1); PG8_STAGE(PG8_SB(0, 0), b2, voffB); PG8_STAGE(PG8_SB(0, 1), b2 + hstepB, voffB); PG8_STAGE(PG8_SA(0, 0), a2, o2[0]);
            PG8_WAIT_V(8); PG8_WAIT_L(0); PG8_BAR; PG8_MMA(1, 0, At, B0); PG8_MMA(1, 1, At, B1); PG8_BAR; PG8_SCHED;
            PG8_LDB(B0, 1, 0); PG8_LDB(B1, 1, 1); PG8_SCHED; PG8_LDA(At, 1, 0); PG8_STAGE(PG8_SA(0, 1), a2, o2[1]);
            PG8_WAIT_V(8); PG8_WAIT_L(0); PG8_BAR; PG8_MMA(0, 0, At, B0); PG8_MMA(0, 1, At, B1); PG8_BAR; PG8_SCHED;
            PG8_LDA(At, 1, 1); PG8_STAGE(PG8_SB(1, 0), b3, voffB); PG8_STAGE(PG8_SB(1, 1), b3 + hstepB, voffB); PG8_STAGE(PG8_SA(1, 0), a3, o2[0]);
            PG8_WAIT_V(8); PG8_WAIT_L(0); PG8_BAR; PG8_MMA(1, 0, At, B0); PG8_MMA(1, 1, At, B1); PG8_BAR; PG8_SCHED;
        }
        if (wr == 0) PG8_BAR;
        if constexpr (FP8) asm volatile("s_nop 15\n\ts_nop 3" ::: "memory");
        { int l2_ = lane; asm volatile("" : "+v"(l2_)); E(acc, cur, wr, wc, l2_ & 15, l2_ >> 4); }
        if (!has_next) break;
#pragma unroll
        for (int a = 0; a < 2; ++a)
#pragma unroll
            for (int b = 0; b < 2; ++b)
#pragma unroll
                for (int m = 0; m < 4; ++m)
#pragma unroll
                    for (int n = 0; n < 2; ++n) acc[a][b][m][n] = (f32x4){0.f, 0.f, 0.f, 0.f};
        cur = nxt; cA = nA; cB = nB; ++ui;
        if constexpr (GATHER) {
#pragma unroll
            for (int h = 0; h < 2; ++h)
#pragma unroll
                for (int i = 0; i < 2; ++i) offA[h][i] = noffA[h][i];
        }
        if (wr == 1) PG8_BAR;
    }
    PG8_WAIT_V(0);
    PG8_BAR;
#undef PG8_SA
#undef PG8_SB
#undef PG8_STAGE
#undef PG8_LDA
#undef PG8_LDB
#undef PG8_MMA
#undef PG8_WAIT_V
#undef PG8_WAIT_L
#undef PG8_BAR
#undef PG8_SCHED
}
}

#define GAS __attribute__((address_space(1)))
#define LAS __attribute__((address_space(3)))
typedef unsigned short bf16;
typedef unsigned v4u __attribute__((ext_vector_type(4)));
typedef unsigned v2u __attribute__((ext_vector_type(2)));
typedef float f32x4 __attribute__((ext_vector_type(4)));
typedef float f32x2 __attribute__((ext_vector_type(2)));
typedef float f32x16 __attribute__((ext_vector_type(16)));
typedef short bf16x8 __attribute__((ext_vector_type(8)));
typedef short s16x4 __attribute__((ext_vector_type(4)));
typedef GAS unsigned gu32;
#define RLX_AGENT __ATOMIC_RELAXED, __HIP_MEMORY_SCOPE_AGENT
#define LDS_WAIT() asm volatile("s_waitcnt lgkmcnt(0)" ::: "memory")
#define VM_WAIT() asm volatile("s_waitcnt vmcnt(0)" ::: "memory")
__device__ __forceinline__ unsigned f2bf(float f) { unsigned u = __builtin_bit_cast(unsigned, f); return (u + 0x7fffu + ((u >> 16) & 1u)) >> 16; }
__device__ __forceinline__ unsigned pk2(float lo, float hi) { return f2bf(lo) | (f2bf(hi) << 16); }
__device__ __forceinline__ float bf_lo(unsigned w) { return __builtin_bit_cast(float, w << 16); }
__device__ __forceinline__ float bf_hi(unsigned w) { return __builtin_bit_cast(float, w & 0xffff0000u); }
__device__ __forceinline__ float wave_sum(float v) {
#pragma unroll
    for (int o = 1; o < 64; o <<= 1) v += __shfl_xor(v, o);
    return v;
}

#define XB_TMO      128
#define XB_XCNT(j)  (256  + 64 * (j))
#define XB_XSUB(j)  (1280 + 64 * (j))
#define XB_XGEN(j)  (2304 + 64 * (j))
#define XB_TOP      3328
#define XB_TOPGEN   3392
#define XCD_BAR_WORDS 3456
#define XB_SPIN_CAP (1u << 18)
__device__ __forceinline__ unsigned xb_ld(unsigned* p)              { return __hip_atomic_load(p, __ATOMIC_RELAXED, __HIP_MEMORY_SCOPE_AGENT); }
__device__ __forceinline__ unsigned xb_add(unsigned* p, unsigned v) { return __hip_atomic_fetch_add(p, v, __ATOMIC_RELAXED, __HIP_MEMORY_SCOPE_AGENT); }
__device__ __forceinline__ unsigned xb_xcc_id() { return (unsigned)__builtin_amdgcn_s_getreg((3 << 11) | 20) & 0xFu; }
#define XB_SPIN(cond, bar) do { unsigned _sp = 0; while (cond) { __builtin_amdgcn_s_sleep(1); \
    if ((++_sp & 255u) == 0u) { if (xb_ld(&(bar)[XB_TMO])) break; if (_sp > XB_SPIN_CAP) { atomicAdd(&(bar)[XB_TMO], 1u); break; } } } } while (0)
struct XcdBarrier { unsigned* bar; unsigned x; volatile LAS unsigned* st; int wave; };
__device__ __forceinline__ XcdBarrier xcd_barrier_post(unsigned* bar, volatile LAS unsigned* st, int wave) {
    XcdBarrier b; b.bar = bar; b.x = xb_xcc_id(); b.st = st; b.wave = wave;
    if (wave == 0 && lane_now() == 0) (void)xb_add(&bar[XB_XCNT(b.x)], 1u);
    return b;
}
__device__ __forceinline__ void xcd_barrier_complete(unsigned* bar, unsigned x, unsigned& nloc, unsigned& nx) {
    const unsigned G = gridDim.x * gridDim.y * gridDim.z;
    unsigned sum, cnt, mine, sp = 0u;
    for (;;) {
        sum = 0u; cnt = 0u; mine = 0u;
#pragma unroll
        for (unsigned j = 0; j < 16; ++j) { const unsigned c = xb_ld(&bar[XB_XCNT(j)]); sum += c; cnt += (c > 0u) ? 1u : 0u; mine = (j == x) ? c : mine; }
        if (sum == G) break;
        __builtin_amdgcn_s_sleep(1);
        if ((++sp & 255u) == 0u) { if (xb_ld(&bar[XB_TMO])) break; if (sp > XB_SPIN_CAP) { atomicAdd(&bar[XB_TMO], 1u); break; } }
    }
    nloc = mine > 0u ? mine : 1u; nx = cnt > 0u ? cnt : 1u;
}
__device__ __forceinline__ void xcd_barrier(const XcdBarrier& b) {
    asm volatile("s_waitcnt vmcnt(0)" ::: "memory");
    __syncthreads();
    if (b.wave == 0 && lane_now() == 0) {
        unsigned* bar = b.bar;
        __builtin_amdgcn_s_waitcnt(0);
        unsigned nloc = b.st[0], nx = b.st[1];
        if (nloc == 0u) { xcd_barrier_complete(bar, b.x, nloc, nx); b.st[0] = nloc; b.st[1] = nx; }
        const unsigned old = xb_add(&bar[XB_XSUB(b.x)], 1u);
        const unsigned gen = old / nloc;
        if (old + 1u == (gen + 1u) * nloc) {
            __builtin_amdgcn_fence(__ATOMIC_RELEASE, "agent");
            asm volatile("s_waitcnt vmcnt(0)" ::: "memory");
            const unsigned og = xb_add(&bar[XB_TOP], 1u);
            const unsigned tg = og / nx;
            if (og + 1u == (tg + 1u) * nx) xb_add(&bar[XB_TOPGEN], 1u);
            else XB_SPIN(xb_ld(&bar[XB_TOPGEN]) == tg, bar);
            __builtin_amdgcn_fence(__ATOMIC_ACQUIRE, "agent");
            xb_add(&bar[XB_XGEN(b.x)], 1u);
            asm volatile("s_waitcnt vmcnt(0)" ::: "memory");
        } else {
            XB_SPIN(xb_ld(&bar[XB_XGEN(b.x)]) == gen, bar);
            __builtin_amdgcn_fence(__ATOMIC_ACQUIRE, "agent");
            asm volatile("s_waitcnt vmcnt(0)" ::: "memory");
        }
    }
    __syncthreads();
}
namespace mk {
constexpr int D = 1024, NB = 8, SEQ = 2048, CT = 256, NCTX = NB * CT, NLAT = NB * SEQ, NTOK = NCTX + NLAT;
constexpr int NE = 32, LCAP = NTOK;
constexpr int NWAVES = 8, NTHR = 512;
#ifndef MK_WRITE_XS_ALWAYS
#define MK_WRITE_XS_ALWAYS 0
#endif
constexpr bool WRITE_XS_ALWAYS = MK_WRITE_XS_ALWAYS != 0;
#ifndef MK_FP8_G1
#define MK_FP8_G1 0
#endif
#ifndef MK_FP8_G2
#define MK_FP8_G2 0
#endif
constexpr bool FP8_G1 = MK_FP8_G1 != 0, FP8_G2 = MK_FP8_G2 != 0;
constexpr int W1_KB = FP8_G1 ? 1024 : 2048, W2_KB = FP8_G2 ? 1024 : 2048;
constexpr int MAXT = NTOK * 4 / 256 + NE;
constexpr int HB_ROWS = MAXT * 256;

constexpr size_t MiB = 1u << 20;
constexpr size_t al(size_t x) { return (x + MiB - 1) / MiB * MiB; }
constexpr size_t WS_CTL = 0, CTL_ZERO_BYTES = 1 * MiB;
constexpr size_t WS_MOD = WS_CTL + CTL_ZERO_BYTES;
constexpr size_t WS_TAB = WS_MOD + al(2 * 9 * 6144 * 4);
constexpr size_t WS_WIN0 = WS_TAB + MiB;
constexpr size_t WS_WOUT0 = WS_WIN0 + al((size_t)3072 * 1024 * 2);
constexpr size_t WS_WIN1 = WS_WOUT0 + al((size_t)1024 * 1024 * 2);
constexpr size_t WS_WOUT1 = WS_WIN1 + al((size_t)2048 * 1024 * 2);
constexpr size_t WS_WGATE = WS_WOUT1 + al((size_t)1024 * 1024 * 2);
constexpr size_t WS_W1 = WS_WGATE + al((size_t)16 * 256 * 256 * 2);
constexpr size_t WS_W2 = WS_W1 + al((size_t)2 * 32 * 2048 * 1024 * 2);
constexpr size_t WS_XS = WS_W2 + al((size_t)2 * 32 * 1024 * 1024 * 2);
constexpr size_t WS_XN = WS_XS + al((size_t)NTOK * D * 4);
constexpr size_t WS_PROJ = WS_XN + al((size_t)NTOK * D * 2);
constexpr size_t WS_CAT = WS_PROJ + al((size_t)NTOK * 3072 * 2);
constexpr size_t WS_ROUTE = WS_CAT + al((size_t)NTOK * D * 2);
constexpr size_t RT_EIDX = 0, RT_EGATE = (size_t)NTOK * 16, RT_EPOS = 2 * (size_t)NTOK * 16, RT_LIST = 3 * (size_t)NTOK * 16;
constexpr size_t WS_HB = WS_ROUTE + al(3 * (size_t)NTOK * 16 + (size_t)NE * LCAP * 4);
constexpr size_t WS_Y2 = WS_HB + al((size_t)HB_ROWS * D * 2);
constexpr size_t WS_END = WS_Y2 + al((size_t)HB_ROWS * D * 2);
constexpr size_t WS_XC = WS_HB;
constexpr size_t WS_AB = WS_XC + al((size_t)2 * NTOK * D * 2);
constexpr size_t WS_SUM = WS_AB + al((size_t)2 * NTOK * D * 4);
static_assert(WS_SUM + (size_t)2 * 288 * 1024 * 8 <= WS_END, "layer-1 mixer overlay");
constexpr int CW_BAR = 4096;
constexpr int CW_ADALN = 32768 + 64;
constexpr int CW_FILL = 32768;
constexpr int CW_CNT = 65536;
static_assert((CW_CNT + 64 * 64) * 4 <= (int)CTL_ZERO_BYTES && CW_BAR + 8 * XCD_BAR_WORDS <= CW_CNT, "CTL map");

constexpr int RING_OFF = 0, RING_BYTES = 131072;
constexpr int MISC_OFF = RING_BYTES;
constexpr int MISC_BAR = 0;
constexpr int MISC_HIST = 64, MISC_BASE = 64 + 128, MISC_CNT = 64 + 256, MISC_PB = 64 + 384, MISC_NT = 64 + 512;
constexpr int MISC_TAB = 1024;
constexpr int MISC_REC = 4096;
constexpr int LDS_BYTES = 147456;
static_assert(MISC_TAB + MAXT * 4 <= MISC_REC && MISC_OFF + MISC_REC + 8192 <= LDS_BYTES, "LDS map");

struct Args { const float* in[32]; float* out; unsigned char* ws; int ph_lo, ph_hi, li, pad; };

struct Frame {
    LAS unsigned char* lds; LAS unsigned char* misc; gu32* ctl;
    int wave, vcu, G;
    unsigned char* ws;
};

__device__ __forceinline__ int tid_now(const Frame& F) { return F.wave * 64 + lane_now(); }
__device__ __forceinline__ int row_modrow(int r) { return r < NCTX ? 8 : (r - NCTX) >> 11; }

__device__ __forceinline__ unsigned pk4_fp8(float a, float b, float c, float d) { int p = __builtin_amdgcn_cvt_pk_fp8_f32(a, b, 0, false); p = __builtin_amdgcn_cvt_pk_fp8_f32(c, d, p, true); return (unsigned)p; }
#ifdef MK_EMU_FP8
__device__ __forceinline__ float q8(float x) { const int p = __builtin_amdgcn_cvt_pk_fp8_f32(x, x, 0, false); return __builtin_amdgcn_cvt_f32_fp8(p, 0); }
#define Q8W(x) (q8((x) * 32.f) * 0.03125f)
#define Q8A(x) q8(x)
#else
#define Q8W(x) (x)
#define Q8A(x) (x)
#endif
template <bool QW = false> __device__ __forceinline__ void transpose_item(const float* W, int N, int k0, int n0, bf16* dst, int ldd, LAS float* scr, int lane) {
#pragma unroll 8
    for (int i = 0; i < 32; ++i) { const int kk = 2 * i + (lane >> 5); const float wv_ = W[(size_t)(k0 + kk) * N + n0 + (lane & 31)]; scr[kk * 33 + (lane & 31)] = QW ? Q8W(wv_) : wv_; }
    LDS_WAIT(); asm volatile("" ::: "memory");
    const int c = lane & 7;
#pragma unroll
    for (int j = 0; j < 4; ++j) { const int n = (lane >> 3) + 8 * j; const LAS float* s = scr + (8 * c) * 33 + n;
        v4u o; o.x = pk2(s[0 * 33], s[1 * 33]); o.y = pk2(s[2 * 33], s[3 * 33]); o.z = pk2(s[4 * 33], s[5 * 33]); o.w = pk2(s[6 * 33], s[7 * 33]);
        *(GAS v4u*)(dst + (size_t)n * ldd + 8 * c) = o; }
    LDS_WAIT(); asm volatile("" ::: "memory");
}
__device__ __forceinline__ void transpose_item_fp8(const float* W, int N, int k0, int n0, unsigned char* dst, int ldd, int lane) {
    const float* src = W + (size_t)k0 * N + n0 + lane; float v[64];
#pragma unroll
    for (int kk = 0; kk < 64; ++kk) v[kk] = __builtin_nontemporal_load(src + (size_t)kk * N);
    unsigned char* o = dst + (size_t)lane * ldd;
#pragma unroll
    for (int q = 0; q < 4; ++q) { v4u w;
        w.x = pk4_fp8(v[16 * q + 0] * 32.f, v[16 * q + 1] * 32.f, v[16 * q + 2] * 32.f, v[16 * q + 3] * 32.f); w.y = pk4_fp8(v[16 * q + 4] * 32.f, v[16 * q + 5] * 32.f, v[16 * q + 6] * 32.f, v[16 * q + 7] * 32.f);
        w.z = pk4_fp8(v[16 * q + 8] * 32.f, v[16 * q + 9] * 32.f, v[16 * q + 10] * 32.f, v[16 * q + 11] * 32.f); w.w = pk4_fp8(v[16 * q + 12] * 32.f, v[16 * q + 13] * 32.f, v[16 * q + 14] * 32.f, v[16 * q + 15] * 32.f);
        *(GAS v4u*)(o + 16 * q) = w; }
}
constexpr int MOE_ITEMS = 32 * (16 * 32 + 16 * 16);
__device__ __forceinline__ void moe_item_fp8(unsigned char* ws, const float* w1, const float* w2, int layer, int it) {
    constexpr int J1 = 16 * 32, J2 = 16 * 16;
    unsigned char* W81 = ws + WS_W1 + (size_t)layer * 32 * 2048 * 1024; unsigned char* W82 = ws + WS_W2 + (size_t)layer * 32 * 1024 * 1024;
    const float* s1 = w1 + (size_t)layer * 32 * 1024 * 2048; const float* s2 = w2 + (size_t)layer * 32 * 1024 * 1024;
    const int e = it / (J1 + J2); int r = it % (J1 + J2);
    if (r < J1) { const int kb = r / 32, n0 = (r % 32) * 64; const int nn = n0 & 1023, drow = 256 * (nn >> 7) + (n0 >= 1024 ? 128 : 0) + (nn & 127);
        transpose_item_fp8(s1 + (size_t)e * 1024 * 2048, 2048, kb * 64, n0, W81 + (size_t)e * 2048 * 1024 + (size_t)drow * 1024 + kb * 64, 1024, lane_now()); }
    else { r -= J1; const int kb = r / 16, n0 = (r % 16) * 64;
        transpose_item_fp8(s2 + (size_t)e * 1024 * 1024, 1024, kb * 64, n0, W82 + (size_t)e * 1024 * 1024 + (size_t)n0 * 1024 + kb * 64, 1024, lane_now()); }
}
#ifndef MK_FILL_MAX
#define MK_FILL_MAX 1000000
#endif
#ifndef MK_FILLER
#define MK_FILLER 0
#endif
constexpr bool FILLER_ON = (MK_FILLER != 0) && FP8_G1 && FP8_G2;
__device__ __forceinline__ void filler(Frame& F, const float* w1, const float* w2, int budget) {
    if constexpr (!FILLER_ON) return;
    if (budget < 1000 && budget > MK_FILL_MAX) budget = MK_FILL_MAX;
    while (budget > 0) {
        const int chunk = budget < 8 ? budget : 8; budget -= chunk;
        int it0 = 0; if (lane_now() == 0) it0 = (int)__hip_atomic_fetch_add(F.ctl + CW_FILL, (unsigned)chunk, RLX_AGENT);
        it0 = __builtin_amdgcn_readfirstlane(it0);
        if (it0 >= MOE_ITEMS) break;
        for (int it = it0; it < it0 + chunk && it < MOE_ITEMS; ++it) moe_item_fp8(F.ws, w1, w2, 1, it);
    }
}
__device__ __forceinline__ void p0_moe_weights(Frame& F, const float* w1, const float* w2, int layer) {
    LAS float* scr = (LAS float*)(F.lds + RING_OFF + F.wave * 16384);
    const int gw = F.vcu * NWAVES + F.wave, NGW = F.G * NWAVES;
    bf16* WT1 = (bf16*)(F.ws + WS_W1) + (size_t)layer * 32 * 2048 * 1024; bf16* WT2 = (bf16*)(F.ws + WS_W2) + (size_t)layer * 32 * 1024 * 1024;
    unsigned char* W81 = F.ws + WS_W1 + (size_t)layer * 32 * 2048 * 1024; unsigned char* W82 = F.ws + WS_W2 + (size_t)layer * 32 * 1024 * 1024;
    const float* s1 = w1 + (size_t)layer * 32 * 1024 * 2048; const float* s2 = w2 + (size_t)layer * 32 * 1024 * 1024;
    if constexpr (FP8_G1 && FP8_G2) {
        for (int it = gw; it < MOE_ITEMS; it += NGW) moe_item_fp8(F.ws, w1, w2, layer, it);
        return;
    }
    constexpr int I1 = 16 * 64, I2 = 16 * 32, IT = 32 * (I1 + I2);
    for (int it = gw; it < IT; it += NGW) {
        const int e = it / (I1 + I2); int r = it % (I1 + I2);
        if (r < I1) { const int kb = r / 64, nb = r % 64, n0 = nb * 32; const int nn = n0 & 1023, drow = 256 * (nn >> 7) + (n0 >= 1024 ? 128 : 0) + (nn & 127);
            transpose_item<true>(s1 + (size_t)e * 1024 * 2048, 2048, kb * 64, n0, WT1 + (size_t)e * 2048 * 1024 + (size_t)drow * 1024 + kb * 64, 1024, scr, lane_now()); }
        else { r -= I1; const int kb = r / 32, nb = r % 32;
            transpose_item<true>(s2 + (size_t)e * 1024 * 1024, 1024, kb * 64, nb * 32, WT2 + (size_t)e * 1024 * 1024 + (size_t)(nb * 32) * 1024 + kb * 64, 1024, scr, lane_now()); }
    }
}

__device__ __forceinline__ void moe_table(Frame& F, int layer) {
    LAS int* cntl = (LAS int*)(F.misc + MISC_CNT); LAS int* pb = (LAS int*)(F.misc + MISC_PB); LAS int* tab = (LAS int*)(F.misc + MISC_TAB); LAS int* ntl = (LAS int*)(F.misc + MISC_NT);
    if (tid_now(F) < 32) cntl[tid_now(F)] = (int)__hip_atomic_load(F.ctl + CW_CNT + (layer * 32 + tid_now(F)) * 64, RLX_AGENT);
    __syncthreads();
    if (tid_now(F) == 0) { int t = 0; for (int e = 0; e < 32; ++e) { pb[e] = t; const int n = (cntl[e] + 255) >> 8; for (int j = 0; j < n; ++j) tab[t + j] = (e << 16) | j; t += n; } ntl[0] = t; }
    __syncthreads();
}

struct MoeSched1 {
    pg8::TileOrder ord; LAS const int* tab; LAS const int* cntl; const char* XN; const char* W; const int* list; int a_pitch; int wb;
    __device__ __forceinline__ bool next(int i, pg8::Unit& u) const { return ord.tile(i, u); }
    __device__ __forceinline__ const char* a_base(const pg8::Unit&) const { return XN; }
    __device__ __forceinline__ const char* b_base(const pg8::Unit& u) const { const int e = __builtin_amdgcn_readfirstlane(tab[u.pm]) >> 16; return W + ((size_t)e * 2048 + (size_t)u.pn * 256) * wb; }
    __device__ __forceinline__ unsigned a_rowoff(const pg8::Unit& u, int r) const { const int te = __builtin_amdgcn_readfirstlane(tab[u.pm]), e = te >> 16, j = te & 0xffff; int lr = j * 256 + r; const int n = __builtin_amdgcn_readfirstlane(cntl[e]); lr = lr < n ? lr : n - 1;
        return (unsigned)list[(size_t)e * LCAP + lr] * (unsigned)a_pitch; }
};
struct MoeSched2 {
    pg8::TileOrder ord; LAS const int* tab; const char* HB; const char* W; int a_pitch; int wb;
    __device__ __forceinline__ bool next(int i, pg8::Unit& u) const { return ord.tile(i, u); }
    __device__ __forceinline__ const char* a_base(const pg8::Unit& u) const { return HB + (size_t)u.pm * 256 * a_pitch; }
    __device__ __forceinline__ const char* b_base(const pg8::Unit& u) const { const int e = __builtin_amdgcn_readfirstlane(tab[u.pm]) >> 16; return W + ((size_t)e * 1024 + (size_t)u.pn * 256) * wb; }
    __device__ __forceinline__ unsigned a_rowoff(const pg8::Unit&, int) const { return 0u; }
};
struct EpiSwiglu {
    static constexpr bool PERM = true;
    bf16* HB; const float* b1; LAS const int* tab;
    __device__ __forceinline__ void operator()(const pg8::f32x4 (&acc)[2][2][4][2], const pg8::Unit& u, int wr, int wc, int fr, int fq) const {
        const int e = __builtin_amdgcn_readfirstlane(tab[u.pm]) >> 16; const float* bb = b1 + (size_t)e * 2048 + u.pn * 128 + wc * 32 + 8 * fq;
#pragma unroll
        for (int ai = 0; ai < 2; ++ai)
#pragma unroll
            for (int m = 0; m < 4; ++m) { const size_t row = (size_t)u.pm * 256 + ai * 128 + wr * 64 + m * 16 + fr; float o[8];
                asm volatile("" ::: "memory");
                pg8::f32x4 bg[2], bl[2];
#pragma unroll
                for (int n = 0; n < 2; ++n) { bg[n] = *(const pg8::f32x4*)(bb + 4 * n); bl[n] = *(const pg8::f32x4*)(bb + 1024 + 4 * n); }
#pragma unroll
                for (int n = 0; n < 2; ++n)
#pragma unroll
                    for (int i = 0; i < 4; ++i) { float g = acc[ai][0][m][n][i] + bg[n][i], l = acc[ai][1][m][n][i] + bl[n][i];
                        g = fminf(g, 7.f); l = fminf(fmaxf(l, -7.f), 7.f);
                        const float sg = __builtin_amdgcn_rcpf(1.f + __builtin_amdgcn_exp2f(-1.702f * 1.4426950408889634f * g)); o[n * 4 + i] = Q8A(g * sg * (l + 1.f)); }
                if constexpr (FP8_G2) { pg8::u32x2 w; w.x = pk4_fp8(o[0], o[1], o[2], o[3]); w.y = pk4_fp8(o[4], o[5], o[6], o[7]); *(pg8::u32x2*)((unsigned char*)HB + row * 1024 + u.pn * 128 + wc * 32 + 8 * fq) = w; }
                else { pg8::u32x4 w; w.x = pg8::cvt_pk_bf16(o[0], o[1]); w.y = pg8::cvt_pk_bf16(o[2], o[3]); w.z = pg8::cvt_pk_bf16(o[4], o[5]); w.w = pg8::cvt_pk_bf16(o[6], o[7]);
                    *(pg8::u32x4*)(HB + row * 1024 + u.pn * 128 + wc * 32 + 8 * fq) = w; } }
    }
};
struct EpiBias2 {
    static constexpr bool PERM = true;
    bf16* Y2; const float* b2; LAS const int* tab;
    __device__ __forceinline__ void operator()(const pg8::f32x4 (&acc)[2][2][4][2], const pg8::Unit& u, int wr, int wc, int fr, int fq) const {
        const int e = __builtin_amdgcn_readfirstlane(tab[u.pm]) >> 16; const int col0 = u.pn * 256 + wc * 32 + 8 * fq; const float* bb = b2 + (size_t)e * 1024 + col0;
        pg8::f32x4 bv[2][2];
#pragma unroll
        for (int bj = 0; bj < 2; ++bj)
#pragma unroll
            for (int n = 0; n < 2; ++n) bv[bj][n] = *(const pg8::f32x4*)(bb + bj * 128 + 4 * n);
#pragma unroll
        for (int ai = 0; ai < 2; ++ai)
#pragma unroll
            for (int m = 0; m < 4; ++m) { bf16* rowp = Y2 + ((size_t)u.pm * 256 + ai * 128 + wr * 64 + m * 16 + fr) * 1024 + col0;
#pragma unroll
                for (int bj = 0; bj < 2; ++bj) { const pg8::f32x4 v0 = acc[ai][bj][m][0] + bv[bj][0], v1 = acc[ai][bj][m][1] + bv[bj][1];
                    pg8::u32x4 w; w.x = pg8::cvt_pk_bf16(v0[0], v0[1]); w.y = pg8::cvt_pk_bf16(v0[2], v0[3]); w.z = pg8::cvt_pk_bf16(v1[0], v1[1]); w.w = pg8::cvt_pk_bf16(v1[2], v1[3]);
                    *(pg8::u32x4*)(rowp + bj * 128) = w; } }
    }
};

template <int M> __device__ __forceinline__ float xshfl(float x) {
    const int xi = __float_as_int(x);
    if constexpr (M == 1) return __int_as_float(__builtin_amdgcn_update_dpp(xi, xi, 0xB1, 0xF, 0xF, true));
    else if constexpr (M == 2) return __int_as_float(__builtin_amdgcn_update_dpp(xi, xi, 0x4E, 0xF, 0xF, true));
    else if constexpr (M == 32) { auto rr = __builtin_amdgcn_permlane32_swap((unsigned)xi, (unsigned)xi, false, false); return __uint_as_float((lane_now() & 32) ? rr[0] : rr[1]); }
    else return __int_as_float(__builtin_amdgcn_ds_swizzle(xi, (M << 10) | 0x1f));
}
constexpr size_t TAB_WRIMG = 65536;
__device__ __forceinline__ void p0_wr_image(Frame& F, const float* wr_all) {
    unsigned short* img = (unsigned short*)(F.ws + WS_TAB + TAB_WRIMG);
    const int gid0 = (F.vcu * NWAVES + F.wave) * 64 + lane_now(), NG = F.G * NTHR;
    for (int gid = gid0; gid < 2 * 32768; gid += NG) { const int layer = gid >> 15, k = (gid & 32767) >> 5, e = gid & 31; const float w = wr_all[(size_t)layer * 32768 + k * 32 + e];
        const unsigned hi = f2bf(w); const float rem = w - __builtin_bit_cast(float, hi << 16); const unsigned lo = f2bf(rem);
        const size_t o = (size_t)layer * 65536 + e * 1024 + ((((k >> 3) ^ (e & 15)) << 3) + (k & 7));
        img[o] = (unsigned short)hi; img[o + 32768] = (unsigned short)lo; }
}
__device__ __forceinline__ float rowmax16(float v) {
    v = fmaxf(v, __int_as_float(__builtin_amdgcn_update_dpp(0, __float_as_int(v), 0xB1, 0xF, 0xF, true)));
    v = fmaxf(v, __int_as_float(__builtin_amdgcn_update_dpp(0, __float_as_int(v), 0x4E, 0xF, 0xF, true)));
    v = fmaxf(v, __int_as_float(__builtin_amdgcn_update_dpp(0, __float_as_int(v), 0x124, 0xF, 0xF, true)));
    v = fmaxf(v, __int_as_float(__builtin_amdgcn_update_dpp(0, __float_as_int(v), 0x128, 0xF, 0xF, true)));
    return v;
}
__device__ __forceinline__ void phase_router(Frame& F, int layer, int row0, int nrows, const float* gnorm, const float* wr, const float* br) {
    const float* XS = (const float*)(F.ws + WS_XS); bf16* XN = (bf16*)(F.ws + WS_XN); const float* MODL = (const float*)(F.ws + WS_MOD) + (size_t)layer * 9 * 6144;
    int* eidx = (int*)(F.ws + WS_ROUTE + RT_EIDX); float* egate = (float*)(F.ws + WS_ROUTE + RT_EGATE); int* epos = (int*)(F.ws + WS_ROUTE + RT_EPOS); int* list = (int*)(F.ws + WS_ROUTE + RT_LIST);
    LAS int* hist = (LAS int*)(F.misc + MISC_HIST); LAS int* base = (LAS int*)(F.misc + MISC_BASE); LAS int* rec = (LAS int*)(F.misc + MISC_REC);
    (void)wr;
    { const v4u* img = (const v4u*)(F.ws + WS_TAB + TAB_WRIMG + (size_t)layer * 131072); const int t0 = tid_now(F);
#pragma unroll 4
        for (int i = t0; i < 8192; i += NTHR) *(LAS v4u*)(F.lds + RING_OFF + i * 16) = img[i];
        if (t0 < 32) hist[t0] = 0; }
    __syncthreads();
    const int ntiles = nrows >> 4; const int tile = F.wave * F.G + F.vcu; const bool have = tile < ntiles;
    if (have) {
        int lane = lane_now(); const int fr = lane & 15, fq = lane >> 4;
        const int rbase = row0 + tile * 16; const int row = rbase + fr; const float* x = XS + (size_t)row * D + 8 * fq; const float* m = MODL + (size_t)row_modrow(rbase) * 6144 + 8 * fq; const float* gp = gnorm + 8 * fq;
        float ss = 0.f;
#pragma unroll 1
        for (int s0 = 0; s0 < 32; s0 += 8) { f32x4 v[16];
#pragma unroll
            for (int q = 0; q < 8; ++q) { v[2 * q] = *(const GAS f32x4*)(x + 32 * (s0 + q)); v[2 * q + 1] = *(const GAS f32x4*)(x + 32 * (s0 + q) + 4); }
#pragma unroll
            for (int q = 0; q < 16; ++q) ss += (v[q][0] * v[q][0] + v[q][1] * v[q][1]) + (v[q][2] * v[q][2] + v[q][3] * v[q][3]); }
        ss += xshfl<16>(ss); ss += xshfl<32>(ss);
        const float rstd = rsqrtf(ss * (1.f / D) + 1e-6f);
        f32x4 acc0 = (f32x4){0.f, 0.f, 0.f, 0.f}, acc1 = acc0;
        LAS const unsigned char* bb = F.lds + RING_OFF + fr * 2048;
#pragma unroll 2
        for (int s = 0; s < 32; ++s) {
            const f32x4 xa = *(const GAS f32x4*)(x + 32 * s), xb = *(const GAS f32x4*)(x + 32 * s + 4);
            const f32x4 ga = *(const GAS f32x4*)(gp + 32 * s), gb = *(const GAS f32x4*)(gp + 32 * s + 4);
            const f32x4 sca = *(const GAS f32x4*)(m + 4 * D + 32 * s), scb = *(const GAS f32x4*)(m + 4 * D + 32 * s + 4), sha = *(const GAS f32x4*)(m + 3 * D + 32 * s), shb = *(const GAS f32x4*)(m + 3 * D + 32 * s + 4);
            const f32x4 ha = xa * rstd * ga * (1.f + sca) + sha, hb = xb * rstd * gb * (1.f + scb) + shb;
            if constexpr (FP8_G1) { v2u w; w.x = pk4_fp8(ha[0], ha[1], ha[2], ha[3]); w.y = pk4_fp8(hb[0], hb[1], hb[2], hb[3]); *(GAS v2u*)((unsigned char*)XN + (size_t)row * D + 32 * s + 8 * fq) = w; }
            else { v4u w; w.x = pk2(Q8A(ha[0]), Q8A(ha[1])); w.y = pk2(Q8A(ha[2]), Q8A(ha[3])); w.z = pk2(Q8A(hb[0]), Q8A(hb[1])); w.w = pk2(Q8A(hb[2]), Q8A(hb[3])); *(GAS v4u*)(XN + (size_t)row * D + 32 * s + 8 * fq) = w; }
            unsigned hh[4], hl[4];
#pragma unroll
            for (int j = 0; j < 2; ++j) { const unsigned a0 = f2bf(ha[2 * j]), a1 = f2bf(ha[2 * j + 1]), b0 = f2bf(hb[2 * j]), b1 = f2bf(hb[2 * j + 1]);
                hh[j] = a0 | (a1 << 16); hh[2 + j] = b0 | (b1 << 16);
                hl[j] = pk2(ha[2 * j] - __builtin_bit_cast(float, a0 << 16), ha[2 * j + 1] - __builtin_bit_cast(float, a1 << 16)); hl[2 + j] = pk2(hb[2 * j] - __builtin_bit_cast(float, b0 << 16), hb[2 * j + 1] - __builtin_bit_cast(float, b1 << 16)); }
            const bf16x8 Ah = __builtin_bit_cast(bf16x8, (v4u){hh[0], hh[1], hh[2], hh[3]}), Al = __builtin_bit_cast(bf16x8, (v4u){hl[0], hl[1], hl[2], hl[3]});
            const int co = ((4 * s + fq) ^ fr) << 4;
            const bf16x8 B0h = *(const LAS bf16x8*)(bb + co), B1h = *(const LAS bf16x8*)(bb + 32768 + co), B0l = *(const LAS bf16x8*)(bb + 65536 + co), B1l = *(const LAS bf16x8*)(bb + 65536 + 32768 + co);
            acc0 = __builtin_amdgcn_mfma_f32_16x16x32_bf16(Ah, B0h, acc0, 0, 0, 0); acc1 = __builtin_amdgcn_mfma_f32_16x16x32_bf16(Ah, B1h, acc1, 0, 0, 0);
            acc0 = __builtin_amdgcn_mfma_f32_16x16x32_bf16(Ah, B0l, acc0, 0, 0, 0); acc1 = __builtin_amdgcn_mfma_f32_16x16x32_bf16(Ah, B1l, acc1, 0, 0, 0);
            acc0 = __builtin_amdgcn_mfma_f32_16x16x32_bf16(Al, B0h, acc0, 0, 0, 0); acc1 = __builtin_amdgcn_mfma_f32_16x16x32_bf16(Al, B1h, acc1, 0, 0, 0);
        }
        const float b0v = br[fr], b1v = br[fr + 16];
        float k0[4], k1[4];
#pragma unroll
        for (int i = 0; i < 4; ++i) { k0[i] = __int_as_float((__float_as_int(acc0[i] + b0v) & ~31) | (31 - fr)); k1[i] = __int_as_float((__float_as_int(acc1[i] + b1v) & ~31) | (15 - fr)); }
        float tv[4][4]; int te[4][4];
#pragma unroll
        for (int kk = 0; kk < 4; ++kk) {
#pragma unroll
            for (int i = 0; i < 4; ++i) { const float w = rowmax16(fmaxf(k0[i], k1[i])); const int wb = __float_as_int(w); te[i][kk] = 31 - (wb & 31); tv[i][kk] = __int_as_float(wb & ~31);
                k0[i] = (k0[i] == w) ? -3.0e38f : k0[i]; k1[i] = (k1[i] == w) ? -3.0e38f : k1[i]; } }
#pragma unroll
        for (int i = 0; i < 4; ++i) { float p[4], ps = 0.f;
#pragma unroll
            for (int kk = 0; kk < 4; ++kk) { p[kk] = __expf(tv[i][kk] - tv[i][0]); ps += p[kk]; }
            if (fr < 4) { const int e = fr == 0 ? te[i][0] : fr == 1 ? te[i][1] : fr == 2 ? te[i][2] : te[i][3]; const float g = (fr == 0 ? p[0] : fr == 1 ? p[1] : fr == 2 ? p[2] : p[3]) / ps;
                const int r = rbase + 4 * fq + i; const int li = F.wave * 16 + 4 * fq + i;
                const int pl = __hip_atomic_fetch_add(hist + e, 1, __ATOMIC_RELAXED, __HIP_MEMORY_SCOPE_WORKGROUP);
                eidx[r * 4 + fr] = e; egate[r * 4 + fr] = g; rec[(li * 4 + fr) * 2] = e; rec[(li * 4 + fr) * 2 + 1] = pl; } }
    }
    __syncthreads();
    if (tid_now(F) < 32) base[tid_now(F)] = (int)__hip_atomic_fetch_add(F.ctl + CW_CNT + (layer * 32 + tid_now(F)) * 64, (unsigned)hist[tid_now(F)], RLX_AGENT);
    __syncthreads();
    { const int q = tid_now(F); const int w = q >> 6, rit = (q >> 2) & 15, k = q & 3; const int t2 = w * F.G + F.vcu;
        if (t2 < ntiles) { const int r = row0 + t2 * 16 + rit; const int e = rec[q * 2], pos = base[e] + rec[q * 2 + 1]; epos[r * 4 + k] = pos; list[(size_t)e * LCAP + pos] = r; } }
}

__device__ __forceinline__ void phase_combine(Frame& F, int layer, int row0, int nrows, int mode, const float* gnext, const float* MODN, float* out) {
    float* XS = (float*)(F.ws + WS_XS); bf16* XN = (bf16*)(F.ws + WS_XN); const bf16* Y2 = (const bf16*)(F.ws + WS_Y2); const float* MODL = (const float*)(F.ws + WS_MOD) + (size_t)layer * 9 * 6144;
    const int* eidx = (const int*)(F.ws + WS_ROUTE + RT_EIDX); const float* egate = (const float*)(F.ws + WS_ROUTE + RT_EGATE); const int* epos = (const int*)(F.ws + WS_ROUTE + RT_EPOS);
    LAS const int* pb = (LAS const int*)(F.misc + MISC_PB);
    const int lane_ = lane_now(); const int nloc = (nrows - F.vcu + F.G - 1) / F.G;
    for (int i0 = F.wave; i0 < nloc; i0 += NWAVES * 2) {
        int lane = lane_; asm volatile("" : "+v"(lane));
        const int i1 = i0 + 8; const bool ok1 = i1 < nloc; const int rA = row0 + i0 * F.G + F.vcu, rB = row0 + (ok1 ? i1 : i0) * F.G + F.vcu;
        int eA[4], eB[4], sA[4], sB[4]; float pA[4], pB[4];
#pragma unroll
        for (int k = 0; k < 4; ++k) { eA[k] = eidx[rA * 4 + k]; eB[k] = eidx[rB * 4 + k]; pA[k] = egate[rA * 4 + k]; pB[k] = egate[rB * 4 + k]; sA[k] = epos[rA * 4 + k]; sB[k] = epos[rB * 4 + k]; }
#pragma unroll
        for (int k = 0; k < 4; ++k) { sA[k] += pb[eA[k]] * 256; sB[k] += pb[eB[k]] * 256; }
        v4u yA[4][2], yB[4][2];
#pragma unroll
        for (int k = 0; k < 4; ++k)
#pragma unroll
            for (int h = 0; h < 2; ++h) { yA[k][h] = *(const GAS v4u*)(Y2 + (size_t)sA[k] * D + 512 * h + 8 * lane); yB[k][h] = *(const GAS v4u*)(Y2 + (size_t)sB[k] * D + 512 * h + 8 * lane); }
        const float* gA = MODL + (size_t)row_modrow(rA) * 6144 + 5 * D; const float* gB = MODL + (size_t)row_modrow(rB) * 6144 + 5 * D;
        f32x4 xA[2][2], xB[2][2]; float ssA = 0.f, ssB = 0.f;
#pragma unroll
        for (int h = 0; h < 2; ++h)
#pragma unroll
            for (int q = 0; q < 2; ++q) { const int c = 512 * h + 8 * lane + 4 * q;
                f32x4 aA = (f32x4){0.f, 0.f, 0.f, 0.f}, aB = aA;
#pragma unroll
                for (int k = 0; k < 4; ++k) { const unsigned wa0 = q ? yA[k][h].z : yA[k][h].x, wa1 = q ? yA[k][h].w : yA[k][h].y, wb0 = q ? yB[k][h].z : yB[k][h].x, wb1 = q ? yB[k][h].w : yB[k][h].y;
                    aA += pA[k] * (f32x4){bf_lo(wa0), bf_hi(wa0), bf_lo(wa1), bf_hi(wa1)}; aB += pB[k] * (f32x4){bf_lo(wb0), bf_hi(wb0), bf_lo(wb1), bf_hi(wb1)}; }
                const f32x4 xoA = *(const GAS f32x4*)(XS + (size_t)rA * D + c), xoB = *(const GAS f32x4*)(XS + (size_t)rB * D + c); const f32x4 ggA = *(const GAS f32x4*)(gA + c), ggB = *(const GAS f32x4*)(gB + c);
                const f32x4 nA = xoA + ggA * aA, nB = xoB + ggB * aB; xA[h][q] = nA; xB[h][q] = nB;
                if (mode == 0 || WRITE_XS_ALWAYS) { *(GAS f32x4*)(XS + (size_t)rA * D + c) = nA; if (ok1) *(GAS f32x4*)(XS + (size_t)rB * D + c) = nB; }
                ssA += (nA[0] * nA[0] + nA[1] * nA[1]) + (nA[2] * nA[2] + nA[3] * nA[3]); ssB += (nB[0] * nB[0] + nB[1] * nB[1]) + (nB[2] * nB[2] + nB[3] * nB[3]); }
#pragma unroll
        for (int o = 1; o < 64; o <<= 1) { ssA += __shfl_xor(ssA, o); ssB += __shfl_xor(ssB, o); }
        const float rsA = rsqrtf(ssA * (1.f / D) + 1e-6f), rsB = rsqrtf(ssB * (1.f / D) + 1e-6f);
        if (mode == 0) { const float* mA = MODN + (size_t)row_modrow(rA) * 6144; const float* mB = MODN + (size_t)row_modrow(rB) * 6144;
#pragma unroll
            for (int h = 0; h < 2; ++h) { float oA[8], oB[8];
#pragma unroll
                for (int q = 0; q < 2; ++q) { const int c = 512 * h + 8 * lane + 4 * q; const f32x4 gn = *(const GAS f32x4*)(gnext + c);
                    const f32x4 yA_ = xA[h][q] * rsA * gn * (1.f + *(const GAS f32x4*)(mA + D + c)) + *(const GAS f32x4*)(mA + c), yB_ = xB[h][q] * rsB * gn * (1.f + *(const GAS f32x4*)(mB + D + c)) + *(const GAS f32x4*)(mB + c);
                    oA[4 * q] = yA_[0]; oA[4 * q + 1] = yA_[1]; oA[4 * q + 2] = yA_[2]; oA[4 * q + 3] = yA_[3]; oB[4 * q] = yB_[0]; oB[4 * q + 1] = yB_[1]; oB[4 * q + 2] = yB_[2]; oB[4 * q + 3] = yB_[3]; }
                v4u w; w.x = pk2(oA[0], oA[1]); w.y = pk2(oA[2], oA[3]); w.z = pk2(oA[4], oA[5]); w.w = pk2(oA[6], oA[7]);
                *(GAS v4u*)(XN + (size_t)rA * D + 512 * h + 8 * lane) = w;
                if (ok1) { w.x = pk2(oB[0], oB[1]); w.y = pk2(oB[2], oB[3]); w.z = pk2(oB[4], oB[5]); w.w = pk2(oB[6], oB[7]); *(GAS v4u*)(XN + (size_t)rB * D + 512 * h + 8 * lane) = w; } }
        } else {
#pragma unroll
            for (int h = 0; h < 2; ++h)
#pragma unroll
                for (int q = 0; q < 2; ++q) { const int c = 512 * h + 8 * lane + 4 * q; const f32x4 gn = *(const GAS f32x4*)(gnext + c);
                    *(GAS f32x4*)(out + (size_t)(rA - NCTX) * D + c) = xA[h][q] * rsA * gn; if (ok1) *(GAS f32x4*)(out + (size_t)(rB - NCTX) * D + c) = xB[h][q] * rsB * gn; }
        }
    }
}
}
namespace mk {
__device__ __forceinline__ void p0_dense_weight(Frame& F, const float* W, int K, int N, bf16* WT, int rot) {
    LAS float* scr = (LAS float*)(F.lds + RING_OFF + F.wave * 16384);
    const int NGW = F.G * NWAVES; const int gw = (F.vcu * NWAVES + F.wave + rot) % NGW;
    const int nb = N / 32, items = (K / 64) * nb;
    for (int it = gw; it < items; it += NGW) { const int kb = it / nb, n0 = (it % nb) * 32; transpose_item(W, N, kb * 64, n0, WT + (size_t)n0 * K + kb * 64, K, scr, lane_now()); }
}
__device__ __forceinline__ void p0_gate_weights(Frame& F, const float* ga, const float* gx, int rot) {
    LAS float* scr = (LAS float*)(F.lds + RING_OFF + F.wave * 16384);
    const int NGW = F.G * NWAVES; const int gw = (F.vcu * NWAVES + F.wave + rot) % NGW;
    bf16* WG = (bf16*)(F.ws + WS_WGATE);
    for (int it = gw; it < 16 * 32; it += NGW) { const int mat = it >> 5, r = it & 31, kb = r >> 3, nbk = r & 7, n0 = nbk * 32; const int ty = mat & 1, dg = mat >> 1;
        const float* W = (ty ? gx : ga) + (size_t)dg * 65536; const int jt = n0 >> 7, rr = (n0 & 127) + (ty ? 128 : 0);
        transpose_item(W, 256, kb * 64, n0, WG + ((size_t)(dg * 2 + jt) * 256 + rr) * 256 + kb * 64, 256, scr, lane_now()); }
}
__device__ __forceinline__ void p0_adaln(Frame& F, const float* c, const float* cctx, const float* w_mod, const float* b_mod) {
    LAS float* sil = (LAS float*)(F.lds + RING_OFF);
    LAS float* part = (LAS float*)(F.lds + RING_OFF + 40960);
    float* MOD = (float*)(F.ws + WS_MOD);
    if (F.vcu >= 192 && F.G >= 256) return;
    for (int idx = tid_now(F); idx < 9 * 1024; idx += NTHR) { const float v = idx < 8192 ? c[idx] : cctx[idx - 8192]; sil[idx] = v / (1.f + __expf(-v)); }
    __syncthreads();
    for (int item = F.vcu; item < 192; item += F.G) {
        const int layer = item / 96, n0 = (item % 96) * 64; const float* w = w_mod + (size_t)layer * 1024 * 6144 + n0 + lane_now(); const int k0 = F.wave * 128;
        float acc[9];
#pragma unroll
        for (int b = 0; b < 9; ++b) acc[b] = 0.f;
        for (int kk = 0; kk < 128; kk += 16) { float wv[16];
#pragma unroll
            for (int j = 0; j < 16; ++j) wv[j] = w[(size_t)(k0 + kk + j) * 6144];
#pragma unroll
            for (int q = 0; q < 4; ++q)
#pragma unroll
                for (int b = 0; b < 9; ++b) { const f32x4 s = *(const LAS f32x4*)(sil + b * 1024 + k0 + kk + 4 * q); acc[b] += s[0] * wv[4 * q] + s[1] * wv[4 * q + 1] + s[2] * wv[4 * q + 2] + s[3] * wv[4 * q + 3]; } }
#pragma unroll
        for (int b = 0; b < 9; ++b) part[(F.wave * 9 + b) * 64 + lane_now()] = acc[b];
        __syncthreads();
        for (int q = tid_now(F); q < 9 * 64; q += NTHR) { const int b = q >> 6, l = q & 63; float s = 0.f;
#pragma unroll
            for (int wv = 0; wv < 8; ++wv) s += part[(wv * 9 + b) * 64 + l];
            MOD[((size_t)layer * 9 + b) * 6144 + n0 + l] = s + b_mod[layer * 6144 + n0 + l]; }
        __syncthreads();
    }
}
__device__ __forceinline__ void p0_wait_adaln(Frame& F) {
    if (tid_now(F) == 0) { unsigned sp = 0; while (__hip_atomic_load(F.ctl + CW_ADALN, RLX_AGENT) < 192u) { __builtin_amdgcn_s_sleep(2); if (++sp > (1u << 22)) break; }
        __builtin_amdgcn_fence(__ATOMIC_ACQUIRE, "agent"); asm volatile("s_waitcnt vmcnt(0)" ::: "memory"); }
    __syncthreads();
}
constexpr int TAB_COS = 0, TAB_SIN = 1024, TAB_SP = 2048, TAB_LAM = 4096;
__device__ __forceinline__ void p0_tables(Frame& F, const float* lq1, const float* lk1, const float* lq2, const float* lk2, const float* lru) {
    if (F.vcu != (F.G > 200 ? 200 : 0)) return;
    float* T = (float*)(F.ws + WS_TAB);
    for (int i = tid_now(F); i < 1024; i += NTHR) { const int pos = i >> 4, f = i & 15; const float inv = powf(10000.f, -(float)f / 16.f); const float ang = (float)pos * inv; T[TAB_COS + i] = cosf(ang); T[TAB_SIN + i] = sinf(ang); }
    for (int i = tid_now(F); i < 2048; i += NTHR) T[TAB_SP + i] = log1pf(expf(-lru[i]));
    if (tid_now(F) == 0) { float a = 0.f, b = 0.f; for (int i = 0; i < 64; ++i) { a += lq1[i] * lk1[i]; b += lq2[i] * lk2[i]; } T[TAB_LAM] = expf(a) - expf(b) + 0.2f; }
}

__device__ __forceinline__ void phase_norm1_l0(Frame& F, const float* x, const float* ctx, const float* g) {
    bf16* XN = (bf16*)(F.ws + WS_XN); const float* MODL = (const float*)(F.ws + WS_MOD);
    int lane_ = lane_now(); asm volatile("" : "+v"(lane_)); const int lane = lane_;
    const int gw = F.vcu * NWAVES + F.wave, NGW = F.G * NWAVES;
    for (int r = gw; r < NTOK; r += NGW) {
        const float* src = r < NCTX ? ctx + (size_t)r * D : x + (size_t)(r - NCTX) * D; const float* m = MODL + (size_t)row_modrow(r) * 6144;
        f32x4 v[2][2]; float ss = 0.f;
#pragma unroll
        for (int h = 0; h < 2; ++h)
#pragma unroll
            for (int q = 0; q < 2; ++q) { v[h][q] = *(const GAS f32x4*)(src + 512 * h + 8 * lane + 4 * q); ss += (v[h][q][0] * v[h][q][0] + v[h][q][1] * v[h][q][1]) + (v[h][q][2] * v[h][q][2] + v[h][q][3] * v[h][q][3]); }
        const float rstd = rsqrtf(wave_sum(ss) * (1.f / D) + 1e-6f);
#pragma unroll
        for (int h = 0; h < 2; ++h) { float o[8];
#pragma unroll
            for (int q = 0; q < 2; ++q) { const int c = 512 * h + 8 * lane + 4 * q; const f32x4 gn = *(const GAS f32x4*)(g + c), sc = *(const GAS f32x4*)(m + D + c), sh = *(const GAS f32x4*)(m + c);
                const f32x4 y = v[h][q] * rstd * gn * (1.f + sc) + sh; o[4 * q] = y[0]; o[4 * q + 1] = y[1]; o[4 * q + 2] = y[2]; o[4 * q + 3] = y[3]; }
            v4u w; w.x = pk2(o[0], o[1]); w.y = pk2(o[2], o[3]); w.z = pk2(o[4], o[5]); w.w = pk2(o[6], o[7]);
            *(GAS v4u*)(XN + (size_t)r * D + 512 * h + 8 * lane) = w; }
    }
}

struct DenseSched {
    pg8::TileOrder ord; const char* A; const char* W; int a_pitch; int K2;
    __device__ __forceinline__ bool next(int i, pg8::Unit& u) const { return ord.tile(i, u); }
    __device__ __forceinline__ const char* a_base(const pg8::Unit& u) const { return A + (size_t)u.pm * 256 * a_pitch; }
    __device__ __forceinline__ const char* b_base(const pg8::Unit& u) const { return W + (size_t)u.pn * 256 * K2; }
    __device__ __forceinline__ unsigned a_rowoff(const pg8::Unit&, int) const { return 0u; }
};
constexpr float ATT_C2 = 0.125f * 1.4426950408889634f;
struct EpiInProj0 {
    static constexpr bool PERM = false;
    bf16* PROJ; const float* TAB;
    __device__ __forceinline__ void operator()(const pg8::f32x4 (&acc)[2][2][4][2], const pg8::Unit& u, int wr, int wc, int fr, int fq) const {
        const bool rope = u.pn < 4 && u.pm >= 8; const float sc = u.pn < 2 ? ATT_C2 : 1.f; const int axis = wc & 1;
#pragma unroll
        for (int ai = 0; ai < 2; ++ai)
#pragma unroll
            for (int m = 0; m < 4; ++m) { const int r = u.pm * 256 + ai * 128 + wr * 64 + m * 16 + fr;
                pg8::f32x4 cs = (pg8::f32x4){1.f, 1.f, 1.f, 1.f}, sn = (pg8::f32x4){0.f, 0.f, 0.f, 0.f};
                if (rope) { const int t = (r - NCTX) & 2047; const int pos = axis ? (t & 63) : (t >> 6); cs = *(const pg8::f32x4*)(TAB + TAB_COS + pos * 16 + 4 * fq); sn = *(const pg8::f32x4*)(TAB + TAB_SIN + pos * 16 + 4 * fq); }
                bf16* rowp = PROJ + (size_t)r * 3072 + u.pn * 256 + wc * 32 + 4 * fq;
#pragma unroll
                for (int bj = 0; bj < 2; ++bj) { const pg8::f32x4 x1 = acc[ai][bj][m][0], x2 = acc[ai][bj][m][1];
                    const pg8::f32x4 o1 = (x1 * cs - x2 * sn) * sc, o2 = (x2 * cs + x1 * sn) * sc;
                    pg8::u32x2 w1, w2; w1.x = pg8::cvt_pk_bf16(o1[0], o1[1]); w1.y = pg8::cvt_pk_bf16(o1[2], o1[3]); w2.x = pg8::cvt_pk_bf16(o2[0], o2[1]); w2.y = pg8::cvt_pk_bf16(o2[2], o2[3]);
                    *(pg8::u32x2*)(rowp + bj * 128) = w1; *(pg8::u32x2*)(rowp + bj * 128 + 16) = w2; } }
    }
};
struct EpiResid {
    static constexpr bool PERM = true;
    float* XS; const float* x_in; const float* ctx_in; const float* gate;
    int row0;
    __device__ __forceinline__ void operator()(const pg8::f32x4 (&acc)[2][2][4][2], const pg8::Unit& u, int wr, int wc, int fr, int fq) const {
        const int col0 = u.pn * 256 + wc * 32 + 8 * fq;
#pragma unroll
        for (int ai = 0; ai < 2; ++ai)
#pragma unroll
            for (int m = 0; m < 4; ++m) { const int r = row0 + u.pm * 256 + ai * 128 + wr * 64 + m * 16 + fr; const float* g = gate + (size_t)row_modrow(r) * 6144 + col0;
                const float* bp = x_in ? (r < NCTX ? ctx_in + (size_t)r * D : x_in + (size_t)(r - NCTX) * D) : XS + (size_t)r * D; float* op = XS + (size_t)r * D + col0; bp += col0;
#pragma unroll
                for (int bj = 0; bj < 2; ++bj)
#pragma unroll
                    for (int n = 0; n < 2; ++n) { const int o = bj * 128 + n * 4; const pg8::f32x4 gg = *(const pg8::f32x4*)(g + o), bb = *(const pg8::f32x4*)(bp + o);
                        *(pg8::f32x4*)(op + o) = bb + gg * acc[ai][bj][m][n]; }
                if (m & 1) asm volatile("" ::: "memory"); }
    }
};
}
namespace mk {
namespace att {
constexpr int PITCH = 3072;
constexpr int SLOT = 32768, NSL = 4;
static_assert(NSL * SLOT <= RING_BYTES && MISC_REC + 8 * 512 <= LDS_BYTES - MISC_OFF, "attention LDS: four K/V slots fill the ring; the per-wave f32 scratch [8][128] lives in the MISC area");
__device__ __forceinline__ int crow(int r, int hi) { return (r & 3) + 8 * (r >> 2) + 4 * hi; }
#define ATT_WAIT_BAR(N) asm volatile("s_waitcnt vmcnt(" #N ") lgkmcnt(0)\n\ts_barrier" ::: "memory")
typedef short v4i16_t __attribute__((ext_vector_type(4)));
__device__ __forceinline__ s16x4 vtr(LAS const unsigned char* p) { return __builtin_bit_cast(s16x4, __builtin_amdgcn_ds_read_tr16_b64_v4i16((LAS v4i16_t*)p)); }
__device__ __forceinline__ unsigned cvtpk(float lo, float hi) { typedef float f2 __attribute__((ext_vector_type(2))); typedef __bf16 b2 __attribute__((ext_vector_type(2))); f2 v = {lo, hi}; b2 b = __builtin_convertvector(v, b2); return __builtin_bit_cast(unsigned, b); }
__device__ __forceinline__ float half_swap_max(float m) { auto rr = __builtin_amdgcn_permlane32_swap(__float_as_uint(m), __float_as_uint(m), false, false); return fmaxf(__uint_as_float(rr[0]), __uint_as_float(rr[1])); }
__device__ __forceinline__ float half_swap_sum(float m) { auto rr = __builtin_amdgcn_permlane32_swap(__float_as_uint(m), __float_as_uint(m), false, false); return __uint_as_float(rr[0]) + __uint_as_float(rr[1]); }

template <int ABL = 0> __device__ __forceinline__ void attn_unit(LAS unsigned char* lds, LAS float* scr, const bf16* PROJ, bf16* CAT, const int qrow0, const int krow_ctx, const int krow_lat, const int NT, const int h, const float lam, const float* subln, const int tid_in) {
    int tid = tid_in; asm volatile("" : "+v"(tid));
    const int lane = tid & 63, r32 = lane & 31, hi = lane >> 5; const int wid = __builtin_amdgcn_readfirstlane(tid >> 6); const int mh = wid >> 2, wq = wid & 3;
    LAS float* wsf = scr + wid * 128; LAS float* wsfh = wsf + 4 * hi;
#define CR(r) (((r) & 3) + 8 * ((r) >> 2))
    const int krow_ = 8 * wid + (lane >> 3);
    const bf16* kbase = PROJ + 512 + h * 128 + (size_t)krow_ * PITCH + (((lane & 7) ^ ((krow_ >> 1) & 7)) * 8);
    const bf16* vbase0 = PROJ + 1024 + h * 128 + ((wid >> 2) * 32) + (lane & 3) * 8 + (size_t)(16 * (wid & 3) + (lane >> 2)) * PITCH;
    const bf16* vbase1 = vbase0 + 64;
    const unsigned lds0 = (unsigned)__builtin_amdgcn_readfirstlane((int)(unsigned)(uintptr_t)lds) + (unsigned)wid * 1024u;
#define ATT_GLDS(gsrc, dst) do { unsigned keep_; asm volatile("s_mov_b32 %0, m0\n\ts_mov_b32 m0, %2\n\ts_nop 0\n\tglobal_load_lds_dwordx4 %1, off\n\ts_mov_b32 m0, %0" : "=&s"(keep_) : "v"(gsrc), "s"(dst) : "memory"); } while (0)
#define ATT_DMA(t, slot) do { const size_t kr_ = (size_t)((t) < 4 ? krow_ctx + 64 * (t) : krow_lat + 64 * ((t) - 4)) * PITCH; const unsigned d_ = lds0 + (unsigned)(slot) * SLOT; \
        ATT_GLDS(kbase + kr_, d_); ATT_GLDS(kbase + kr_ + 64, d_ + 8192u); ATT_GLDS(vbase0 + kr_, d_ + 16384u); ATT_GLDS(vbase1 + kr_, d_ + 24576u); } while (0)
#ifndef MK_ATT_LAG
#define MK_ATT_LAG 0
#endif
    ATT_DMA(0, 0); ATT_DMA(1, 1);
    const bf16* Qw = PROJ + (size_t)(qrow0 + wq * 32 + r32) * PITCH + h * 128 + mh * 64 + hi * 8;
    bf16x8 qr[4];
#pragma unroll
    for (int d0 = 0; d0 < 4; ++d0) qr[d0] = *(const GAS bf16x8*)(Qw + d0 * 16);
    asm volatile("" : "+v"(qr[0]), "+v"(qr[1]), "+v"(qr[2]), "+v"(qr[3]));
    float mrow = 0.f, l_reg = 0.f; f32x16 o[4]; f32x16 negm;
#pragma unroll
    for (int d0 = 0; d0 < 4; ++d0)
#pragma unroll
        for (int r = 0; r < 16; ++r) o[d0][r] = 0.f;
#pragma unroll
    for (int r = 0; r < 16; ++r) negm[r] = 0.f;
    int koffs[4];
#pragma unroll
    for (int d0 = 0; d0 < 4; ++d0) koffs[d0] = mh * 8192 + r32 * 128 + (((2 * d0 + hi) ^ ((r32 >> 1) & 7)) << 4);
    const int voff = 16384 + ((lane >> 4) & 1) * 32 + (lane & 3) * 8 + (4 * hi + ((lane & 15) >> 2)) * 64;
#define SBAR() __builtin_amdgcn_sched_barrier(0)
#define ATT_VF(lo_, hi_) ((bf16x8){lo_[0], lo_[1], lo_[2], lo_[3], hi_[0], hi_[1], hi_[2], hi_[3]})
    v4u pwp[4];
#pragma unroll
    for (int k = 0; k < 4; ++k) pwp[k] = (v4u){0u, 0u, 0u, 0u};
#define ATT_STEP(T_, HASQK, HASPV) do { const int t = (T_); \
        if (HASQK) { if (t + 1 < NT) { ATT_WAIT_BAR(4); } else { ATT_WAIT_BAR(0); } \
            if (t + 2 < NT && ABL != 3) ATT_DMA(t + 2, (t + 2) & 3); } \
        f32x16 p0 = negm, p1 = negm; bool resc = false; \
        if (HASQK) { \
            LAS const unsigned char* kp = lds + (t & 3) * SLOT; \
            bf16x8 kf[8]; \
            _Pragma("unroll") for (int d0 = 0; d0 < 4; ++d0) { kf[2 * d0] = *(const LAS bf16x8*)(kp + koffs[d0]); kf[2 * d0 + 1] = *(const LAS bf16x8*)(kp + koffs[d0] + 4096); } \
            SBAR(); \
            _Pragma("unroll") for (int d0 = 0; d0 < 4; ++d0) { p0 = __builtin_amdgcn_mfma_f32_32x32x16_bf16(kf[2 * d0], qr[d0], p0, 0, 0, 0); p1 = __builtin_amdgcn_mfma_f32_32x32x16_bf16(kf[2 * d0 + 1], qr[d0], p1, 0, 0, 0); } \
            SBAR(); \
            float rm = __builtin_fmaxf(p0[0], p1[0]); \
            _Pragma("unroll") for (int r = 1; r < 16; ++r) rm = __builtin_fmaxf(rm, __builtin_fmaxf(p0[r], p1[r])); \
            rm = half_swap_max(rm); \
            if (!(HASPV) || __any(rm > 8.f)) { \
                const float dl = !(HASPV) ? rm : __builtin_fmaxf(rm, 0.f); mrow += dl; \
                _Pragma("unroll") for (int r = 0; r < 16; ++r) { p0[r] -= dl; p1[r] -= dl; negm[r] = -mrow; } \
                if (HASPV) { const float f = __builtin_amdgcn_exp2f(-dl); l_reg *= f; if (hi == 0) wsf[r32] = f; resc = true; } \
            } \
            SBAR(); \
        } \
        { LAS const unsigned char* vp = lds + ((t - 1) & 3) * SLOT + voff; \
            v4u pwn[4]; float sacc = 0.f; \
            if (HASPV) { \
                _Pragma("unroll") for (int d0 = 0; d0 < 4; ++d0) { \
                    s16x4 lo[4], hh[4]; \
                    _Pragma("unroll") for (int ks = 0; ks < 4; ++ks) { lo[ks] = vtr(vp + d0 * 4096 + ks * 1024); hh[ks] = vtr(vp + d0 * 4096 + ks * 1024 + 512); } \
                    _Pragma("unroll") for (int ks = 0; ks < 4; ++ks) o[d0] = __builtin_amdgcn_mfma_f32_32x32x16_bf16(__builtin_bit_cast(bf16x8, pwp[ks]), ATT_VF(lo[ks], hh[ks]), o[d0], 0, 0, 0); \
                } \
            } \
            if (HASQK) { \
                _Pragma("unroll") for (int r = 0; r < 16; ++r) { p0[r] = __builtin_amdgcn_exp2f(p0[r]); p1[r] = __builtin_amdgcn_exp2f(p1[r]); sacc += p0[r] + p1[r]; } \
                l_reg += sacc; \
                pwn[0] = (v4u){cvtpk(p0[0], p0[1]), cvtpk(p0[2], p0[3]), cvtpk(p0[4], p0[5]), cvtpk(p0[6], p0[7])}; \
                pwn[1] = (v4u){cvtpk(p0[8], p0[9]), cvtpk(p0[10], p0[11]), cvtpk(p0[12], p0[13]), cvtpk(p0[14], p0[15])}; \
                pwn[2] = (v4u){cvtpk(p1[0], p1[1]), cvtpk(p1[2], p1[3]), cvtpk(p1[4], p1[5]), cvtpk(p1[6], p1[7])}; \
                pwn[3] = (v4u){cvtpk(p1[8], p1[9]), cvtpk(p1[10], p1[11]), cvtpk(p1[12], p1[13]), cvtpk(p1[14], p1[15])}; \
            } \
            if (HASQK) asm volatile("" : "+v"(pwn[0]), "+v"(pwn[1]), "+v"(pwn[2]), "+v"(pwn[3]), "+v"(l_reg));     \
            if ((HASQK) && (HASPV)) { \
                __builtin_amdgcn_sched_group_barrier(0x100, 6, 0);     \
                _Pragma("unroll") for (int g = 0; g < 16; ++g) { __builtin_amdgcn_sched_group_barrier(0x008, 1, 0); if (g < 13) __builtin_amdgcn_sched_group_barrier(0x100, 2, 0); __builtin_amdgcn_sched_group_barrier(0x400, 2, 0); __builtin_amdgcn_sched_group_barrier(0x002, 5, 0); } \
            } \
            SBAR(); \
            if (HASQK) { _Pragma("unroll") for (int k = 0; k < 4; ++k) pwp[k] = pwn[k]; } \
        } \
        if (resc) { LDS_WAIT(); float fr_[16]; \
            _Pragma("unroll") for (int r = 0; r < 16; ++r) fr_[r] = wsfh[CR(r)]; \
            _Pragma("unroll") for (int d0 = 0; d0 < 4; ++d0) _Pragma("unroll") for (int r = 0; r < 16; ++r) o[d0][r] *= fr_[r]; } \
        SBAR(); } while (0)
    ATT_STEP(0, true, false);
    for (int tt = 1; tt < NT; ++tt) ATT_STEP(tt, true, true);
    ATT_STEP(NT, false, true);
#undef ATT_STEP
#undef ATT_VF
#undef SBAR
    l_reg = half_swap_sum(l_reg);
    const float coef = (mh == 0 ? 1.f : -lam) / l_reg;
    if (hi == 0) wsf[64 + r32] = coef;
    ATT_WAIT_BAR(0);
    float cf[16];
#pragma unroll
    for (int r = 0; r < 16; ++r) cf[r] = wsfh[64 + CR(r)];
    LAS float* X = (LAS float*)lds + wq * 4096 + 4 * hi * 128 + r32;
    if (mh == 1) {
#pragma unroll
        for (int d0 = 0; d0 < 4; ++d0)
#pragma unroll
            for (int r = 0; r < 16; ++r) X[CR(r) * 128 + d0 * 32] = o[d0][r] * cf[r];
    }
    ATT_WAIT_BAR(0);
    if (mh == 0) {
        float ssq[16];
#pragma unroll
        for (int r = 0; r < 16; ++r) ssq[r] = 0.f;
#pragma unroll
        for (int d0 = 0; d0 < 4; ++d0)
#pragma unroll
            for (int r = 0; r < 16; ++r) { const float v = o[d0][r] * cf[r] + X[CR(r) * 128 + d0 * 32]; o[d0][r] = v; ssq[r] += v * v; }
#pragma unroll
        for (int r = 0; r < 16; ++r) { float s = ssq[r]; s += __shfl_xor(s, 1); s += __shfl_xor(s, 2); s += __shfl_xor(s, 4); s += __shfl_xor(s, 8); s += __shfl_xor(s, 16); ssq[r] = rsqrtf(s * (1.f / 128.f) + 1e-6f) * 0.8f; }
        LDS_WAIT();
        LAS bf16* stg = (LAS bf16*)(lds + wq * 16384);
        LAS bf16* stgh = stg + 4 * hi * 128 + r32;
#pragma unroll
        for (int d0 = 0; d0 < 4; ++d0) { const float g = subln[d0 * 32 + r32];
#pragma unroll
            for (int r = 0; r < 16; ++r) stgh[CR(r) * 128 + d0 * 32] = (bf16)f2bf(o[d0][r] * ssq[r] * g); }
        LDS_WAIT();
        bf16* Ow = CAT + (size_t)(qrow0 + wq * 32) * D + h * 128;
        int le = lane; asm volatile("" : "+v"(le));
#pragma unroll
        for (int i = 0; i < 8; ++i) { const int row = i * 4 + (le >> 4), ch = le & 15; const v4u v = *(const LAS v4u*)(stg + row * 128 + ch * 8); *(GAS v4u*)(Ow + (size_t)row * D + ch * 8) = v; }
    }
    ATT_WAIT_BAR(0);
#undef ATT_DMA
#undef ATT_GLDS
#undef CR
}
__device__ __forceinline__ void conv_items(Frame& F, const bf16* PROJ, bf16* CAT, const float* cw) {
    int lane_ = lane_now(); asm volatile("" : "+v"(lane_)); const int lane = lane_;
    const int gw = F.vcu * NWAVES + F.wave, NGW = F.G * NWAVES; const int c0 = 8 * lane;
    float w0[8], w1[8], w2[8];
#pragma unroll
    for (int j = 0; j < 8; ++j) { w0[j] = cw[c0 + j]; w1[j] = cw[512 + c0 + j]; w2[j] = cw[1024 + c0 + j]; }
    for (int it = gw; it < NTOK / 16; it += NGW) {
        const int r0 = it * 16; const int seg0 = r0 < NCTX ? (r0 & ~255) : NCTX + ((r0 - NCTX) & ~2047); const int seg1 = r0 < NCTX ? seg0 + 256 : seg0 + 2048;
        float pm1[8], pc[8], pn[8];
        auto prod = [&](int r, float (&dst)[8]) { if (r < seg0 || r >= seg1) {
#pragma unroll
                for (int j = 0; j < 8; ++j) dst[j] = 0.f; return; }
            const v4u a = *(const GAS v4u*)(PROJ + (size_t)r * att::PITCH + 2048 + c0), b = *(const GAS v4u*)(PROJ + (size_t)r * att::PITCH + 2560 + c0);
            dst[0] = bf_lo(a.x) * bf_lo(b.x); dst[1] = bf_hi(a.x) * bf_hi(b.x); dst[2] = bf_lo(a.y) * bf_lo(b.y); dst[3] = bf_hi(a.y) * bf_hi(b.y);
            dst[4] = bf_lo(a.z) * bf_lo(b.z); dst[5] = bf_hi(a.z) * bf_hi(b.z); dst[6] = bf_lo(a.w) * bf_lo(b.w); dst[7] = bf_hi(a.w) * bf_hi(b.w); };
        prod(r0 - 1, pm1); prod(r0, pc);
        for (int i = 0; i < 16; ++i) { const int r = r0 + i; prod(r + 1, pn);
            const v4u g = *(const GAS v4u*)(PROJ + (size_t)r * att::PITCH + 1536 + c0); const float bg[8] = {bf_lo(g.x), bf_hi(g.x), bf_lo(g.y), bf_hi(g.y), bf_lo(g.z), bf_hi(g.z), bf_lo(g.w), bf_hi(g.w)};
            float o[8];
#pragma unroll
            for (int j = 0; j < 8; ++j) { o[j] = bg[j] * (w0[j] * pm1[j] + w1[j] * pc[j] + w2[j] * pn[j]); pm1[j] = pc[j]; pc[j] = pn[j]; }
            v4u w; w.x = pk2(o[0], o[1]); w.y = pk2(o[2], o[3]); w.z = pk2(o[4], o[5]); w.w = pk2(o[6], o[7]);
            *(GAS v4u*)(CAT + (size_t)r * D + 512 + c0) = w; }
    }
}
}
template <int ABL = 0> __device__ __forceinline__ void phase_attn(Frame& F, const float* subln, const float* cw, const float* fw1 = nullptr, const float* fw2 = nullptr) {
    const bf16* PROJ = (const bf16*)(F.ws + WS_PROJ); bf16* CAT = (bf16*)(F.ws + WS_CAT); const float lam = ((const float*)(F.ws + WS_TAB))[TAB_LAM];
    int tid_ = tid_now(F); asm volatile("" : "+v"(tid_));
    if (F.G == 256) {
        const int xq = F.vcu >> 5, j = F.vcu & 31;
        for (int pass = 0; pass < 2; ++pass) { const int bh = 4 * xq + 2 * pass + (j >> 4), qb = j & 15, b = bh >> 2, h = bh & 3;
            att::attn_unit<ABL>(F.lds + RING_OFF, (LAS float*)(F.misc + MISC_REC), PROJ, CAT, NCTX + b * SEQ + qb * 128, b * CT, NCTX + b * SEQ, 36, h, lam, subln, tid_); }
    } else {
        for (int u = F.vcu; u < 512; u += F.G) { const int bh = u >> 4, qb = u & 15, b = bh >> 2, h = bh & 3;
            att::attn_unit<ABL>(F.lds + RING_OFF, (LAS float*)(F.misc + MISC_REC), PROJ, CAT, NCTX + b * SEQ + qb * 128, b * CT, NCTX + b * SEQ, 36, h, lam, subln, tid_); }
    }
    for (int u = F.vcu; u < 64; u += F.G) { const int bh = u >> 1, qb = u & 1, b = bh >> 2, h = bh & 3;
        att::attn_unit<ABL>(F.lds + RING_OFF, (LAS float*)(F.misc + MISC_REC), PROJ, CAT, b * CT + qb * 128, b * CT, NCTX + b * SEQ, 4, h, lam, subln, tid_); }
    if (ABL == 0) att::conv_items(F, PROJ, CAT, cw);
    if (ABL == 0 && fw1 && F.vcu >= 64) filler(F, fw1, fw2, 1);
}
}
namespace mk {
struct EpiBf16 {
    static constexpr bool PERM = true;
    bf16* O; int ldc;
    __device__ __forceinline__ void operator()(const pg8::f32x4 (&acc)[2][2][4][2], const pg8::Unit& u, int wr, int wc, int fr, int fq) const {
        const int col0 = u.pn * 256 + wc * 32 + 8 * fq;
#pragma unroll
        for (int ai = 0; ai < 2; ++ai)
#pragma unroll
            for (int m = 0; m < 4; ++m) { bf16* rowp = O + (size_t)(u.pm * 256 + ai * 128 + wr * 64 + m * 16 + fr) * ldc + col0;
#pragma unroll
                for (int bj = 0; bj < 2; ++bj) { const pg8::f32x4 v0 = acc[ai][bj][m][0], v1 = acc[ai][bj][m][1];
                    pg8::u32x4 w; w.x = pg8::cvt_pk_bf16(v0[0], v0[1]); w.y = pg8::cvt_pk_bf16(v0[2], v0[3]); w.z = pg8::cvt_pk_bf16(v1[0], v1[1]); w.w = pg8::cvt_pk_bf16(v1[2], v1[3]);
                    *(pg8::u32x4*)(rowp + bj * 128) = w; } }
    }
};
struct InProj1Sched {
    pg8::TileOrder ord; int G, c; const char* A; const char* W; int a_pitch;
    __device__ __forceinline__ bool next(int i, pg8::Unit& u) const { const int L = i * G + c; if (L >= 544) return false;
        if (L < 512) { ord.map(L, u); u.pm += 8; } else { const int q = L - 512; u.pm = q >> 2; u.pn = 4 + (q & 3); } return true; }
    __device__ __forceinline__ const char* a_base(const pg8::Unit& u) const { return A + (size_t)u.pm * 256 * 2048; }
    __device__ __forceinline__ const char* b_base(const pg8::Unit& u) const { return W + (size_t)u.pn * 256 * 2048; }
    __device__ __forceinline__ unsigned a_rowoff(const pg8::Unit&, int) const { return 0u; }
};
__device__ __forceinline__ void phase_conv1(Frame& F, const float* cw, const float* cb) {
    const bf16* GU = (const bf16*)(F.ws + WS_PROJ); bf16* XC = (bf16*)(F.ws + WS_XC);
    int lane_ = lane_now(); asm volatile("" : "+v"(lane_)); const int lane = lane_;
    const int gw = F.vcu * NWAVES + F.wave, NGW = F.G * NWAVES;
    for (int it = gw; it < (NTOK / 16) * 2; it += NGW) {
        const int r0 = (it >> 1) * 16, c0 = (it & 1) * 512 + 8 * lane; const int seg0 = r0 < NCTX ? (r0 & ~255) : NCTX + ((r0 - NCTX) & ~2047); const int seg1 = r0 < NCTX ? seg0 + 256 : seg0 + 2048;
        float wf[4][8], wb[4][8], bf_[8], bb_[8];
#pragma unroll
        for (int j = 0; j < 8; ++j) { bf_[j] = cb[c0 + j]; bb_[j] = cb[1024 + c0 + j];
#pragma unroll
            for (int k = 0; k < 4; ++k) { wf[k][j] = cw[k * 1024 + c0 + j]; wb[k][j] = cw[(4 + k) * 1024 + c0 + j]; } }
        float win[7][8];
        auto ld = [&](int r, float (&dst)[8]) { if (r < seg0 || r >= seg1) {
#pragma unroll
                for (int j = 0; j < 8; ++j) dst[j] = 0.f; return; }
            const v4u a = *(const GAS v4u*)(GU + (size_t)r * 2048 + 1024 + c0);
            dst[0] = bf_lo(a.x); dst[1] = bf_hi(a.x); dst[2] = bf_lo(a.y); dst[3] = bf_hi(a.y); dst[4] = bf_lo(a.z); dst[5] = bf_hi(a.z); dst[6] = bf_lo(a.w); dst[7] = bf_hi(a.w); };
#pragma unroll
        for (int q = 0; q < 6; ++q) ld(r0 - 3 + q, win[q + 1]);
#pragma unroll 4
        for (int i = 0; i < 16; ++i) { const int r = r0 + i;
#pragma unroll
            for (int q = 0; q < 6; ++q)
#pragma unroll
                for (int j = 0; j < 8; ++j) win[q][j] = win[q + 1][j];
            ld(r + 3, win[6]);
            float of[8], ob[8];
#pragma unroll
            for (int j = 0; j < 8; ++j) { of[j] = bf_[j] + wf[0][j] * win[0][j] + wf[1][j] * win[1][j] + wf[2][j] * win[2][j] + wf[3][j] * win[3][j];
                ob[j] = bb_[j] + wb[0][j] * win[3][j] + wb[1][j] * win[4][j] + wb[2][j] * win[5][j] + wb[3][j] * win[6][j]; }
            v4u w; w.x = pk2(of[0], of[1]); w.y = pk2(of[2], of[3]); w.z = pk2(of[4], of[5]); w.w = pk2(of[6], of[7]);
            *(GAS v4u*)(XC + (size_t)r * D + c0) = w;
            w.x = pk2(ob[0], ob[1]); w.y = pk2(ob[2], ob[3]); w.z = pk2(ob[4], ob[5]); w.w = pk2(ob[6], ob[7]);
            *(GAS v4u*)(XC + ((size_t)NTOK + r) * D + c0) = w; }
    }
}
struct GateSched {
    pg8::TileOrder ord; const char* XC; const char* W; int a_pitch;
    __device__ __forceinline__ bool next(int i, pg8::Unit& u) const { return ord.tile(i, u); }
    __device__ __forceinline__ const char* a_base(const pg8::Unit& u) const { const int d = u.pm >= 72 ? 1 : 0, rt = u.pm - 72 * d; return XC + ((size_t)d * NTOK + (size_t)rt * 256) * 2048 + (u.pn >> 1) * 512; }
    __device__ __forceinline__ const char* b_base(const pg8::Unit& u) const { const int d = u.pm >= 72 ? 1 : 0; return W + (size_t)(d * 8 + u.pn) * 256 * 512; }
    __device__ __forceinline__ unsigned a_rowoff(const pg8::Unit&, int) const { return 0u; }
};
struct EpiGate {
    static constexpr bool PERM = true;
    const bf16* XC; unsigned* AB; const float* gab; const float* gxb; const float* SP;
    __device__ __forceinline__ void operator()(const pg8::f32x4 (&acc)[2][2][4][2], const pg8::Unit& u, int wr, int wc, int fr, int fq) const {
        const int d = u.pm >= 72 ? 1 : 0, rt = u.pm - 72 * d; const int ch0 = (u.pn >> 1) * 256 + (u.pn & 1) * 128 + wc * 32 + 8 * fq;
#pragma unroll
        for (int ai = 0; ai < 2; ++ai)
#pragma unroll
            for (int m = 0; m < 4; ++m) { const size_t row = (size_t)d * NTOK + rt * 256 + ai * 128 + wr * 64 + m * 16 + fr;
#pragma unroll
                for (int n = 0; n < 2; ++n) {
                    asm volatile("" ::: "memory");
                    const int ch = ch0 + 4 * n; const pg8::f32x4 ba = *(const pg8::f32x4*)(gab + d * 1024 + ch), bx = *(const pg8::f32x4*)(gxb + d * 1024 + ch), sp = *(const pg8::f32x4*)(SP + d * 1024 + ch);
                    const v2u xw = *(const GAS v2u*)(XC + row * D + ch); const float xc[4] = {bf_lo(xw.x), bf_hi(xw.x), bf_lo(xw.y), bf_hi(xw.y)};
                    unsigned o[4];
#pragma unroll
                    for (int i = 0; i < 4; ++i) { const float rp = acc[ai][0][m][n][i] + ba[i], ip = acc[ai][1][m][n][i] + bx[i];
                        const float rg = __builtin_amdgcn_rcpf(1.f + __builtin_amdgcn_exp2f(-1.4426950408889634f * rp)), ig = __builtin_amdgcn_rcpf(1.f + __builtin_amdgcn_exp2f(-1.4426950408889634f * ip));
                        const float la2 = rg * sp[i] * (-8.f * 1.4426950408889634f); const float a = __builtin_amdgcn_exp2f(la2); const float bv = __builtin_amdgcn_sqrtf(fmaxf(1.f - a * a, 0.f)) * ig * xc[i];
                        o[i] = (f2bf(la2) << 16) | f2bf(bv); }
                    *(GAS v4u*)(AB + row * D + ch) = (v4u){o[0], o[1], o[2], o[3]}; } }
    }
};
__device__ __forceinline__ void phase_scan1(Frame& F) {
    const unsigned* AB = (const unsigned*)(F.ws + WS_AB); f32x2* SUM = (f32x2*)(F.ws + WS_SUM);
    int lane_ = lane_now(); asm volatile("" : "+v"(lane_)); const int lane = lane_;
    const int gw = F.vcu * NWAVES + F.wave, NGW = F.G * NWAVES;
    for (int it = gw; it < 2 * 288 * 16; it += NGW) {
        const int cg = it & 15, sc = (it >> 4) % 288, d = it / (288 * 16); const int c = cg * 64 + lane;
        const unsigned* p = AB + ((size_t)d * NTOK + sc * 64) * D + c; float h = 0.f, la = 0.f;
#pragma unroll
        for (int blk = 0; blk < 4; ++blk) { unsigned w[16];
#pragma unroll
            for (int i = 0; i < 16; ++i) { const int row = d == 0 ? blk * 16 + i : 63 - (blk * 16 + i); w[i] = p[(size_t)row * D]; }
#pragma unroll
            for (int i = 0; i < 16; ++i) { const float l2 = bf_hi(w[i]), b = bf_lo(w[i]); la += l2; h = __builtin_amdgcn_exp2f(l2) * h + b; } }
        SUM[((size_t)d * 288 + sc) * D + c] = (f32x2){la, h};
    }
}
__device__ __forceinline__ void phase_scan2(Frame& F) {
    const unsigned* AB = (const unsigned*)(F.ws + WS_AB); const f32x2* SUM = (const f32x2*)(F.ws + WS_SUM); const bf16* GU = (const bf16*)(F.ws + WS_PROJ); bf16* CAT = (bf16*)(F.ws + WS_CAT);
    int lane_ = lane_now(); asm volatile("" : "+v"(lane_)); const int lane = lane_;
    const int gw = F.vcu * NWAVES + F.wave, NGW = F.G * NWAVES;
    for (int it = gw; it < 8 * 32 * 16; it += NGW) {
        const int cg = it & 15, s = (it >> 4) & 31, b = it >> 9; const int c = cg * 64 + lane;
        float hf = 0.f, hb = 0.f;
        for (int q = 0; q < 4 + s; ++q) { const int sc = q < 4 ? b * 4 + q : 32 + b * 32 + (q - 4); const f32x2 v = SUM[(size_t)sc * D + c]; hf = __builtin_amdgcn_exp2f(v[0]) * hf + v[1]; }
        for (int q = 0; q < 4 + (31 - s); ++q) { const int sc = q < 4 ? b * 4 + (3 - q) : 32 + b * 32 + (31 - (q - 4)); const f32x2 v = SUM[((size_t)288 + sc) * D + c]; hb = __builtin_amdgcn_exp2f(v[0]) * hb + v[1]; }
        const size_t row0 = (size_t)NCTX + (size_t)b * SEQ + s * 64;
        float hfv[64];
#pragma unroll
        for (int blk = 0; blk < 4; ++blk) { unsigned w[16];
#pragma unroll
            for (int i = 0; i < 16; ++i) w[i] = AB[(row0 + blk * 16 + i) * D + c];
#pragma unroll
            for (int i = 0; i < 16; ++i) { hf = __builtin_amdgcn_exp2f(bf_hi(w[i])) * hf + bf_lo(w[i]); hfv[blk * 16 + i] = hf; } }
#pragma unroll
        for (int blk = 3; blk >= 0; --blk) { unsigned w[16]; unsigned short gt[16];
#pragma unroll
            for (int i = 0; i < 16; ++i) { const size_t row = row0 + blk * 16 + 15 - i; w[i] = AB[((size_t)NTOK + row) * D + c]; gt[i] = GU[row * 2048 + c]; }
#pragma unroll
            for (int i = 0; i < 16; ++i) { const int ri = blk * 16 + 15 - i; hb = __builtin_amdgcn_exp2f(bf_hi(w[i])) * hb + bf_lo(w[i]);
                const float g = bf_lo((unsigned)gt[i]); const float z = 0.7978845608028654f * (g + 0.044715f * g * g * g);
                const float th = 1.f - 2.f * __builtin_amdgcn_rcpf(__builtin_amdgcn_exp2f(2.f * 1.4426950408889634f * z) + 1.f);
                CAT[(row0 + ri) * D + c] = (bf16)f2bf((hfv[ri] + hb) * (0.5f * g * (1.f + th))); } }
    }
}
}
namespace mk {
#define IN(k) (lo <= (k) && (k) < hi)
#define SEAM(k) do { if (IN(k) && IN((k) + 1)) xcd_barrier(bar); } while (0)
template <int LAYER> __device__ __forceinline__ void moe_section(Frame& F, const Args& args, const XcdBarrier& bar, const int lo, const int hi) {
        constexpr int layer = LAYER; constexpr int mb = layer == 0 ? 5 : 15;
        constexpr int row0 = layer == 0 ? 0 : NCTX, nrows = layer == 0 ? NTOK : NLAT;
        if (IN(mb)) { phase_router(F, layer, row0, nrows, args.in[7] + layer * D, args.in[25] + (size_t)layer * D * 32, args.in[26] + layer * 32);
            if (layer == 1) filler(F, args.in[27], args.in[29], 1 << 20); }
        SEAM(mb);
        if (IN(mb + 1)) {
            moe_table(F, layer);
            LAS const int* tab = (LAS const int*)(F.misc + MISC_TAB); const int T = *(LAS const int*)(F.misc + MISC_NT);
            MoeSched1 S; S.ord.init(T, 8, F.G, (int)blockIdx.x); S.tab = tab; S.cntl = (LAS const int*)(F.misc + MISC_CNT); S.XN = (const char*)(F.ws + WS_XN);
            S.W = (const char*)(F.ws + WS_W1) + (size_t)layer * 32 * 2048 * (size_t)W1_KB; S.list = (const int*)(F.ws + WS_ROUTE + RT_LIST); S.a_pitch = W1_KB; S.wb = W1_KB;
            EpiSwiglu E{(bf16*)(F.ws + WS_HB), args.in[28] + (size_t)layer * 32 * 2048, tab};
            pg8::gemm_phase<EpiSwiglu, MoeSched1, true, FP8_G1, 122>(F.lds + RING_OFF, W1_KB, S, E, F.wave);
            if (layer == 0 && S.ord.early()) filler(F, args.in[27], args.in[29], 2);
        }
        SEAM(mb + 1);
        if (IN(mb + 2)) {
            moe_table(F, layer);
            LAS const int* tab = (LAS const int*)(F.misc + MISC_TAB); const int T = *(LAS const int*)(F.misc + MISC_NT);
            MoeSched2 S; S.ord.init(T, 4, F.G, (int)blockIdx.x); S.tab = tab; S.HB = (const char*)(F.ws + WS_HB); S.W = (const char*)(F.ws + WS_W2) + (size_t)layer * 32 * 1024 * (size_t)W2_KB; S.a_pitch = W2_KB; S.wb = W2_KB;
            EpiBias2 E{(bf16*)(F.ws + WS_Y2), args.in[30] + (size_t)layer * 32 * 1024, tab};
            pg8::gemm_phase<EpiBias2, MoeSched2, false, FP8_G2, 122>(F.lds + RING_OFF, W2_KB, S, E, F.wave);
            if (layer == 0 && S.ord.early()) filler(F, args.in[27], args.in[29], 2);
        }
        SEAM(mb + 2);
        if (IN(mb + 3)) {
            moe_table(F, layer);
            if (layer == 0) phase_combine(F, 0, row0, nrows, 0, args.in[6] + D, (const float*)(F.ws + WS_MOD) + (size_t)9 * 6144, args.out);
            else phase_combine(F, 1, row0, nrows, 1, args.in[31], nullptr, args.out);
        }
        SEAM(mb + 3);
}
#undef IN
#undef SEAM
constexpr int NPHASE = 19;
__global__ void __launch_bounds__(NTHR, 2) mk_fwd(Args args) {
    extern __shared__ __attribute__((aligned(16))) unsigned char lds_raw[];
    Frame F;
    F.lds = (LAS unsigned char*)lds_raw; F.misc = F.lds + MISC_OFF;
    F.wave = __builtin_amdgcn_readfirstlane((int)threadIdx.x >> 6);
    F.G = gridDim.x; { const int bx = blockIdx.x; F.vcu = (F.G % 8 == 0) ? (bx % 8) * (F.G / 8) + bx / 8 : bx; }
    F.ws = args.ws; F.ctl = (gu32*)(args.ws + WS_CTL);
    for (int u = tid_now(F); u < (LDS_BYTES - MISC_OFF) / 4; u += NTHR) ((LAS unsigned*)F.misc)[u] = 0u;
    __syncthreads();
    const int lo = args.ph_lo, hi = args.ph_hi;
    XcdBarrier bar = xcd_barrier_post((unsigned*)(F.ctl + CW_BAR) + args.li * XCD_BAR_WORDS, (volatile LAS unsigned*)(F.misc + MISC_BAR), F.wave);
#define IN(k) (lo <= (k) && (k) < hi)
#define SEAM(k) do { if (IN(k) && IN((k) + 1)) xcd_barrier(bar); } while (0)

    if (IN(0)) {
        p0_adaln(F, args.in[1], args.in[3], args.in[4], args.in[5]);
        p0_tables(F, args.in[10], args.in[11], args.in[12], args.in[13], args.in[24]);
        p0_wr_image(F, args.in[25]);
        __syncthreads();
        p0_dense_weight(F, args.in[8], 1024, 3072, (bf16*)(F.ws + WS_WIN0), 0);
        p0_dense_weight(F, args.in[9], 1024, 1024, (bf16*)(F.ws + WS_WOUT0), 1536);
        p0_dense_weight(F, args.in[16], 1024, 2048, (bf16*)(F.ws + WS_WIN1), 0);
        p0_dense_weight(F, args.in[17], 1024, 1024, (bf16*)(F.ws + WS_WOUT1), 1024);
        p0_gate_weights(F, args.in[20], args.in[22], 1536);
        p0_moe_weights(F, args.in[27], args.in[29], 0);
        if constexpr (!FILLER_ON) p0_moe_weights(F, args.in[27], args.in[29], 1);
    }
    SEAM(0);
    if (IN(1)) phase_norm1_l0(F, args.in[0], args.in[2], args.in[6]);
    SEAM(1);
    if (IN(2)) {
        DenseSched S; S.ord.init(NTOK / 256, 12, F.G, (int)blockIdx.x); S.A = (const char*)(F.ws + WS_XN); S.W = (const char*)(F.ws + WS_WIN0); S.a_pitch = 2048; S.K2 = 2048;
        EpiInProj0 E{(bf16*)(F.ws + WS_PROJ), (const float*)(F.ws + WS_TAB)};
        pg8::gemm_phase<EpiInProj0, DenseSched, false>(F.lds + RING_OFF, 2048, S, E, F.wave);
        if (S.ord.early()) filler(F, args.in[27], args.in[29], 3);
    }
    SEAM(2);
    if (IN(3)) phase_attn(F, args.in[14], args.in[15], args.in[27], args.in[29]);
    SEAM(3);
    if (IN(4)) {
        DenseSched S; S.ord.init(NTOK / 256, 4, F.G, (int)blockIdx.x); S.A = (const char*)(F.ws + WS_CAT); S.W = (const char*)(F.ws + WS_WOUT0); S.a_pitch = 2048; S.K2 = 2048;
        EpiResid E{(float*)(F.ws + WS_XS), args.in[0], args.in[2], (const float*)(F.ws + WS_MOD) + 2 * D, 0};
        pg8::gemm_phase<EpiResid, DenseSched, false>(F.lds + RING_OFF, 2048, S, E, F.wave);
        if (S.ord.early()) filler(F, args.in[27], args.in[29], 3);
    }
    SEAM(4);

    moe_section<0>(F, args, bar, lo, hi);
    if (IN(9)) {
        InProj1Sched S; S.ord.init(64, 8, F.G, (int)blockIdx.x); S.G = F.G; S.c = (int)blockIdx.x; S.A = (const char*)(F.ws + WS_XN); S.W = (const char*)(F.ws + WS_WIN1); S.a_pitch = 2048;
        EpiBf16 E{(bf16*)(F.ws + WS_PROJ), 2048};
        pg8::gemm_phase<EpiBf16, InProj1Sched, false>(F.lds + RING_OFF, 2048, S, E, F.wave);
        if (2 * F.G + (int)blockIdx.x >= 544) filler(F, args.in[27], args.in[29], 3);
    }
    SEAM(9);
    if (IN(10)) phase_conv1(F, args.in[18], args.in[19]);
    SEAM(10);
    if (IN(11)) {
        GateSched S; S.ord.init(144, 8, F.G, (int)blockIdx.x); S.XC = (const char*)(F.ws + WS_XC); S.W = (const char*)(F.ws + WS_WGATE); S.a_pitch = 2048;
        EpiGate E{(const bf16*)(F.ws + WS_XC), (unsigned*)(F.ws + WS_AB), args.in[21], args.in[23], (const float*)(F.ws + WS_TAB) + TAB_SP};
        pg8::gemm_phase<EpiGate, GateSched, false>(F.lds + RING_OFF, 512, S, E, F.wave);
        if (S.ord.early()) filler(F, args.in[27], args.in[29], 1);
    }
    SEAM(11);
    if (IN(12)) phase_scan1(F);
    SEAM(12);
    if (IN(13)) phase_scan2(F);
    SEAM(13);
    if (IN(14)) {
        DenseSched S; S.ord.init(NLAT / 256, 4, F.G, (int)blockIdx.x); S.A = (const char*)(F.ws + WS_CAT) + (size_t)NCTX * 2048; S.W = (const char*)(F.ws + WS_WOUT1); S.a_pitch = 2048; S.K2 = 2048;
        EpiResid E{(float*)(F.ws + WS_XS), nullptr, nullptr, (const float*)(F.ws + WS_MOD) + (size_t)9 * 6144 + 2 * D, NCTX};
        pg8::gemm_phase<EpiResid, DenseSched, false>(F.lds + RING_OFF, 2048, S, E, F.wave);
    }
    SEAM(14);
    moe_section<1>(F, args, bar, lo, hi);
#ifdef MK_ABLATION_PHASES
    if (IN(20)) phase_attn<MK_ABLATION_PHASES>(F, args.in[14], args.in[15]);
    if (IN(21)) { for (int i = 0; i < 10; ++i) xcd_barrier(bar); }
#endif
#undef IN
#undef SEAM
}

struct Launcher { int grid; bool ok; };
inline Launcher& launcher() {
    static Launcher L{0, false};
    if (L.grid == 0) {
        int dev = 0, cus = 0, per_cu = 0;
        if (hipGetDevice(&dev) != hipSuccess || hipDeviceGetAttribute(&cus, hipDeviceAttributeMultiprocessorCount, dev) != hipSuccess) { fprintf(stderr, "mk: device query failed\n"); L.grid = -1; return L; }
        if (hipFuncSetAttribute((const void*)mk_fwd, hipFuncAttributeMaxDynamicSharedMemorySize, LDS_BYTES) != hipSuccess) { fprintf(stderr, "mk: hipFuncSetAttribute failed\n"); L.grid = -1; return L; }
        if (hipOccupancyMaxActiveBlocksPerMultiprocessor(&per_cu, (const void*)mk_fwd, NTHR, LDS_BYTES) != hipSuccess || per_cu < 1) fprintf(stderr, "mk: note: occupancy query reports %d\n", per_cu);
        (void)hipGetLastError();
        L.grid = cus; L.ok = true;
    }
    return L;
}
inline void launch(hipStream_t st, void* const* d_in, float* out, unsigned char* ws, int ph_lo, int ph_hi, int li) {
    Launcher& L = launcher(); if (L.grid <= 0) return;
    Args a{}; for (int i = 0; i < 32; ++i) a.in[i] = (const float*)d_in[i];
    a.out = out; a.ws = ws; a.ph_lo = ph_lo; a.ph_hi = ph_hi; a.li = li; a.pad = 0;
    hipLaunchKernelGGL(mk_fwd, dim3(L.grid), dim3(NTHR), LDS_BYTES, st, a);
}
}
extern "C" void kernel_launch(void* const* d_in, const int* in_sizes, int n_in, void* d_out, int out_size, void* d_ws, size_t ws_size, hipStream_t stream) {
    unsigned char* ws = (unsigned char*)d_ws;
    if (mk::WS_END > ws_size) { fprintf(stderr, "kernel_launch: workspace too small: need %zu have %zu\n", (size_t)mk::WS_END, ws_size); return; }
    (void)hipMemsetAsync(ws + mk::WS_CTL, 0, mk::CTL_ZERO_BYTES, stream);
    mk::launch(stream, d_in, (float*)d_out, ws, 0, 19, 0);
}
```

```cpp
#define MK_FP8_G1 1
#define MK_FP8_G2 1
#include <hip/hip_runtime.h>
#include <cstdio>
#include <cstdint>
__device__ __forceinline__ int lane_now() { int l = (int)__builtin_amdgcn_mbcnt_hi(~0u, __builtin_amdgcn_mbcnt_lo(~0u, 0u)); asm volatile("" : "+v"(l)); return l; }
namespace pg8 {
#define PG8_LAS __attribute__((address_space(3)))
typedef unsigned short bf16_t;
typedef short bf16x8 __attribute__((ext_vector_type(8)));
typedef float f32x4 __attribute__((ext_vector_type(4)));
typedef float f32x2 __attribute__((ext_vector_type(2)));
typedef unsigned u32x4 __attribute__((ext_vector_type(4)));
typedef unsigned u32x2 __attribute__((ext_vector_type(2)));
constexpr int BM = 256, BK = 64, HALF = 128, HTB = HALF * BK * 2  , STAGE_BYTES = 8 * HTB, NXCD = 8, WGM = 2;

__host__ __device__ __forceinline__ int lds_byte(int r, int c) { const int st = (r >> 4) * 2 + (c >> 5), rr = r & 15, cc = c & 31, ob = rr * 64 + cc * 2; return st * 1024 + (ob ^ (((ob >> 9) & 1) << 5)); }
__host__ __device__ __forceinline__ void stage_rc(int b, int& R, int& C) { const int st = b / 1024, sb = b % 1024, swz = sb ^ (((sb >> 9) & 1) << 5); R = (st >> 1) * 16 + swz / 64; C = (st & 1) * 32 + (swz % 64) / 2; }
__host__ __device__ __forceinline__ int perm32(int rho) { const int n = rho >> 4, i = rho & 15; return 8 * (i >> 2) + 4 * n + (i & 3); }

struct Unit { int pm, pn; };

struct TileOrder {
    int nM, nN, nwg, G, c;
    __device__ __forceinline__ void init(int nM_, int nN_, int G_, int c_) { nM = nM_; nN = nN_; nwg = nM * nN; G = G_; c = c_; }
    __device__ __forceinline__ bool tile(int i, Unit& u) const { const long L = (long)i * G + c; if (L >= nwg) return false; map((int)L, u); return true; }
    __device__ __forceinline__ bool early() const { const int mine = nwg > c ? (nwg - 1 - c) / G + 1 : 0; return mine < (nwg + G - 1) / G; }
    __device__ __forceinline__ void map(int L, Unit& u) const {
        int wgid = L; { const int q = nwg / NXCD, r = nwg % NXCD, xcd = wgid % NXCD, off = wgid / NXCD; wgid = (xcd < r ? xcd * (q + 1) : r * (q + 1) + (xcd - r) * q) + off; }
        const int nig = WGM * nN, gid = wgid / nig, fm = gid * WGM, gsz = (nM - fm) < WGM ? (nM - fm) : WGM;
        u.pm = fm + ((wgid % nig) % gsz); u.pn = (wgid % nig) / gsz;
    }
};

__device__ __forceinline__ unsigned cvt_pk_bf16(float lo, float hi) { unsigned r; asm volatile("v_cvt_pk_bf16_f32 %0, %1, %2" : "=v"(r) : "v"(lo), "v"(hi)); return r; }

template <class Epi, class Sched, bool GATHER, bool FP8 = false, int SCALE_W = 127>
__device__ __forceinline__ void gemm_phase(PG8_LAS unsigned char* lds, const int Kb, const Sched& S, const Epi& E, const int wave_id) {
    int tid_ = wave_id * 64 + lane_now(); asm volatile("" : "+v"(tid_));
    const int tid = tid_, wid = __builtin_amdgcn_readfirstlane(tid >> 6), lane = tid & 63, wr = wid >> 2, wc = wid & 3, fr = lane & 15, fq = lane >> 4;
    const int nt = Kb / 128;
    unsigned voffB[2];
    unsigned offA[2][2], noffA[2][2];
#pragma unroll
    for (int i = 0; i < 2; ++i) { int R, C; stage_rc(tid * 16 + i * 8192, R, C); const int Rb = Epi::PERM ? ((R & ~31) + perm32(R & 31)) : R;
        voffB[i] = (unsigned)(Rb * Kb + C * 2);
        offA[0][i] = (unsigned)(R * S.a_pitch + C * 2); offA[1][i] = (unsigned)((R + HALF) * S.a_pitch + C * 2); noffA[0][i] = offA[0][i]; noffA[1][i] = offA[1][i]; }
    const size_t kstep = (size_t)(BK * 2);
    const size_t hstepB = (size_t)HALF * Kb;
    const unsigned ldsw = (unsigned)wid * 1024u;
    const int aoff = lds_byte(wr * 64 + fr, fq * 8), boff = lds_byte(wc * 32 + fr, fq * 8);
#define PG8_SA(b, h) (((b) * 2 + (h)) * HTB)
#define PG8_SB(b, h) ((4 + (b) * 2 + (h)) * HTB)
#define PG8_STAGE(bufoff, gbase, voff) do { const char* gb_ = (const char*)(gbase); asm volatile("" : "+s"(gb_));     \
        _Pragma("unroll") for (int _i = 0; _i < 2; ++_i) \
        __builtin_amdgcn_global_load_lds((const unsigned*)(gb_ + (voff)[_i]), (PG8_LAS unsigned*)(lds + (bufoff) + ldsw + _i * 8192), 16, 0, 0); } while (0)
    typedef int v4i_ __attribute__((ext_vector_type(4))); typedef int v8i_ __attribute__((ext_vector_type(8)));
#define PG8_LDA(dst, b, h) do { _Pragma("unroll") for (int m = 0; m < 4; ++m) { if constexpr (FP8) { const v4i_ lo_ = *(const PG8_LAS v4i_*)(lds + PG8_SA(b, h) + aoff + m * 2048), hi_ = *(const PG8_LAS v4i_*)(lds + PG8_SA(b, h) + aoff + m * 2048 + 1024); \
            dst##8[m] = __builtin_shufflevector(lo_, hi_, 0, 1, 2, 3, 4, 5, 6, 7); } else { _Pragma("unroll") for (int k = 0; k < 2; ++k) dst[m][k] = *(const PG8_LAS bf16x8*)(lds + PG8_SA(b, h) + aoff + m * 2048 + k * 1024); } } } while (0)
#define PG8_LDB(dst, b, h) do { _Pragma("unroll") for (int n = 0; n < 2; ++n) { if constexpr (FP8) { const v4i_ lo_ = *(const PG8_LAS v4i_*)(lds + PG8_SB(b, h) + boff + n * 2048), hi_ = *(const PG8_LAS v4i_*)(lds + PG8_SB(b, h) + boff + n * 2048 + 1024); \
            dst##8[n] = __builtin_shufflevector(lo_, hi_, 0, 1, 2, 3, 4, 5, 6, 7); } else { _Pragma("unroll") for (int k = 0; k < 2; ++k) dst[n][k] = *(const PG8_LAS bf16x8*)(lds + PG8_SB(b, h) + boff + n * 2048 + k * 1024); } } } while (0)
#define PG8_MMA(ai, bj, At, Bt) do { __builtin_amdgcn_s_setprio(1); _Pragma("unroll") for (int m = 0; m < 4; ++m) _Pragma("unroll") for (int n = 0; n < 2; ++n) { \
        if constexpr (FP8) { asm volatile("v_mfma_scale_f32_16x16x128_f8f6f4 %0, %1, %2, %0, %3, %4 op_sel_hi:[0,0,0]" : "+v"(acc[ai][bj][m][n]) : "v"(Bt##8[n]), "v"(At##8[m]), "v"(sclw_), "v"(scla_)); } \
        else { _Pragma("unroll") for (int k = 0; k < 2; ++k) acc[ai][bj][m][n] = __builtin_amdgcn_mfma_f32_16x16x32_bf16(Bt[n][k], At[m][k], acc[ai][bj][m][n], 0, 0, 0); } } \
        __builtin_amdgcn_s_setprio(0); } while (0)
#define PG8_WAIT_V(n) asm volatile("s_waitcnt vmcnt(" #n ")" ::: "memory")
#define PG8_WAIT_L(n) asm volatile("s_waitcnt lgkmcnt(" #n ")" ::: "memory")
#define PG8_BAR __builtin_amdgcn_s_barrier()
#define PG8_SCHED __builtin_amdgcn_sched_barrier(0)
    int sclw_ = SCALE_W, scla_ = 127; asm volatile("" : "+v"(sclw_), "+v"(scla_));
    Unit cur, nxt; int ui = 0;
    if (!S.next(0, cur)) return;
    if constexpr (GATHER) {
#pragma unroll
        for (int i = 0; i < 2; ++i) { int R, C; stage_rc(tid * 16 + i * 8192, R, C); offA[0][i] = S.a_rowoff(cur, R) + (unsigned)(C * 2); offA[1][i] = S.a_rowoff(cur, R + HALF) + (unsigned)(C * 2); }
    }
    f32x4 acc[2][2][4][2];
#pragma unroll
    for (int a = 0; a < 2; ++a)
#pragma unroll
        for (int b = 0; b < 2; ++b)
#pragma unroll
            for (int m = 0; m < 4; ++m)
#pragma unroll
                for (int n = 0; n < 2; ++n) acc[a][b][m][n] = (f32x4){0.f, 0.f, 0.f, 0.f};
    bf16x8 At[4][2], B0[2][2], B1[2][2]; v8i_ At8[4], B08[2], B18[2];
    const char* cA = S.a_base(cur); const char* cB = S.b_base(cur);
    PG8_STAGE(PG8_SB(0, 0), cB, voffB); PG8_STAGE(PG8_SB(0, 1), cB + hstepB, voffB); PG8_STAGE(PG8_SA(0, 0), cA, offA[0]); PG8_STAGE(PG8_SA(0, 1), cA, offA[1]);
    if (wr == 1) PG8_BAR;
    PG8_WAIT_V(2); PG8_BAR;
    PG8_STAGE(PG8_SB(1, 0), cB + kstep, voffB); PG8_STAGE(PG8_SA(1, 0), cA + kstep, offA[0]); PG8_STAGE(PG8_SB(1, 1), cB + hstepB + kstep, voffB);
    PG8_WAIT_V(6); PG8_BAR;
    for (;;) {
        const bool has_next = S.next(ui + 1, nxt);
        const char* nA = has_next ? S.a_base(nxt) : cA; const char* nB = has_next ? S.b_base(nxt) : cB;
        if constexpr (GATHER) {
            if (has_next) {
#pragma unroll
                for (int i = 0; i < 2; ++i) { int t2_ = tid; asm volatile("" : "+v"(t2_)); int R, C; stage_rc(t2_ * 16 + i * 8192, R, C);
                    noffA[0][i] = S.a_rowoff(nxt, R) + (unsigned)(C * 2); noffA[1][i] = S.a_rowoff(nxt, R + HALF) + (unsigned)(C * 2); }
            } else {
#pragma unroll
                for (int i = 0; i < 2; ++i) { noffA[0][i] = offA[0][i]; noffA[1][i] = offA[1][i]; }
            }
        }
#pragma unroll 1
        for (int t = 0; t < nt; t += 2) {
            const bool last = (t == nt - 2);
            const char* a1 = cA + (size_t)(t + 1) * kstep;
            const char* a2 = last ? nA : cA + (size_t)(t + 2) * kstep; const char* b2 = last ? nB : cB + (size_t)(t + 2) * kstep;
            const char* a3 = a2 + kstep; const char* b3 = b2 + kstep;
            unsigned o2[2][2];
#pragma unroll
            for (int h = 0; h < 2; ++h)
#pragma unroll
                for (int i = 0; i < 2; ++i) o2[h][i] = GATHER ? (last ? noffA[h][i] : offA[h][i]) : offA[h][i];
            PG8_LDB(B0, 0, 0); PG8_LDB(B1, 0, 1); PG8_SCHED; PG8_LDA(At, 0, 0); PG8_STAGE(PG8_SA(1, 1), a1, offA[1]);
            PG8_WAIT_V(8); PG8_WAIT_L(0); PG8_BAR; PG8_MMA(0, 0, At, B0); PG8_MMA(0, 1, At, B1); PG8_BAR; PG8_SCHED;
            PG8_LDA(At, 0, 1); PG8_STAGE(PG8_SB(0, 0), b2, voffB); PG8_STAGE(PG8_SB(0, 1), b2 + hstepB, voffB); PG8_STAGE(PG8_SA(0, 0), a2, o2[0]);
            PG8_WAIT_V(8); PG8_WAIT_L(0); PG8_BAR; PG8_MMA(1, 0, At, B0); PG8_MMA(1, 1, At, B1); PG8_BAR; PG8_SCHED;
            PG8_LDB(B0, 1, 0); PG8_LDB(B1, 1, 1); PG8_SCHED; PG8_LDA(At, 1, 0); PG8_STAGE(PG8_SA(0, 1), a2, o2[1]);
            PG8_WAIT_V(8); PG8_WAIT_L(0); PG8_BAR; PG8_MMA(0, 0, At, B0); PG8_MMA(0, 1, At, B1); PG8_BAR; PG8_SCHED;
            PG8_LDA(At, 1, 1); PG8_STAGE(PG8_SB(1, 0), b3, voffB); PG8_STAGE(PG8_SB(1, 1), b3 + hstepB, voffB); PG8_STAGE(PG8_SA(1, 0), a3, o2[0]);
            PG8_WAIT_V(8); PG8_WAIT_L(0); PG8_BAR; PG8_MMA(1, 0, At, B0); PG8_MMA(1, 1, At, B1); PG8_BAR; PG8_SCHED;
        }
        if (wr == 0) PG8_BAR;
        if constexpr (FP8) asm volatile("s_nop 15\n\ts_nop 3" ::: "memory");
        { int l2_ = lane; asm volatile("" : "+v"(l2_)); E(acc, cur, wr, wc, l2_ & 15, l2_ >> 4); }
#ifdef MK_EPI_DUP
        if constexpr ((MK_EPI_DUP == 1 && FP8 && !GATHER) || (MK_EPI_DUP == 2 && !FP8)) { int l3_ = lane; asm volatile("" : "+v"(l3_)); asm volatile("" ::: "memory"); E(acc, cur, wr, wc, l3_ & 15, l3_ >> 4); }
#endif
        if (!has_next) break;
#pragma unroll
        for (int a = 0; a < 2; ++a)
#pragma unroll
            for (int b = 0; b < 2; ++b)
#pragma unroll
                for (int m = 0; m < 4; ++m)
#pragma unroll
                    for (int n = 0; n < 2; ++n) acc[a][b][m][n] = (f32x4){0.f, 0.f, 0.f, 0.f};
        cur = nxt; cA = nA; cB = nB; ++ui;
        if constexpr (GATHER) {
#pragma unroll
            for (int h = 0; h < 2; ++h)
#pragma unroll
                for (int i = 0; i < 2; ++i) offA[h][i] = noffA[h][i];
        }
        if (wr == 1) PG8_BAR;
    }
    PG8_WAIT_V(0);
    PG8_BAR;
#undef PG8_SA
#undef PG8_SB
#undef PG8_STAGE
#undef PG8_LDA
#undef PG8_LDB
#undef PG8_MMA
#undef PG8_WAIT_V
#undef PG8_WAIT_L
#undef PG8_BAR
#undef PG8_SCHED
}
}

#define GAS __attribute__((address_space(1)))
#define LAS __attribute__((address_space(3)))
typedef unsigned short bf16;
typedef unsigned v4u __attribute__((ext_vector_type(4)));
typedef unsigned v2u __attribute__((ext_vector_type(2)));
typedef float f32x4 __attribute__((ext_vector_type(4)));
typedef float f32x2 __attribute__((ext_vector_type(2)));
typedef float f32x16 __attribute__((ext_vector_type(16)));
typedef short bf16x8 __attribute__((ext_vector_type(8)));
typedef short s16x4 __attribute__((ext_vector_type(4)));
typedef GAS unsigned gu32;
#define RLX_AGENT __ATOMIC_RELAXED, __HIP_MEMORY_SCOPE_AGENT
#define LDS_WAIT() asm volatile("s_waitcnt lgkmcnt(0)" ::: "memory")
#define VM_WAIT() asm volatile("s_waitcnt vmcnt(0)" ::: "memory")
__device__ __forceinline__ unsigned f2bf(float f) { unsigned u = __builtin_bit_cast(unsigned, f); return (u + 0x7fffu + ((u >> 16) & 1u)) >> 16; }
__device__ __forceinline__ unsigned pk2(float lo, float hi) { return f2bf(lo) | (f2bf(hi) << 16); }
__device__ __forceinline__ float bf_lo(unsigned w) { return __builtin_bit_cast(float, w << 16); }
__device__ __forceinline__ float bf_hi(unsigned w) { return __builtin_bit_cast(float, w & 0xffff0000u); }
__device__ __forceinline__ float wave_sum(float v) {
#pragma unroll
    for (int o = 1; o < 64; o <<= 1) v += __shfl_xor(v, o);
    return v;
}

#define XB_TMO      128
#define XB_XCNT(j)  (256  + 64 * (j))
#define XB_XSUB(j)  (1280 + 64 * (j))
#define XB_XGEN(j)  (2304 + 64 * (j))
#define XB_TOP      3328
#define XB_TOPGEN   3392
#define XCD_BAR_WORDS 3456
#define XB_SPIN_CAP (1u << 18)
__device__ __forceinline__ unsigned xb_ld(unsigned* p)              { return __hip_atomic_load(p, __ATOMIC_RELAXED, __HIP_MEMORY_SCOPE_AGENT); }
__device__ __forceinline__ unsigned xb_add(unsigned* p, unsigned v) { return __hip_atomic_fetch_add(p, v, __ATOMIC_RELAXED, __HIP_MEMORY_SCOPE_AGENT); }
__device__ __forceinline__ unsigned xb_xcc_id() { return (unsigned)__builtin_amdgcn_s_getreg((3 << 11) | 20) & 0xFu; }
#define XB_SPIN(cond, bar) do { unsigned _sp = 0; while (cond) { __builtin_amdgcn_s_sleep(1); \
    if ((++_sp & 255u) == 0u) { if (xb_ld(&(bar)[XB_TMO])) break; if (_sp > XB_SPIN_CAP) { atomicAdd(&(bar)[XB_TMO], 1u); break; } } } } while (0)
struct XcdBarrier { unsigned* bar; unsigned x; volatile LAS unsigned* st; int wave; };
__device__ __forceinline__ XcdBarrier xcd_barrier_post(unsigned* bar, volatile LAS unsigned* st, int wave) {
    XcdBarrier b; b.bar = bar; b.x = xb_xcc_id(); b.st = st; b.wave = wave;
    if (wave == 0 && lane_now() == 0) (void)xb_add(&bar[XB_XCNT(b.x)], 1u);
    return b;
}
__device__ __forceinline__ void xcd_barrier_complete(unsigned* bar, unsigned x, unsigned& nloc, unsigned& nx) {
    const unsigned G = gridDim.x * gridDim.y * gridDim.z;
    unsigned sum, cnt, mine, sp = 0u;
    for (;;) {
        sum = 0u; cnt = 0u; mine = 0u;
#pragma unroll
        for (unsigned j = 0; j < 16; ++j) { const unsigned c = xb_ld(&bar[XB_XCNT(j)]); sum += c; cnt += (c > 0u) ? 1u : 0u; mine = (j == x) ? c : mine; }
        if (sum == G) break;
        __builtin_amdgcn_s_sleep(1);
        if ((++sp & 255u) == 0u) { if (xb_ld(&bar[XB_TMO])) break; if (sp > XB_SPIN_CAP) { atomicAdd(&bar[XB_TMO], 1u); break; } }
    }
    nloc = mine > 0u ? mine : 1u; nx = cnt > 0u ? cnt : 1u;
}
__device__ __forceinline__ void xcd_barrier(const XcdBarrier& b) {
    asm volatile("s_waitcnt vmcnt(0)" ::: "memory");
    __syncthreads();
    if (b.wave == 0 && lane_now() == 0) {
        unsigned* bar = b.bar;
        __builtin_amdgcn_s_waitcnt(0);
        unsigned nloc = b.st[0], nx = b.st[1];
        if (nloc == 0u) { xcd_barrier_complete(bar, b.x, nloc, nx); b.st[0] = nloc; b.st[1] = nx; }
        const unsigned old = xb_add(&bar[XB_XSUB(b.x)], 1u);
        const unsigned gen = old / nloc;
        if (old + 1u == (gen + 1u) * nloc) {
            __builtin_amdgcn_fence(__ATOMIC_RELEASE, "agent");
            asm volatile("s_waitcnt vmcnt(0)" ::: "memory");
            const unsigned og = xb_add(&bar[XB_TOP], 1u);
            const unsigned tg = og / nx;
            if (og + 1u == (tg + 1u) * nx) xb_add(&bar[XB_TOPGEN], 1u);
            else XB_SPIN(xb_ld(&bar[XB_TOPGEN]) == tg, bar);
            __builtin_amdgcn_fence(__ATOMIC_ACQUIRE, "agent");
            xb_add(&bar[XB_XGEN(b.x)], 1u);
            asm volatile("s_waitcnt vmcnt(0)" ::: "memory");
        } else {
            XB_SPIN(xb_ld(&bar[XB_XGEN(b.x)]) == gen, bar);
            __builtin_amdgcn_fence(__ATOMIC_ACQUIRE, "agent");
            asm volatile("s_waitcnt vmcnt(0)" ::: "memory");
        }
    }
    __syncthreads();
}
namespace mk {
constexpr int D = 1024, NB = 8, SEQ = 2048, CT = 256, NCTX = NB * CT, NLAT = NB * SEQ, NTOK = NCTX + NLAT;
constexpr int NE = 32, LCAP = NTOK;
constexpr int NWAVES = 8, NTHR = 512;
#ifndef MK_WRITE_XS_ALWAYS
#define MK_WRITE_XS_ALWAYS 0
#endif
constexpr bool WRITE_XS_ALWAYS = MK_WRITE_XS_ALWAYS != 0;
#ifndef MK_FP8_G1
#define MK_FP8_G1 0
#endif
#ifndef MK_FP8_G2
#define MK_FP8_G2 0
#endif
constexpr bool FP8_G1 = MK_FP8_G1 != 0, FP8_G2 = MK_FP8_G2 != 0;
constexpr int W1_KB = FP8_G1 ? 1024 : 2048, W2_KB = FP8_G2 ? 1024 : 2048;
constexpr int MAXT = NTOK * 4 / 256 + NE;
constexpr int HB_ROWS = MAXT * 256;

constexpr size_t MiB = 1u << 20;
constexpr size_t al(size_t x) { return (x + MiB - 1) / MiB * MiB; }
constexpr size_t WS_CTL = 0, CTL_ZERO_BYTES = 1 * MiB;
constexpr size_t WS_MOD = WS_CTL + CTL_ZERO_BYTES;
constexpr size_t WS_TAB = WS_MOD + al(2 * 9 * 6144 * 4);
constexpr size_t WS_WIN0 = WS_TAB + MiB;
constexpr size_t WS_WOUT0 = WS_WIN0 + al((size_t)3072 * 1024 * 2);
constexpr size_t WS_WIN1 = WS_WOUT0 + al((size_t)1024 * 1024 * 2);
constexpr size_t WS_WOUT1 = WS_WIN1 + al((size_t)2048 * 1024 * 2);
constexpr size_t WS_WGATE = WS_WOUT1 + al((size_t)1024 * 1024 * 2);
constexpr size_t WS_W1 = WS_WGATE + al((size_t)16 * 256 * 256 * 2);
constexpr size_t WS_W2 = WS_W1 + al((size_t)2 * 32 * 2048 * 1024 * 2);
constexpr size_t WS_XS = WS_W2 + al((size_t)2 * 32 * 1024 * 1024 * 2);
constexpr size_t WS_XN = WS_XS + al((size_t)NTOK * D * 4);
constexpr size_t WS_PROJ = WS_XN + al((size_t)NTOK * D * 2);
constexpr size_t WS_CAT = WS_PROJ + al((size_t)NTOK * 3072 * 2);
constexpr size_t WS_ROUTE = WS_CAT + al((size_t)NTOK * D * 2);
constexpr size_t RT_EIDX = 0, RT_EGATE = (size_t)NTOK * 16, RT_EPOS = 2 * (size_t)NTOK * 16, RT_LIST = 3 * (size_t)NTOK * 16;
constexpr size_t WS_HB = WS_ROUTE + al(3 * (size_t)NTOK * 16 + (size_t)NE * LCAP * 4);
constexpr size_t WS_Y2 = WS_HB + al((size_t)HB_ROWS * D * 2);
constexpr size_t WS_END = WS_Y2 + al((size_t)HB_ROWS * D * 2);
constexpr size_t WS_XC = WS_HB;
constexpr size_t WS_AB = WS_XC + al((size_t)2 * NTOK * D * 2);
constexpr size_t WS_SUM = WS_AB + al((size_t)2 * NTOK * D * 4);
static_assert(WS_SUM + (size_t)2 * 288 * 1024 * 8 <= WS_END, "layer-1 mixer overlay");
constexpr int CW_BAR = 4096;
constexpr int CW_ADALN = 32768 + 64;
constexpr int CW_FILL = 32768;
constexpr int CW_CNT = 65536;
static_assert((CW_CNT + 64 * 64) * 4 <= (int)CTL_ZERO_BYTES && CW_BAR + 8 * XCD_BAR_WORDS <= CW_CNT, "CTL map");

constexpr int RING_OFF = 0, RING_BYTES = 131072;
constexpr int MISC_OFF = RING_BYTES;
constexpr int MISC_BAR = 0;
constexpr int MISC_HIST = 64, MISC_BASE = 64 + 128, MISC_CNT = 64 + 256, MISC_PB = 64 + 384, MISC_NT = 64 + 512;
constexpr int MISC_TAB = 1024;
constexpr int MISC_REC = 4096;
constexpr int LDS_BYTES = 147456;
static_assert(MISC_TAB + MAXT * 4 <= MISC_REC && MISC_OFF + MISC_REC + 8192 <= LDS_BYTES, "LDS map");

struct Args { const float* in[32]; float* out; unsigned char* ws; int ph_lo, ph_hi, li, pad; };

struct Frame {
    LAS unsigned char* lds; LAS unsigned char* misc; gu32* ctl;
    int wave, vcu, G;
    unsigned char* ws;
};

__device__ __forceinline__ int tid_now(const Frame& F) { return F.wave * 64 + lane_now(); }
__device__ __forceinline__ int row_modrow(int r) { return r < NCTX ? 8 : (r - NCTX) >> 11; }

__device__ __forceinline__ unsigned pk4_fp8(float a, float b, float c, float d) { int p = __builtin_amdgcn_cvt_pk_fp8_f32(a, b, 0, false); p = __builtin_amdgcn_cvt_pk_fp8_f32(c, d, p, true); return (unsigned)p; }
#ifdef MK_EMU_OUT
__device__ __forceinline__ float q8o(float x) { const int p = __builtin_amdgcn_cvt_pk_fp8_f32(x, x, 0, false); return __builtin_amdgcn_cvt_f32_fp8(p, 0); }
#define QO(x) q8o(x)
#define QOW(x) (q8o((x) * 32.f) * 0.03125f)
#else
#define QO(x) (x)
#define QOW(x) (x)
#endif
#ifdef MK_EMU_FP8
__device__ __forceinline__ float q8(float x) { const int p = __builtin_amdgcn_cvt_pk_fp8_f32(x, x, 0, false); return __builtin_amdgcn_cvt_f32_fp8(p, 0); }
#define Q8W(x) (q8((x) * 32.f) * 0.03125f)
#define Q8A(x) q8(x)
#else
#define Q8W(x) (x)
#define Q8A(x) (x)
#endif
template <bool QW = false, bool QOUT = false> __device__ __forceinline__ void transpose_item(const float* W, int N, int k0, int n0, bf16* dst, int ldd, LAS float* scr, int lane) {
#pragma unroll 8
    for (int i = 0; i < 32; ++i) { const int kk = 2 * i + (lane >> 5); const float wv_ = W[(size_t)(k0 + kk) * N + n0 + (lane & 31)]; scr[kk * 33 + (lane & 31)] = QW ? Q8W(wv_) : (QOUT ? QOW(wv_) : wv_); }
    LDS_WAIT(); asm volatile("" ::: "memory");
    const int c = lane & 7;
#pragma unroll
    for (int j = 0; j < 4; ++j) { const int n = (lane >> 3) + 8 * j; const LAS float* s = scr + (8 * c) * 33 + n;
        v4u o; o.x = pk2(s[0 * 33], s[1 * 33]); o.y = pk2(s[2 * 33], s[3 * 33]); o.z = pk2(s[4 * 33], s[5 * 33]); o.w = pk2(s[6 * 33], s[7 * 33]);
        *(GAS v4u*)(dst + (size_t)n * ldd + 8 * c) = o; }
    LDS_WAIT(); asm volatile("" ::: "memory");
}
template <int KK = 64> __device__ __forceinline__ void transpose_item_fp8(const float* W, int N, int k0, int n0, unsigned char* dst, int ldd, int lane) {
    const float* src = W + (size_t)k0 * N + n0 + lane; float v[KK];
#pragma unroll
    for (int kk = 0; kk < KK; ++kk) v[kk] = __builtin_nontemporal_load(src + (size_t)kk * N);
    unsigned char* o = dst + (size_t)lane * ldd;
#pragma unroll
    for (int q = 0; q < KK / 16; ++q) { v4u w;
        w.x = pk4_fp8(v[16 * q + 0] * 32.f, v[16 * q + 1] * 32.f, v[16 * q + 2] * 32.f, v[16 * q + 3] * 32.f); w.y = pk4_fp8(v[16 * q + 4] * 32.f, v[16 * q + 5] * 32.f, v[16 * q + 6] * 32.f, v[16 * q + 7] * 32.f);
        w.z = pk4_fp8(v[16 * q + 8] * 32.f, v[16 * q + 9] * 32.f, v[16 * q + 10] * 32.f, v[16 * q + 11] * 32.f); w.w = pk4_fp8(v[16 * q + 12] * 32.f, v[16 * q + 13] * 32.f, v[16 * q + 14] * 32.f, v[16 * q + 15] * 32.f);
        *(GAS v4u*)(o + 16 * q) = w; }
}
template <class RowMap> __device__ __forceinline__ void transpose_item_fp8_wide(const float* W, int N, int k0, int n0, unsigned char* dst, int ldd, int lane, const RowMap& rowmap) {
    const float* src = W + (size_t)k0 * N + n0 + 4 * lane; f32x4 v[16];
#pragma unroll
    for (int kk = 0; kk < 16; ++kk) v[kk] = __builtin_nontemporal_load((const f32x4*)(src + (size_t)kk * N));
    unsigned char* o = dst + (size_t)rowmap(n0 + 4 * lane) * ldd + k0;
#pragma unroll
    for (int j = 0; j < 4; ++j) { v4u w;
        w.x = pk4_fp8(v[0][j] * 32.f, v[1][j] * 32.f, v[2][j] * 32.f, v[3][j] * 32.f); w.y = pk4_fp8(v[4][j] * 32.f, v[5][j] * 32.f, v[6][j] * 32.f, v[7][j] * 32.f);
        w.z = pk4_fp8(v[8][j] * 32.f, v[9][j] * 32.f, v[10][j] * 32.f, v[11][j] * 32.f); w.w = pk4_fp8(v[12][j] * 32.f, v[13][j] * 32.f, v[14][j] * 32.f, v[15][j] * 32.f);
        *(GAS v4u*)(o + (size_t)j * ldd) = w; }
}
#ifdef MK_CONV_K128
constexpr int MOE_ITEMS = 32 * (8 * 32 + 8 * 16);
#else
constexpr int MOE_ITEMS = 32 * (16 * 32 + 16 * 16);
#endif
__device__ __forceinline__ void moe_item_fp8(unsigned char* ws, const float* w1, const float* w2, int layer, int it) {
#ifdef MK_CONV_K128
    constexpr int J1 = 8 * 32, J2 = 8 * 16;
#else
    constexpr int J1 = 16 * 32, J2 = 16 * 16;
#endif
    unsigned char* W81 = ws + WS_W1 + (size_t)layer * 32 * 2048 * 1024; unsigned char* W82 = ws + WS_W2 + (size_t)layer * 32 * 1024 * 1024;
    const float* s1 = w1 + (size_t)layer * 32 * 1024 * 2048; const float* s2 = w2 + (size_t)layer * 32 * 1024 * 1024;
    const int e = it / (J1 + J2); int r = it % (J1 + J2);
#if defined(MK_CONV_K128)
    if (r < J1) { const int kb = r >> 5, n0 = (r & 31) * 64; const int nn = n0 & 1023, drow = 256 * (nn >> 7) + (n0 >= 1024 ? 128 : 0) + (nn & 127);
        transpose_item_fp8<128>(s1 + (size_t)e * 1024 * 2048, 2048, kb * 128, n0, W81 + (size_t)e * 2048 * 1024 + (size_t)drow * 1024 + kb * 128, 1024, lane_now()); }
    else { r -= J1; const int kb = r >> 4, n0 = (r & 15) * 64;
        transpose_item_fp8<128>(s2 + (size_t)e * 1024 * 1024, 1024, kb * 128, n0, W82 + (size_t)e * 1024 * 1024 + (size_t)n0 * 1024 + kb * 128, 1024, lane_now()); }
#elif defined(MK_WIDE_CONV)
    if (r < J1) { const int kb = r >> 3, n0 = (r & 7) * 256;
        transpose_item_fp8_wide(s1 + (size_t)e * 1024 * 2048, 2048, kb * 16, n0, W81 + (size_t)e * 2048 * 1024, 1024, lane_now(), [](int n) { const int nn = n & 1023; return 256 * (nn >> 7) + (n >= 1024 ? 128 : 0) + (nn & 127); }); }
    else { r -= J1; const int kb = r >> 2, n0 = (r & 3) * 256;
        transpose_item_fp8_wide(s2 + (size_t)e * 1024 * 1024, 1024, kb * 16, n0, W82 + (size_t)e * 1024 * 1024, 1024, lane_now(), [](int n) { return n; }); }
#else
    if (r < J1) { const int kb = r / 32, n0 = (r % 32) * 64; const int nn = n0 & 1023, drow = 256 * (nn >> 7) + (n0 >= 1024 ? 128 : 0) + (nn & 127);
        transpose_item_fp8(s1 + (size_t)e * 1024 * 2048, 2048, kb * 64, n0, W81 + (size_t)e * 2048 * 1024 + (size_t)drow * 1024 + kb * 64, 1024, lane_now()); }
    else { r -= J1; const int kb = r / 16, n0 = (r % 16) * 64;
        transpose_item_fp8(s2 + (size_t)e * 1024 * 1024, 1024, kb * 64, n0, W82 + (size_t)e * 1024 * 1024 + (size_t)n0 * 1024 + kb * 64, 1024, lane_now()); }
#endif
}
#ifndef MK_FILL_MAX
#define MK_FILL_MAX 1000000
#endif
#ifndef MK_FILLER
#define MK_FILLER 0
#endif
constexpr bool FILLER_ON = (MK_FILLER != 0) && FP8_G1 && FP8_G2;
__device__ __forceinline__ void filler(Frame& F, const float* w1, const float* w2, int budget) {
    if constexpr (!FILLER_ON) return;
    if (budget < 1000 && budget > MK_FILL_MAX) budget = MK_FILL_MAX;
    while (budget > 0) {
        const int chunk = budget < 8 ? budget : 8; budget -= chunk;
        int it0 = 0; if (lane_now() == 0) it0 = (int)__hip_atomic_fetch_add(F.ctl + CW_FILL, (unsigned)chunk, RLX_AGENT);
        it0 = __builtin_amdgcn_readfirstlane(it0);
        if (it0 >= MOE_ITEMS) break;
        for (int it = it0; it < it0 + chunk && it < MOE_ITEMS; ++it) moe_item_fp8(F.ws, w1, w2, 1, it);
    }
}
__device__ __forceinline__ void p0_moe_weights(Frame& F, const float* w1, const float* w2, int layer) {
    LAS float* scr = (LAS float*)(F.lds + RING_OFF + F.wave * 16384);
    const int gw = F.vcu * NWAVES + F.wave, NGW = F.G * NWAVES;
    bf16* WT1 = (bf16*)(F.ws + WS_W1) + (size_t)layer * 32 * 2048 * 1024; bf16* WT2 = (bf16*)(F.ws + WS_W2) + (size_t)layer * 32 * 1024 * 1024;
    unsigned char* W81 = F.ws + WS_W1 + (size_t)layer * 32 * 2048 * 1024; unsigned char* W82 = F.ws + WS_W2 + (size_t)layer * 32 * 1024 * 1024;
    const float* s1 = w1 + (size_t)layer * 32 * 1024 * 2048; const float* s2 = w2 + (size_t)layer * 32 * 1024 * 1024;
    if constexpr (FP8_G1 && FP8_G2) {
        for (int it = gw; it < MOE_ITEMS; it += NGW) moe_item_fp8(F.ws, w1, w2, layer, it);
        return;
    }
    constexpr int I1 = 16 * 64, I2 = 16 * 32, IT = 32 * (I1 + I2);
    for (int it = gw; it < IT; it += NGW) {
        const int e = it / (I1 + I2); int r = it % (I1 + I2);
        if (r < I1) { const int kb = r / 64, nb = r % 64, n0 = nb * 32; const int nn = n0 & 1023, drow = 256 * (nn >> 7) + (n0 >= 1024 ? 128 : 0) + (nn & 127);
            transpose_item<true>(s1 + (size_t)e * 1024 * 2048, 2048, kb * 64, n0, WT1 + (size_t)e * 2048 * 1024 + (size_t)drow * 1024 + kb * 64, 1024, scr, lane_now()); }
        else { r -= I1; const int kb = r / 32, nb = r % 32;
            transpose_item<true>(s2 + (size_t)e * 1024 * 1024, 1024, kb * 64, nb * 32, WT2 + (size_t)e * 1024 * 1024 + (size_t)(nb * 32) * 1024 + kb * 64, 1024, scr, lane_now()); }
    }
}

__device__ __forceinline__ void moe_table(Frame& F, int layer) {
    LAS int* cntl = (LAS int*)(F.misc + MISC_CNT); LAS int* pb = (LAS int*)(F.misc + MISC_PB); LAS int* tab = (LAS int*)(F.misc + MISC_TAB); LAS int* ntl = (LAS int*)(F.misc + MISC_NT);
    if (tid_now(F) < 32) cntl[tid_now(F)] = (int)__hip_atomic_load(F.ctl + CW_CNT + (layer * 32 + tid_now(F)) * 64, RLX_AGENT);
    __syncthreads();
    if (tid_now(F) == 0) { int t = 0; for (int e = 0; e < 32; ++e) { pb[e] = t; const int n = (cntl[e] + 255) >> 8; for (int j = 0; j < n; ++j) tab[t + j] = (e << 16) | j; t += n; } ntl[0] = t; }
    __syncthreads();
}

struct MoeSched1 {
    pg8::TileOrder ord; LAS const int* tab; LAS const int* cntl; const char* XN; const char* W; const int* list; int a_pitch; int wb;
    __device__ __forceinline__ bool next(int i, pg8::Unit& u) const { return ord.tile(i, u); }
    __device__ __forceinline__ const char* a_base(const pg8::Unit&) const { return XN; }
    __device__ __forceinline__ const char* b_base(const pg8::Unit& u) const { const int e = __builtin_amdgcn_readfirstlane(tab[u.pm]) >> 16; return W + ((size_t)e * 2048 + (size_t)u.pn * 256) * wb; }
    __device__ __forceinline__ unsigned a_rowoff(const pg8::Unit& u, int r) const { const int te = __builtin_amdgcn_readfirstlane(tab[u.pm]), e = te >> 16, j = te & 0xffff; int lr = j * 256 + r; const int n = __builtin_amdgcn_readfirstlane(cntl[e]); lr = lr < n ? lr : n - 1;
        return (unsigned)list[(size_t)e * LCAP + lr] * (unsigned)a_pitch; }
};
struct MoeSched2 {
    pg8::TileOrder ord; LAS const int* tab; const char* HB; const char* W; int a_pitch; int wb;
    __device__ __forceinline__ bool next(int i, pg8::Unit& u) const { return ord.tile(i, u); }
    __device__ __forceinline__ const char* a_base(const pg8::Unit& u) const { return HB + (size_t)u.pm * 256 * a_pitch; }
    __device__ __forceinline__ const char* b_base(const pg8::Unit& u) const { const int e = __builtin_amdgcn_readfirstlane(tab[u.pm]) >> 16; return W + ((size_t)e * 1024 + (size_t)u.pn * 256) * wb; }
    __device__ __forceinline__ unsigned a_rowoff(const pg8::Unit&, int) const { return 0u; }
};
struct EpiSwiglu {
    static constexpr bool PERM = true;
    bf16* HB; const float* b1; LAS const int* tab;
    __device__ __forceinline__ void operator()(const pg8::f32x4 (&acc)[2][2][4][2], const pg8::Unit& u, int wr, int wc, int fr, int fq) const {
        const int e = __builtin_amdgcn_readfirstlane(tab[u.pm]) >> 16; const float* bb = b1 + (size_t)e * 2048 + u.pn * 128 + wc * 32 + 8 * fq;
        pg8::f32x4 bg[2], bl[2];
#pragma unroll
        for (int n = 0; n < 2; ++n) { bg[n] = *(const pg8::f32x4*)(bb + 4 * n); bl[n] = *(const pg8::f32x4*)(bb + 1024 + 4 * n); }
#pragma unroll
        for (int ai = 0; ai < 2; ++ai)
#pragma unroll
            for (int m = 0; m < 4; ++m) { const size_t row = (size_t)u.pm * 256 + ai * 128 + wr * 64 + m * 16 + fr; float o[8];
#pragma unroll
                for (int n = 0; n < 2; ++n)
#pragma unroll
                    for (int i = 0; i < 4; i += 2) { typedef float f2 __attribute__((ext_vector_type(2)));
                        f2 g = (f2){acc[ai][0][m][n][i], acc[ai][0][m][n][i + 1]} + (f2){bg[n][i], bg[n][i + 1]}; f2 l = (f2){acc[ai][1][m][n][i], acc[ai][1][m][n][i + 1]} + (f2){bl[n][i], bl[n][i + 1]};
                        g.x = fminf(g.x, 7.f); g.y = fminf(g.y, 7.f); l.x = __builtin_amdgcn_fmed3f(l.x, -7.f, 7.f); l.y = __builtin_amdgcn_fmed3f(l.y, -7.f, 7.f);
                        const f2 t = g * (-1.702f * 1.4426950408889634f); f2 d; d.x = __builtin_amdgcn_exp2f(t.x); d.y = __builtin_amdgcn_exp2f(t.y); d = d + 1.f;
                        f2 sg; sg.x = __builtin_amdgcn_rcpf(d.x); sg.y = __builtin_amdgcn_rcpf(d.y);
                        const f2 ov = (g * sg) * (l + 1.f); o[n * 4 + i] = ov.x; o[n * 4 + i + 1] = ov.y; }
                if constexpr (FP8_G2) { pg8::u32x2 w; w.x = pk4_fp8(o[0], o[1], o[2], o[3]); w.y = pk4_fp8(o[4], o[5], o[6], o[7]); *(pg8::u32x2*)((unsigned char*)HB + row * 1024 + u.pn * 128 + wc * 32 + 8 * fq) = w; }
                else { pg8::u32x4 w; w.x = pg8::cvt_pk_bf16(o[0], o[1]); w.y = pg8::cvt_pk_bf16(o[2], o[3]); w.z = pg8::cvt_pk_bf16(o[4], o[5]); w.w = pg8::cvt_pk_bf16(o[6], o[7]);
                    *(pg8::u32x4*)(HB + row * 1024 + u.pn * 128 + wc * 32 + 8 * fq) = w; } }
    }
};
struct EpiBias2 {
    static constexpr bool PERM = true;
    bf16* Y2; const float* b2; LAS const int* tab;
    __device__ __forceinline__ void operator()(const pg8::f32x4 (&acc)[2][2][4][2], const pg8::Unit& u, int wr, int wc, int fr, int fq) const {
        const int e = __builtin_amdgcn_readfirstlane(tab[u.pm]) >> 16; const int col0 = u.pn * 256 + wc * 32 + 8 * fq; const float* bb = b2 + (size_t)e * 1024 + col0;
        pg8::f32x4 bv[2][2];
#pragma unroll
        for (int bj = 0; bj < 2; ++bj)
#pragma unroll
            for (int n = 0; n < 2; ++n) bv[bj][n] = *(const pg8::f32x4*)(bb + bj * 128 + 4 * n);
#pragma unroll
        for (int ai = 0; ai < 2; ++ai)
#pragma unroll
            for (int m = 0; m < 4; ++m) { bf16* rowp = Y2 + ((size_t)u.pm * 256 + ai * 128 + wr * 64 + m * 16 + fr) * 1024 + col0;
#pragma unroll
                for (int bj = 0; bj < 2; ++bj) { const pg8::f32x4 v0 = acc[ai][bj][m][0] + bv[bj][0], v1 = acc[ai][bj][m][1] + bv[bj][1];
                    pg8::u32x4 w; w.x = pg8::cvt_pk_bf16(v0[0], v0[1]); w.y = pg8::cvt_pk_bf16(v0[2], v0[3]); w.z = pg8::cvt_pk_bf16(v1[0], v1[1]); w.w = pg8::cvt_pk_bf16(v1[2], v1[3]);
                    *(pg8::u32x4*)(rowp + bj * 128) = w; } }
    }
};

template <int M> __device__ __forceinline__ float xshfl(float x) {
    const int xi = __float_as_int(x);
    if constexpr (M == 1) return __int_as_float(__builtin_amdgcn_update_dpp(xi, xi, 0xB1, 0xF, 0xF, true));
    else if constexpr (M == 2) return __int_as_float(__builtin_amdgcn_update_dpp(xi, xi, 0x4E, 0xF, 0xF, true));
    else if constexpr (M == 32) { auto rr = __builtin_amdgcn_permlane32_swap((unsigned)xi, (unsigned)xi, false, false); return __uint_as_float((lane_now() & 32) ? rr[0] : rr[1]); }
    else return __int_as_float(__builtin_amdgcn_ds_swizzle(xi, (M << 10) | 0x1f));
}
constexpr size_t TAB_WRIMG = 65536;
__device__ __forceinline__ void p0_wr_image(Frame& F, const float* wr_all) {
    unsigned short* img = (unsigned short*)(F.ws + WS_TAB + TAB_WRIMG);
    const int gid0 = (F.vcu * NWAVES + F.wave) * 64 + lane_now(), NG = F.G * NTHR;
    for (int gid = gid0; gid < 2 * 32768; gid += NG) { const int layer = gid >> 15, k = (gid & 32767) >> 5, e = gid & 31; const float w = wr_all[(size_t)layer * 32768 + k * 32 + e];
        const unsigned hi = f2bf(w); const float rem = w - __builtin_bit_cast(float, hi << 16); const unsigned lo = f2bf(rem);
        const size_t o = (size_t)layer * 65536 + e * 1024 + ((((k >> 3) ^ (e & 15)) << 3) + (k & 7));
        img[o] = (unsigned short)hi; img[o + 32768] = (unsigned short)lo; }
}
__device__ __forceinline__ float rowmax16(float v) {
    v = fmaxf(v, __int_as_float(__builtin_amdgcn_update_dpp(0, __float_as_int(v), 0xB1, 0xF, 0xF, true)));
    v = fmaxf(v, __int_as_float(__builtin_amdgcn_update_dpp(0, __float_as_int(v), 0x4E, 0xF, 0xF, true)));
    v = fmaxf(v, __int_as_float(__builtin_amdgcn_update_dpp(0, __float_as_int(v), 0x124, 0xF, 0xF, true)));
    v = fmaxf(v, __int_as_float(__builtin_amdgcn_update_dpp(0, __float_as_int(v), 0x128, 0xF, 0xF, true)));
    return v;
}
__device__ __forceinline__ void phase_router(Frame& F, int layer, int row0, int nrows, const float* gnorm, const float* wr, const float* br) {
    const float* XS = (const float*)(F.ws + WS_XS); bf16* XN = (bf16*)(F.ws + WS_XN); const float* MODL = (const float*)(F.ws + WS_MOD) + (size_t)layer * 9 * 6144;
    int* eidx = (int*)(F.ws + WS_ROUTE + RT_EIDX); float* egate = (float*)(F.ws + WS_ROUTE + RT_EGATE); int* epos = (int*)(F.ws + WS_ROUTE + RT_EPOS); int* list = (int*)(F.ws + WS_ROUTE + RT_LIST);
    LAS int* hist = (LAS int*)(F.misc + MISC_HIST); LAS int* base = (LAS int*)(F.misc + MISC_BASE); LAS int* rec = (LAS int*)(F.misc + MISC_REC);
    (void)wr;
    { const v4u* img = (const v4u*)(F.ws + WS_TAB + TAB_WRIMG + (size_t)layer * 131072); const int t0 = tid_now(F);
#pragma unroll 4
        for (int i = t0; i < 8192; i += NTHR) *(LAS v4u*)(F.lds + RING_OFF + i * 16) = img[i];
        if (t0 < 32) hist[t0] = 0; }
    __syncthreads();
    const int ntiles = nrows >> 4; const int tile = F.wave * F.G + F.vcu; const bool have = tile < ntiles;
    if (have) {
        int lane = lane_now(); const int fr = lane & 15, fq = lane >> 4;
        const int rbase = row0 + tile * 16; const int row = rbase + fr; const float* x = XS + (size_t)row * D + 8 * fq; const float* m = MODL + (size_t)row_modrow(rbase) * 6144 + 8 * fq; const float* gp = gnorm + 8 * fq;
        float ss = 0.f;
#pragma unroll 1
        for (int s0 = 0; s0 < 32; s0 += 8) { f32x4 v[16];
#pragma unroll
            for (int q = 0; q < 8; ++q) { v[2 * q] = *(const GAS f32x4*)(x + 32 * (s0 + q)); v[2 * q + 1] = *(const GAS f32x4*)(x + 32 * (s0 + q) + 4); }
#pragma unroll
            for (int q = 0; q < 16; ++q) ss += (v[q][0] * v[q][0] + v[q][1] * v[q][1]) + (v[q][2] * v[q][2] + v[q][3] * v[q][3]); }
        ss += xshfl<16>(ss); ss += xshfl<32>(ss);
        const float rstd = rsqrtf(ss * (1.f / D) + 1e-6f);
        f32x4 acc0 = (f32x4){0.f, 0.f, 0.f, 0.f}, acc1 = acc0;
        LAS const unsigned char* bb = F.lds + RING_OFF + fr * 2048;
#pragma unroll 2
        for (int s = 0; s < 32; ++s) {
            const f32x4 xa = *(const GAS f32x4*)(x + 32 * s), xb = *(const GAS f32x4*)(x + 32 * s + 4);
            const f32x4 ga = *(const GAS f32x4*)(gp + 32 * s), gb = *(const GAS f32x4*)(gp + 32 * s + 4);
            const f32x4 sca = *(const GAS f32x4*)(m + 4 * D + 32 * s), scb = *(const GAS f32x4*)(m + 4 * D + 32 * s + 4), sha = *(const GAS f32x4*)(m + 3 * D + 32 * s), shb = *(const GAS f32x4*)(m + 3 * D + 32 * s + 4);
            const f32x4 ha = xa * rstd * ga * (1.f + sca) + sha, hb = xb * rstd * gb * (1.f + scb) + shb;
            if constexpr (FP8_G1) { v2u w; w.x = pk4_fp8(ha[0], ha[1], ha[2], ha[3]); w.y = pk4_fp8(hb[0], hb[1], hb[2], hb[3]); *(GAS v2u*)((unsigned char*)XN + (size_t)row * D + 32 * s + 8 * fq) = w; }
            else { v4u w; w.x = pk2(Q8A(ha[0]), Q8A(ha[1])); w.y = pk2(Q8A(ha[2]), Q8A(ha[3])); w.z = pk2(Q8A(hb[0]), Q8A(hb[1])); w.w = pk2(Q8A(hb[2]), Q8A(hb[3])); *(GAS v4u*)(XN + (size_t)row * D + 32 * s + 8 * fq) = w; }
            unsigned hh[4], hl[4];
#pragma unroll
            for (int j = 0; j < 2; ++j) { const unsigned a0 = f2bf(ha[2 * j]), a1 = f2bf(ha[2 * j + 1]), b0 = f2bf(hb[2 * j]), b1 = f2bf(hb[2 * j + 1]);
                hh[j] = a0 | (a1 << 16); hh[2 + j] = b0 | (b1 << 16);
                hl[j] = pk2(ha[2 * j] - __builtin_bit_cast(float, a0 << 16), ha[2 * j + 1] - __builtin_bit_cast(float, a1 << 16)); hl[2 + j] = pk2(hb[2 * j] - __builtin_bit_cast(float, b0 << 16), hb[2 * j + 1] - __builtin_bit_cast(float, b1 << 16)); }
            const bf16x8 Ah = __builtin_bit_cast(bf16x8, (v4u){hh[0], hh[1], hh[2], hh[3]}), Al = __builtin_bit_cast(bf16x8, (v4u){hl[0], hl[1], hl[2], hl[3]});
            const int co = ((4 * s + fq) ^ fr) << 4;
            const bf16x8 B0h = *(const LAS bf16x8*)(bb + co), B1h = *(const LAS bf16x8*)(bb + 32768 + co), B0l = *(const LAS bf16x8*)(bb + 65536 + co), B1l = *(const LAS bf16x8*)(bb + 65536 + 32768 + co);
            acc0 = __builtin_amdgcn_mfma_f32_16x16x32_bf16(Ah, B0h, acc0, 0, 0, 0); acc1 = __builtin_amdgcn_mfma_f32_16x16x32_bf16(Ah, B1h, acc1, 0, 0, 0);
            acc0 = __builtin_amdgcn_mfma_f32_16x16x32_bf16(Ah, B0l, acc0, 0, 0, 0); acc1 = __builtin_amdgcn_mfma_f32_16x16x32_bf16(Ah, B1l, acc1, 0, 0, 0);
            acc0 = __builtin_amdgcn_mfma_f32_16x16x32_bf16(Al, B0h, acc0, 0, 0, 0); acc1 = __builtin_amdgcn_mfma_f32_16x16x32_bf16(Al, B1h, acc1, 0, 0, 0);
        }
        const float b0v = br[fr], b1v = br[fr + 16];
        float k0[4], k1[4];
#pragma unroll
        for (int i = 0; i < 4; ++i) { k0[i] = __int_as_float((__float_as_int(acc0[i] + b0v) & ~31) | (31 - fr)); k1[i] = __int_as_float((__float_as_int(acc1[i] + b1v) & ~31) | (15 - fr)); }
        float tv[4][4]; int te[4][4];
#pragma unroll
        for (int kk = 0; kk < 4; ++kk) {
#pragma unroll
            for (int i = 0; i < 4; ++i) { const float w = rowmax16(fmaxf(k0[i], k1[i])); const int wb = __float_as_int(w); te[i][kk] = 31 - (wb & 31); tv[i][kk] = __int_as_float(wb & ~31);
                k0[i] = (k0[i] == w) ? -3.0e38f : k0[i]; k1[i] = (k1[i] == w) ? -3.0e38f : k1[i]; } }
#pragma unroll
        for (int i = 0; i < 4; ++i) { float p[4], ps = 0.f;
#pragma unroll
            for (int kk = 0; kk < 4; ++kk) { p[kk] = __expf(tv[i][kk] - tv[i][0]); ps += p[kk]; }
            if (fr < 4) { const int e = fr == 0 ? te[i][0] : fr == 1 ? te[i][1] : fr == 2 ? te[i][2] : te[i][3]; const float g = (fr == 0 ? p[0] : fr == 1 ? p[1] : fr == 2 ? p[2] : p[3]) / ps;
                const int r = rbase + 4 * fq + i; const int li = F.wave * 16 + 4 * fq + i;
                const int pl = __hip_atomic_fetch_add(hist + e, 1, __ATOMIC_RELAXED, __HIP_MEMORY_SCOPE_WORKGROUP);
                eidx[r * 4 + fr] = e; egate[r * 4 + fr] = g; rec[(li * 4 + fr) * 2] = e; rec[(li * 4 + fr) * 2 + 1] = pl; } }
    }
    __syncthreads();
    if (tid_now(F) < 32) base[tid_now(F)] = (int)__hip_atomic_fetch_add(F.ctl + CW_CNT + (layer * 32 + tid_now(F)) * 64, (unsigned)hist[tid_now(F)], RLX_AGENT);
    __syncthreads();
    { const int q = tid_now(F); const int w = q >> 6, rit = (q >> 2) & 15, k = q & 3; const int t2 = w * F.G + F.vcu;
        if (t2 < ntiles) { const int r = row0 + t2 * 16 + rit; const int e = rec[q * 2], pos = base[e] + rec[q * 2 + 1]; epos[r * 4 + k] = pos; list[(size_t)e * LCAP + pos] = r; } }
}

__device__ __forceinline__ void phase_combine(Frame& F, int layer, int row0, int nrows, int mode, const float* gnext, const float* MODN, float* out) {
    float* XS = (float*)(F.ws + WS_XS); bf16* XN = (bf16*)(F.ws + WS_XN); const bf16* Y2 = (const bf16*)(F.ws + WS_Y2); const float* MODL = (const float*)(F.ws + WS_MOD) + (size_t)layer * 9 * 6144;
    const int* eidx = (const int*)(F.ws + WS_ROUTE + RT_EIDX); const float* egate = (const float*)(F.ws + WS_ROUTE + RT_EGATE); const int* epos = (const int*)(F.ws + WS_ROUTE + RT_EPOS);
    LAS const int* pb = (LAS const int*)(F.misc + MISC_PB);
    const int lane_ = lane_now(); const int nloc = (nrows - F.vcu + F.G - 1) / F.G;
    for (int i0 = F.wave; i0 < nloc; i0 += NWAVES * 2) {
        int lane = lane_; asm volatile("" : "+v"(lane));
        const int i1 = i0 + 8; const bool ok1 = i1 < nloc; const int rA = row0 + i0 * F.G + F.vcu, rB = row0 + (ok1 ? i1 : i0) * F.G + F.vcu;
        int eA[4], eB[4], sA[4], sB[4]; float pA[4], pB[4];
#pragma unroll
        for (int k = 0; k < 4; ++k) { eA[k] = eidx[rA * 4 + k]; eB[k] = eidx[rB * 4 + k]; pA[k] = egate[rA * 4 + k]; pB[k] = egate[rB * 4 + k]; sA[k] = epos[rA * 4 + k]; sB[k] = epos[rB * 4 + k]; }
#pragma unroll
        for (int k = 0; k < 4; ++k) { sA[k] += pb[eA[k]] * 256; sB[k] += pb[eB[k]] * 256; }
        v4u yA[4][2], yB[4][2];
#pragma unroll
        for (int k = 0; k < 4; ++k)
#pragma unroll
            for (int h = 0; h < 2; ++h) { yA[k][h] = *(const GAS v4u*)(Y2 + (size_t)sA[k] * D + 512 * h + 8 * lane); yB[k][h] = *(const GAS v4u*)(Y2 + (size_t)sB[k] * D + 512 * h + 8 * lane); }
        const float* gA = MODL + (size_t)row_modrow(rA) * 6144 + 5 * D; const float* gB = MODL + (size_t)row_modrow(rB) * 6144 + 5 * D;
        f32x4 xA[2][2], xB[2][2]; float ssA = 0.f, ssB = 0.f;
#pragma unroll
        for (int h = 0; h < 2; ++h)
#pragma unroll
            for (int q = 0; q < 2; ++q) { const int c = 512 * h + 8 * lane + 4 * q;
                f32x4 aA = (f32x4){0.f, 0.f, 0.f, 0.f}, aB = aA;
#pragma unroll
                for (int k = 0; k < 4; ++k) { const unsigned wa0 = q ? yA[k][h].z : yA[k][h].x, wa1 = q ? yA[k][h].w : yA[k][h].y, wb0 = q ? yB[k][h].z : yB[k][h].x, wb1 = q ? yB[k][h].w : yB[k][h].y;
                    aA += pA[k] * (f32x4){bf_lo(wa0), bf_hi(wa0), bf_lo(wa1), bf_hi(wa1)}; aB += pB[k] * (f32x4){bf_lo(wb0), bf_hi(wb0), bf_lo(wb1), bf_hi(wb1)}; }
                const f32x4 xoA = *(const GAS f32x4*)(XS + (size_t)rA * D + c), xoB = *(const GAS f32x4*)(XS + (size_t)rB * D + c); const f32x4 ggA = *(const GAS f32x4*)(gA + c), ggB = *(const GAS f32x4*)(gB + c);
                const f32x4 nA = xoA + ggA * aA, nB = xoB + ggB * aB; xA[h][q] = nA; xB[h][q] = nB;
                if (mode == 0 || WRITE_XS_ALWAYS) { *(GAS f32x4*)(XS + (size_t)rA * D + c) = nA; if (ok1) *(GAS f32x4*)(XS + (size_t)rB * D + c) = nB; }
                ssA += (nA[0] * nA[0] + nA[1] * nA[1]) + (nA[2] * nA[2] + nA[3] * nA[3]); ssB += (nB[0] * nB[0] + nB[1] * nB[1]) + (nB[2] * nB[2] + nB[3] * nB[3]); }
#pragma unroll
        for (int o = 1; o < 64; o <<= 1) { ssA += __shfl_xor(ssA, o); ssB += __shfl_xor(ssB, o); }
        const float rsA = rsqrtf(ssA * (1.f / D) + 1e-6f), rsB = rsqrtf(ssB * (1.f / D) + 1e-6f);
        if (mode == 0) { const float* mA = MODN + (size_t)row_modrow(rA) * 6144; const float* mB = MODN + (size_t)row_modrow(rB) * 6144;
#pragma unroll
            for (int h = 0; h < 2; ++h) { float oA[8], oB[8];
#pragma unroll
                for (int q = 0; q < 2; ++q) { const int c = 512 * h + 8 * lane + 4 * q; const f32x4 gn = *(const GAS f32x4*)(gnext + c);
                    const f32x4 yA_ = xA[h][q] * rsA * gn * (1.f + *(const GAS f32x4*)(mA + D + c)) + *(const GAS f32x4*)(mA + c), yB_ = xB[h][q] * rsB * gn * (1.f + *(const GAS f32x4*)(mB + D + c)) + *(const GAS f32x4*)(mB + c);
                    oA[4 * q] = yA_[0]; oA[4 * q + 1] = yA_[1]; oA[4 * q + 2] = yA_[2]; oA[4 * q + 3] = yA_[3]; oB[4 * q] = yB_[0]; oB[4 * q + 1] = yB_[1]; oB[4 * q + 2] = yB_[2]; oB[4 * q + 3] = yB_[3]; }
                v4u w; w.x = pk2(oA[0], oA[1]); w.y = pk2(oA[2], oA[3]); w.z = pk2(oA[4], oA[5]); w.w = pk2(oA[6], oA[7]);
                *(GAS v4u*)(XN + (size_t)rA * D + 512 * h + 8 * lane) = w;
                if (ok1) { w.x = pk2(oB[0], oB[1]); w.y = pk2(oB[2], oB[3]); w.z = pk2(oB[4], oB[5]); w.w = pk2(oB[6], oB[7]); *(GAS v4u*)(XN + (size_t)rB * D + 512 * h + 8 * lane) = w; } }
        } else {
#pragma unroll
            for (int h = 0; h < 2; ++h)
#pragma unroll
                for (int q = 0; q < 2; ++q) { const int c = 512 * h + 8 * lane + 4 * q; const f32x4 gn = *(const GAS f32x4*)(gnext + c);
                    *(GAS f32x4*)(out + (size_t)(rA - NCTX) * D + c) = xA[h][q] * rsA * gn; if (ok1) *(GAS f32x4*)(out + (size_t)(rB - NCTX) * D + c) = xB[h][q] * rsB * gn; }
        }
    }
}
}
namespace mk {
template <bool QOUT = false> __device__ __forceinline__ void p0_dense_weight(Frame& F, const float* W, int K, int N, bf16* WT, int rot) {
    LAS float* scr = (LAS float*)(F.lds + RING_OFF + F.wave * 16384);
    const int NGW = F.G * NWAVES; const int gw = (F.vcu * NWAVES + F.wave + rot) % NGW;
    const int nb = N / 32, items = (K / 64) * nb;
    for (int it = gw; it < items; it += NGW) { const int kb = it / nb, n0 = (it % nb) * 32; transpose_item<false, QOUT>(W, N, kb * 64, n0, WT + (size_t)n0 * K + kb * 64, K, scr, lane_now()); }
}
__device__ __forceinline__ void p0_gate_weights(Frame& F, const float* ga, const float* gx, int rot) {
    LAS float* scr = (LAS float*)(F.lds + RING_OFF + F.wave * 16384);
    const int NGW = F.G * NWAVES; const int gw = (F.vcu * NWAVES + F.wave + rot) % NGW;
    bf16* WG = (bf16*)(F.ws + WS_WGATE);
    for (int it = gw; it < 16 * 32; it += NGW) { const int mat = it >> 5, r = it & 31, kb = r >> 3, nbk = r & 7, n0 = nbk * 32; const int ty = mat & 1, dg = mat >> 1;
        const float* W = (ty ? gx : ga) + (size_t)dg * 65536; const int jt = n0 >> 7, rr = (n0 & 127) + (ty ? 128 : 0);
        transpose_item(W, 256, kb * 64, n0, WG + ((size_t)(dg * 2 + jt) * 256 + rr) * 256 + kb * 64, 256, scr, lane_now()); }
}
__device__ __forceinline__ void p0_adaln(Frame& F, const float* c, const float* cctx, const float* w_mod, const float* b_mod) {
    LAS float* sil = (LAS float*)(F.lds + RING_OFF);
    LAS float* part = (LAS float*)(F.lds + RING_OFF + 40960);
    float* MOD = (float*)(F.ws + WS_MOD);
    if (F.vcu >= 192 && F.G >= 256) return;
    for (int idx = tid_now(F); idx < 9 * 1024; idx += NTHR) { const float v = idx < 8192 ? c[idx] : cctx[idx - 8192]; sil[idx] = v / (1.f + __expf(-v)); }
    __syncthreads();
    for (int item = F.vcu; item < 192; item += F.G) {
        const int layer = item / 96, n0 = (item % 96) * 64; const float* w = w_mod + (size_t)layer * 1024 * 6144 + n0 + lane_now(); const int k0 = F.wave * 128;
        float acc[9];
#pragma unroll
        for (int b = 0; b < 9; ++b) acc[b] = 0.f;
        for (int kk = 0; kk < 128; kk += 16) { float wv[16];
#pragma unroll
            for (int j = 0; j < 16; ++j) wv[j] = w[(size_t)(k0 + kk + j) * 6144];
#pragma unroll
            for (int q = 0; q < 4; ++q)
#pragma unroll
                for (int b = 0; b < 9; ++b) { const f32x4 s = *(const LAS f32x4*)(sil + b * 1024 + k0 + kk + 4 * q); acc[b] += s[0] * wv[4 * q] + s[1] * wv[4 * q + 1] + s[2] * wv[4 * q + 2] + s[3] * wv[4 * q + 3]; } }
#pragma unroll
        for (int b = 0; b < 9; ++b) part[(F.wave * 9 + b) * 64 + lane_now()] = acc[b];
        __syncthreads();
        for (int q = tid_now(F); q < 9 * 64; q += NTHR) { const int b = q >> 6, l = q & 63; float s = 0.f;
#pragma unroll
            for (int wv = 0; wv < 8; ++wv) s += part[(wv * 9 + b) * 64 + l];
            MOD[((size_t)layer * 9 + b) * 6144 + n0 + l] = s + b_mod[layer * 6144 + n0 + l]; }
        __syncthreads();
    }
}
__device__ __forceinline__ void p0_wait_adaln(Frame& F) {
    if (tid_now(F) == 0) { unsigned sp = 0; while (__hip_atomic_load(F.ctl + CW_ADALN, RLX_AGENT) < 192u) { __builtin_amdgcn_s_sleep(2); if (++sp > (1u << 22)) break; }
        __builtin_amdgcn_fence(__ATOMIC_ACQUIRE, "agent"); asm volatile("s_waitcnt vmcnt(0)" ::: "memory"); }
    __syncthreads();
}
constexpr int TAB_COS = 0, TAB_SIN = 1024, TAB_SP = 2048, TAB_LAM = 4096;
__device__ __forceinline__ void p0_tables(Frame& F, const float* lq1, const float* lk1, const float* lq2, const float* lk2, const float* lru) {
    if (F.vcu != (F.G > 200 ? 200 : 0)) return;
    float* T = (float*)(F.ws + WS_TAB);
    for (int i = tid_now(F); i < 1024; i += NTHR) { const int pos = i >> 4, f = i & 15; const float inv = powf(10000.f, -(float)f / 16.f); const float ang = (float)pos * inv; T[TAB_COS + i] = cosf(ang); T[TAB_SIN + i] = sinf(ang); }
    for (int i = tid_now(F); i < 2048; i += NTHR) T[TAB_SP + i] = log1pf(expf(-lru[i]));
    if (tid_now(F) == 0) { float a = 0.f, b = 0.f; for (int i = 0; i < 64; ++i) { a += lq1[i] * lk1[i]; b += lq2[i] * lk2[i]; } T[TAB_LAM] = expf(a) - expf(b) + 0.2f; }
}

__device__ __forceinline__ void phase_norm1_l0(Frame& F, const float* x, const float* ctx, const float* g) {
    bf16* XN = (bf16*)(F.ws + WS_XN); const float* MODL = (const float*)(F.ws + WS_MOD);
    int lane_ = lane_now(); asm volatile("" : "+v"(lane_)); const int lane = lane_;
    const int gw = F.vcu * NWAVES + F.wave, NGW = F.G * NWAVES;
    for (int r = gw; r < NTOK; r += NGW) {
        const float* src = r < NCTX ? ctx + (size_t)r * D : x + (size_t)(r - NCTX) * D; const float* m = MODL + (size_t)row_modrow(r) * 6144;
        f32x4 v[2][2]; float ss = 0.f;
#pragma unroll
        for (int h = 0; h < 2; ++h)
#pragma unroll
            for (int q = 0; q < 2; ++q) { v[h][q] = *(const GAS f32x4*)(src + 512 * h + 8 * lane + 4 * q); ss += (v[h][q][0] * v[h][q][0] + v[h][q][1] * v[h][q][1]) + (v[h][q][2] * v[h][q][2] + v[h][q][3] * v[h][q][3]); }
        const float rstd = rsqrtf(wave_sum(ss) * (1.f / D) + 1e-6f);
#pragma unroll
        for (int h = 0; h < 2; ++h) { float o[8];
#pragma unroll
            for (int q = 0; q < 2; ++q) { const int c = 512 * h + 8 * lane + 4 * q; const f32x4 gn = *(const GAS f32x4*)(g + c), sc = *(const GAS f32x4*)(m + D + c), sh = *(const GAS f32x4*)(m + c);
                const f32x4 y = v[h][q] * rstd * gn * (1.f + sc) + sh; o[4 * q] = y[0]; o[4 * q + 1] = y[1]; o[4 * q + 2] = y[2]; o[4 * q + 3] = y[3]; }
            v4u w; w.x = pk2(o[0], o[1]); w.y = pk2(o[2], o[3]); w.z = pk2(o[4], o[5]); w.w = pk2(o[6], o[7]);
            *(GAS v4u*)(XN + (size_t)r * D + 512 * h + 8 * lane) = w; }
    }
}

struct DenseSched {
    pg8::TileOrder ord; const char* A; const char* W; int a_pitch; int K2;
    __device__ __forceinline__ bool next(int i, pg8::Unit& u) const { return ord.tile(i, u); }
    __device__ __forceinline__ const char* a_base(const pg8::Unit& u) const { return A + (size_t)u.pm * 256 * a_pitch; }
    __device__ __forceinline__ const char* b_base(const pg8::Unit& u) const { return W + (size_t)u.pn * 256 * K2; }
    __device__ __forceinline__ unsigned a_rowoff(const pg8::Unit&, int) const { return 0u; }
};
constexpr float ATT_C2 = 0.125f * 1.4426950408889634f;
struct EpiInProj0 {
    static constexpr bool PERM = false;
    bf16* PROJ; const float* TAB;
    __device__ __forceinline__ void operator()(const pg8::f32x4 (&acc)[2][2][4][2], const pg8::Unit& u, int wr, int wc, int fr, int fq) const {
        const bool rope = u.pn < 4 && u.pm >= 8; const float sc = u.pn < 2 ? ATT_C2 : 1.f; const int axis = wc & 1;
#pragma unroll
        for (int ai = 0; ai < 2; ++ai)
#pragma unroll
            for (int m = 0; m < 4; ++m) { const int r = u.pm * 256 + ai * 128 + wr * 64 + m * 16 + fr;
                pg8::f32x4 cs = (pg8::f32x4){1.f, 1.f, 1.f, 1.f}, sn = (pg8::f32x4){0.f, 0.f, 0.f, 0.f};
                if (rope) { const int t = (r - NCTX) & 2047; const int pos = axis ? (t & 63) : (t >> 6); cs = *(const pg8::f32x4*)(TAB + TAB_COS + pos * 16 + 4 * fq); sn = *(const pg8::f32x4*)(TAB + TAB_SIN + pos * 16 + 4 * fq); }
                bf16* rowp = PROJ + (size_t)r * 3072 + u.pn * 256 + wc * 32 + 4 * fq;
#pragma unroll
                for (int bj = 0; bj < 2; ++bj) { const pg8::f32x4 x1 = acc[ai][bj][m][0], x2 = acc[ai][bj][m][1];
                    const pg8::f32x4 o1 = (x1 * cs - x2 * sn) * sc, o2 = (x2 * cs + x1 * sn) * sc;
                    pg8::u32x2 w1, w2; w1.x = pg8::cvt_pk_bf16(o1[0], o1[1]); w1.y = pg8::cvt_pk_bf16(o1[2], o1[3]); w2.x = pg8::cvt_pk_bf16(o2[0], o2[1]); w2.y = pg8::cvt_pk_bf16(o2[2], o2[3]);
                    *(pg8::u32x2*)(rowp + bj * 128) = w1; *(pg8::u32x2*)(rowp + bj * 128 + 16) = w2; } }
    }
};
struct EpiResid {
    static constexpr bool PERM = true;
    float* XS; const float* x_in; const float* ctx_in; const float* gate;
    int row0;
    __device__ __forceinline__ void operator()(const pg8::f32x4 (&acc)[2][2][4][2], const pg8::Unit& u, int wr, int wc, int fr, int fq) const {
        const int col0 = u.pn * 256 + wc * 32 + 8 * fq;
#pragma unroll
        for (int ai = 0; ai < 2; ++ai)
#pragma unroll
            for (int m = 0; m < 4; ++m) { const int r = row0 + u.pm * 256 + ai * 128 + wr * 64 + m * 16 + fr; const float* g = gate + (size_t)row_modrow(r) * 6144 + col0;
                const float* bp = x_in ? (r < NCTX ? ctx_in + (size_t)r * D : x_in + (size_t)(r - NCTX) * D) : XS + (size_t)r * D; float* op = XS + (size_t)r * D + col0; bp += col0;
#pragma unroll
                for (int bj = 0; bj < 2; ++bj)
#pragma unroll
                    for (int n = 0; n < 2; ++n) { const int o = bj * 128 + n * 4; const pg8::f32x4 gg = *(const pg8::f32x4*)(g + o), bb = *(const pg8::f32x4*)(bp + o);
                        *(pg8::f32x4*)(op + o) = bb + gg * acc[ai][bj][m][n]; }
                if (m & 1) asm volatile("" ::: "memory"); }
    }
};
}
namespace mk {
namespace att {
#ifndef MK_ATT_DUP
#define MK_ATT_DUP 0
#endif
constexpr int PITCH = 3072;
constexpr int SLOT = 32768, NSL = 4;
static_assert(NSL * SLOT <= RING_BYTES && MISC_REC + 8 * 512 <= LDS_BYTES - MISC_OFF, "attention LDS: four K/V slots fill the ring; the per-wave f32 scratch [8][128] lives in the MISC area");
__device__ __forceinline__ int crow(int r, int hi) { return (r & 3) + 8 * (r >> 2) + 4 * hi; }
#define ATT_WAIT_BAR(N) asm volatile("s_waitcnt vmcnt(" #N ") lgkmcnt(0)\n\ts_barrier" ::: "memory")
typedef short v4i16_t __attribute__((ext_vector_type(4)));
__device__ __forceinline__ s16x4 vtr(LAS const unsigned char* p) { return __builtin_bit_cast(s16x4, __builtin_amdgcn_ds_read_tr16_b64_v4i16((LAS v4i16_t*)p)); }
__device__ __forceinline__ unsigned cvtpk(float lo, float hi) { typedef float f2 __attribute__((ext_vector_type(2))); typedef __bf16 b2 __attribute__((ext_vector_type(2))); f2 v = {lo, hi}; b2 b = __builtin_convertvector(v, b2); return __builtin_bit_cast(unsigned, b); }
__device__ __forceinline__ float max3f(float a, float b, float c) { float r; asm("v_max3_f32 %0, %1, %2, %3" : "=v"(r) : "v"(a), "v"(b), "v"(c)); return r; }
__device__ __forceinline__ float half_swap_max(float m) { auto rr = __builtin_amdgcn_permlane32_swap(__float_as_uint(m), __float_as_uint(m), false, false); return fmaxf(__uint_as_float(rr[0]), __uint_as_float(rr[1])); }
__device__ __forceinline__ float half_swap_sum(float m) { auto rr = __builtin_amdgcn_permlane32_swap(__float_as_uint(m), __float_as_uint(m), false, false); return __uint_as_float(rr[0]) + __uint_as_float(rr[1]); }

template <int ABL = 0> __device__ __forceinline__ void attn_unit(LAS unsigned char* lds, LAS float* scr, const bf16* PROJ, bf16* CAT, const int qrow0, const int krow_ctx, const int krow_lat, const int NT, const int h, const float lam, const float* subln, const int tid_in) {
    int tid = tid_in; asm volatile("" : "+v"(tid));
    const int lane = tid & 63, r32 = lane & 31, hi = lane >> 5; const int wid = __builtin_amdgcn_readfirstlane(tid >> 6); const int mh = wid >> 2, wq = wid & 3;
    LAS float* wsf = scr + wid * 128; LAS float* wsfh = wsf + 4 * hi;
#define CR(r) (((r) & 3) + 8 * ((r) >> 2))
    const int krow_ = 8 * wid + (lane >> 3);
    const bf16* kbase = PROJ + 512 + h * 128 + (size_t)krow_ * PITCH + (((lane & 7) ^ ((krow_ >> 1) & 7)) * 8);
    const bf16* vbase0 = PROJ + 1024 + h * 128 + ((wid >> 2) * 32) + (lane & 3) * 8 + (size_t)(16 * (wid & 3) + (lane >> 2)) * PITCH;
    const bf16* vbase1 = vbase0 + 64;
    const unsigned lds0 = (unsigned)__builtin_amdgcn_readfirstlane((int)(unsigned)(uintptr_t)lds) + (unsigned)wid * 1024u;
#define ATT_GLDS(gsrc, dst) do { unsigned keep_; asm volatile("s_mov_b32 %0, m0\n\ts_mov_b32 m0, %2\n\ts_nop 0\n\tglobal_load_lds_dwordx4 %1, off\n\ts_mov_b32 m0, %0" : "=&s"(keep_) : "v"(gsrc), "s"(dst) : "memory"); } while (0)
#define ATT_DMA(t, slot) do { const size_t kr_ = (size_t)((t) < 4 ? krow_ctx + 64 * (t) : krow_lat + 64 * ((t) - 4)) * PITCH; const unsigned d_ = lds0 + (unsigned)(slot) * SLOT; \
        ATT_GLDS(kbase + kr_, d_); ATT_GLDS(kbase + kr_ + 64, d_ + 8192u); ATT_GLDS(vbase0 + kr_, d_ + 16384u); ATT_GLDS(vbase1 + kr_, d_ + 24576u); } while (0)
#ifndef MK_ATT_LAG
#define MK_ATT_LAG 0
#endif
    ATT_DMA(0, 0); if (MK_ATT_DUP == 4) ATT_DMA(0, 0); ATT_DMA(1, 1); if (MK_ATT_DUP == 4) ATT_DMA(1, 1);
    const bf16* Qw = PROJ + (size_t)(qrow0 + wq * 32 + r32) * PITCH + h * 128 + mh * 64 + hi * 8;
    bf16x8 qr[4];
#pragma unroll
    for (int d0 = 0; d0 < 4; ++d0) qr[d0] = *(const GAS bf16x8*)(Qw + d0 * 16);
    asm volatile("" : "+v"(qr[0]), "+v"(qr[1]), "+v"(qr[2]), "+v"(qr[3]));
    float mrow = 0.f, l_reg = 0.f; f32x16 o[4]; f32x16 negm;
#pragma unroll
    for (int d0 = 0; d0 < 4; ++d0)
#pragma unroll
        for (int r = 0; r < 16; ++r) o[d0][r] = 0.f;
#pragma unroll
    for (int r = 0; r < 16; ++r) negm[r] = 0.f;
    int koffs[4];
#pragma unroll
    for (int d0 = 0; d0 < 4; ++d0) koffs[d0] = mh * 8192 + r32 * 128 + (((2 * d0 + hi) ^ ((r32 >> 1) & 7)) << 4);
    const int voff = 16384 + ((lane >> 4) & 1) * 32 + (lane & 3) * 8 + (4 * hi + ((lane & 15) >> 2)) * 64;
#define SBAR() __builtin_amdgcn_sched_barrier(0)
#define ATT_VF(lo_, hi_) ((bf16x8){lo_[0], lo_[1], lo_[2], lo_[3], hi_[0], hi_[1], hi_[2], hi_[3]})
    v4u pwp[4];
#pragma unroll
    for (int k = 0; k < 4; ++k) pwp[k] = (v4u){0u, 0u, 0u, 0u};
#define ATT_STEP(T_, HASQK, HASPV, PIN, POUT) do { const int t = (T_); \
        if (HASQK) { if (MK_ATT_DUP == 4) { if (t + 1 < NT) { ATT_WAIT_BAR(8); } else { ATT_WAIT_BAR(0); } } else { if (t + 1 < NT) { ATT_WAIT_BAR(4); } else { ATT_WAIT_BAR(0); } } \
            if (MK_ATT_DUP == 5) { ATT_WAIT_BAR(4); } \
            if (t + 2 < NT && ABL != 3) { ATT_DMA(t + 2, (t + 2) & 3); if (MK_ATT_DUP == 4) ATT_DMA(t + 2, (t + 2) & 3); } } \
        f32x16 p0 = negm, p1 = negm; bool resc = false; \
        if (HASQK) { \
            LAS const unsigned char* kp = lds + (t & 3) * SLOT; \
            bf16x8 kf[8]; \
            _Pragma("unroll") for (int d0 = 0; d0 < 4; ++d0) { kf[2 * d0] = *(const LAS bf16x8*)(kp + koffs[d0]); kf[2 * d0 + 1] = *(const LAS bf16x8*)(kp + koffs[d0] + 4096); } \
            if (MK_ATT_DUP == 6) { bf16x8 kg[8]; _Pragma("unroll") for (int d0 = 0; d0 < 4; ++d0) { kg[2 * d0] = *(const volatile LAS bf16x8*)(kp + koffs[d0]); kg[2 * d0 + 1] = *(const volatile LAS bf16x8*)(kp + koffs[d0] + 4096); } \
                _Pragma("unroll") for (int i = 0; i < 8; ++i) asm volatile("" :: "v"(kg[i])); } \
            SBAR(); \
            _Pragma("unroll") for (int d0 = 0; d0 < 4; ++d0) { p0 = __builtin_amdgcn_mfma_f32_32x32x16_bf16(kf[2 * d0], qr[d0], p0, 0, 0, 0); p1 = __builtin_amdgcn_mfma_f32_32x32x16_bf16(kf[2 * d0 + 1], qr[d0], p1, 0, 0, 0); } \
            if (MK_ATT_DUP == 1) { f32x16 q0 = negm, q1 = negm; _Pragma("unroll") for (int d0 = 0; d0 < 4; ++d0) { q0 = __builtin_amdgcn_mfma_f32_32x32x16_bf16(kf[2 * d0], qr[d0], q0, 0, 0, 0); q1 = __builtin_amdgcn_mfma_f32_32x32x16_bf16(kf[2 * d0 + 1], qr[d0], q1, 0, 0, 0); } asm volatile("" :: "v"(q0), "v"(q1)); } \
            SBAR(); \
            asm volatile("s_nop 15\n\ts_nop 7" : "+v"(p0), "+v"(p1));     \
            float rma = max3f(p0[0], p1[0], p0[1]), rmb = max3f(p1[1], p0[2], p1[2]); \
            _Pragma("unroll") for (int r = 3; r < 15; r += 2) { rma = max3f(rma, p0[r], p1[r]); rmb = max3f(rmb, p0[r + 1], p1[r + 1]); } \
            float rm = max3f(rma, rmb, __builtin_fmaxf(p0[15], p1[15])); \
            rm = half_swap_max(rm); \
            if (MK_ATT_DUP == 7) { float r2 = __builtin_fmaxf(p0[0] + 1.f, p1[0] + 1.f); _Pragma("unroll") for (int r = 1; r < 16; ++r) r2 = __builtin_fmaxf(r2, __builtin_fmaxf(p0[r] + 1.f, p1[r] + 1.f)); r2 = half_swap_max(r2); if (__any(r2 > 1.0e30f)) mrow += 1.f; } \
            if (!(HASPV) || __any(rm > 8.f)) { \
                const float dl = !(HASPV) ? rm : __builtin_fmaxf(rm, 0.f); mrow += dl; \
                _Pragma("unroll") for (int r = 0; r < 16; ++r) { p0[r] -= dl; p1[r] -= dl; negm[r] = -mrow; } \
                if (HASPV) { const float f = __builtin_amdgcn_exp2f(-dl); l_reg *= f; if (hi == 0) wsf[r32] = f; resc = true; } \
            } \
            SBAR(); \
        } \
        { LAS const unsigned char* vp = lds + ((t - 1) & 3) * SLOT + voff; \
            f32x2 sacc2 = (f32x2){0.f, 0.f}; \
            if (HASPV) { \
                _Pragma("unroll") for (int d0 = 0; d0 < 4; ++d0) { \
                    s16x4 lo[4], hh[4]; \
                    _Pragma("unroll") for (int ks = 0; ks < 4; ++ks) { lo[ks] = vtr(vp + d0 * 4096 + ks * 1024); hh[ks] = vtr(vp + d0 * 4096 + ks * 1024 + 512); } \
                    _Pragma("unroll") for (int ks = 0; ks < 4; ++ks) o[d0] = __builtin_amdgcn_mfma_f32_32x32x16_bf16(__builtin_bit_cast(bf16x8, PIN[ks]), ATT_VF(lo[ks], hh[ks]), o[d0], 0, 0, 0); \
                    if (MK_ATT_DUP == 2) { f32x16 od = o[d0]; _Pragma("unroll") for (int ks = 0; ks < 4; ++ks) od = __builtin_amdgcn_mfma_f32_32x32x16_bf16(__builtin_bit_cast(bf16x8, PIN[ks]), ATT_VF(lo[ks], hh[ks]), od, 0, 0, 0); asm volatile("" :: "v"(od)); } \
                } \
            } \
            if (HASQK) { \
                if (MK_ATT_DUP == 3) { float sd = 0.f; _Pragma("unroll") for (int r = 0; r < 16; ++r) { sd += __builtin_amdgcn_exp2f(p0[r] - 1.f) + __builtin_amdgcn_exp2f(p1[r] - 1.f); } asm volatile("" :: "v"(sd)); } \
                f32x2 sb2 = (f32x2){0.f, 0.f}, sc2 = sb2, sd2 = sb2;     \
                _Pragma("unroll") for (int r = 0; r < 16; r += 4) { \
                    p0[r] = __builtin_amdgcn_exp2f(p0[r]); p1[r] = __builtin_amdgcn_exp2f(p1[r]); sacc2 += (f32x2){p0[r], p1[r]}; \
                    p0[r + 1] = __builtin_amdgcn_exp2f(p0[r + 1]); p1[r + 1] = __builtin_amdgcn_exp2f(p1[r + 1]); sb2 += (f32x2){p0[r + 1], p1[r + 1]}; \
                    p0[r + 2] = __builtin_amdgcn_exp2f(p0[r + 2]); p1[r + 2] = __builtin_amdgcn_exp2f(p1[r + 2]); sc2 += (f32x2){p0[r + 2], p1[r + 2]}; \
                    p0[r + 3] = __builtin_amdgcn_exp2f(p0[r + 3]); p1[r + 3] = __builtin_amdgcn_exp2f(p1[r + 3]); sd2 += (f32x2){p0[r + 3], p1[r + 3]}; } \
                sacc2 = (sacc2 + sb2) + (sc2 + sd2); l_reg += sacc2[0] + sacc2[1]; \
                POUT[0] = (v4u){cvtpk(p0[0], p0[1]), cvtpk(p0[2], p0[3]), cvtpk(p0[4], p0[5]), cvtpk(p0[6], p0[7])}; \
                POUT[1] = (v4u){cvtpk(p0[8], p0[9]), cvtpk(p0[10], p0[11]), cvtpk(p0[12], p0[13]), cvtpk(p0[14], p0[15])}; \
                POUT[2] = (v4u){cvtpk(p1[0], p1[1]), cvtpk(p1[2], p1[3]), cvtpk(p1[4], p1[5]), cvtpk(p1[6], p1[7])}; \
                POUT[3] = (v4u){cvtpk(p1[8], p1[9]), cvtpk(p1[10], p1[11]), cvtpk(p1[12], p1[13]), cvtpk(p1[14], p1[15])}; \
            } \
            if (HASQK) asm volatile("" : "+v"(POUT[0]), "+v"(POUT[1]), "+v"(POUT[2]), "+v"(POUT[3]), "+v"(l_reg));     \
            if ((HASQK) && (HASPV)) { \
                __builtin_amdgcn_sched_group_barrier(0x100, 6, 0);     \
                _Pragma("unroll") for (int g = 0; g < 16; ++g) { __builtin_amdgcn_sched_group_barrier(0x008, 1, 0); if (g < 13) __builtin_amdgcn_sched_group_barrier(0x100, 2, 0); __builtin_amdgcn_sched_group_barrier(0x400, 2, 0); __builtin_amdgcn_sched_group_barrier(0x002, 5, 0); } \
            } \
            SBAR(); \
        } \
        if (resc) { LDS_WAIT(); float fr_[16]; \
            _Pragma("unroll") for (int r = 0; r < 16; ++r) fr_[r] = wsfh[CR(r)]; \
            _Pragma("unroll") for (int d0 = 0; d0 < 4; ++d0) _Pragma("unroll") for (int r = 0; r < 16; ++r) o[d0][r] *= fr_[r]; } \
        SBAR(); } while (0)
    v4u pwq[4];
#pragma unroll
    for (int k = 0; k < 4; ++k) pwq[k] = (v4u){0u, 0u, 0u, 0u};
    ATT_STEP(0, true, false, pwq, pwp);
    for (int tt = 1; tt < NT - 1; tt += 2) { ATT_STEP(tt, true, true, pwp, pwq); ATT_STEP(tt + 1, true, true, pwq, pwp); }
    ATT_STEP(NT - 1, true, true, pwp, pwq);
    ATT_STEP(NT, false, true, pwq, pwp);
#undef ATT_STEP
#undef ATT_VF
#undef SBAR
    l_reg = half_swap_sum(l_reg);
    const float coef = (mh == 0 ? 1.f : -lam) / l_reg;
    if (hi == 0) wsf[64 + r32] = coef;
    ATT_WAIT_BAR(0);
    float cf[16];
#pragma unroll
    for (int r = 0; r < 16; ++r) cf[r] = wsfh[64 + CR(r)];
    LAS float* X = (LAS float*)lds + wq * 4096 + 4 * hi * 128 + r32;
    if (mh == 1) {
#pragma unroll
        for (int d0 = 0; d0 < 4; ++d0)
#pragma unroll
            for (int r = 0; r < 16; ++r) X[CR(r) * 128 + d0 * 32] = o[d0][r] * cf[r];
    }
    ATT_WAIT_BAR(0);
    if (mh == 0) {
        float ssq[16];
#pragma unroll
        for (int r = 0; r < 16; ++r) ssq[r] = 0.f;
#pragma unroll
        for (int d0 = 0; d0 < 4; ++d0)
#pragma unroll
            for (int r = 0; r < 16; ++r) { const float v = o[d0][r] * cf[r] + X[CR(r) * 128 + d0 * 32]; o[d0][r] = v; ssq[r] += v * v; }
#pragma unroll
        for (int r = 0; r < 16; ++r) { float s = ssq[r]; s += __shfl_xor(s, 1); s += __shfl_xor(s, 2); s += __shfl_xor(s, 4); s += __shfl_xor(s, 8); s += __shfl_xor(s, 16); ssq[r] = rsqrtf(s * (1.f / 128.f) + 1e-6f) * 0.8f; }
        LDS_WAIT();
        LAS bf16* stg = (LAS bf16*)(lds + wq * 16384);
        LAS bf16* stgh = stg + 4 * hi * 128 + r32;
#pragma unroll
        for (int d0 = 0; d0 < 4; ++d0) { const float g = subln[d0 * 32 + r32];
#pragma unroll
            for (int r = 0; r < 16; ++r) stgh[CR(r) * 128 + d0 * 32] = (bf16)f2bf(QO(o[d0][r] * ssq[r] * g)); }
        LDS_WAIT();
        bf16* Ow = CAT + (size_t)(qrow0 + wq * 32) * D + h * 128;
        int le = lane; asm volatile("" : "+v"(le));
#pragma unroll
        for (int i = 0; i < 8; ++i) { const int row = i * 4 + (le >> 4), ch = le & 15; const v4u v = *(const LAS v4u*)(stg + row * 128 + ch * 8); *(GAS v4u*)(Ow + (size_t)row * D + ch * 8) = v; }
    }
    ATT_WAIT_BAR(0);
#undef ATT_DMA
#undef ATT_GLDS
#undef CR
}
__device__ __forceinline__ void conv_items(Frame& F, const bf16* PROJ, bf16* CAT, const float* cw) {
    int lane_ = lane_now(); asm volatile("" : "+v"(lane_)); const int lane = lane_;
    const int gw = F.vcu * NWAVES + F.wave, NGW = F.G * NWAVES; const int c0 = 8 * lane;
    float w0[8], w1[8], w2[8];
#pragma unroll
    for (int j = 0; j < 8; ++j) { w0[j] = cw[c0 + j]; w1[j] = cw[512 + c0 + j]; w2[j] = cw[1024 + c0 + j]; }
    for (int it = gw; it < NTOK / 16; it += NGW) {
        const int r0 = it * 16; const int seg0 = r0 < NCTX ? (r0 & ~255) : NCTX + ((r0 - NCTX) & ~2047); const int seg1 = r0 < NCTX ? seg0 + 256 : seg0 + 2048;
        float pm1[8], pc[8], pn[8];
        auto prod = [&](int r, float (&dst)[8]) { if (r < seg0 || r >= seg1) {
#pragma unroll
                for (int j = 0; j < 8; ++j) dst[j] = 0.f; return; }
            const v4u a = *(const GAS v4u*)(PROJ + (size_t)r * att::PITCH + 2048 + c0), b = *(const GAS v4u*)(PROJ + (size_t)r * att::PITCH + 2560 + c0);
            dst[0] = bf_lo(a.x) * bf_lo(b.x); dst[1] = bf_hi(a.x) * bf_hi(b.x); dst[2] = bf_lo(a.y) * bf_lo(b.y); dst[3] = bf_hi(a.y) * bf_hi(b.y);
            dst[4] = bf_lo(a.z) * bf_lo(b.z); dst[5] = bf_hi(a.z) * bf_hi(b.z); dst[6] = bf_lo(a.w) * bf_lo(b.w); dst[7] = bf_hi(a.w) * bf_hi(b.w); };
        prod(r0 - 1, pm1); prod(r0, pc);
        for (int i = 0; i < 16; ++i) { const int r = r0 + i; prod(r + 1, pn);
            const v4u g = *(const GAS v4u*)(PROJ + (size_t)r * att::PITCH + 1536 + c0); const float bg[8] = {bf_lo(g.x), bf_hi(g.x), bf_lo(g.y), bf_hi(g.y), bf_lo(g.z), bf_hi(g.z), bf_lo(g.w), bf_hi(g.w)};
            float o[8];
#pragma unroll
            for (int j = 0; j < 8; ++j) { o[j] = QO(bg[j] * (w0[j] * pm1[j] + w1[j] * pc[j] + w2[j] * pn[j])); pm1[j] = pc[j]; pc[j] = pn[j]; }
            v4u w; w.x = pk2(o[0], o[1]); w.y = pk2(o[2], o[3]); w.z = pk2(o[4], o[5]); w.w = pk2(o[6], o[7]);
            *(GAS v4u*)(CAT + (size_t)r * D + 512 + c0) = w; }
    }
}
}
template <int ABL = 0> __device__ __forceinline__ void phase_attn(Frame& F, const float* subln, const float* cw, const float* fw1 = nullptr, const float* fw2 = nullptr) {
    const bf16* PROJ = (const bf16*)(F.ws + WS_PROJ); bf16* CAT = (bf16*)(F.ws + WS_CAT); const float lam = ((const float*)(F.ws + WS_TAB))[TAB_LAM];
    int tid_ = tid_now(F); asm volatile("" : "+v"(tid_));
    if (F.G == 256) {
        const int xq = F.vcu >> 5, j = F.vcu & 31;
        for (int pass = 0; pass < 2; ++pass) { const int bh = 4 * xq + 2 * pass + (j >> 4), qb = j & 15, b = bh >> 2, h = bh & 3;
            att::attn_unit<ABL>(F.lds + RING_OFF, (LAS float*)(F.misc + MISC_REC), PROJ, CAT, NCTX + b * SEQ + qb * 128, b * CT, NCTX + b * SEQ, 36, h, lam, subln, tid_); }
    } else {
        for (int u = F.vcu; u < 512; u += F.G) { const int bh = u >> 4, qb = u & 15, b = bh >> 2, h = bh & 3;
            att::attn_unit<ABL>(F.lds + RING_OFF, (LAS float*)(F.misc + MISC_REC), PROJ, CAT, NCTX + b * SEQ + qb * 128, b * CT, NCTX + b * SEQ, 36, h, lam, subln, tid_); }
    }
    for (int u = F.vcu; u < 64; u += F.G) { const int bh = u >> 1, qb = u & 1, b = bh >> 2, h = bh & 3;
        att::attn_unit<ABL>(F.lds + RING_OFF, (LAS float*)(F.misc + MISC_REC), PROJ, CAT, b * CT + qb * 128, b * CT, NCTX + b * SEQ, 4, h, lam, subln, tid_); }
    if (ABL == 0) att::conv_items(F, PROJ, CAT, cw);
    if (ABL == 0 && fw1 && F.vcu >= 64) filler(F, fw1, fw2, 1);
}
}
namespace mk {
struct EpiBf16 {
    static constexpr bool PERM = true;
    bf16* O; int ldc;
    __device__ __forceinline__ void operator()(const pg8::f32x4 (&acc)[2][2][4][2], const pg8::Unit& u, int wr, int wc, int fr, int fq) const {
        const int col0 = u.pn * 256 + wc * 32 + 8 * fq;
#pragma unroll
        for (int ai = 0; ai < 2; ++ai)
#pragma unroll
            for (int m = 0; m < 4; ++m) { bf16* rowp = O + (size_t)(u.pm * 256 + ai * 128 + wr * 64 + m * 16 + fr) * ldc + col0;
#pragma unroll
                for (int bj = 0; bj < 2; ++bj) { const pg8::f32x4 v0 = acc[ai][bj][m][0], v1 = acc[ai][bj][m][1];
                    pg8::u32x4 w; w.x = pg8::cvt_pk_bf16(v0[0], v0[1]); w.y = pg8::cvt_pk_bf16(v0[2], v0[3]); w.z = pg8::cvt_pk_bf16(v1[0], v1[1]); w.w = pg8::cvt_pk_bf16(v1[2], v1[3]);
                    *(pg8::u32x4*)(rowp + bj * 128) = w; } }
    }
};
struct InProj1Sched {
    pg8::TileOrder ord; int G, c; const char* A; const char* W; int a_pitch;
    __device__ __forceinline__ bool next(int i, pg8::Unit& u) const { const int L = i * G + c; if (L >= 544) return false;
        if (L < 512) { ord.map(L, u); u.pm += 8; } else { const int q = L - 512; u.pm = q >> 2; u.pn = 4 + (q & 3); } return true; }
    __device__ __forceinline__ const char* a_base(const pg8::Unit& u) const { return A + (size_t)u.pm * 256 * 2048; }
    __device__ __forceinline__ const char* b_base(const pg8::Unit& u) const { return W + (size_t)u.pn * 256 * 2048; }
    __device__ __forceinline__ unsigned a_rowoff(const pg8::Unit&, int) const { return 0u; }
};
__device__ __forceinline__ void phase_conv1(Frame& F, const float* cw, const float* cb) {
    const bf16* GU = (const bf16*)(F.ws + WS_PROJ); bf16* XC = (bf16*)(F.ws + WS_XC);
    int lane_ = lane_now(); asm volatile("" : "+v"(lane_)); const int lane = lane_;
    const int gw = F.vcu * NWAVES + F.wave, NGW = F.G * NWAVES;
    for (int it = gw; it < (NTOK / 16) * 2; it += NGW) {
        const int r0 = (it >> 1) * 16, c0 = (it & 1) * 512 + 8 * lane; const int seg0 = r0 < NCTX ? (r0 & ~255) : NCTX + ((r0 - NCTX) & ~2047); const int seg1 = r0 < NCTX ? seg0 + 256 : seg0 + 2048;
        float wf[4][8], wb[4][8], bf_[8], bb_[8];
#pragma unroll
        for (int j = 0; j < 8; ++j) { bf_[j] = cb[c0 + j]; bb_[j] = cb[1024 + c0 + j];
#pragma unroll
            for (int k = 0; k < 4; ++k) { wf[k][j] = cw[k * 1024 + c0 + j]; wb[k][j] = cw[(4 + k) * 1024 + c0 + j]; } }
        v4u raw[22];
#pragma unroll
        for (int q = 0; q < 22; ++q) { const int r = r0 - 3 + q; raw[q] = (r < seg0 || r >= seg1) ? (v4u){0u, 0u, 0u, 0u} : *(const GAS v4u*)(GU + (size_t)r * 2048 + 1024 + c0); }
        float win[7][8];
#define CV_UNPK(dst, a) do { dst[0] = bf_lo(a.x); dst[1] = bf_hi(a.x); dst[2] = bf_lo(a.y); dst[3] = bf_hi(a.y); dst[4] = bf_lo(a.z); dst[5] = bf_hi(a.z); dst[6] = bf_lo(a.w); dst[7] = bf_hi(a.w); } while (0)
#pragma unroll
        for (int q = 0; q < 6; ++q) CV_UNPK(win[q + 1], raw[q]);
#pragma unroll
        for (int i = 0; i < 16; ++i) { const int r = r0 + i;
#pragma unroll
            for (int q = 0; q < 6; ++q)
#pragma unroll
                for (int j = 0; j < 8; ++j) win[q][j] = win[q + 1][j];
            CV_UNPK(win[6], raw[i + 6]);
            float of[8], ob[8];
#pragma unroll
            for (int j = 0; j < 8; ++j) { of[j] = bf_[j] + wf[0][j] * win[0][j] + wf[1][j] * win[1][j] + wf[2][j] * win[2][j] + wf[3][j] * win[3][j];
                ob[j] = bb_[j] + wb[0][j] * win[3][j] + wb[1][j] * win[4][j] + wb[2][j] * win[5][j] + wb[3][j] * win[6][j]; }
            v4u w; w.x = pk2(of[0], of[1]); w.y = pk2(of[2], of[3]); w.z = pk2(of[4], of[5]); w.w = pk2(of[6], of[7]);
            *(GAS v4u*)(XC + (size_t)r * D + c0) = w;
            w.x = pk2(ob[0], ob[1]); w.y = pk2(ob[2], ob[3]); w.z = pk2(ob[4], ob[5]); w.w = pk2(ob[6], ob[7]);
            *(GAS v4u*)(XC + ((size_t)NTOK + r) * D + c0) = w; }
#undef CV_UNPK
    }
}
struct GateSched {
    pg8::TileOrder ord; const char* XC; const char* W; int a_pitch;
    __device__ __forceinline__ bool next(int i, pg8::Unit& u) const { return ord.tile(i, u); }
    __device__ __forceinline__ const char* a_base(const pg8::Unit& u) const { const int d = u.pm >= 72 ? 1 : 0, rt = u.pm - 72 * d; return XC + ((size_t)d * NTOK + (size_t)rt * 256) * 2048 + (u.pn >> 1) * 512; }
    __device__ __forceinline__ const char* b_base(const pg8::Unit& u) const { const int d = u.pm >= 72 ? 1 : 0; return W + (size_t)(d * 8 + u.pn) * 256 * 512; }
    __device__ __forceinline__ unsigned a_rowoff(const pg8::Unit&, int) const { return 0u; }
};
struct EpiGate {
    static constexpr bool PERM = true;
    const bf16* XC; unsigned* AB; const float* gab; const float* gxb; const float* SP;
    __device__ __forceinline__ void operator()(const pg8::f32x4 (&acc)[2][2][4][2], const pg8::Unit& u, int wr, int wc, int fr, int fq) const {
        const int d = u.pm >= 72 ? 1 : 0, rt = u.pm - 72 * d; const int ch0 = (u.pn >> 1) * 256 + (u.pn & 1) * 128 + wc * 32 + 8 * fq;
        pg8::f32x4 ba[2], bx[2], sp[2];
#pragma unroll
        for (int n = 0; n < 2; ++n) { ba[n] = *(const pg8::f32x4*)(gab + d * 1024 + ch0 + 4 * n); bx[n] = *(const pg8::f32x4*)(gxb + d * 1024 + ch0 + 4 * n); sp[n] = *(const pg8::f32x4*)(SP + d * 1024 + ch0 + 4 * n) * (-8.f * 1.4426950408889634f); }
        const size_t rowb = (size_t)d * NTOK + rt * 256 + wr * 64 + fr;
        v4u xw[2][4];
#pragma unroll
        for (int ai = 0; ai < 2; ++ai)
#pragma unroll
            for (int m = 0; m < 4; ++m) xw[ai][m] = *(const GAS v4u*)(XC + (rowb + ai * 128 + m * 16) * D + ch0);
#pragma unroll
        for (int ai = 0; ai < 2; ++ai)
#pragma unroll
            for (int m = 0; m < 4; ++m) { const size_t row = rowb + ai * 128 + m * 16; const v4u xq = xw[ai][m];
                const float xc[8] = {bf_lo(xq.x), bf_hi(xq.x), bf_lo(xq.y), bf_hi(xq.y), bf_lo(xq.z), bf_hi(xq.z), bf_lo(xq.w), bf_hi(xq.w)};
                unsigned o[8];
#pragma unroll
                for (int n = 0; n < 2; ++n)
#pragma unroll
                    for (int i = 0; i < 4; ++i) { const float rp = acc[ai][0][m][n][i] + ba[n][i], ip = acc[ai][1][m][n][i] + bx[n][i];
                        const float rg = __builtin_amdgcn_rcpf(1.f + __builtin_amdgcn_exp2f(-1.4426950408889634f * rp)), ig = __builtin_amdgcn_rcpf(1.f + __builtin_amdgcn_exp2f(-1.4426950408889634f * ip));
                        const float la2 = rg * sp[n][i]; const float a = __builtin_amdgcn_exp2f(la2); const float bv = __builtin_amdgcn_sqrtf(fmaxf(1.f - a * a, 0.f)) * ig * xc[4 * n + i];
                        o[4 * n + i] = (f2bf(la2) << 16) | f2bf(bv); }
                unsigned* op = AB + row * D + ch0; *(GAS v4u*)op = (v4u){o[0], o[1], o[2], o[3]}; *(GAS v4u*)(op + 4) = (v4u){o[4], o[5], o[6], o[7]}; }
    }
};
__device__ __forceinline__ void phase_scan1(Frame& F) {
    const unsigned* AB = (const unsigned*)(F.ws + WS_AB); f32x2* SUM = (f32x2*)(F.ws + WS_SUM);
    int lane_ = lane_now(); asm volatile("" : "+v"(lane_)); const int lane = lane_;
    const int gw = F.vcu * NWAVES + F.wave, NGW = F.G * NWAVES;
    for (int it = gw; it < 2 * 288 * 16; it += NGW) {
        const int cg = it & 15, sc = (it >> 4) % 288, d = it / (288 * 16); const int c = cg * 64 + lane;
        const unsigned* p = AB + ((size_t)d * NTOK + sc * 64) * D + c; float h = 0.f, la = 0.f;
#pragma unroll
        for (int blk = 0; blk < 4; ++blk) { unsigned w[16];
#pragma unroll
            for (int i = 0; i < 16; ++i) { const int row = d == 0 ? blk * 16 + i : 63 - (blk * 16 + i); w[i] = p[(size_t)row * D]; }
#pragma unroll
            for (int i = 0; i < 16; ++i) { const float l2 = bf_hi(w[i]), b = bf_lo(w[i]); la += l2; h = __builtin_amdgcn_exp2f(l2) * h + b; } }
        SUM[((size_t)d * 288 + sc) * D + c] = (f32x2){la, h};
    }
}
__device__ __forceinline__ void phase_scan2(Frame& F) {
    const unsigned* AB = (const unsigned*)(F.ws + WS_AB); const f32x2* SUM = (const f32x2*)(F.ws + WS_SUM); const bf16* GU = (const bf16*)(F.ws + WS_PROJ); bf16* CAT = (bf16*)(F.ws + WS_CAT);
    int lane_ = lane_now(); asm volatile("" : "+v"(lane_)); const int lane = lane_;
    const int gw = F.vcu * NWAVES + F.wave, NGW = F.G * NWAVES;
    for (int it = gw; it < 8 * 32 * 16; it += NGW) {
        const int cg = it & 15, s = (it >> 4) & 31, b = it >> 9; const int c = cg * 64 + lane;
        float hf = 0.f, hb = 0.f;
        for (int q = 0; q < 4 + s; ++q) { const int sc = q < 4 ? b * 4 + q : 32 + b * 32 + (q - 4); const f32x2 v = SUM[(size_t)sc * D + c]; hf = __builtin_amdgcn_exp2f(v[0]) * hf + v[1]; }
        for (int q = 0; q < 4 + (31 - s); ++q) { const int sc = q < 4 ? b * 4 + (3 - q) : 32 + b * 32 + (31 - (q - 4)); const f32x2 v = SUM[((size_t)288 + sc) * D + c]; hb = __builtin_amdgcn_exp2f(v[0]) * hb + v[1]; }
        const size_t row0 = (size_t)NCTX + (size_t)b * SEQ + s * 64;
        float hfv[64];
        unsigned wf[4][16];
#pragma unroll
        for (int i = 0; i < 16; ++i) wf[0][i] = AB[(row0 + i) * D + c];
#pragma unroll
        for (int blk = 0; blk < 4; ++blk) {
            if (blk < 3) {
#pragma unroll
                for (int i = 0; i < 16; ++i) wf[blk + 1][i] = AB[(row0 + (blk + 1) * 16 + i) * D + c]; }
#pragma unroll
            for (int i = 0; i < 16; ++i) { hf = __builtin_amdgcn_exp2f(bf_hi(wf[blk][i])) * hf + bf_lo(wf[blk][i]); hfv[blk * 16 + i] = hf; } }
        unsigned wb[4][16]; unsigned short gt[4][16];
#pragma unroll
        for (int i = 0; i < 16; ++i) { const size_t row = row0 + 63 - i; wb[3][i] = AB[((size_t)NTOK + row) * D + c]; gt[3][i] = GU[row * 2048 + c]; }
#pragma unroll
        for (int blk = 3; blk >= 0; --blk) {
            if (blk > 0) {
#pragma unroll
                for (int i = 0; i < 16; ++i) { const size_t row = row0 + (blk - 1) * 16 + 15 - i; wb[blk - 1][i] = AB[((size_t)NTOK + row) * D + c]; gt[blk - 1][i] = GU[row * 2048 + c]; } }
#pragma unroll
            for (int i = 0; i < 16; ++i) { const int ri = blk * 16 + 15 - i; hb = __builtin_amdgcn_exp2f(bf_hi(wb[blk][i])) * hb + bf_lo(wb[blk][i]);
                const float g = bf_lo((unsigned)gt[blk][i]); const float z = 0.7978845608028654f * (g + 0.044715f * g * g * g);
                const float th = 1.f - 2.f * __builtin_amdgcn_rcpf(__builtin_amdgcn_exp2f(2.f * 1.4426950408889634f * z) + 1.f);
                CAT[(row0 + ri) * D + c] = (bf16)f2bf(QO((hfv[ri] + hb) * (0.5f * g * (1.f + th)))); } }
    }
}
}
namespace mk {
#define IN(k) (lo <= (k) && (k) < hi)
#define SEAM(k) do { if (IN(k) && IN((k) + 1)) xcd_barrier(bar); } while (0)
template <int LAYER> __device__ __forceinline__ void moe_section(Frame& F, const Args& args, const XcdBarrier& bar, const int lo, const int hi) {
        constexpr int layer = LAYER; constexpr int mb = layer == 0 ? 5 : 15;
        constexpr int row0 = layer == 0 ? 0 : NCTX, nrows = layer == 0 ? NTOK : NLAT;
        if (IN(mb)) { phase_router(F, layer, row0, nrows, args.in[7] + layer * D, args.in[25] + (size_t)layer * D * 32, args.in[26] + layer * 32);
            if (layer == 1) filler(F, args.in[27], args.in[29], 1 << 20); }
        SEAM(mb);
        if (IN(mb + 1)) {
            moe_table(F, layer);
            LAS const int* tab = (LAS const int*)(F.misc + MISC_TAB); const int T = *(LAS const int*)(F.misc + MISC_NT);
            MoeSched1 S; S.ord.init(T, 8, F.G, (int)blockIdx.x); S.tab = tab; S.cntl = (LAS const int*)(F.misc + MISC_CNT); S.XN = (const char*)(F.ws + WS_XN);
            S.W = (const char*)(F.ws + WS_W1) + (size_t)layer * 32 * 2048 * (size_t)W1_KB; S.list = (const int*)(F.ws + WS_ROUTE + RT_LIST); S.a_pitch = W1_KB; S.wb = W1_KB;
            EpiSwiglu E{(bf16*)(F.ws + WS_HB), args.in[28] + (size_t)layer * 32 * 2048, tab};
            pg8::gemm_phase<EpiSwiglu, MoeSched1, true, FP8_G1, 122>(F.lds + RING_OFF, W1_KB, S, E, F.wave);
            if (layer == 0 && S.ord.early()) filler(F, args.in[27], args.in[29], 2);
        }
        SEAM(mb + 1);
        if (IN(mb + 2)) {
            moe_table(F, layer);
            LAS const int* tab = (LAS const int*)(F.misc + MISC_TAB); const int T = *(LAS const int*)(F.misc + MISC_NT);
            MoeSched2 S; S.ord.init(T, 4, F.G, (int)blockIdx.x); S.tab = tab; S.HB = (const char*)(F.ws + WS_HB); S.W = (const char*)(F.ws + WS_W2) + (size_t)layer * 32 * 1024 * (size_t)W2_KB; S.a_pitch = W2_KB; S.wb = W2_KB;
            EpiBias2 E{(bf16*)(F.ws + WS_Y2), args.in[30] + (size_t)layer * 32 * 1024, tab};
            pg8::gemm_phase<EpiBias2, MoeSched2, false, FP8_G2, 122>(F.lds + RING_OFF, W2_KB, S, E, F.wave);
            if (layer == 0 && S.ord.early()) filler(F, args.in[27], args.in[29], 2);
        }
        SEAM(mb + 2);
        if (IN(mb + 3)) {
            moe_table(F, layer);
            if (layer == 0) phase_combine(F, 0, row0, nrows, 0, args.in[6] + D, (const float*)(F.ws + WS_MOD) + (size_t)9 * 6144, args.out);
            else phase_combine(F, 1, row0, nrows, 1, args.in[31], nullptr, args.out);
        }
        SEAM(mb + 3);
}
#undef IN
#undef SEAM
constexpr int NPHASE = 19;
__global__ void __launch_bounds__(NTHR, 2) mk_fwd(Args args) {
    extern __shared__ __attribute__((aligned(16))) unsigned char lds_raw[];
    Frame F;
    F.lds = (LAS unsigned char*)lds_raw; F.misc = F.lds + MISC_OFF;
    F.wave = __builtin_amdgcn_readfirstlane((int)threadIdx.x >> 6);
    F.G = gridDim.x; { const int bx = blockIdx.x; F.vcu = (F.G % 8 == 0) ? (bx % 8) * (F.G / 8) + bx / 8 : bx; }
    F.ws = args.ws; F.ctl = (gu32*)(args.ws + WS_CTL);
    for (int u = tid_now(F); u < (LDS_BYTES - MISC_OFF) / 4; u += NTHR) ((LAS unsigned*)F.misc)[u] = 0u;
    __syncthreads();
    const int lo = args.ph_lo, hi = args.ph_hi;
    XcdBarrier bar = xcd_barrier_post((unsigned*)(F.ctl + CW_BAR) + args.li * XCD_BAR_WORDS, (volatile LAS unsigned*)(F.misc + MISC_BAR), F.wave);
#define IN(k) (lo <= (k) && (k) < hi)
#define SEAM(k) do { if (IN(k) && IN((k) + 1)) xcd_barrier(bar); } while (0)

    if (IN(0)) {
        p0_adaln(F, args.in[1], args.in[3], args.in[4], args.in[5]);
        p0_tables(F, args.in[10], args.in[11], args.in[12], args.in[13], args.in[24]);
        p0_wr_image(F, args.in[25]);
        __syncthreads();
        p0_dense_weight(F, args.in[8], 1024, 3072, (bf16*)(F.ws + WS_WIN0), 0);
        p0_dense_weight<true>(F, args.in[9], 1024, 1024, (bf16*)(F.ws + WS_WOUT0), 1536);
        p0_dense_weight(F, args.in[16], 1024, 2048, (bf16*)(F.ws + WS_WIN1), 0);
        p0_dense_weight<true>(F, args.in[17], 1024, 1024, (bf16*)(F.ws + WS_WOUT1), 1024);
        p0_gate_weights(F, args.in[20], args.in[22], 1536);
        p0_moe_weights(F, args.in[27], args.in[29], 0);
        if constexpr (!FILLER_ON) p0_moe_weights(F, args.in[27], args.in[29], 1);
    }
    SEAM(0);
    if (IN(1)) phase_norm1_l0(F, args.in[0], args.in[2], args.in[6]);
    SEAM(1);
    if (IN(2)) {
        DenseSched S; S.ord.init(NTOK / 256, 12, F.G, (int)blockIdx.x); S.A = (const char*)(F.ws + WS_XN); S.W = (const char*)(F.ws + WS_WIN0); S.a_pitch = 2048; S.K2 = 2048;
        EpiInProj0 E{(bf16*)(F.ws + WS_PROJ), (const float*)(F.ws + WS_TAB)};
        pg8::gemm_phase<EpiInProj0, DenseSched, false>(F.lds + RING_OFF, 2048, S, E, F.wave);
        if (S.ord.early()) filler(F, args.in[27], args.in[29], 3);
    }
    SEAM(2);
    if (IN(3)) phase_attn(F, args.in[14], args.in[15], args.in[27], args.in[29]);
    SEAM(3);
    if (IN(4)) {
        DenseSched S; S.ord.init(NTOK / 256, 4, F.G, (int)blockIdx.x); S.A = (const char*)(F.ws + WS_CAT); S.W = (const char*)(F.ws + WS_WOUT0); S.a_pitch = 2048; S.K2 = 2048;
        EpiResid E{(float*)(F.ws + WS_XS), args.in[0], args.in[2], (const float*)(F.ws + WS_MOD) + 2 * D, 0};
        pg8::gemm_phase<EpiResid, DenseSched, false>(F.lds + RING_OFF, 2048, S, E, F.wave);
        if (S.ord.early()) filler(F, args.in[27], args.in[29], 3);
    }
    SEAM(4);

    moe_section<0>(F, args, bar, lo, hi);
    if (IN(9)) {
        InProj1Sched S; S.ord.init(64, 8, F.G, (int)blockIdx.x); S.G = F.G; S.c = (int)blockIdx.x; S.A = (const char*)(F.ws + WS_XN); S.W = (const char*)(F.ws + WS_WIN1); S.a_pitch = 2048;
        EpiBf16 E{(bf16*)(F.ws + WS_PROJ), 2048};
        pg8::gemm_phase<EpiBf16, InProj1Sched, false>(F.lds + RING_OFF, 2048, S, E, F.wave);
        if (2 * F.G + (int)blockIdx.x >= 544) filler(F, args.in[27], args.in[29], 3);
    }
    SEAM(9);
    if (IN(10)) phase_conv1(F, args.in[18], args.in[19]);
    SEAM(10);
    if (IN(11)) {
        GateSched S; S.ord.init(144, 8, F.G, (int)blockIdx.x); S.XC = (const char*)(F.ws + WS_XC); S.W = (const char*)(F.ws + WS_WGATE); S.a_pitch = 2048;
        EpiGate E{(const bf16*)(F.ws + WS_XC), (unsigned*)(F.ws + WS_AB), args.in[21], args.in[23], (const float*)(F.ws + WS_TAB) + TAB_SP};
        pg8::gemm_phase<EpiGate, GateSched, false>(F.lds + RING_OFF, 512, S, E, F.wave);
        if (S.ord.early()) filler(F, args.in[27], args.in[29], 1);
    }
    SEAM(11);
    if (IN(12)) phase_scan1(F);
    SEAM(12);
    if (IN(13)) phase_scan2(F);
    SEAM(13);
    if (IN(14)) {
        DenseSched S; S.ord.init(NLAT / 256, 4, F.G, (int)blockIdx.x); S.A = (const char*)(F.ws + WS_CAT) + (size_t)NCTX * 2048; S.W = (const char*)(F.ws + WS_WOUT1); S.a_pitch = 2048; S.K2 = 2048;
        EpiResid E{(float*)(F.ws + WS_XS), nullptr, nullptr, (const float*)(F.ws + WS_MOD) + (size_t)9 * 6144 + 2 * D, NCTX};
        pg8::gemm_phase<EpiResid, DenseSched, false>(F.lds + RING_OFF, 2048, S, E, F.wave);
    }
    SEAM(14);
    moe_section<1>(F, args, bar, lo, hi);
#ifdef MK_ABLATION_PHASES
    if (IN(20)) phase_attn<MK_ABLATION_PHASES>(F, args.in[14], args.in[15]);
    if (IN(21)) { for (int i = 0; i < 10; ++i) xcd_barrier(bar); }
#endif
#undef IN
#undef SEAM
}

struct Launcher { int grid; bool ok; };
inline Launcher& launcher() {
    static Launcher L{0, false};
    if (L.grid == 0) {
        int dev = 0, cus = 0, per_cu = 0;
        if (hipGetDevice(&dev) != hipSuccess || hipDeviceGetAttribute(&cus, hipDeviceAttributeMultiprocessorCount, dev) != hipSuccess) { fprintf(stderr, "mk: device query failed\n"); L.grid = -1; return L; }
        if (hipFuncSetAttribute((const void*)mk_fwd, hipFuncAttributeMaxDynamicSharedMemorySize, LDS_BYTES) != hipSuccess) { fprintf(stderr, "mk: hipFuncSetAttribute failed\n"); L.grid = -1; return L; }
        if (hipOccupancyMaxActiveBlocksPerMultiprocessor(&per_cu, (const void*)mk_fwd, NTHR, LDS_BYTES) != hipSuccess || per_cu < 1) fprintf(stderr, "mk: note: occupancy query reports %d\n", per_cu);
        (void)hipGetLastError();
        L.grid = cus; L.ok = true;
    }
    return L;
}
inline void launch(hipStream_t st, void* const* d_in, float* out, unsigned char* ws, int ph_lo, int ph_hi, int li) {
    Launcher& L = launcher(); if (L.grid <= 0) return;
    Args a{}; for (int i = 0; i < 32; ++i) a.in[i] = (const float*)d_in[i];
    a.out = out; a.ws = ws; a.ph_lo = ph_lo; a.ph_hi = ph_hi; a.li = li; a.pad = 0;
    hipLaunchKernelGGL(mk_fwd, dim3(L.grid), dim3(NTHR), LDS_BYTES, st, a);
}
}
extern "C" void kernel_launch(void* const* d_in, const int* in_sizes, int n_in, void* d_out, int out_size, void* d_ws, size_t ws_size, hipStream_t stream) {
    unsigned char* ws = (unsigned char*)d_ws;
    if (mk::WS_END > ws_size) { fprintf(stderr, "kernel_launch: workspace too small: need %zu have %zu\n", (size_t)mk::WS_END, ws_size); return; }
    (void)hipMemsetAsync(ws + mk::WS_CTL, 0, mk::CTL_ZERO_BYTES, stream);
    mk::launch(stream, d_in, (float*)d_out, ws, 0, 19, 0);
}
```

```cpp
#define MK_FP8_G1 1
#define MK_FP8_G2 1
#include <hip/hip_runtime.h>
#include <cstdio>
#include <cstdint>
__device__ __forceinline__ int lane_now() { int l = (int)__builtin_amdgcn_mbcnt_hi(~0u, __builtin_amdgcn_mbcnt_lo(~0u, 0u)); asm volatile("" : "+v"(l)); return l; }
namespace pg8 {
#define PG8_LAS __attribute__((address_space(3)))
typedef unsigned short bf16_t;
typedef short bf16x8 __attribute__((ext_vector_type(8)));
typedef float f32x4 __attribute__((ext_vector_type(4)));
typedef float f32x2 __attribute__((ext_vector_type(2)));
typedef unsigned u32x4 __attribute__((ext_vector_type(4)));
typedef unsigned u32x2 __attribute__((ext_vector_type(2)));
constexpr int BM = 256, BK = 64, HALF = 128, HTB = HALF * BK * 2  , STAGE_BYTES = 8 * HTB, NXCD = 8, WGM = 2;

__host__ __device__ __forceinline__ int lds_byte(int r, int c) { const int st = (r >> 4) * 2 + (c >> 5), rr = r & 15, cc = c & 31, ob = rr * 64 + cc * 2; return st * 1024 + (ob ^ (((ob >> 9) & 1) << 5)); }
__host__ __device__ __forceinline__ void stage_rc(int b, int& R, int& C) { const int st = b / 1024, sb = b % 1024, swz = sb ^ (((sb >> 9) & 1) << 5); R = (st >> 1) * 16 + swz / 64; C = (st & 1) * 32 + (swz % 64) / 2; }
__host__ __device__ __forceinline__ int perm32(int rho) { const int n = rho >> 4, i = rho & 15; return 8 * (i >> 2) + 4 * n + (i & 3); }

struct Unit { int pm, pn; };

struct TileOrder {
    int nM, nN, nwg, G, c, wgm;
    __device__ __forceinline__ void init(int nM_, int nN_, int G_, int c_, int wgm_ = WGM) { nM = nM_; nN = nN_; nwg = nM * nN; G = G_; c = c_; wgm = wgm_; }
    __device__ __forceinline__ bool tile(int i, Unit& u) const { const long L = (long)i * G + c; if (L >= nwg) return false; map((int)L, u); return true; }
    __device__ __forceinline__ bool early() const { const int mine = nwg > c ? (nwg - 1 - c) / G + 1 : 0; return mine < (nwg + G - 1) / G; }
    __device__ __forceinline__ void map(int L, Unit& u) const {
        int wgid = L; { const int q = nwg / NXCD, r = nwg % NXCD, xcd = wgid % NXCD, off = wgid / NXCD; wgid = (xcd < r ? xcd * (q + 1) : r * (q + 1) + (xcd - r) * q) + off; }
        const int nig = wgm * nN, gid = wgid / nig, fm = gid * wgm, gsz = (nM - fm) < wgm ? (nM - fm) : wgm;
        const int x = wgid % nig;
        if (wgm == 2) { if (gsz == 2) { u.pm = fm + (x & 1); u.pn = x >> 1; } else { u.pm = fm; u.pn = x; } }
        else { u.pm = fm + (x % gsz); u.pn = x / gsz; }
    }
};

__device__ __forceinline__ unsigned cvt_pk_bf16(float lo, float hi) { unsigned r; asm volatile("v_cvt_pk_bf16_f32 %0, %1, %2" : "=v"(r) : "v"(lo), "v"(hi)); return r; }

template <class Epi, class Sched, bool GATHER, bool FP8 = false, int SCALE_W = 127>
__device__ __forceinline__ void gemm_phase(PG8_LAS unsigned char* lds, const int Kb, const Sched& S, const Epi& E, const int wave_id) {
    int tid_ = wave_id * 64 + lane_now(); asm volatile("" : "+v"(tid_));
    const int tid = tid_, wid = __builtin_amdgcn_readfirstlane(tid >> 6), lane = tid & 63, wr = wid >> 2, wc = wid & 3, fr = lane & 15, fq = lane >> 4;
    const int nt = Kb / 128;
    unsigned voffB[2];
    unsigned offA[2][2], noffA[2][2];
#pragma unroll
    for (int i = 0; i < 2; ++i) { int R, C; stage_rc(tid * 16 + i * 8192, R, C); const int Rb = Epi::PERM ? ((R & ~31) + perm32(R & 31)) : R;
        voffB[i] = (unsigned)(Rb * Kb + C * 2);
        offA[0][i] = (unsigned)(R * S.a_pitch + C * 2); offA[1][i] = (unsigned)((R + HALF) * S.a_pitch + C * 2); noffA[0][i] = offA[0][i]; noffA[1][i] = offA[1][i]; }
    const size_t kstep = (size_t)(BK * 2);
    const size_t hstepB = (size_t)HALF * Kb;
    const unsigned ldsw = (unsigned)wid * 1024u;
    const int aoff = lds_byte(wr * 64 + fr, fq * 8), boff = lds_byte(wc * 32 + fr, fq * 8);
#define PG8_SA(b, h) (((b) * 2 + (h)) * HTB)
#define PG8_SB(b, h) ((4 + (b) * 2 + (h)) * HTB)
#define PG8_STAGE(bufoff, gbase, voff) do { const char* gb_ = (const char*)(gbase); asm volatile("" : "+s"(gb_));     \
        _Pragma("unroll") for (int _i = 0; _i < 2; ++_i) \
        __builtin_amdgcn_global_load_lds((const unsigned*)(gb_ + (voff)[_i]), (PG8_LAS unsigned*)(lds + (bufoff) + ldsw + _i * 8192), 16, 0, 0); } while (0)
    typedef int v4i_ __attribute__((ext_vector_type(4))); typedef int v8i_ __attribute__((ext_vector_type(8)));
#define PG8_LDA(dst, b, h) do { _Pragma("unroll") for (int m = 0; m < 4; ++m) { if constexpr (FP8) { const v4i_ lo_ = *(const PG8_LAS v4i_*)(lds + PG8_SA(b, h) + aoff + m * 2048), hi_ = *(const PG8_LAS v4i_*)(lds + PG8_SA(b, h) + aoff + m * 2048 + 1024); \
            dst##8[m] = __builtin_shufflevector(lo_, hi_, 0, 1, 2, 3, 4, 5, 6, 7); } else { _Pragma("unroll") for (int k = 0; k < 2; ++k) dst[m][k] = *(const PG8_LAS bf16x8*)(lds + PG8_SA(b, h) + aoff + m * 2048 + k * 1024); } } } while (0)
#define PG8_LDB(dst, b, h) do { _Pragma("unroll") for (int n = 0; n < 2; ++n) { if constexpr (FP8) { const v4i_ lo_ = *(const PG8_LAS v4i_*)(lds + PG8_SB(b, h) + boff + n * 2048), hi_ = *(const PG8_LAS v4i_*)(lds + PG8_SB(b, h) + boff + n * 2048 + 1024); \
            dst##8[n] = __builtin_shufflevector(lo_, hi_, 0, 1, 2, 3, 4, 5, 6, 7); } else { _Pragma("unroll") for (int k = 0; k < 2; ++k) dst[n][k] = *(const PG8_LAS bf16x8*)(lds + PG8_SB(b, h) + boff + n * 2048 + k * 1024); } } } while (0)
#define PG8_MMA(ai, bj, At, Bt) do { __builtin_amdgcn_s_setprio(1); _Pragma("unroll") for (int m = 0; m < 4; ++m) _Pragma("unroll") for (int n = 0; n < 2; ++n) { \
        if constexpr (FP8) { asm volatile("v_mfma_scale_f32_16x16x128_f8f6f4 %0, %1, %2, %0, %3, %4 op_sel_hi:[0,0,0]" : "+v"(acc[ai][bj][m][n]) : "v"(Bt##8[n]), "v"(At##8[m]), "v"(sclw_), "v"(scla_)); } \
        else { _Pragma("unroll") for (int k = 0; k < 2; ++k) acc[ai][bj][m][n] = __builtin_amdgcn_mfma_f32_16x16x32_bf16(Bt[n][k], At[m][k], acc[ai][bj][m][n], 0, 0, 0); } } \
        __builtin_amdgcn_s_setprio(0); } while (0)
#define PG8_WAIT_V(n) asm volatile("s_waitcnt vmcnt(" #n ")" ::: "memory")
#define PG8_WAIT_L(n) asm volatile("s_waitcnt lgkmcnt(" #n ")" ::: "memory")
#define PG8_BAR __builtin_amdgcn_s_barrier()
#define PG8_SCHED __builtin_amdgcn_sched_barrier(0)
    int sclw_ = SCALE_W, scla_ = 127; asm volatile("" : "+v"(sclw_), "+v"(scla_));
    Unit cur, nxt; int ui = 0;
    if (!S.next(0, cur)) return;
    unsigned rawN[2][2];
    if constexpr (GATHER) {
#pragma unroll
        for (int i = 0; i < 2; ++i) { int R, C; stage_rc(tid * 16 + i * 8192, R, C); offA[0][i] = S.a_rowraw(cur, R) * (unsigned)S.a_pitch + (unsigned)(C * 2); offA[1][i] = S.a_rowraw(cur, R + HALF) * (unsigned)S.a_pitch + (unsigned)(C * 2); }
        Unit n1;
        if (Sched::RAW_EARLY && S.next(1, n1)) {
#pragma unroll
            for (int i = 0; i < 2; ++i) { int R, C; stage_rc(tid * 16 + i * 8192, R, C); rawN[0][i] = S.a_rowraw(n1, R); rawN[1][i] = S.a_rowraw(n1, R + HALF); } }
        else {
#pragma unroll
            for (int i = 0; i < 2; ++i) { rawN[0][i] = 0u; rawN[1][i] = 0u; } }
    }
    f32x4 acc[2][2][4][2];
#pragma unroll
    for (int a = 0; a < 2; ++a)
#pragma unroll
        for (int b = 0; b < 2; ++b)
#pragma unroll
            for (int m = 0; m < 4; ++m)
#pragma unroll
                for (int n = 0; n < 2; ++n) acc[a][b][m][n] = (f32x4){0.f, 0.f, 0.f, 0.f};
    bf16x8 At[4][2], B0[2][2], B1[2][2]; v8i_ At8[4], B08[2], B18[2];
    const char* cA = S.a_base(cur); const char* cB = S.b_base(cur);
    PG8_STAGE(PG8_SB(0, 0), cB, voffB); PG8_STAGE(PG8_SB(0, 1), cB + hstepB, voffB); PG8_STAGE(PG8_SA(0, 0), cA, offA[0]); PG8_STAGE(PG8_SA(0, 1), cA, offA[1]);
    if (wr == 1) PG8_BAR;
    PG8_WAIT_V(2); PG8_BAR;
    PG8_STAGE(PG8_SB(1, 0), cB + kstep, voffB); PG8_STAGE(PG8_SA(1, 0), cA + kstep, offA[0]); PG8_STAGE(PG8_SB(1, 1), cB + hstepB + kstep, voffB);
    PG8_WAIT_V(6); PG8_BAR;
    for (;;) {
        const bool has_next = S.next(ui + 1, nxt);
        const char* nA = has_next ? S.a_base(nxt) : cA; const char* nB = has_next ? S.b_base(nxt) : cB;
        if constexpr (GATHER) {
            {
                u32x4 nv;
                if (has_next) { unsigned t_[2][2];
#pragma unroll
                    for (int i = 0; i < 2; ++i) { int t2_ = tid; asm volatile("" : "+v"(t2_)); int R, C; stage_rc(t2_ * 16 + i * 8192, R, C);
                        const unsigned r0_ = Sched::RAW_EARLY ? rawN[0][i] : S.a_rowraw(nxt, R), r1_ = Sched::RAW_EARLY ? rawN[1][i] : S.a_rowraw(nxt, R + HALF);
                        t_[0][i] = r0_ * (unsigned)S.a_pitch + (unsigned)(C * 2); t_[1][i] = r1_ * (unsigned)S.a_pitch + (unsigned)(C * 2); }
                    nv = (u32x4){t_[0][0], t_[0][1], t_[1][0], t_[1][1]}; }
                else nv = (u32x4){offA[0][0], offA[0][1], offA[1][0], offA[1][1]};
                int t4_ = tid; asm volatile("" : "+v"(t4_)); *(PG8_LAS u32x4*)(lds + 131072 + 8192 + t4_ * 16) = nv; }
            { Unit n2;
                if (Sched::RAW_EARLY && S.next(ui + 2, n2)) {
#pragma unroll
                    for (int i = 0; i < 2; ++i) { int t3_ = tid; asm volatile("" : "+v"(t3_)); int R, C; stage_rc(t3_ * 16 + i * 8192, R, C); rawN[0][i] = S.a_rowraw(n2, R); rawN[1][i] = S.a_rowraw(n2, R + HALF); } } }
        }
#pragma unroll 1
        for (int t = 0; t < nt; t += 2) {
            const bool last = (t == nt - 2);
            const char* a1 = cA + (size_t)(t + 1) * kstep;
            const char* a2 = last ? nA : cA + (size_t)(t + 2) * kstep; const char* b2 = last ? nB : cB + (size_t)(t + 2) * kstep;
            const char* a3 = a2 + kstep; const char* b3 = b2 + kstep;
            unsigned o2[2][2];
#pragma unroll
            for (int h = 0; h < 2; ++h)
#pragma unroll
                for (int i = 0; i < 2; ++i) o2[h][i] = offA[h][i];
            if constexpr (GATHER) { if (last) { int t5_ = tid; asm volatile("" : "+v"(t5_)); const u32x4 nv = *(const PG8_LAS u32x4*)(lds + 131072 + 8192 + t5_ * 16);
                    noffA[0][0] = nv.x; noffA[0][1] = nv.y; noffA[1][0] = nv.z; noffA[1][1] = nv.w; o2[0][0] = nv.x; o2[0][1] = nv.y; o2[1][0] = nv.z; o2[1][1] = nv.w; } }
            PG8_LDB(B0, 0, 0); PG8_LDB(B1, 0, 1); PG8_SCHED; PG8_LDA(At, 0, 0); PG8_STAGE(PG8_SA(1, 1), a1, offA[1]);
            PG8_WAIT_V(8); PG8_WAIT_L(0); PG8_BAR; PG8_MMA(0, 0, At, B0); PG8_MMA(0, 1, At, B1); PG8_BAR; PG8_SCHED;
            PG8_LDA(At, 0, 1); PG8_STAGE(PG8_SB(0, 0), b2, voffB); PG8_STAGE(PG8_SB(0, 1), b2 + hstepB, voffB); PG8_STAGE(PG8_SA(0, 0), a2, o2[0]);
            PG8_WAIT_V(8); PG8_WAIT_L(0); PG8_BAR; PG8_MMA(1, 0, At, B0); PG8_MMA(1, 1, At, B1); PG8_BAR; PG8_SCHED;
            PG8_LDB(B0, 1, 0); PG8_LDB(B1, 1, 1); PG8_SCHED; PG8_LDA(At, 1, 0); PG8_STAGE(PG8_SA(0, 1), a2, o2[1]);
            PG8_WAIT_V(8); PG8_WAIT_L(0); PG8_BAR; PG8_MMA(0, 0, At, B0); PG8_MMA(0, 1, At, B1); PG8_BAR; PG8_SCHED;
            PG8_LDA(At, 1, 1); PG8_STAGE(PG8_SB(1, 0), b3, voffB); PG8_STAGE(PG8_SB(1, 1), b3 + hstepB, voffB); PG8_STAGE(PG8_SA(1, 0), a3, o2[0]);
            PG8_WAIT_V(8); PG8_WAIT_L(0); PG8_BAR; PG8_MMA(1, 0, At, B0); PG8_MMA(1, 1, At, B1); PG8_BAR; PG8_SCHED;
        }
        if (wr == 0) PG8_BAR;
        if constexpr (FP8) asm volatile("s_nop 15\n\ts_nop 3" ::: "memory");
        { int l2_ = lane; asm volatile("" : "+v"(l2_)); E(acc, cur, wr, wc, l2_ & 15, l2_ >> 4); }
#ifdef MK_EPI_DUP
        if constexpr ((MK_EPI_DUP == 1 && FP8 && !GATHER) || (MK_EPI_DUP == 2 && !FP8)) { int l3_ = lane; asm volatile("" : "+v"(l3_)); asm volatile("" ::: "memory"); E(acc, cur, wr, wc, l3_ & 15, l3_ >> 4); }
#endif
        if (!has_next) break;
#pragma unroll
        for (int a = 0; a < 2; ++a)
#pragma unroll
            for (int b = 0; b < 2; ++b)
#pragma unroll
                for (int m = 0; m < 4; ++m)
#pragma unroll
                    for (int n = 0; n < 2; ++n) acc[a][b][m][n] = (f32x4){0.f, 0.f, 0.f, 0.f};
        cur = nxt; cA = nA; cB = nB; ++ui;
        if constexpr (GATHER) {
#pragma unroll
            for (int h = 0; h < 2; ++h)
#pragma unroll
                for (int i = 0; i < 2; ++i) offA[h][i] = noffA[h][i];
        }
        if (wr == 1) PG8_BAR;
    }
    PG8_WAIT_V(0);
    PG8_BAR;
#undef PG8_SA
#undef PG8_SB
#undef PG8_STAGE
#undef PG8_LDA
#undef PG8_LDB
#undef PG8_MMA
#undef PG8_WAIT_V
#undef PG8_WAIT_L
#undef PG8_BAR
#undef PG8_SCHED
}
}

#define GAS __attribute__((address_space(1)))
#define LAS __attribute__((address_space(3)))
typedef unsigned short bf16;
typedef unsigned v4u __attribute__((ext_vector_type(4)));
typedef unsigned v2u __attribute__((ext_vector_type(2)));
typedef float f32x4 __attribute__((ext_vector_type(4)));
typedef float f32x2 __attribute__((ext_vector_type(2)));
typedef float f32x16 __attribute__((ext_vector_type(16)));
typedef short bf16x8 __attribute__((ext_vector_type(8)));
typedef short s16x4 __attribute__((ext_vector_type(4)));
typedef GAS unsigned gu32;
#define RLX_AGENT __ATOMIC_RELAXED, __HIP_MEMORY_SCOPE_AGENT
#define LDS_WAIT() asm volatile("s_waitcnt lgkmcnt(0)" ::: "memory")
#define VM_WAIT() asm volatile("s_waitcnt vmcnt(0)" ::: "memory")
typedef __bf16 hwbf2_ __attribute__((ext_vector_type(2))); typedef float hwf2_ __attribute__((ext_vector_type(2)));
__device__ __forceinline__ unsigned pk2(float lo, float hi) { return __builtin_bit_cast(unsigned, __builtin_convertvector((hwf2_){lo, hi}, hwbf2_)); }
__device__ __forceinline__ unsigned f2bf(float f) { return pk2(f, 0.f) & 0xffffu; }
__device__ __forceinline__ float bf_lo(unsigned w) { return __builtin_bit_cast(float, w << 16); }
__device__ __forceinline__ float bf_hi(unsigned w) { return __builtin_bit_cast(float, w & 0xffff0000u); }
__device__ __forceinline__ float wave_sum(float v) {
#pragma unroll
    for (int o = 1; o < 64; o <<= 1) v += __shfl_xor(v, o);
    return v;
}

#define XB_TMO      128
#define XB_XCNT(j)  (256  + 64 * (j))
#define XB_XSUB(j)  (1280 + 64 * (j))
#define XB_XGEN(j)  (2304 + 64 * (j))
#define XB_TOP      3328
#define XB_TOPGEN   3392
#define XCD_BAR_WORDS 3456
#define XB_SPIN_CAP (1u << 18)
__device__ __forceinline__ unsigned xb_ld(unsigned* p)              { return __hip_atomic_load(p, __ATOMIC_RELAXED, __HIP_MEMORY_SCOPE_AGENT); }
__device__ __forceinline__ unsigned xb_add(unsigned* p, unsigned v) { return __hip_atomic_fetch_add(p, v, __ATOMIC_RELAXED, __HIP_MEMORY_SCOPE_AGENT); }
__device__ __forceinline__ unsigned xb_xcc_id() { return (unsigned)__builtin_amdgcn_s_getreg((3 << 11) | 20) & 0xFu; }
#define XB_SPIN(cond, bar) do { unsigned _sp = 0; while (cond) { __builtin_amdgcn_s_sleep(1); \
    if ((++_sp & 255u) == 0u) { if (xb_ld(&(bar)[XB_TMO])) break; if (_sp > XB_SPIN_CAP) { atomicAdd(&(bar)[XB_TMO], 1u); break; } } } } while (0)
struct XcdBarrier { unsigned* bar; unsigned x; volatile LAS unsigned* st; int wave; };
__device__ __forceinline__ XcdBarrier xcd_barrier_post(unsigned* bar, volatile LAS unsigned* st, int wave) {
    XcdBarrier b; b.bar = bar; b.x = xb_xcc_id(); b.st = st; b.wave = wave;
    if (wave == 0 && lane_now() == 0) (void)xb_add(&bar[XB_XCNT(b.x)], 1u);
    return b;
}
__device__ __forceinline__ void xcd_barrier_complete(unsigned* bar, unsigned x, unsigned& nloc, unsigned& nx) {
    const unsigned G = gridDim.x * gridDim.y * gridDim.z;
    unsigned sum, cnt, mine, sp = 0u;
    for (;;) {
        sum = 0u; cnt = 0u; mine = 0u;
#pragma unroll
        for (unsigned j = 0; j < 16; ++j) { const unsigned c = xb_ld(&bar[XB_XCNT(j)]); sum += c; cnt += (c > 0u) ? 1u : 0u; mine = (j == x) ? c : mine; }
        if (sum == G) break;
        __builtin_amdgcn_s_sleep(1);
        if ((++sp & 255u) == 0u) { if (xb_ld(&bar[XB_TMO])) break; if (sp > XB_SPIN_CAP) { atomicAdd(&bar[XB_TMO], 1u); break; } }
    }
    nloc = mine > 0u ? mine : 1u; nx = cnt > 0u ? cnt : 1u;
}
__device__ __forceinline__ void xcd_barrier(const XcdBarrier& b) {
    asm volatile("s_waitcnt vmcnt(0)" ::: "memory");
    __syncthreads();
    if (b.wave == 0 && lane_now() == 0) {
        unsigned* bar = b.bar;
        __builtin_amdgcn_s_waitcnt(0);
        unsigned nloc = b.st[0], nx = b.st[1];
        if (nloc == 0u) { xcd_barrier_complete(bar, b.x, nloc, nx); b.st[0] = nloc; b.st[1] = nx; }
        const unsigned ep = b.st[2]; b.st[2] = ep + 1u;
        const unsigned old = xb_add(&bar[XB_XSUB(b.x)], 1u);
        if (old + 1u == (ep + 1u) * nloc) {
            __builtin_amdgcn_fence(__ATOMIC_RELEASE, "agent");
            asm volatile("s_waitcnt vmcnt(0)" ::: "memory");
            (void)xb_add(&bar[XB_TOP], 1u);
        }
        const unsigned want = (ep + 1u) * nx;
        XB_SPIN(xb_ld(&bar[XB_TOP]) < want, bar);
        __builtin_amdgcn_fence(__ATOMIC_ACQUIRE, "agent");
        asm volatile("s_waitcnt vmcnt(0)" ::: "memory");
    }
    __syncthreads();
}
namespace mk {
constexpr int D = 1024, NB = 8, SEQ = 2048, CT = 256, NCTX = NB * CT, NLAT = NB * SEQ, NTOK = NCTX + NLAT;
constexpr int NE = 32, LCAP = NTOK;
constexpr int NWAVES = 8, NTHR = 512;
#ifndef MK_WRITE_XS_ALWAYS
#define MK_WRITE_XS_ALWAYS 0
#endif
constexpr bool WRITE_XS_ALWAYS = MK_WRITE_XS_ALWAYS != 0;
#ifndef MK_FP8_G1
#define MK_FP8_G1 0
#endif
#ifndef MK_FP8_G2
#define MK_FP8_G2 0
#endif
constexpr bool FP8_G1 = MK_FP8_G1 != 0, FP8_G2 = MK_FP8_G2 != 0;
#ifndef MK_FP8_Y2
#define MK_FP8_Y2 1
#endif
constexpr bool FP8_Y2 = (MK_FP8_Y2 != 0) && FP8_G2;
constexpr int W1_KB = FP8_G1 ? 1024 : 2048, W2_KB = FP8_G2 ? 1024 : 2048;
constexpr int MAXT = NTOK * 4 / 256 + NE;
constexpr int HB_ROWS = MAXT * 256;

constexpr size_t MiB = 1u << 20;
constexpr size_t al(size_t x) { return (x + MiB - 1) / MiB * MiB; }
constexpr size_t WS_CTL = 0, CTL_ZERO_BYTES = 1 * MiB;
constexpr size_t WS_MOD = WS_CTL + CTL_ZERO_BYTES;
constexpr size_t WS_TAB = WS_MOD + al(2 * 9 * 6144 * 4);
constexpr size_t WS_WIN0 = WS_TAB + MiB;
constexpr size_t WS_WOUT0 = WS_WIN0 + al((size_t)3072 * 1024 * 2);
constexpr size_t WS_WIN1 = WS_WOUT0 + al((size_t)1024 * 1024 * 2);
constexpr size_t WS_WOUT1 = WS_WIN1 + al((size_t)2048 * 1024 * 2);
constexpr size_t WS_WGATE = WS_WOUT1 + al((size_t)1024 * 1024 * 2);
constexpr size_t WS_W1 = WS_WGATE + al((size_t)16 * 256 * 256 * 2);
constexpr size_t WS_W2 = WS_W1 + al((size_t)2 * 32 * 2048 * 1024 * 2);
constexpr size_t WS_XS = WS_W2 + al((size_t)2 * 32 * 1024 * 1024 * 2);
constexpr size_t WS_XN = WS_XS + al((size_t)NTOK * D * 4);
constexpr size_t WS_PROJ = WS_XN + al((size_t)NTOK * D * 2);
constexpr size_t WS_CAT = WS_PROJ + al((size_t)NTOK * 3072 * 2);
constexpr size_t WS_ROUTE = WS_CAT + al((size_t)NTOK * D * 2);
constexpr size_t RT_EIDX = 0, RT_EGATE = (size_t)NTOK * 16, RT_EPOS = 2 * (size_t)NTOK * 16, RT_LIST = 3 * (size_t)NTOK * 16;
constexpr size_t WS_HB = WS_ROUTE + al(3 * (size_t)NTOK * 16 + (size_t)NE * LCAP * 4);
constexpr size_t WS_Y2 = WS_HB + al((size_t)HB_ROWS * D * 2);
constexpr size_t WS_END = WS_Y2 + al((size_t)HB_ROWS * D * 2);
constexpr size_t WS_XC = WS_HB;
constexpr size_t WS_AB = WS_XC + al((size_t)2 * NTOK * D * 2);
constexpr size_t WS_SUM = WS_AB + al((size_t)2 * NTOK * D * 4);
static_assert(WS_SUM + (size_t)2 * 288 * 1024 * 8 <= WS_END, "layer-1 mixer overlay");
constexpr int CW_BAR = 4096;
constexpr int CW_ADALN = 32768 + 64;
constexpr int CW_FILL = 32768;
constexpr int CW_CNT = 65536;
static_assert((CW_CNT + 64 * 64) * 4 <= (int)CTL_ZERO_BYTES && CW_BAR + 8 * XCD_BAR_WORDS <= CW_CNT, "CTL map");

constexpr int RING_OFF = 0, RING_BYTES = 131072;
constexpr int MISC_OFF = RING_BYTES;
constexpr int MISC_BAR = 0;
constexpr int MISC_HIST = 64, MISC_BASE = 64 + 128, MISC_CNT = 64 + 256, MISC_PB = 64 + 384, MISC_NT = 64 + 512;
constexpr int MISC_TAB = 1024;
constexpr int MISC_REC = 4096;
constexpr int LDS_BYTES = 147456;
static_assert(MISC_TAB + MAXT * 4 <= MISC_REC && MISC_OFF + MISC_REC + 8192 <= LDS_BYTES, "LDS map");

struct Args { const float* in[32]; float* out; unsigned char* ws; int ph_lo, ph_hi, li, pad; };

struct Frame {
    LAS unsigned char* lds; LAS unsigned char* misc; gu32* ctl;
    int wave, vcu, G;
    unsigned char* ws;
#ifdef MK_RT_SKIP
    int li;
#endif
};

__device__ __forceinline__ int tid_now(const Frame& F) { return F.wave * 64 + lane_now(); }
__device__ __forceinline__ int row_modrow(int r) { return r < NCTX ? 8 : (r - NCTX) >> 11; }

__device__ __forceinline__ unsigned pk4_fp8(float a, float b, float c, float d) { int p = __builtin_amdgcn_cvt_pk_fp8_f32(a, b, 0, false); p = __builtin_amdgcn_cvt_pk_fp8_f32(c, d, p, true); return (unsigned)p; }
#ifdef MK_EMU_OUT
__device__ __forceinline__ float q8o(float x) { const int p = __builtin_amdgcn_cvt_pk_fp8_f32(x, x, 0, false); return __builtin_amdgcn_cvt_f32_fp8(p, 0); }
#define QO(x) q8o(x)
#define QOW(x) (q8o((x) * 32.f) * 0.03125f)
#else
#define QO(x) (x)
#define QOW(x) (x)
#endif
#ifdef MK_EMU_FP8
__device__ __forceinline__ float q8(float x) { const int p = __builtin_amdgcn_cvt_pk_fp8_f32(x, x, 0, false); return __builtin_amdgcn_cvt_f32_fp8(p, 0); }
#define Q8W(x) (q8((x) * 32.f) * 0.03125f)
#define Q8A(x) q8(x)
#else
#define Q8W(x) (x)
#define Q8A(x) (x)
#endif
template <bool QW = false, bool QOUT = false> __device__ __forceinline__ void transpose_item(const float* W, int N, int k0, int n0, bf16* dst, int ldd, LAS float* scr, int lane) {
#pragma unroll 8
    for (int i = 0; i < 32; ++i) { const int kk = 2 * i + (lane >> 5); const float wv_ = W[(size_t)(k0 + kk) * N + n0 + (lane & 31)]; scr[kk * 33 + (lane & 31)] = QW ? Q8W(wv_) : (QOUT ? QOW(wv_) : wv_); }
    LDS_WAIT(); asm volatile("" ::: "memory");
    const int c = lane & 7;
#pragma unroll
    for (int j = 0; j < 4; ++j) { const int n = (lane >> 3) + 8 * j; const LAS float* s = scr + (8 * c) * 33 + n;
        v4u o; o.x = pk2(s[0 * 33], s[1 * 33]); o.y = pk2(s[2 * 33], s[3 * 33]); o.z = pk2(s[4 * 33], s[5 * 33]); o.w = pk2(s[6 * 33], s[7 * 33]);
        *(GAS v4u*)(dst + (size_t)n * ldd + 8 * c) = o; }
    LDS_WAIT(); asm volatile("" ::: "memory");
}
template <int KK = 64> __device__ __forceinline__ void transpose_item_fp8(const float* W, int N, int k0, int n0, unsigned char* dst, int ldd, int lane) {
    const float* src = W + (size_t)k0 * N + n0 + lane; float v[KK];
#pragma unroll
    for (int kk = 0; kk < KK; ++kk) v[kk] = __builtin_nontemporal_load(src + (size_t)kk * N);
    unsigned char* o = dst + (size_t)lane * ldd;
#pragma unroll
    for (int q = 0; q < KK / 16; ++q) { v4u w;
        w.x = pk4_fp8(v[16 * q + 0] * 32.f, v[16 * q + 1] * 32.f, v[16 * q + 2] * 32.f, v[16 * q + 3] * 32.f); w.y = pk4_fp8(v[16 * q + 4] * 32.f, v[16 * q + 5] * 32.f, v[16 * q + 6] * 32.f, v[16 * q + 7] * 32.f);
        w.z = pk4_fp8(v[16 * q + 8] * 32.f, v[16 * q + 9] * 32.f, v[16 * q + 10] * 32.f, v[16 * q + 11] * 32.f); w.w = pk4_fp8(v[16 * q + 12] * 32.f, v[16 * q + 13] * 32.f, v[16 * q + 14] * 32.f, v[16 * q + 15] * 32.f);
        *(GAS v4u*)(o + 16 * q) = w; }
}
template <class RowMap> __device__ __forceinline__ void transpose_item_fp8_wide(const float* W, int N, int k0, int n0, unsigned char* dst, int ldd, int lane, const RowMap& rowmap) {
    const float* src = W + (size_t)k0 * N + n0 + 4 * lane; f32x4 v[16];
#pragma unroll
    for (int kk = 0; kk < 16; ++kk) v[kk] = __builtin_nontemporal_load((const f32x4*)(src + (size_t)kk * N));
    unsigned char* o = dst + (size_t)rowmap(n0 + 4 * lane) * ldd + k0;
#pragma unroll
    for (int j = 0; j < 4; ++j) { v4u w;
        w.x = pk4_fp8(v[0][j] * 32.f, v[1][j] * 32.f, v[2][j] * 32.f, v[3][j] * 32.f); w.y = pk4_fp8(v[4][j] * 32.f, v[5][j] * 32.f, v[6][j] * 32.f, v[7][j] * 32.f);
        w.z = pk4_fp8(v[8][j] * 32.f, v[9][j] * 32.f, v[10][j] * 32.f, v[11][j] * 32.f); w.w = pk4_fp8(v[12][j] * 32.f, v[13][j] * 32.f, v[14][j] * 32.f, v[15][j] * 32.f);
        *(GAS v4u*)(o + (size_t)j * ldd) = w; }
}
#ifdef MK_CONV_K128
constexpr int MOE_ITEMS = 32 * (8 * 32 + 8 * 16);
#else
constexpr int MOE_ITEMS = 32 * (16 * 32 + 16 * 16);
#endif
__device__ __forceinline__ void moe_item_fp8(unsigned char* ws, const float* w1, const float* w2, int layer, int it) {
#ifdef MK_CONV_K128
    constexpr int J1 = 8 * 32, J2 = 8 * 16;
#else
    constexpr int J1 = 16 * 32, J2 = 16 * 16;
#endif
    unsigned char* W81 = ws + WS_W1 + (size_t)layer * 32 * 2048 * 1024; unsigned char* W82 = ws + WS_W2 + (size_t)layer * 32 * 1024 * 1024;
    const float* s1 = w1 + (size_t)layer * 32 * 1024 * 2048; const float* s2 = w2 + (size_t)layer * 32 * 1024 * 1024;
    const int e = it / (J1 + J2); int r = it % (J1 + J2);
#if defined(MK_CONV_K128)
    if (r < J1) { const int kb = r >> 5, n0 = (r & 31) * 64; const int nn = n0 & 1023, drow = 256 * (nn >> 7) + (n0 >= 1024 ? 128 : 0) + (nn & 127);
        transpose_item_fp8<128>(s1 + (size_t)e * 1024 * 2048, 2048, kb * 128, n0, W81 + (size_t)e * 2048 * 1024 + (size_t)drow * 1024 + kb * 128, 1024, lane_now()); }
    else { r -= J1; const int kb = r >> 4, n0 = (r & 15) * 64;
        transpose_item_fp8<128>(s2 + (size_t)e * 1024 * 1024, 1024, kb * 128, n0, W82 + (size_t)e * 1024 * 1024 + (size_t)n0 * 1024 + kb * 128, 1024, lane_now()); }
#elif defined(MK_WIDE_CONV)
    if (r < J1) { const int kb = r >> 3, n0 = (r & 7) * 256;
        transpose_item_fp8_wide(s1 + (size_t)e * 1024 * 2048, 2048, kb * 16, n0, W81 + (size_t)e * 2048 * 1024, 1024, lane_now(), [](int n) { const int nn = n & 1023; return 256 * (nn >> 7) + (n >= 1024 ? 128 : 0) + (nn & 127); }); }
    else { r -= J1; const int kb = r >> 2, n0 = (r & 3) * 256;
        transpose_item_fp8_wide(s2 + (size_t)e * 1024 * 1024, 1024, kb * 16, n0, W82 + (size_t)e * 1024 * 1024, 1024, lane_now(), [](int n) { return n; }); }
#else
    if (r < J1) { const int kb = r / 32, n0 = (r % 32) * 64; const int nn = n0 & 1023, drow = 256 * (nn >> 7) + (n0 >= 1024 ? 128 : 0) + (nn & 127);
        transpose_item_fp8(s1 + (size_t)e * 1024 * 2048, 2048, kb * 64, n0, W81 + (size_t)e * 2048 * 1024 + (size_t)drow * 1024 + kb * 64, 1024, lane_now()); }
    else { r -= J1; const int kb = r / 16, n0 = (r % 16) * 64;
        transpose_item_fp8(s2 + (size_t)e * 1024 * 1024, 1024, kb * 64, n0, W82 + (size_t)e * 1024 * 1024 + (size_t)n0 * 1024 + kb * 64, 1024, lane_now()); }
#endif
}
#ifndef MK_FILL_MAX
#define MK_FILL_MAX 1000000
#endif
#ifndef MK_FILLER
#define MK_FILLER 0
#endif
constexpr bool FILLER_ON = (MK_FILLER != 0) && FP8_G1 && FP8_G2;
__device__ __forceinline__ void filler(Frame& F, const float* w1, const float* w2, int budget) {
    if constexpr (!FILLER_ON) return;
    if (budget < 1000 && budget > MK_FILL_MAX) budget = MK_FILL_MAX;
    while (budget > 0) {
        const int chunk = budget < 8 ? budget : 8; budget -= chunk;
        int it0 = 0; if (lane_now() == 0) it0 = (int)__hip_atomic_fetch_add(F.ctl + CW_FILL, (unsigned)chunk, RLX_AGENT);
        it0 = __builtin_amdgcn_readfirstlane(it0);
        if (it0 >= MOE_ITEMS) break;
        for (int it = it0; it < it0 + chunk && it < MOE_ITEMS; ++it) moe_item_fp8(F.ws, w1, w2, 1, it);
    }
}
#ifndef MK_TF_N0
#define MK_TF_N0 4
#endif
#ifndef MK_TF_N1
#define MK_TF_N1 4
#endif
#ifndef MK_TF_N2
#define MK_TF_N2 4
#endif
#ifndef MK_TF_N3
#define MK_TF_N3 2
#endif
constexpr bool TF_ON = FP8_G1 && FP8_G2;
#ifndef MK_TF_N4
#define MK_TF_N4 2
#endif
constexpr int TF_FIRST[5] = {32, 32, 96, 128, 64}, TF_N[5] = {TF_ON ? MK_TF_N0 : 0, TF_ON ? MK_TF_N1 : 0, TF_ON ? MK_TF_N2 : 0, TF_ON ? MK_TF_N3 : 0, TF_ON ? MK_TF_N4 : 0};
constexpr int tf_base(int s) { int b = 0; for (int i = 0; i < s; ++i) b += (256 - TF_FIRST[i]) * NWAVES * TF_N[i]; return b; }
constexpr int TF_TOTAL = tf_base(5);
#ifndef MK_RF_N
#define MK_RF_N 6
#endif
constexpr int RF_N = TF_ON ? MK_RF_N : 0, RF_TOTAL = 256 * 3 * RF_N;
static_assert(TF_TOTAL <= 32 * (16 * 32 + 16 * 16), "tail-fill slices exceed the layer's items");
template <int SLICE> __device__ __forceinline__ void tail_fill(Frame& F, const float* w1, const float* w2) {
    if constexpr (TF_N[SLICE] > 0) { const int rank = (SLICE == 4 ? F.vcu : (int)blockIdx.x) - TF_FIRST[SLICE]; if (F.G != 256 || rank < 0) return;
        const int it0 = tf_base(SLICE) + (rank * NWAVES + F.wave) * TF_N[SLICE];
        for (int j = 0; j < TF_N[SLICE]; ++j) moe_item_fp8(F.ws, w1, w2, 1, it0 + j); }
}
__device__ __forceinline__ void p0_moe_weights(Frame& F, const float* w1, const float* w2, int layer) {
    LAS float* scr = (LAS float*)(F.lds + RING_OFF + F.wave * 16384);
    const int gw = F.vcu * NWAVES + F.wave, NGW = F.G * NWAVES;
    bf16* WT1 = (bf16*)(F.ws + WS_W1) + (size_t)layer * 32 * 2048 * 1024; bf16* WT2 = (bf16*)(F.ws + WS_W2) + (size_t)layer * 32 * 1024 * 1024;
    unsigned char* W81 = F.ws + WS_W1 + (size_t)layer * 32 * 2048 * 1024; unsigned char* W82 = F.ws + WS_W2 + (size_t)layer * 32 * 1024 * 1024;
    const float* s1 = w1 + (size_t)layer * 32 * 1024 * 2048; const float* s2 = w2 + (size_t)layer * 32 * 1024 * 1024;
    if constexpr (FP8_G1 && FP8_G2) {
        constexpr int PB_EXTRA = 64 * NWAVES * 2;
        const bool bal = layer == 0 && F.G == 256; const int end = MOE_ITEMS - ((layer == 0 && F.G == 256) ? RF_TOTAL + PB_EXTRA : 0);
        for (int it = gw + ((layer == 1 && F.G == 256) ? TF_TOTAL : 0); it < end; it += NGW) moe_item_fp8(F.ws, w1, w2, layer, it);
        if (bal && F.vcu >= 192) { const int it0 = end + ((F.vcu - 192) * NWAVES + F.wave) * 2; moe_item_fp8(F.ws, w1, w2, 0, it0); moe_item_fp8(F.ws, w1, w2, 0, it0 + 1); }
        return;
    }
    constexpr int I1 = 16 * 64, I2 = 16 * 32, IT = 32 * (I1 + I2);
    for (int it = gw; it < IT; it += NGW) {
        const int e = it / (I1 + I2); int r = it % (I1 + I2);
        if (r < I1) { const int kb = r / 64, nb = r % 64, n0 = nb * 32; const int nn = n0 & 1023, drow = 256 * (nn >> 7) + (n0 >= 1024 ? 128 : 0) + (nn & 127);
            transpose_item<true>(s1 + (size_t)e * 1024 * 2048, 2048, kb * 64, n0, WT1 + (size_t)e * 2048 * 1024 + (size_t)drow * 1024 + kb * 64, 1024, scr, lane_now()); }
        else { r -= I1; const int kb = r / 32, nb = r % 32;
            transpose_item<true>(s2 + (size_t)e * 1024 * 1024, 1024, kb * 64, nb * 32, WT2 + (size_t)e * 1024 * 1024 + (size_t)(nb * 32) * 1024 + kb * 64, 1024, scr, lane_now()); }
    }
}

__device__ __forceinline__ void moe_table(Frame& F, int layer) {
    LAS int* cntl = (LAS int*)(F.misc + MISC_CNT); LAS int* pb = (LAS int*)(F.misc + MISC_PB); LAS int* tab = (LAS int*)(F.misc + MISC_TAB); LAS int* ntl = (LAS int*)(F.misc + MISC_NT);
    const int t0 = tid_now(F);
    LAS int* vf = (LAS int*)(F.misc + 16);
    if (*vf == layer + 1) return;
    if (t0 < 64) { const int e = t0 & 31; const int cn = (int)__hip_atomic_load(F.ctl + CW_CNT + (layer * 32 + e) * 64, RLX_AGENT); const int n = (cn + 255) >> 8;
        int incl = n;
#pragma unroll
        for (int o = 1; o < 32; o <<= 1) { const int v = __shfl_up(incl, o, 32); if (e >= o) incl += v; }
        if (t0 < 32) { cntl[e] = cn; pb[e] = incl - n; if (e == 31) ntl[0] = incl; } }
    __syncthreads();
    const int T = ntl[0];
    for (int pm = t0; pm < T; pm += NTHR) { int e = 0;
#pragma unroll
        for (int k = 1; k < 32; ++k) e += (pb[k] <= pm) ? 1 : 0;
        tab[pm] = (e << 16) | (pm - pb[e]); }
    __syncthreads();
    if (t0 == 0) *vf = layer + 1;
}
struct MoeSched1 {   static constexpr bool RAW_EARLY = true;
    pg8::TileOrder ord; LAS const int* tab; LAS const int* cntl; const char* XN; const char* W; const int* list; int a_pitch; int wb;
    __device__ __forceinline__ bool next(int i, pg8::Unit& u) const { return ord.tile(i, u); }
    __device__ __forceinline__ const char* a_base(const pg8::Unit&) const { return XN; }
    __device__ __forceinline__ const char* b_base(const pg8::Unit& u) const { const int e = __builtin_amdgcn_readfirstlane(tab[u.pm]) >> 16; return W + ((size_t)e * 2048 + (size_t)u.pn * 256) * wb; }
    __device__ __forceinline__ unsigned a_rowraw(const pg8::Unit& u, int r) const { const int te = __builtin_amdgcn_readfirstlane(tab[u.pm]), e = te >> 16, j = te & 0xffff; int lr = j * 256 + r; const int n = __builtin_amdgcn_readfirstlane(cntl[e]); lr = lr < n ? lr : n - 1;
        return (unsigned)list[(size_t)e * LCAP + lr]; }
};
struct MoeSched2 {   static constexpr bool RAW_EARLY = false;
    pg8::TileOrder ord; LAS const int* tab; const char* HB; const char* W; int a_pitch; int wb;
    __device__ __forceinline__ bool next(int i, pg8::Unit& u) const { return ord.tile(i, u); }
    __device__ __forceinline__ const char* a_base(const pg8::Unit& u) const { return HB + (size_t)u.pm * 256 * a_pitch; }
    __device__ __forceinline__ const char* b_base(const pg8::Unit& u) const { const int e = __builtin_amdgcn_readfirstlane(tab[u.pm]) >> 16; return W + ((size_t)e * 1024 + (size_t)u.pn * 256) * wb; }
    __device__ __forceinline__ unsigned a_rowraw(const pg8::Unit&, int) const { return 0u; }
};
__device__ __forceinline__ v4u widen_pair(v2u a, v2u b) {
    const auto rx = __builtin_amdgcn_permlane16_swap(a.x, b.x, false, false), ry = __builtin_amdgcn_permlane16_swap(a.y, b.y, false, false);
    return (v4u){rx[0], ry[0], rx[1], ry[1]};
}
struct EpiSwiglu {
    static constexpr bool PERM = true;
    bf16* HB; const float* b1; LAS const int* tab;
    __device__ __forceinline__ void operator()(const pg8::f32x4 (&acc)[2][2][4][2], const pg8::Unit& u, int wr, int wc, int fr, int fq) const {
        const int e = __builtin_amdgcn_readfirstlane(tab[u.pm]) >> 16; const float* bb = b1 + (size_t)e * 2048 + u.pn * 128 + wc * 32 + 8 * fq;
        pg8::f32x4 bg[2], bl[2];
#pragma unroll
        for (int n = 0; n < 2; ++n) { bg[n] = *(const pg8::f32x4*)(bb + 4 * n); bl[n] = *(const pg8::f32x4*)(bb + 1024 + 4 * n); }
#pragma unroll
        for (int ai = 0; ai < 2; ++ai) { v2u wprev = (v2u){0u, 0u};
#pragma unroll
            for (int m = 0; m < 4; ++m) { const size_t row = (size_t)u.pm * 256 + ai * 128 + wr * 64 + m * 16 + fr; float o[8];
#pragma unroll
                for (int n = 0; n < 2; ++n)
#pragma unroll
                    for (int i = 0; i < 4; i += 2) { typedef float f2 __attribute__((ext_vector_type(2)));
                        f2 g = (f2){acc[ai][0][m][n][i], acc[ai][0][m][n][i + 1]} + (f2){bg[n][i], bg[n][i + 1]}; f2 l = (f2){acc[ai][1][m][n][i], acc[ai][1][m][n][i + 1]} + (f2){bl[n][i], bl[n][i + 1]};
                        g.x = fminf(g.x, 7.f); g.y = fminf(g.y, 7.f); l.x = __builtin_amdgcn_fmed3f(l.x, -7.f, 7.f); l.y = __builtin_amdgcn_fmed3f(l.y, -7.f, 7.f);
                        const f2 t = g * (-1.702f * 1.4426950408889634f); f2 d; d.x = __builtin_amdgcn_exp2f(t.x); d.y = __builtin_amdgcn_exp2f(t.y); d = d + 1.f;
                        f2 sg; sg.x = __builtin_amdgcn_rcpf(d.x); sg.y = __builtin_amdgcn_rcpf(d.y);
                        const f2 ov = (g * sg) * (l + 1.f); o[n * 4 + i] = ov.x; o[n * 4 + i + 1] = ov.y; }
                if constexpr (FP8_G2) { v2u w; w.x = pk4_fp8(o[0], o[1], o[2], o[3]); w.y = pk4_fp8(o[4], o[5], o[6], o[7]);
                    if (m & 1) { const v4u ww = widen_pair(wprev, w);
                        const size_t r2 = (size_t)u.pm * 256 + ai * 128 + wr * 64 + (m - 1 + (fq & 1)) * 16 + fr;
                        *(GAS v4u*)((unsigned char*)HB + r2 * 1024 + u.pn * 128 + wc * 32 + 8 * (fq & ~1)) = ww; }
                    else wprev = w; }
                else { pg8::u32x4 w; w.x = pg8::cvt_pk_bf16(o[0], o[1]); w.y = pg8::cvt_pk_bf16(o[2], o[3]); w.z = pg8::cvt_pk_bf16(o[4], o[5]); w.w = pg8::cvt_pk_bf16(o[6], o[7]);
                    *(pg8::u32x4*)(HB + row * 1024 + u.pn * 128 + wc * 32 + 8 * fq) = w; } } }
    }
};
struct EpiBias2 {
    static constexpr bool PERM = true;
    bf16* Y2; const float* b2; LAS const int* tab;
    __device__ __forceinline__ void operator()(const pg8::f32x4 (&acc)[2][2][4][2], const pg8::Unit& u, int wr, int wc, int fr, int fq) const {
        const int e = __builtin_amdgcn_readfirstlane(tab[u.pm]) >> 16; const int col0 = u.pn * 256 + wc * 32 + 8 * fq; const float* bb = b2 + (size_t)e * 1024 + col0;
        pg8::f32x4 bv[2][2];
#pragma unroll
        for (int bj = 0; bj < 2; ++bj)
#pragma unroll
            for (int n = 0; n < 2; ++n) bv[bj][n] = *(const pg8::f32x4*)(bb + bj * 128 + 4 * n);
#pragma unroll
        for (int ai = 0; ai < 2; ++ai) { v2u wprev[2] = {(v2u){0u, 0u}, (v2u){0u, 0u}};
#pragma unroll
            for (int m = 0; m < 4; ++m) { bf16* rowp = Y2 + ((size_t)u.pm * 256 + ai * 128 + wr * 64 + m * 16 + fr) * 1024 + col0;
#pragma unroll
                for (int bj = 0; bj < 2; ++bj) { const pg8::f32x4 v0 = acc[ai][bj][m][0] + bv[bj][0], v1 = acc[ai][bj][m][1] + bv[bj][1];
                    if constexpr (FP8_Y2) { float t[8];
#pragma unroll
                        for (int i = 0; i < 4; ++i) { t[i] = fminf(fmaxf(v0[i] * 16.f, -448.f), 448.f); t[4 + i] = fminf(fmaxf(v1[i] * 16.f, -448.f), 448.f); }
                        v2u w; w.x = pk4_fp8(t[0], t[1], t[2], t[3]); w.y = pk4_fp8(t[4], t[5], t[6], t[7]);
                        if (m & 1) { const v4u ww = widen_pair(wprev[bj], w);
                            *(GAS v4u*)((unsigned char*)Y2 + ((size_t)u.pm * 256 + ai * 128 + wr * 64 + (m - 1 + (fq & 1)) * 16 + fr) * 1024 + (col0 & ~8) + bj * 128) = ww; }
                        else wprev[bj] = w; }
                    else { pg8::u32x4 w; w.x = pg8::cvt_pk_bf16(v0[0], v0[1]); w.y = pg8::cvt_pk_bf16(v0[2], v0[3]); w.z = pg8::cvt_pk_bf16(v1[0], v1[1]); w.w = pg8::cvt_pk_bf16(v1[2], v1[3]);
                        *(pg8::u32x4*)(rowp + bj * 128) = w; } } } }
    }
};

template <int M> __device__ __forceinline__ float xshfl(float x) {
    const int xi = __float_as_int(x);
    if constexpr (M == 1) return __int_as_float(__builtin_amdgcn_update_dpp(xi, xi, 0xB1, 0xF, 0xF, true));
    else if constexpr (M == 2) return __int_as_float(__builtin_amdgcn_update_dpp(xi, xi, 0x4E, 0xF, 0xF, true));
    else if constexpr (M == 32) { auto rr = __builtin_amdgcn_permlane32_swap((unsigned)xi, (unsigned)xi, false, false); return __uint_as_float((lane_now() & 32) ? rr[0] : rr[1]); }
    else return __int_as_float(__builtin_amdgcn_ds_swizzle(xi, (M << 10) | 0x1f));
}
constexpr size_t TAB_WRIMG = 65536;
__device__ __forceinline__ void p0_wr_image(Frame& F, const float* wr_all) {
    unsigned short* img = (unsigned short*)(F.ws + WS_TAB + TAB_WRIMG);
    const int gid0 = (F.vcu * NWAVES + F.wave) * 64 + lane_now(), NG = F.G * NTHR;
    for (int gid = gid0; gid < 2 * 32768; gid += NG) { const int layer = gid >> 15, k = (gid & 32767) >> 5, e = gid & 31; const float w = wr_all[(size_t)layer * 32768 + k * 32 + e];
        const unsigned hi = f2bf(w); const float rem = w - __builtin_bit_cast(float, hi << 16); const unsigned lo = f2bf(rem);
        const size_t o = (size_t)layer * 65536 + e * 1024 + ((((k >> 3) ^ (e & 15)) << 3) + (k & 7));
        img[o] = (unsigned short)hi; img[o + 32768] = (unsigned short)lo; }
}
__device__ __forceinline__ float rowmax16(float v) {
    v = fmaxf(v, __int_as_float(__builtin_amdgcn_update_dpp(0, __float_as_int(v), 0xB1, 0xF, 0xF, true)));
    v = fmaxf(v, __int_as_float(__builtin_amdgcn_update_dpp(0, __float_as_int(v), 0x4E, 0xF, 0xF, true)));
    v = fmaxf(v, __int_as_float(__builtin_amdgcn_update_dpp(0, __float_as_int(v), 0x124, 0xF, 0xF, true)));
    v = fmaxf(v, __int_as_float(__builtin_amdgcn_update_dpp(0, __float_as_int(v), 0x128, 0xF, 0xF, true)));
    return v;
}
__device__ __forceinline__ void phase_router(Frame& F, int layer, int row0, int nrows, const float* gnorm, const float* wr, const float* br, const float* fw1 = nullptr, const float* fw2 = nullptr) {
    const bf16* XS = (const bf16*)(F.ws + WS_XS); bf16* XN = (bf16*)(F.ws + WS_XN); const float* MODL = (const float*)(F.ws + WS_MOD) + (size_t)layer * 9 * 6144;
    int* eidx = (int*)(F.ws + WS_ROUTE + RT_EIDX); float* egate = (float*)(F.ws + WS_ROUTE + RT_EGATE); int* epos = (int*)(F.ws + WS_ROUTE + RT_EPOS); int* list = (int*)(F.ws + WS_ROUTE + RT_LIST);
    LAS int* hist = (LAS int*)(F.misc + MISC_HIST); LAS int* base = (LAS int*)(F.misc + MISC_BASE); LAS int* rec = (LAS int*)(F.misc + MISC_REC);
    (void)wr;
    const int ntiles = nrows >> 4; const int tile = F.wave * F.G + F.vcu; const bool have = tile < ntiles;
    int lane = lane_now(); const int fr = lane & 15, fq = lane >> 4;
    const int rbase = row0 + (have ? tile : 0) * 16; const int row = rbase + fr; const bf16* x = XS + (size_t)row * D + 8 * fq; const float* m = MODL + (size_t)row_modrow(rbase) * 6144 + 8 * fq; const float* gp = gnorm + 8 * fq;
#ifndef RT_BLK
#define RT_BLK 8
#endif
#ifdef MK_RT_SKIP
#define RT_SKIP(k) (F.li > 0 && MK_RT_SKIP == (k))
#else
#define RT_SKIP(k) false
#endif
    unsigned xr[32][4]; float ss = 0.f;
    { const v4u* img = (const v4u*)(F.ws + WS_TAB + TAB_WRIMG + (size_t)layer * 131072); const int t0 = tid_now(F); v4u tmp[16];
#pragma unroll
        for (int i = 0; i < 16; ++i) tmp[i] = RT_SKIP(3) ? (v4u){0u, 0u, 0u, 0u} : img[t0 + i * NTHR];
        if (have && !RT_SKIP(4)) {
#pragma unroll
            for (int s = 0; s < 32; ++s) { const v4u w = *(const GAS v4u*)(x + 32 * s); xr[s][0] = w.x; xr[s][1] = w.y; xr[s][2] = w.z; xr[s][3] = w.w; }
#pragma unroll
            for (int s = 0; s < 32; ++s)
#pragma unroll
                for (int j = 0; j < 4; ++j) { const float a = bf_lo(xr[s][j]), b = bf_hi(xr[s][j]); ss += a * a + b * b; }
        }
#pragma unroll
        for (int i = 0; i < 16; ++i) *(LAS v4u*)(F.lds + RING_OFF + (t0 + i * NTHR) * 16) = tmp[i];
        if (t0 < 32) hist[t0] = 0; }
    __syncthreads();
    if (have) {
        ss += xshfl<16>(ss); ss += xshfl<32>(ss);
        const float rstd = rsqrtf(ss * (1.f / D) + 1e-6f);
        f32x4 acc0 = (f32x4){0.f, 0.f, 0.f, 0.f}, acc1 = acc0;
        LAS const unsigned char* bb = F.lds + RING_OFF + fr * 2048;
        f32x4 nx[2][6];
#define RT_LOAD(b_, s_) do { nx[b_][0] = *(const GAS f32x4*)(gp + 32 * (s_)); nx[b_][1] = *(const GAS f32x4*)(gp + 32 * (s_) + 4); \
        nx[b_][2] = *(const GAS f32x4*)(m + 4 * D + 32 * (s_)); nx[b_][3] = *(const GAS f32x4*)(m + 4 * D + 32 * (s_) + 4); nx[b_][4] = *(const GAS f32x4*)(m + 3 * D + 32 * (s_)); nx[b_][5] = *(const GAS f32x4*)(m + 3 * D + 32 * (s_) + 4); } while (0)
        RT_LOAD(0, 0); RT_LOAD(1, 1);
        bf16x8 Bn[4];
#define RT_LDB(s_) do { const int co_ = ((4 * (s_) + fq) ^ fr) << 4; Bn[0] = *(const LAS bf16x8*)(bb + co_); Bn[1] = *(const LAS bf16x8*)(bb + 32768 + co_); Bn[2] = *(const LAS bf16x8*)(bb + 65536 + co_); Bn[3] = *(const LAS bf16x8*)(bb + 65536 + 32768 + co_); } while (0)
        if (!RT_SKIP(1))
#pragma unroll
        for (int s = 0; s < 32; ++s) {
            const f32x4 ga = nx[s & 1][0], gb = nx[s & 1][1], sca = nx[s & 1][2], scb = nx[s & 1][3], sha = nx[s & 1][4], shb = nx[s & 1][5];
            if (s + 2 < 32) RT_LOAD(s & 1, s + 2);
            __builtin_amdgcn_sched_barrier(0);
            const f32x4 xa = (f32x4){bf_lo(xr[s][0]), bf_hi(xr[s][0]), bf_lo(xr[s][1]), bf_hi(xr[s][1])}, xb = (f32x4){bf_lo(xr[s][2]), bf_hi(xr[s][2]), bf_lo(xr[s][3]), bf_hi(xr[s][3])};
            const f32x4 ha = xa * rstd * ga * (1.f + sca) + sha, hb = xb * rstd * gb * (1.f + scb) + shb;
            if constexpr (FP8_G1) { xr[s][0] = pk4_fp8(ha[0], ha[1], ha[2], ha[3]); xr[s][1] = pk4_fp8(hb[0], hb[1], hb[2], hb[3]); }
            else { xr[s][0] = pk2(Q8A(ha[0]), Q8A(ha[1])); xr[s][1] = pk2(Q8A(ha[2]), Q8A(ha[3])); xr[s][2] = pk2(Q8A(hb[0]), Q8A(hb[1])); xr[s][3] = pk2(Q8A(hb[2]), Q8A(hb[3])); }
            unsigned hh[4], hl[4];
#pragma unroll
            for (int j = 0; j < 2; ++j) { hh[j] = pk2(ha[2 * j], ha[2 * j + 1]); hh[2 + j] = pk2(hb[2 * j], hb[2 * j + 1]);
                hl[j] = pk2(ha[2 * j] - bf_lo(hh[j]), ha[2 * j + 1] - bf_hi(hh[j])); hl[2 + j] = pk2(hb[2 * j] - bf_lo(hh[2 + j]), hb[2 * j + 1] - bf_hi(hh[2 + j])); }
            const bf16x8 Ah = __builtin_bit_cast(bf16x8, (v4u){hh[0], hh[1], hh[2], hh[3]}), Al = __builtin_bit_cast(bf16x8, (v4u){hl[0], hl[1], hl[2], hl[3]});
            RT_LDB(s); const bf16x8 B0h = Bn[0], B1h = Bn[1], B0l = Bn[2], B1l = Bn[3];
            acc0 = __builtin_amdgcn_mfma_f32_16x16x32_bf16(Ah, B0h, acc0, 0, 0, 0); acc1 = __builtin_amdgcn_mfma_f32_16x16x32_bf16(Ah, B1h, acc1, 0, 0, 0);
            acc0 = __builtin_amdgcn_mfma_f32_16x16x32_bf16(Ah, B0l, acc0, 0, 0, 0); acc1 = __builtin_amdgcn_mfma_f32_16x16x32_bf16(Ah, B1l, acc1, 0, 0, 0);
            acc0 = __builtin_amdgcn_mfma_f32_16x16x32_bf16(Al, B0h, acc0, 0, 0, 0); acc1 = __builtin_amdgcn_mfma_f32_16x16x32_bf16(Al, B1h, acc1, 0, 0, 0);
            __builtin_amdgcn_sched_barrier(0);
        }
#undef RT_LOAD
#undef RT_LDB
#pragma unroll
        for (int s = 0; s < 32; s += 2) {
            if constexpr (FP8_G1) {
                const v4u ww = widen_pair((v2u){xr[s][0], xr[s][1]}, (v2u){xr[s + 1][0], xr[s + 1][1]});
                *(GAS v4u*)((unsigned char*)XN + (size_t)row * D + 32 * (s + (fq & 1)) + 8 * (fq & ~1)) = ww; }
            else { *(GAS v4u*)(XN + (size_t)row * D + 32 * s + 8 * fq) = (v4u){xr[s][0], xr[s][1], xr[s][2], xr[s][3]}; *(GAS v4u*)(XN + (size_t)row * D + 32 * (s + 1) + 8 * fq) = (v4u){xr[s + 1][0], xr[s + 1][1], xr[s + 1][2], xr[s + 1][3]}; } }
        const float b0v = br[fr], b1v = br[fr + 16];
        float k0[4], k1[4];
#pragma unroll
        for (int i = 0; i < 4; ++i) { k0[i] = __int_as_float((__float_as_int(acc0[i] + b0v) & ~31) | (31 - fr)); k1[i] = __int_as_float((__float_as_int(acc1[i] + b1v) & ~31) | (15 - fr)); }
        float tv[4][4]; int te[4][4];
#pragma unroll
        for (int kk = 0; kk < 4; ++kk) {
#pragma unroll
            for (int i = 0; i < 4; ++i) { const float w = rowmax16(fmaxf(k0[i], k1[i])); const int wb = __float_as_int(w); te[i][kk] = 31 - (wb & 31); tv[i][kk] = __int_as_float(wb & ~31);
                k0[i] = (k0[i] == w) ? -3.0e38f : k0[i]; k1[i] = (k1[i] == w) ? -3.0e38f : k1[i]; } }
#pragma unroll
        for (int i = 0; i < 4; ++i) { float p[4], ps = 0.f;
#pragma unroll
            for (int kk = 0; kk < 4; ++kk) { p[kk] = __expf(tv[i][kk] - tv[i][0]); ps += p[kk]; }
            if (fr < 4) { const int e = fr == 0 ? te[i][0] : fr == 1 ? te[i][1] : fr == 2 ? te[i][2] : te[i][3]; const float g = (fr == 0 ? p[0] : fr == 1 ? p[1] : fr == 2 ? p[2] : p[3]) / ps;
                const int r = rbase + 4 * fq + i; const int li = F.wave * 16 + 4 * fq + i;
                const int pl = __hip_atomic_fetch_add(hist + e, 1, __ATOMIC_RELAXED, __HIP_MEMORY_SCOPE_WORKGROUP);
                eidx[r * 4 + fr] = e; egate[r * 4 + fr] = g; rec[(li * 4 + fr) * 2] = e; rec[(li * 4 + fr) * 2 + 1] = pl; } }
    } else if (RF_N > 0 && layer == 0 && fw1 && F.G == 256 && F.wave >= 5) {
        const int it0 = MOE_ITEMS - RF_TOTAL + (F.vcu * 3 + (F.wave - 5)) * RF_N;
        for (int j = 0; j < RF_N; ++j) moe_item_fp8(F.ws, fw1, fw2, 0, it0 + j);
    }
    __syncthreads();
    if (RT_SKIP(2)) return;
    if (tid_now(F) < 32) base[tid_now(F)] = (int)__hip_atomic_fetch_add(F.ctl + CW_CNT + (layer * 32 + tid_now(F)) * 64, (unsigned)hist[tid_now(F)], RLX_AGENT);
    __syncthreads();
    { const int q = tid_now(F); const int w = q >> 6, rit = (q >> 2) & 15, k = q & 3; const int t2 = w * F.G + F.vcu;
        if (t2 < ntiles) { const int r = row0 + t2 * 16 + rit; const int e = rec[q * 2], pos = base[e] + rec[q * 2 + 1]; epos[r * 4 + k] = pos; list[(size_t)e * LCAP + pos] = r; } }
}

__device__ __forceinline__ void phase_combine_rows(Frame& F, int layer, int row0, int nrows, int mode, const float* gnext, const float* MODN, float* out) {
    bf16* XS = (bf16*)(F.ws + WS_XS); bf16* XN = (bf16*)(F.ws + WS_XN); const bf16* Y2 = (const bf16*)(F.ws + WS_Y2); const float* MODL = (const float*)(F.ws + WS_MOD) + (size_t)layer * 9 * 6144;
    const int* eidx = (const int*)(F.ws + WS_ROUTE + RT_EIDX); const float* egate = (const float*)(F.ws + WS_ROUTE + RT_EGATE); const int* epos = (const int*)(F.ws + WS_ROUTE + RT_EPOS);
    LAS const int* pb = (LAS const int*)(F.misc + MISC_PB);
    const int lane_ = lane_now(); const int nloc = (nrows - F.vcu + F.G - 1) / F.G;
    for (int i0 = F.wave; i0 < nloc; i0 += NWAVES * 2) {
        int lane = lane_; asm volatile("" : "+v"(lane));
        const int i1 = i0 + 8; const bool ok1 = i1 < nloc; const int rA = row0 + i0 * F.G + F.vcu, rB = row0 + (ok1 ? i1 : i0) * F.G + F.vcu;
        int eA[4], eB[4], sA[4], sB[4]; float pA[4], pB[4];
#pragma unroll
        for (int k = 0; k < 4; ++k) { eA[k] = eidx[rA * 4 + k]; eB[k] = eidx[rB * 4 + k]; pA[k] = egate[rA * 4 + k]; pB[k] = egate[rB * 4 + k]; sA[k] = epos[rA * 4 + k]; sB[k] = epos[rB * 4 + k]; }
#pragma unroll
        for (int k = 0; k < 4; ++k) { sA[k] += pb[eA[k]] * 256; sB[k] += pb[eB[k]] * 256; }
        v4u yA[4][2], yB[4][2];
#pragma unroll
        for (int k = 0; k < 4; ++k)
#pragma unroll
            for (int h = 0; h < 2; ++h) {
                if constexpr (FP8_Y2) { const v2u a = *(const GAS v2u*)((const unsigned char*)Y2 + (size_t)sA[k] * D + 512 * h + 8 * lane), b = *(const GAS v2u*)((const unsigned char*)Y2 + (size_t)sB[k] * D + 512 * h + 8 * lane);
                    yA[k][h].x = a.x; yA[k][h].y = a.y; yB[k][h].x = b.x; yB[k][h].y = b.y; }
                else { yA[k][h] = *(const GAS v4u*)(Y2 + (size_t)sA[k] * D + 512 * h + 8 * lane); yB[k][h] = *(const GAS v4u*)(Y2 + (size_t)sB[k] * D + 512 * h + 8 * lane); } }
        if constexpr (FP8_Y2) {
#pragma unroll
            for (int k = 0; k < 4; ++k) { pA[k] *= 0.0625f; pB[k] *= 0.0625f; } }
        const float* gA = MODL + (size_t)row_modrow(rA) * 6144 + 5 * D; const float* gB = MODL + (size_t)row_modrow(rB) * 6144 + 5 * D;
        f32x4 xA[2][2], xB[2][2]; float ssA = 0.f, ssB = 0.f;
#pragma unroll
        for (int h = 0; h < 2; ++h) { const v4u xwA = *(const GAS v4u*)(XS + (size_t)rA * D + 512 * h + 8 * lane), xwB = *(const GAS v4u*)(XS + (size_t)rB * D + 512 * h + 8 * lane);
#pragma unroll
            for (int q = 0; q < 2; ++q) { const int c = 512 * h + 8 * lane + 4 * q;
                f32x4 aA = (f32x4){0.f, 0.f, 0.f, 0.f}, aB = aA;
#pragma unroll
                for (int k = 0; k < 4; ++k) {
                    if constexpr (FP8_Y2) { const int wa = (int)(q ? yA[k][h].y : yA[k][h].x), wb = (int)(q ? yB[k][h].y : yB[k][h].x);
                        const auto a01 = __builtin_amdgcn_cvt_pk_f32_fp8(wa, false), a23 = __builtin_amdgcn_cvt_pk_f32_fp8(wa, true), b01 = __builtin_amdgcn_cvt_pk_f32_fp8(wb, false), b23 = __builtin_amdgcn_cvt_pk_f32_fp8(wb, true);
                        aA += pA[k] * (f32x4){a01[0], a01[1], a23[0], a23[1]}; aB += pB[k] * (f32x4){b01[0], b01[1], b23[0], b23[1]}; }
                    else { const unsigned wa0 = q ? yA[k][h].z : yA[k][h].x, wa1 = q ? yA[k][h].w : yA[k][h].y, wb0 = q ? yB[k][h].z : yB[k][h].x, wb1 = q ? yB[k][h].w : yB[k][h].y;
                        aA += pA[k] * (f32x4){bf_lo(wa0), bf_hi(wa0), bf_lo(wa1), bf_hi(wa1)}; aB += pB[k] * (f32x4){bf_lo(wb0), bf_hi(wb0), bf_lo(wb1), bf_hi(wb1)}; } }
                const unsigned xa0 = q ? xwA.z : xwA.x, xa1 = q ? xwA.w : xwA.y, xb0 = q ? xwB.z : xwB.x, xb1 = q ? xwB.w : xwB.y;
                const f32x4 xoA = (f32x4){bf_lo(xa0), bf_hi(xa0), bf_lo(xa1), bf_hi(xa1)}, xoB = (f32x4){bf_lo(xb0), bf_hi(xb0), bf_lo(xb1), bf_hi(xb1)}; const f32x4 ggA = *(const GAS f32x4*)(gA + c), ggB = *(const GAS f32x4*)(gB + c);
                const f32x4 nA = xoA + ggA * aA, nB = xoB + ggB * aB; xA[h][q] = nA; xB[h][q] = nB;
                ssA += (nA[0] * nA[0] + nA[1] * nA[1]) + (nA[2] * nA[2] + nA[3] * nA[3]); ssB += (nB[0] * nB[0] + nB[1] * nB[1]) + (nB[2] * nB[2] + nB[3] * nB[3]); }
            if (mode == 0 || WRITE_XS_ALWAYS) { v4u w; w.x = pk2(xA[h][0][0], xA[h][0][1]); w.y = pk2(xA[h][0][2], xA[h][0][3]); w.z = pk2(xA[h][1][0], xA[h][1][1]); w.w = pk2(xA[h][1][2], xA[h][1][3]); *(GAS v4u*)(XS + (size_t)rA * D + 512 * h + 8 * lane) = w;
                if (ok1) { w.x = pk2(xB[h][0][0], xB[h][0][1]); w.y = pk2(xB[h][0][2], xB[h][0][3]); w.z = pk2(xB[h][1][0], xB[h][1][1]); w.w = pk2(xB[h][1][2], xB[h][1][3]); *(GAS v4u*)(XS + (size_t)rB * D + 512 * h + 8 * lane) = w; } } }
#pragma unroll
        for (int o = 1; o < 64; o <<= 1) { ssA += __shfl_xor(ssA, o); ssB += __shfl_xor(ssB, o); }
        const float rsA = rsqrtf(ssA * (1.f / D) + 1e-6f), rsB = rsqrtf(ssB * (1.f / D) + 1e-6f);
        if (mode == 0) { const float* mA = MODN + (size_t)row_modrow(rA) * 6144; const float* mB = MODN + (size_t)row_modrow(rB) * 6144;
#pragma unroll
            for (int h = 0; h < 2; ++h) { float oA[8], oB[8];
#pragma unroll
                for (int q = 0; q < 2; ++q) { const int c = 512 * h + 8 * lane + 4 * q; const f32x4 gn = *(const GAS f32x4*)(gnext + c);
                    const f32x4 yA_ = xA[h][q] * rsA * gn * (1.f + *(const GAS f32x4*)(mA + D + c)) + *(const GAS f32x4*)(mA + c), yB_ = xB[h][q] * rsB * gn * (1.f + *(const GAS f32x4*)(mB + D + c)) + *(const GAS f32x4*)(mB + c);
                    oA[4 * q] = yA_[0]; oA[4 * q + 1] = yA_[1]; oA[4 * q + 2] = yA_[2]; oA[4 * q + 3] = yA_[3]; oB[4 * q] = yB_[0]; oB[4 * q + 1] = yB_[1]; oB[4 * q + 2] = yB_[2]; oB[4 * q + 3] = yB_[3]; }
                v4u w; w.x = pk2(oA[0], oA[1]); w.y = pk2(oA[2], oA[3]); w.z = pk2(oA[4], oA[5]); w.w = pk2(oA[6], oA[7]);
                *(GAS v4u*)(XN + (size_t)rA * D + 512 * h + 8 * lane) = w;
                if (ok1) { w.x = pk2(oB[0], oB[1]); w.y = pk2(oB[2], oB[3]); w.z = pk2(oB[4], oB[5]); w.w = pk2(oB[6], oB[7]); *(GAS v4u*)(XN + (size_t)rB * D + 512 * h + 8 * lane) = w; } }
        } else {
#pragma unroll
            for (int h = 0; h < 2; ++h)
#pragma unroll
                for (int q = 0; q < 2; ++q) { const int c = 512 * h + 8 * lane + 4 * q; const f32x4 gn = *(const GAS f32x4*)(gnext + c);
                    *(GAS f32x4*)(out + (size_t)(rA - NCTX) * D + c) = xA[h][q] * rsA * gn; if (ok1) *(GAS f32x4*)(out + (size_t)(rB - NCTX) * D + c) = xB[h][q] * rsB * gn; }
        }
    }
}
typedef int v4i __attribute__((ext_vector_type(4)));
__device__ __forceinline__ void phase_combine(Frame& F, int layer, int row0, int nrows, int mode, const float* gnext, const float* MODN, float* out) {
    if constexpr (!FP8_Y2) { phase_combine_rows(F, layer, row0, nrows, mode, gnext, MODN, out); return; }
    bf16* XS = (bf16*)(F.ws + WS_XS); bf16* XN = (bf16*)(F.ws + WS_XN); const unsigned char* Y2 = (const unsigned char*)(F.ws + WS_Y2); const float* MODL = (const float*)(F.ws + WS_MOD) + (size_t)layer * 9 * 6144;
    const int* eidx = (const int*)(F.ws + WS_ROUTE + RT_EIDX); const float* egate = (const float*)(F.ws + WS_ROUTE + RT_EGATE); const int* epos = (const int*)(F.ws + WS_ROUTE + RT_EPOS);
    LAS const int* pb = (LAS const int*)(F.misc + MISC_PB);
    int lane = lane_now(); asm volatile("" : "+v"(lane)); const int c0 = 16 * lane;
    const int NGW = F.G * NWAVES, rpw = (nrows + NGW - 1) / NGW; const int rbeg = row0 + (F.vcu * NWAVES + F.wave) * rpw, rend = (rbeg + rpw < row0 + nrows) ? rbeg + rpw : row0 + nrows;
    f32x4 vg[4], vn[4], vsc[4], vsh[4]; int cur = -1;
#pragma unroll
    for (int q = 0; q < 4; ++q) { vn[q] = *(const GAS f32x4*)(gnext + c0 + 4 * q); vg[q] = vn[q]; vsc[q] = vn[q]; vsh[q] = vn[q]; }
    for (int r = rbeg; r < rend; ) {
        const int mr = row_modrow(r); const bool two = (r + 1 < rend) && (row_modrow(r + 1) == mr); const int rA = r, rB = two ? r + 1 : r; r += two ? 2 : 1;
        if (mr != cur) { cur = mr;
#pragma unroll
            for (int q = 0; q < 4; ++q) { vg[q] = *(const GAS f32x4*)(MODL + (size_t)mr * 6144 + 5 * D + c0 + 4 * q);
                if (mode == 0) { vsh[q] = *(const GAS f32x4*)(MODN + (size_t)mr * 6144 + c0 + 4 * q); vsc[q] = *(const GAS f32x4*)(MODN + (size_t)mr * 6144 + D + c0 + 4 * q); } } }
        const v4i eA = *(const GAS v4i*)(eidx + rA * 4), eB = *(const GAS v4i*)(eidx + rB * 4), sA0 = *(const GAS v4i*)(epos + rA * 4), sB0 = *(const GAS v4i*)(epos + rB * 4);
        const f32x4 pA = *(const GAS f32x4*)(egate + rA * 4) * 0.0625f, pB = *(const GAS f32x4*)(egate + rB * 4) * 0.0625f;
        v4u yA[4], yB[4];
#pragma unroll
        for (int k = 0; k < 4; ++k) { const int sa = sA0[k] + pb[eA[k]] * 256, sb = sB0[k] + pb[eB[k]] * 256;
            yA[k] = *(const GAS v4u*)(Y2 + (size_t)sa * D + c0); yB[k] = *(const GAS v4u*)(Y2 + (size_t)sb * D + c0); }
        const v4u xa0 = *(const GAS v4u*)(XS + (size_t)rA * D + c0), xa1 = *(const GAS v4u*)(XS + (size_t)rA * D + c0 + 8), xb0 = *(const GAS v4u*)(XS + (size_t)rB * D + c0), xb1 = *(const GAS v4u*)(XS + (size_t)rB * D + c0 + 8);
        f32x4 xA[4], xB[4]; float ssA = 0.f, ssB = 0.f;
#pragma unroll
        for (int q = 0; q < 4; ++q) { f32x4 aA = (f32x4){0.f, 0.f, 0.f, 0.f}, aB = aA;
#pragma unroll
            for (int k = 0; k < 4; ++k) { const int wa = (int)(q == 0 ? yA[k].x : q == 1 ? yA[k].y : q == 2 ? yA[k].z : yA[k].w), wb = (int)(q == 0 ? yB[k].x : q == 1 ? yB[k].y : q == 2 ? yB[k].z : yB[k].w);
                const auto a01 = __builtin_amdgcn_cvt_pk_f32_fp8(wa, false), a23 = __builtin_amdgcn_cvt_pk_f32_fp8(wa, true), b01 = __builtin_amdgcn_cvt_pk_f32_fp8(wb, false), b23 = __builtin_amdgcn_cvt_pk_f32_fp8(wb, true);
                aA += pA[k] * (f32x4){a01[0], a01[1], a23[0], a23[1]}; aB += pB[k] * (f32x4){b01[0], b01[1], b23[0], b23[1]}; }
            const v4u& xwA = q < 2 ? xa0 : xa1; const v4u& xwB = q < 2 ? xb0 : xb1;
            const unsigned ua0 = (q & 1) ? xwA.z : xwA.x, ua1 = (q & 1) ? xwA.w : xwA.y, ub0 = (q & 1) ? xwB.z : xwB.x, ub1 = (q & 1) ? xwB.w : xwB.y;
            const f32x4 nA = (f32x4){bf_lo(ua0), bf_hi(ua0), bf_lo(ua1), bf_hi(ua1)} + vg[q] * aA, nB = (f32x4){bf_lo(ub0), bf_hi(ub0), bf_lo(ub1), bf_hi(ub1)} + vg[q] * aB; xA[q] = nA; xB[q] = nB;
            ssA += (nA[0] * nA[0] + nA[1] * nA[1]) + (nA[2] * nA[2] + nA[3] * nA[3]); ssB += (nB[0] * nB[0] + nB[1] * nB[1]) + (nB[2] * nB[2] + nB[3] * nB[3]); }
        if (mode == 0 || WRITE_XS_ALWAYS) {
#pragma unroll
            for (int h = 0; h < 2; ++h) { v4u w; w.x = pk2(xA[2 * h][0], xA[2 * h][1]); w.y = pk2(xA[2 * h][2], xA[2 * h][3]); w.z = pk2(xA[2 * h + 1][0], xA[2 * h + 1][1]); w.w = pk2(xA[2 * h + 1][2], xA[2 * h + 1][3]); *(GAS v4u*)(XS + (size_t)rA * D + c0 + 8 * h) = w;
                if (two) { w.x = pk2(xB[2 * h][0], xB[2 * h][1]); w.y = pk2(xB[2 * h][2], xB[2 * h][3]); w.z = pk2(xB[2 * h + 1][0], xB[2 * h + 1][1]); w.w = pk2(xB[2 * h + 1][2], xB[2 * h + 1][3]); *(GAS v4u*)(XS + (size_t)rB * D + c0 + 8 * h) = w; } } }
#pragma unroll
        for (int o = 1; o < 64; o <<= 1) { ssA += __shfl_xor(ssA, o); ssB += __shfl_xor(ssB, o); }
        const float rsA = rsqrtf(ssA * (1.f / D) + 1e-6f), rsB = rsqrtf(ssB * (1.f / D) + 1e-6f);
        if (mode == 0) {
#pragma unroll
            for (int h = 0; h < 2; ++h) { f32x4 oA[2], oB[2];
#pragma unroll
                for (int j = 0; j < 2; ++j) { const int q = 2 * h + j; oA[j] = xA[q] * rsA * vn[q] * (1.f + vsc[q]) + vsh[q]; oB[j] = xB[q] * rsB * vn[q] * (1.f + vsc[q]) + vsh[q]; }
                v4u w; w.x = pk2(oA[0][0], oA[0][1]); w.y = pk2(oA[0][2], oA[0][3]); w.z = pk2(oA[1][0], oA[1][1]); w.w = pk2(oA[1][2], oA[1][3]); *(GAS v4u*)(XN + (size_t)rA * D + c0 + 8 * h) = w;
                if (two) { w.x = pk2(oB[0][0], oB[0][1]); w.y = pk2(oB[0][2], oB[0][3]); w.z = pk2(oB[1][0], oB[1][1]); w.w = pk2(oB[1][2], oB[1][3]); *(GAS v4u*)(XN + (size_t)rB * D + c0 + 8 * h) = w; } }
        } else {
#pragma unroll
            for (int q = 0; q < 4; ++q) { *(GAS f32x4*)(out + (size_t)(rA - NCTX) * D + c0 + 4 * q) = xA[q] * rsA * vn[q]; if (two) *(GAS f32x4*)(out + (size_t)(rB - NCTX) * D + c0 + 4 * q) = xB[q] * rsB * vn[q]; }
        }
    }
}
}
namespace mk {
template <bool QOUT = false> __device__ __forceinline__ void p0_dense_weight(Frame& F, const float* W, int K, int N, bf16* WT, int rot) {
    LAS float* scr = (LAS float*)(F.lds + RING_OFF + F.wave * 16384);
    const int NGW = F.G * NWAVES; const int gw = (F.vcu * NWAVES + F.wave + rot) % NGW;
    const int nb = N / 32, items = (K / 64) * nb;
    for (int it = gw; it < items; it += NGW) { const int kb = it / nb, n0 = (it % nb) * 32; transpose_item<false, QOUT>(W, N, kb * 64, n0, WT + (size_t)n0 * K + kb * 64, K, scr, lane_now()); }
}
__device__ __forceinline__ void p0_gate_weights(Frame& F, const float* ga, const float* gx, int rot) {
    LAS float* scr = (LAS float*)(F.lds + RING_OFF + F.wave * 16384);
    const int NGW = F.G * NWAVES; const int gw = (F.vcu * NWAVES + F.wave + rot) % NGW;
    bf16* WG = (bf16*)(F.ws + WS_WGATE);
    for (int it = gw; it < 16 * 32; it += NGW) { const int mat = it >> 5, r = it & 31, kb = r >> 3, nbk = r & 7, n0 = nbk * 32; const int ty = mat & 1, dg = mat >> 1;
        const float* W = (ty ? gx : ga) + (size_t)dg * 65536; const int jt = n0 >> 7, rr = (n0 & 127) + (ty ? 128 : 0);
        transpose_item(W, 256, kb * 64, n0, WG + ((size_t)(dg * 2 + jt) * 256 + rr) * 256 + kb * 64, 256, scr, lane_now()); }
}
__device__ __forceinline__ void p0_adaln(Frame& F, const float* c, const float* cctx, const float* w_mod, const float* b_mod) {
    LAS float* sil = (LAS float*)(F.lds + RING_OFF);
    LAS float* part = (LAS float*)(F.lds + RING_OFF + 40960);
    float* MOD = (float*)(F.ws + WS_MOD);
    if (F.vcu >= 192 && F.G >= 256) return;
    for (int idx = tid_now(F); idx < 9 * 1024; idx += NTHR) { const float v = idx < 8192 ? c[idx] : cctx[idx - 8192]; sil[idx] = v / (1.f + __expf(-v)); }
    __syncthreads();
    for (int item = F.vcu; item < 192; item += F.G) {
        const int layer = item / 96, n0 = (item % 96) * 64; const float* w = w_mod + (size_t)layer * 1024 * 6144 + n0 + lane_now(); const int k0 = F.wave * 128;
        float acc[9];
#pragma unroll
        for (int b = 0; b < 9; ++b) acc[b] = 0.f;
        for (int kk = 0; kk < 128; kk += 16) { float wv[16];
#pragma unroll
            for (int j = 0; j < 16; ++j) wv[j] = w[(size_t)(k0 + kk + j) * 6144];
#pragma unroll
            for (int q = 0; q < 4; ++q)
#pragma unroll
                for (int b = 0; b < 9; ++b) { const f32x4 s = *(const LAS f32x4*)(sil + b * 1024 + k0 + kk + 4 * q); acc[b] += s[0] * wv[4 * q] + s[1] * wv[4 * q + 1] + s[2] * wv[4 * q + 2] + s[3] * wv[4 * q + 3]; } }
#pragma unroll
        for (int b = 0; b < 9; ++b) part[(F.wave * 9 + b) * 64 + lane_now()] = acc[b];
        __syncthreads();
        for (int q = tid_now(F); q < 9 * 64; q += NTHR) { const int b = q >> 6, l = q & 63; float s = 0.f;
#pragma unroll
            for (int wv = 0; wv < 8; ++wv) s += part[(wv * 9 + b) * 64 + l];
            MOD[((size_t)layer * 9 + b) * 6144 + n0 + l] = s + b_mod[layer * 6144 + n0 + l]; }
        __syncthreads();
    }
}
__device__ __forceinline__ void p0_wait_adaln(Frame& F) {
    if (tid_now(F) == 0) { unsigned sp = 0; while (__hip_atomic_load(F.ctl + CW_ADALN, RLX_AGENT) < 192u) { __builtin_amdgcn_s_sleep(2); if (++sp > (1u << 22)) break; }
        __builtin_amdgcn_fence(__ATOMIC_ACQUIRE, "agent"); asm volatile("s_waitcnt vmcnt(0)" ::: "memory"); }
    __syncthreads();
}
constexpr int TAB_COS = 0, TAB_SIN = 1024, TAB_SP = 2048, TAB_LAM = 4096;
__device__ __forceinline__ void p0_tables(Frame& F, const float* lq1, const float* lk1, const float* lq2, const float* lk2, const float* lru) {
    if (F.vcu != (F.G > 200 ? 200 : 0)) return;
    float* T = (float*)(F.ws + WS_TAB);
    for (int i = tid_now(F); i < 1024; i += NTHR) { const int pos = i >> 4, f = i & 15; const float inv = powf(10000.f, -(float)f / 16.f); const float ang = (float)pos * inv; T[TAB_COS + i] = cosf(ang); T[TAB_SIN + i] = sinf(ang); }
    for (int i = tid_now(F); i < 2048; i += NTHR) T[TAB_SP + i] = log1pf(expf(-lru[i]));
    if (tid_now(F) == 0) { float a = 0.f, b = 0.f; for (int i = 0; i < 64; ++i) { a += lq1[i] * lk1[i]; b += lq2[i] * lk2[i]; } T[TAB_LAM] = expf(a) - expf(b) + 0.2f; }
}

__device__ __forceinline__ void phase_norm1_l0(Frame& F, const float* x, const float* ctx, const float* g) {
    bf16* XN = (bf16*)(F.ws + WS_XN); const float* MODL = (const float*)(F.ws + WS_MOD);
    int lane_ = lane_now(); asm volatile("" : "+v"(lane_)); const int lane = lane_;
    const int gw = F.vcu * NWAVES + F.wave, NGW = F.G * NWAVES;
    for (int r0 = gw; r0 < NTOK; r0 += 2 * NGW) {
        const int r1 = r0 + NGW; const bool ok1 = r1 < NTOK; const int rr[2] = {r0, ok1 ? r1 : r0};
        f32x4 v[2][2][2]; float ss[2] = {0.f, 0.f};
#pragma unroll
        for (int t = 0; t < 2; ++t) { const float* src = rr[t] < NCTX ? ctx + (size_t)rr[t] * D : x + (size_t)(rr[t] - NCTX) * D;
#pragma unroll
            for (int h = 0; h < 2; ++h)
#pragma unroll
                for (int q = 0; q < 2; ++q) v[t][h][q] = *(const GAS f32x4*)(src + 512 * h + 8 * lane + 4 * q); }
#pragma unroll
        for (int t = 0; t < 2; ++t)
#pragma unroll
            for (int h = 0; h < 2; ++h)
#pragma unroll
                for (int q = 0; q < 2; ++q) ss[t] += (v[t][h][q][0] * v[t][h][q][0] + v[t][h][q][1] * v[t][h][q][1]) + (v[t][h][q][2] * v[t][h][q][2] + v[t][h][q][3] * v[t][h][q][3]);
#pragma unroll
        for (int o = 1; o < 64; o <<= 1) { ss[0] += __shfl_xor(ss[0], o); ss[1] += __shfl_xor(ss[1], o); }
#pragma unroll
        for (int t = 0; t < 2; ++t) { if (t == 1 && !ok1) break; const float rstd = rsqrtf(ss[t] * (1.f / D) + 1e-6f); const float* m = MODL + (size_t)row_modrow(rr[t]) * 6144;
#pragma unroll
            for (int h = 0; h < 2; ++h) { float o[8];
#pragma unroll
                for (int q = 0; q < 2; ++q) { const int c = 512 * h + 8 * lane + 4 * q; const f32x4 gn = *(const GAS f32x4*)(g + c), sc = *(const GAS f32x4*)(m + D + c), sh = *(const GAS f32x4*)(m + c);
                    const f32x4 y = v[t][h][q] * rstd * gn * (1.f + sc) + sh; o[4 * q] = y[0]; o[4 * q + 1] = y[1]; o[4 * q + 2] = y[2]; o[4 * q + 3] = y[3]; }
                v4u w; w.x = pk2(o[0], o[1]); w.y = pk2(o[2], o[3]); w.z = pk2(o[4], o[5]); w.w = pk2(o[6], o[7]);
                *(GAS v4u*)(XN + (size_t)rr[t] * D + 512 * h + 8 * lane) = w; } }
    }
}

struct DenseSched { static constexpr bool RAW_EARLY = false;
    pg8::TileOrder ord; const char* A; const char* W; int a_pitch; int K2;
    __device__ __forceinline__ bool next(int i, pg8::Unit& u) const { return ord.tile(i, u); }
    __device__ __forceinline__ const char* a_base(const pg8::Unit& u) const { return A + (size_t)u.pm * 256 * a_pitch; }
    __device__ __forceinline__ const char* b_base(const pg8::Unit& u) const { return W + (size_t)u.pn * 256 * K2; }
    __device__ __forceinline__ unsigned a_rowraw(const pg8::Unit&, int) const { return 0u; }
};
constexpr float ATT_C2 = 0.125f * 1.4426950408889634f;
struct EpiInProj0 {
    static constexpr bool PERM = false;
    bf16* PROJ; const float* TAB;
    __device__ __forceinline__ void operator()(const pg8::f32x4 (&acc)[2][2][4][2], const pg8::Unit& u, int wr, int wc, int fr, int fq) const {
        const bool rope = u.pn < 4 && u.pm >= 8; const float sc = u.pn < 2 ? ATT_C2 : 1.f; const int axis = wc & 1;
        pg8::f32x4 cs[2][4], sn[2][4];
#pragma unroll
        for (int ai = 0; ai < 2; ++ai)
#pragma unroll
            for (int m = 0; m < 4; ++m) { cs[ai][m] = (pg8::f32x4){1.f, 1.f, 1.f, 1.f}; sn[ai][m] = (pg8::f32x4){0.f, 0.f, 0.f, 0.f};
                if (rope) { const int r = u.pm * 256 + ai * 128 + wr * 64 + m * 16 + fr; const int t = (r - NCTX) & 2047; const int pos = axis ? (t & 63) : (t >> 6);
                    cs[ai][m] = *(const pg8::f32x4*)(TAB + TAB_COS + pos * 16 + 4 * fq); sn[ai][m] = *(const pg8::f32x4*)(TAB + TAB_SIN + pos * 16 + 4 * fq); } }
#pragma unroll
        for (int ai = 0; ai < 2; ++ai) { v2u p1[2], p2[2];
#pragma unroll
            for (int m = 0; m < 4; ++m) {
#pragma unroll
                for (int bj = 0; bj < 2; ++bj) { const pg8::f32x4 x1 = acc[ai][bj][m][0], x2 = acc[ai][bj][m][1];
                    const pg8::f32x4 o1 = (x1 * cs[ai][m] - x2 * sn[ai][m]) * sc, o2 = (x2 * cs[ai][m] + x1 * sn[ai][m]) * sc;
                    v2u w1, w2; w1.x = pg8::cvt_pk_bf16(o1[0], o1[1]); w1.y = pg8::cvt_pk_bf16(o1[2], o1[3]); w2.x = pg8::cvt_pk_bf16(o2[0], o2[1]); w2.y = pg8::cvt_pk_bf16(o2[2], o2[3]);
                    if (m & 1) { const int r = u.pm * 256 + ai * 128 + wr * 64 + (m - 1 + (fq & 1)) * 16 + fr;
                        bf16* rowp = PROJ + (size_t)r * 3072 + u.pn * 256 + wc * 32 + 4 * (fq & ~1) + bj * 128;
                        *(GAS v4u*)rowp = widen_pair(p1[bj], w1); *(GAS v4u*)(rowp + 16) = widen_pair(p2[bj], w2); }
                    else { p1[bj] = w1; p2[bj] = w2; } } } }
    }
};
struct EpiResid {
    static constexpr bool PERM = true;
    bf16* XS; const float* x_in; const float* ctx_in; const float* gate;
    int row0;
    __device__ __forceinline__ void operator()(const pg8::f32x4 (&acc)[2][2][4][2], const pg8::Unit& u, int wr, int wc, int fr, int fq) const {
        const int col0 = u.pn * 256 + wc * 32 + 8 * fq; const int rb = row0 + u.pm * 256 + wr * 64 + fr;
        const float* g = gate + (size_t)row_modrow(rb) * 6144 + col0;
        pg8::f32x4 gg[2][2];
#pragma unroll
        for (int bj = 0; bj < 2; ++bj)
#pragma unroll
            for (int n = 0; n < 2; ++n) gg[bj][n] = *(const pg8::f32x4*)(g + bj * 128 + n * 4);
#pragma unroll
        for (int ai = 0; ai < 2; ++ai) {
            pg8::f32x4 bb[4][2][2];
            if (x_in) {
#pragma unroll
                for (int m = 0; m < 4; ++m) { const int r = rb + ai * 128 + m * 16; const float* bp = (r < NCTX ? ctx_in + (size_t)r * D : x_in + (size_t)(r - NCTX) * D) + col0;
#pragma unroll
                    for (int bj = 0; bj < 2; ++bj)
#pragma unroll
                        for (int n = 0; n < 2; ++n) bb[m][bj][n] = *(const pg8::f32x4*)(bp + bj * 128 + n * 4); }
            } else { v4u bw[4][2];
#pragma unroll
                for (int m = 0; m < 4; ++m)
#pragma unroll
                    for (int bj = 0; bj < 2; ++bj) bw[m][bj] = *(const GAS v4u*)(XS + (size_t)(rb + ai * 128 + m * 16) * D + col0 + bj * 128);
#pragma unroll
                for (int m = 0; m < 4; ++m)
#pragma unroll
                    for (int bj = 0; bj < 2; ++bj) { const v4u w = bw[m][bj]; bb[m][bj][0] = (pg8::f32x4){bf_lo(w.x), bf_hi(w.x), bf_lo(w.y), bf_hi(w.y)}; bb[m][bj][1] = (pg8::f32x4){bf_lo(w.z), bf_hi(w.z), bf_lo(w.w), bf_hi(w.w)}; }
            }
#pragma unroll
            for (int m = 0; m < 4; ++m) { bf16* op = XS + (size_t)(rb + ai * 128 + m * 16) * D + col0;
#pragma unroll
                for (int bj = 0; bj < 2; ++bj) { const pg8::f32x4 o0 = bb[m][bj][0] + gg[bj][0] * acc[ai][bj][m][0], o1 = bb[m][bj][1] + gg[bj][1] * acc[ai][bj][m][1];
                    v4u w; w.x = pk2(o0[0], o0[1]); w.y = pk2(o0[2], o0[3]); w.z = pk2(o1[0], o1[1]); w.w = pk2(o1[2], o1[3]); *(GAS v4u*)(op + bj * 128) = w; } }
            asm volatile("" ::: "memory");
        }
    }
};
}
namespace mk {
namespace att {
#ifndef MK_ATT_DUP
#define MK_ATT_DUP 0
#endif
constexpr int PITCH = 3072;
constexpr int SLOT = 32768, NSL = 4;
static_assert(NSL * SLOT <= RING_BYTES && MISC_REC + 8 * 512 <= LDS_BYTES - MISC_OFF, "attention LDS: four K/V slots fill the ring; the per-wave f32 scratch [8][128] lives in the MISC area");
__device__ __forceinline__ int crow(int r, int hi) { return (r & 3) + 8 * (r >> 2) + 4 * hi; }
#define ATT_WAIT_BAR(N) asm volatile("s_waitcnt vmcnt(" #N ") lgkmcnt(0)\n\ts_barrier" ::: "memory")
typedef short v4i16_t __attribute__((ext_vector_type(4)));
__device__ __forceinline__ s16x4 vtr(LAS const unsigned char* p) { return __builtin_bit_cast(s16x4, __builtin_amdgcn_ds_read_tr16_b64_v4i16((LAS v4i16_t*)p)); }
__device__ __forceinline__ unsigned cvtpk(float lo, float hi) { typedef float f2 __attribute__((ext_vector_type(2))); typedef __bf16 b2 __attribute__((ext_vector_type(2))); f2 v = {lo, hi}; b2 b = __builtin_convertvector(v, b2); return __builtin_bit_cast(unsigned, b); }
__device__ __forceinline__ float max3f(float a, float b, float c) { float r; asm("v_max3_f32 %0, %1, %2, %3" : "=v"(r) : "v"(a), "v"(b), "v"(c)); return r; }
__device__ __forceinline__ float half_swap_max(float m) { auto rr = __builtin_amdgcn_permlane32_swap(__float_as_uint(m), __float_as_uint(m), false, false); return fmaxf(__uint_as_float(rr[0]), __uint_as_float(rr[1])); }
__device__ __forceinline__ float half_swap_sum(float m) { auto rr = __builtin_amdgcn_permlane32_swap(__float_as_uint(m), __float_as_uint(m), false, false); return __uint_as_float(rr[0]) + __uint_as_float(rr[1]); }

template <int ABL = 0> __device__ __forceinline__ void attn_unit(LAS unsigned char* lds, LAS float* scr, const bf16* PROJ, bf16* CAT, const int qrow0, const int krow_ctx, const int krow_lat, const int NT, const int h, const float lam, const float* subln, const int tid_in) {
    int tid = tid_in; asm volatile("" : "+v"(tid));
    const int lane = tid & 63, r32 = lane & 31, hi = lane >> 5; const int wid = __builtin_amdgcn_readfirstlane(tid >> 6); const int mh = wid >> 2, wq = wid & 3;
    LAS float* wsf = scr + wid * 128; LAS float* wsfh = wsf + 4 * hi;
#define CR(r) (((r) & 3) + 8 * ((r) >> 2))
    const int krow_ = 8 * wid + (lane >> 3);
    const bf16* kbase = PROJ + 512 + h * 128 + (size_t)krow_ * PITCH + (((lane & 7) ^ ((krow_ >> 1) & 7)) * 8);
    const bf16* vbase0 = PROJ + 1024 + h * 128 + ((wid >> 2) * 32) + (lane & 3) * 8 + (size_t)(16 * (wid & 3) + (lane >> 2)) * PITCH;
    const bf16* vbase1 = vbase0 + 64;
    const unsigned lds0 = (unsigned)__builtin_amdgcn_readfirstlane((int)(unsigned)(uintptr_t)lds) + (unsigned)wid * 1024u;
#define ATT_GLDS(gsrc, dst) do { unsigned keep_; asm volatile("s_mov_b32 %0, m0\n\ts_mov_b32 m0, %2\n\ts_nop 0\n\tglobal_load_lds_dwordx4 %1, off\n\ts_mov_b32 m0, %0" : "=&s"(keep_) : "v"(gsrc), "s"(dst) : "memory"); } while (0)
#define ATT_DMA(t, slot) do { const size_t kr_ = (size_t)((t) < 4 ? krow_ctx + 64 * (t) : krow_lat + 64 * ((t) - 4)) * PITCH; const unsigned d_ = lds0 + (unsigned)(slot) * SLOT; \
        ATT_GLDS(kbase + kr_, d_); ATT_GLDS(kbase + kr_ + 64, d_ + 8192u); ATT_GLDS(vbase0 + kr_, d_ + 16384u); ATT_GLDS(vbase1 + kr_, d_ + 24576u); } while (0)
#ifndef MK_ATT_LAG
#define MK_ATT_LAG 0
#endif
    ATT_DMA(0, 0); if (MK_ATT_DUP == 4) ATT_DMA(0, 0); ATT_DMA(1, 1); if (MK_ATT_DUP == 4) ATT_DMA(1, 1);
    const bf16* Qw = PROJ + (size_t)(qrow0 + wq * 32 + r32) * PITCH + h * 128 + mh * 64 + hi * 8;
    bf16x8 qr[4];
#pragma unroll
    for (int d0 = 0; d0 < 4; ++d0) qr[d0] = *(const GAS bf16x8*)(Qw + d0 * 16);
    asm volatile("" : "+v"(qr[0]), "+v"(qr[1]), "+v"(qr[2]), "+v"(qr[3]));
    float mrow = 0.f, l_reg = 0.f; f32x16 o[4]; f32x16 negm;
#pragma unroll
    for (int d0 = 0; d0 < 4; ++d0)
#pragma unroll
        for (int r = 0; r < 16; ++r) o[d0][r] = 0.f;
#pragma unroll
    for (int r = 0; r < 16; ++r) negm[r] = 0.f;
    int koffs[4];
#pragma unroll
    for (int d0 = 0; d0 < 4; ++d0) koffs[d0] = mh * 8192 + r32 * 128 + (((2 * d0 + hi) ^ ((r32 >> 1) & 7)) << 4);
    const int voff = 16384 + ((lane >> 4) & 1) * 32 + (lane & 3) * 8 + (4 * hi + ((lane & 15) >> 2)) * 64;
#define SBAR() __builtin_amdgcn_sched_barrier(0)
#define ATT_VF(lo_, hi_) ((bf16x8){lo_[0], lo_[1], lo_[2], lo_[3], hi_[0], hi_[1], hi_[2], hi_[3]})
    v4u pwp[4];
#pragma unroll
    for (int k = 0; k < 4; ++k) pwp[k] = (v4u){0u, 0u, 0u, 0u};
#define ATT_STEP(T_, HASQK, HASPV, PIN, POUT) do { const int t = (T_); \
        if (HASQK) { if (MK_ATT_DUP == 4) { if (t + 1 < NT) { ATT_WAIT_BAR(8); } else { ATT_WAIT_BAR(0); } } else { if (t + 1 < NT) { ATT_WAIT_BAR(4); } else { ATT_WAIT_BAR(0); } } \
            if (MK_ATT_DUP == 5) { ATT_WAIT_BAR(4); } \
            if (t + 2 < NT && ABL != 3) { ATT_DMA(t + 2, (t + 2) & 3); if (MK_ATT_DUP == 4) ATT_DMA(t + 2, (t + 2) & 3); } } \
        f32x16 p0 = negm, p1 = negm; bool resc = false; \
        s16x4 va[16], vb[16];     \
        if (HASPV) { LAS const unsigned char* vq = lds + ((t - 1) & 3) * SLOT + voff; \
            _Pragma("unroll") for (int i = 0; i < 8; ++i) { va[2 * i] = vtr(vq + (i >> 2) * 4096 + (i & 3) * 1024); va[2 * i + 1] = vtr(vq + (i >> 2) * 4096 + (i & 3) * 1024 + 512); } \
            SBAR(); } \
        if (HASQK) { \
            LAS const unsigned char* kp = lds + (t & 3) * SLOT; \
            bf16x8 kf[8]; \
            _Pragma("unroll") for (int d0 = 0; d0 < 4; ++d0) { kf[2 * d0] = *(const LAS bf16x8*)(kp + koffs[d0]); kf[2 * d0 + 1] = *(const LAS bf16x8*)(kp + koffs[d0] + 4096); } \
            if (MK_ATT_DUP == 6) { bf16x8 kg[8]; _Pragma("unroll") for (int d0 = 0; d0 < 4; ++d0) { kg[2 * d0] = *(const volatile LAS bf16x8*)(kp + koffs[d0]); kg[2 * d0 + 1] = *(const volatile LAS bf16x8*)(kp + koffs[d0] + 4096); } \
                _Pragma("unroll") for (int i = 0; i < 8; ++i) asm volatile("" :: "v"(kg[i])); } \
            SBAR(); \
            _Pragma("unroll") for (int d0 = 0; d0 < 4; ++d0) { p0 = __builtin_amdgcn_mfma_f32_32x32x16_bf16(kf[2 * d0], qr[d0], p0, 0, 0, 0); p1 = __builtin_amdgcn_mfma_f32_32x32x16_bf16(kf[2 * d0 + 1], qr[d0], p1, 0, 0, 0); } \
            if (MK_ATT_DUP == 1) { f32x16 q0 = negm, q1 = negm; _Pragma("unroll") for (int d0 = 0; d0 < 4; ++d0) { q0 = __builtin_amdgcn_mfma_f32_32x32x16_bf16(kf[2 * d0], qr[d0], q0, 0, 0, 0); q1 = __builtin_amdgcn_mfma_f32_32x32x16_bf16(kf[2 * d0 + 1], qr[d0], q1, 0, 0, 0); } asm volatile("" :: "v"(q0), "v"(q1)); } \
            SBAR(); \
            asm volatile("s_nop 15\n\ts_nop 7" : "+v"(p0), "+v"(p1));     \
            float rma = max3f(p0[0], p1[0], p0[1]), rmb = max3f(p1[1], p0[2], p1[2]); \
            _Pragma("unroll") for (int r = 3; r < 15; r += 2) { rma = max3f(rma, p0[r], p1[r]); rmb = max3f(rmb, p0[r + 1], p1[r + 1]); } \
            float rm = max3f(rma, rmb, __builtin_fmaxf(p0[15], p1[15])); \
            rm = half_swap_max(rm); \
            if (MK_ATT_DUP == 7) { float r2 = __builtin_fmaxf(p0[0] + 1.f, p1[0] + 1.f); _Pragma("unroll") for (int r = 1; r < 16; ++r) r2 = __builtin_fmaxf(r2, __builtin_fmaxf(p0[r] + 1.f, p1[r] + 1.f)); r2 = half_swap_max(r2); if (__any(r2 > 1.0e30f)) mrow += 1.f; } \
            if (!(HASPV) || __any(rm > 8.f)) { \
                const float dl = !(HASPV) ? rm : __builtin_fmaxf(rm, 0.f); mrow += dl; \
                _Pragma("unroll") for (int r = 0; r < 16; ++r) { p0[r] -= dl; p1[r] -= dl; negm[r] = -mrow; } \
                if (HASPV) { const float f = __builtin_amdgcn_exp2f(-dl); l_reg *= f; if (hi == 0) wsf[r32] = f; resc = true; } \
            } \
            SBAR(); \
        } \
        { LAS const unsigned char* vp = lds + ((t - 1) & 3) * SLOT + voff; \
            f32x2 sacc2 = (f32x2){0.f, 0.f}; \
            if (HASPV) { \
                _Pragma("unroll") for (int i = 0; i < 8; ++i) { vb[2 * i] = vtr(vp + (2 + (i >> 2)) * 4096 + (i & 3) * 1024); vb[2 * i + 1] = vtr(vp + (2 + (i >> 2)) * 4096 + (i & 3) * 1024 + 512); } \
                _Pragma("unroll") for (int ks = 0; ks < 4; ++ks) o[0] = __builtin_amdgcn_mfma_f32_32x32x16_bf16(__builtin_bit_cast(bf16x8, PIN[ks]), ATT_VF(va[2 * ks], va[2 * ks + 1]), o[0], 0, 0, 0); \
                _Pragma("unroll") for (int ks = 0; ks < 4; ++ks) o[1] = __builtin_amdgcn_mfma_f32_32x32x16_bf16(__builtin_bit_cast(bf16x8, PIN[ks]), ATT_VF(va[8 + 2 * ks], va[8 + 2 * ks + 1]), o[1], 0, 0, 0); \
                _Pragma("unroll") for (int ks = 0; ks < 4; ++ks) o[2] = __builtin_amdgcn_mfma_f32_32x32x16_bf16(__builtin_bit_cast(bf16x8, PIN[ks]), ATT_VF(vb[2 * ks], vb[2 * ks + 1]), o[2], 0, 0, 0); \
                _Pragma("unroll") for (int ks = 0; ks < 4; ++ks) o[3] = __builtin_amdgcn_mfma_f32_32x32x16_bf16(__builtin_bit_cast(bf16x8, PIN[ks]), ATT_VF(vb[8 + 2 * ks], vb[8 + 2 * ks + 1]), o[3], 0, 0, 0); \
            } \
            if (HASQK) { \
                if (MK_ATT_DUP == 3) { float sd = 0.f; _Pragma("unroll") for (int r = 0; r < 16; ++r) { sd += __builtin_amdgcn_exp2f(p0[r] - 1.f) + __builtin_amdgcn_exp2f(p1[r] - 1.f); } asm volatile("" :: "v"(sd)); } \
                f32x2 sb2 = (f32x2){0.f, 0.f}, sc2 = sb2, sd2 = sb2;     \
                _Pragma("unroll") for (int r = 0; r < 16; r += 4) { \
                    p0[r] = __builtin_amdgcn_exp2f(p0[r]); p1[r] = __builtin_amdgcn_exp2f(p1[r]); sacc2 += (f32x2){p0[r], p1[r]}; \
                    p0[r + 1] = __builtin_amdgcn_exp2f(p0[r + 1]); p1[r + 1] = __builtin_amdgcn_exp2f(p1[r + 1]); sb2 += (f32x2){p0[r + 1], p1[r + 1]}; \
                    p0[r + 2] = __builtin_amdgcn_exp2f(p0[r + 2]); p1[r + 2] = __builtin_amdgcn_exp2f(p1[r + 2]); sc2 += (f32x2){p0[r + 2], p1[r + 2]}; \
                    p0[r + 3] = __builtin_amdgcn_exp2f(p0[r + 3]); p1[r + 3] = __builtin_amdgcn_exp2f(p1[r + 3]); sd2 += (f32x2){p0[r + 3], p1[r + 3]}; } \
                sacc2 = (sacc2 + sb2) + (sc2 + sd2); l_reg += sacc2[0] + sacc2[1]; \
                POUT[0] = (v4u){cvtpk(p0[0], p0[1]), cvtpk(p0[2], p0[3]), cvtpk(p0[4], p0[5]), cvtpk(p0[6], p0[7])}; \
                POUT[1] = (v4u){cvtpk(p0[8], p0[9]), cvtpk(p0[10], p0[11]), cvtpk(p0[12], p0[13]), cvtpk(p0[14], p0[15])}; \
                POUT[2] = (v4u){cvtpk(p1[0], p1[1]), cvtpk(p1[2], p1[3]), cvtpk(p1[4], p1[5]), cvtpk(p1[6], p1[7])}; \
                POUT[3] = (v4u){cvtpk(p1[8], p1[9]), cvtpk(p1[10], p1[11]), cvtpk(p1[12], p1[13]), cvtpk(p1[14], p1[15])}; \
            } \
            if (HASQK) asm volatile("" : "+v"(POUT[0]), "+v"(POUT[1]), "+v"(POUT[2]), "+v"(POUT[3]), "+v"(l_reg));     \
            if ((HASQK) && (HASPV)) { \
                __builtin_amdgcn_sched_group_barrier(0x100, 16, 0);     \
                _Pragma("unroll") for (int g = 0; g < 16; ++g) { __builtin_amdgcn_sched_group_barrier(0x008, 1, 0); __builtin_amdgcn_sched_group_barrier(0x400, 2, 0); __builtin_amdgcn_sched_group_barrier(0x002, 5, 0); } \
            } \
            SBAR(); \
        } \
        if (resc) { LDS_WAIT(); float fr_[16]; \
            _Pragma("unroll") for (int r = 0; r < 16; ++r) fr_[r] = wsfh[CR(r)]; \
            _Pragma("unroll") for (int d0 = 0; d0 < 4; ++d0) _Pragma("unroll") for (int r = 0; r < 16; ++r) o[d0][r] *= fr_[r]; } \
        SBAR(); } while (0)
    v4u pwq[4];
#pragma unroll
    for (int k = 0; k < 4; ++k) pwq[k] = (v4u){0u, 0u, 0u, 0u};
    ATT_STEP(0, true, false, pwq, pwp);
    for (int tt = 1; tt < NT - 1; tt += 2) { ATT_STEP(tt, true, true, pwp, pwq); ATT_STEP(tt + 1, true, true, pwq, pwp); }
    ATT_STEP(NT - 1, true, true, pwp, pwq);
    ATT_STEP(NT, false, true, pwq, pwp);
#undef ATT_STEP
#undef ATT_VF
#undef SBAR
    l_reg = half_swap_sum(l_reg);
    const float coef = (mh == 0 ? 1.f : -lam) / l_reg;
    if (hi == 0) wsf[64 + r32] = coef;
    ATT_WAIT_BAR(0);
    float cf[16];
#pragma unroll
    for (int r = 0; r < 16; ++r) cf[r] = wsfh[64 + CR(r)];
    LAS float* X = (LAS float*)lds + wq * 4096 + 4 * hi * 128 + r32;
    if (mh == 1) {
#pragma unroll
        for (int d0 = 0; d0 < 4; ++d0)
#pragma unroll
            for (int r = 0; r < 16; ++r) X[CR(r) * 128 + d0 * 32] = o[d0][r] * cf[r];
    }
    ATT_WAIT_BAR(0);
    if (mh == 0) {
        float ssq[16];
#pragma unroll
        for (int r = 0; r < 16; ++r) ssq[r] = 0.f;
#pragma unroll
        for (int d0 = 0; d0 < 4; ++d0)
#pragma unroll
            for (int r = 0; r < 16; ++r) { const float v = o[d0][r] * cf[r] + X[CR(r) * 128 + d0 * 32]; o[d0][r] = v; ssq[r] += v * v; }
#pragma unroll
        for (int r = 0; r < 16; ++r) { float s = ssq[r]; s += __shfl_xor(s, 1); s += __shfl_xor(s, 2); s += __shfl_xor(s, 4); s += __shfl_xor(s, 8); s += __shfl_xor(s, 16); ssq[r] = rsqrtf(s * (1.f / 128.f) + 1e-6f) * 0.8f; }
        LDS_WAIT();
        LAS bf16* stg = (LAS bf16*)(lds + wq * 16384);
        LAS bf16* stgh = stg + 4 * hi * 128 + r32;
#pragma unroll
        for (int d0 = 0; d0 < 4; ++d0) { const float g = subln[d0 * 32 + r32];
#pragma unroll
            for (int r = 0; r < 16; ++r) stgh[CR(r) * 128 + d0 * 32] = (bf16)f2bf(QO(o[d0][r] * ssq[r] * g)); }
        LDS_WAIT();
        bf16* Ow = CAT + (size_t)(qrow0 + wq * 32) * D + h * 128;
        int le = lane; asm volatile("" : "+v"(le));
#pragma unroll
        for (int i = 0; i < 8; ++i) { const int row = i * 4 + (le >> 4), ch = le & 15; const v4u v = *(const LAS v4u*)(stg + row * 128 + ch * 8); *(GAS v4u*)(Ow + (size_t)row * D + ch * 8) = v; }
    }
    ATT_WAIT_BAR(0);
#undef ATT_DMA
#undef ATT_GLDS
#undef CR
}
__device__ __forceinline__ void conv_items(Frame& F, const bf16* PROJ, bf16* CAT, const float* cw) {
    int lane_ = lane_now(); asm volatile("" : "+v"(lane_)); const int lane = lane_;
    const int gw = F.vcu * NWAVES + F.wave, NGW = F.G * NWAVES; const int c0 = 8 * lane;
    float w0[8], w1[8], w2[8];
#pragma unroll
    for (int j = 0; j < 8; ++j) { w0[j] = cw[c0 + j]; w1[j] = cw[512 + c0 + j]; w2[j] = cw[1024 + c0 + j]; }
    for (int it = gw; it < NTOK / 8; it += NGW) {
        const int r0 = it * 8; const int seg0 = r0 < NCTX ? (r0 & ~255) : NCTX + ((r0 - NCTX) & ~2047); const int seg1 = r0 < NCTX ? seg0 + 256 : seg0 + 2048;
        v4u ra[10], rb[10], rg[8];
#pragma unroll
        for (int q = 0; q < 10; ++q) { const int r = r0 - 1 + q; const bool ok = r >= seg0 && r < seg1;
            ra[q] = ok ? *(const GAS v4u*)(PROJ + (size_t)r * att::PITCH + 2048 + c0) : (v4u){0u, 0u, 0u, 0u}; rb[q] = ok ? *(const GAS v4u*)(PROJ + (size_t)r * att::PITCH + 2560 + c0) : (v4u){0u, 0u, 0u, 0u}; }
#pragma unroll
        for (int i = 0; i < 8; ++i) rg[i] = *(const GAS v4u*)(PROJ + (size_t)(r0 + i) * att::PITCH + 1536 + c0);
        float pm1[8], pc[8], pn[8];
#define CV_PROD(dst, a, b) do { dst[0] = bf_lo(a.x) * bf_lo(b.x); dst[1] = bf_hi(a.x) * bf_hi(b.x); dst[2] = bf_lo(a.y) * bf_lo(b.y); dst[3] = bf_hi(a.y) * bf_hi(b.y); \
        dst[4] = bf_lo(a.z) * bf_lo(b.z); dst[5] = bf_hi(a.z) * bf_hi(b.z); dst[6] = bf_lo(a.w) * bf_lo(b.w); dst[7] = bf_hi(a.w) * bf_hi(b.w); } while (0)
        CV_PROD(pm1, ra[0], rb[0]); CV_PROD(pc, ra[1], rb[1]);
#pragma unroll
        for (int i = 0; i < 8; ++i) { const int r = r0 + i; CV_PROD(pn, ra[i + 2], rb[i + 2]);
            const v4u g = rg[i]; const float bg[8] = {bf_lo(g.x), bf_hi(g.x), bf_lo(g.y), bf_hi(g.y), bf_lo(g.z), bf_hi(g.z), bf_lo(g.w), bf_hi(g.w)};
            float o[8];
#pragma unroll
            for (int j = 0; j < 8; ++j) { o[j] = bg[j] * (w0[j] * pm1[j] + w1[j] * pc[j] + w2[j] * pn[j]); pm1[j] = pc[j]; pc[j] = pn[j]; }
            v4u w; w.x = pk2(o[0], o[1]); w.y = pk2(o[2], o[3]); w.z = pk2(o[4], o[5]); w.w = pk2(o[6], o[7]);
            *(GAS v4u*)(CAT + (size_t)r * D + 512 + c0) = w; }
#undef CV_PROD
    }
}
}
template <int ABL = 0> __device__ __forceinline__ void phase_attn(Frame& F, const float* subln, const float* cw, const float* fw1 = nullptr, const float* fw2 = nullptr) {
    const bf16* PROJ = (const bf16*)(F.ws + WS_PROJ); bf16* CAT = (bf16*)(F.ws + WS_CAT); const float lam = ((const float*)(F.ws + WS_TAB))[TAB_LAM];
    int tid_ = tid_now(F); asm volatile("" : "+v"(tid_));
    if (F.G == 256) {
        const int xq = F.vcu >> 5, j = F.vcu & 31;
        for (int pass = 0; pass < 2; ++pass) { const int bh = 4 * xq + 2 * pass + (j >> 4), qb = j & 15, b = bh >> 2, h = bh & 3;
            att::attn_unit<ABL>(F.lds + RING_OFF, (LAS float*)(F.misc + MISC_REC), PROJ, CAT, NCTX + b * SEQ + qb * 128, b * CT, NCTX + b * SEQ, 36, h, lam, subln, tid_); }
    } else {
        for (int u = F.vcu; u < 512; u += F.G) { const int bh = u >> 4, qb = u & 15, b = bh >> 2, h = bh & 3;
            att::attn_unit<ABL>(F.lds + RING_OFF, (LAS float*)(F.misc + MISC_REC), PROJ, CAT, NCTX + b * SEQ + qb * 128, b * CT, NCTX + b * SEQ, 36, h, lam, subln, tid_); }
    }
    for (int u = F.vcu; u < 64; u += F.G) { const int bh = u >> 1, qb = u & 1, b = bh >> 2, h = bh & 3;
        att::attn_unit<ABL>(F.lds + RING_OFF, (LAS float*)(F.misc + MISC_REC), PROJ, CAT, b * CT + qb * 128, b * CT, NCTX + b * SEQ, 4, h, lam, subln, tid_); }
    if (ABL == 0) att::conv_items(F, PROJ, CAT, cw);
    if (ABL == 0 && fw1) tail_fill<4>(F, fw1, fw2);
}
}
namespace mk {
struct EpiBf16 {
    static constexpr bool PERM = true;
    bf16* O; int ldc;
    __device__ __forceinline__ void operator()(const pg8::f32x4 (&acc)[2][2][4][2], const pg8::Unit& u, int wr, int wc, int fr, int fq) const {
        const int col0 = u.pn * 256 + wc * 32 + 8 * fq;
#pragma unroll
        for (int ai = 0; ai < 2; ++ai)
#pragma unroll
            for (int m = 0; m < 4; ++m) { bf16* rowp = O + (size_t)(u.pm * 256 + ai * 128 + wr * 64 + m * 16 + fr) * ldc + col0;
#pragma unroll
                for (int bj = 0; bj < 2; ++bj) { const pg8::f32x4 v0 = acc[ai][bj][m][0], v1 = acc[ai][bj][m][1];
                    pg8::u32x4 w; w.x = pg8::cvt_pk_bf16(v0[0], v0[1]); w.y = pg8::cvt_pk_bf16(v0[2], v0[3]); w.z = pg8::cvt_pk_bf16(v1[0], v1[1]); w.w = pg8::cvt_pk_bf16(v1[2], v1[3]);
                    *(pg8::u32x4*)(rowp + bj * 128) = w; } }
    }
};
struct InProj1Sched { static constexpr bool RAW_EARLY = false;
    pg8::TileOrder ord; int G, c; const char* A; const char* W; int a_pitch;
    __device__ __forceinline__ bool next(int i, pg8::Unit& u) const { const int L = i * G + c; if (L >= 544) return false;
        if (L < 512) { ord.map(L, u); u.pm += 8; } else { const int q = L - 512; u.pm = q >> 2; u.pn = 4 + (q & 3); } return true; }
    __device__ __forceinline__ const char* a_base(const pg8::Unit& u) const { return A + (size_t)u.pm * 256 * 2048; }
    __device__ __forceinline__ const char* b_base(const pg8::Unit& u) const { return W + (size_t)u.pn * 256 * 2048; }
    __device__ __forceinline__ unsigned a_rowraw(const pg8::Unit&, int) const { return 0u; }
};
__device__ __forceinline__ void phase_conv1(Frame& F, const float* cw, const float* cb) {
    const bf16* GU = (const bf16*)(F.ws + WS_PROJ); bf16* XC = (bf16*)(F.ws + WS_XC);
    int lane_ = lane_now(); asm volatile("" : "+v"(lane_)); const int lane = lane_;
    const int gw = F.vcu * NWAVES + F.wave, NGW = F.G * NWAVES;
    for (int it = gw; it < (NTOK / 16) * 2; it += NGW) {
        const int r0 = (it >> 1) * 16, c0 = (it & 1) * 512 + 8 * lane; const int seg0 = r0 < NCTX ? (r0 & ~255) : NCTX + ((r0 - NCTX) & ~2047); const int seg1 = r0 < NCTX ? seg0 + 256 : seg0 + 2048;
        float wf[4][8], wb[4][8], bf_[8], bb_[8];
#pragma unroll
        for (int j = 0; j < 8; ++j) { bf_[j] = cb[c0 + j]; bb_[j] = cb[1024 + c0 + j];
#pragma unroll
            for (int k = 0; k < 4; ++k) { wf[k][j] = cw[k * 1024 + c0 + j]; wb[k][j] = cw[(4 + k) * 1024 + c0 + j]; } }
        v4u raw[22];
#pragma unroll
        for (int q = 0; q < 22; ++q) { const int r = r0 - 3 + q; raw[q] = (r < seg0 || r >= seg1) ? (v4u){0u, 0u, 0u, 0u} : *(const GAS v4u*)(GU + (size_t)r * 2048 + 1024 + c0); }
        float win[7][8];
#define CV_UNPK(dst, a) do { dst[0] = bf_lo(a.x); dst[1] = bf_hi(a.x); dst[2] = bf_lo(a.y); dst[3] = bf_hi(a.y); dst[4] = bf_lo(a.z); dst[5] = bf_hi(a.z); dst[6] = bf_lo(a.w); dst[7] = bf_hi(a.w); } while (0)
#pragma unroll
        for (int q = 0; q < 6; ++q) CV_UNPK(win[q + 1], raw[q]);
#pragma unroll
        for (int i = 0; i < 16; ++i) { const int r = r0 + i;
#pragma unroll
            for (int q = 0; q < 6; ++q)
#pragma unroll
                for (int j = 0; j < 8; ++j) win[q][j] = win[q + 1][j];
            CV_UNPK(win[6], raw[i + 6]);
            float of[8], ob[8];
#pragma unroll
            for (int j = 0; j < 8; ++j) { of[j] = bf_[j] + wf[0][j] * win[0][j] + wf[1][j] * win[1][j] + wf[2][j] * win[2][j] + wf[3][j] * win[3][j];
                ob[j] = bb_[j] + wb[0][j] * win[3][j] + wb[1][j] * win[4][j] + wb[2][j] * win[5][j] + wb[3][j] * win[6][j]; }
            v4u w; w.x = pk2(of[0], of[1]); w.y = pk2(of[2], of[3]); w.z = pk2(of[4], of[5]); w.w = pk2(of[6], of[7]);
            *(GAS v4u*)(XC + (size_t)r * D + c0) = w;
            w.x = pk2(ob[0], ob[1]); w.y = pk2(ob[2], ob[3]); w.z = pk2(ob[4], ob[5]); w.w = pk2(ob[6], ob[7]);
            *(GAS v4u*)(XC + ((size_t)NTOK + r) * D + c0) = w; }
#undef CV_UNPK
    }
}
struct GateSched { static constexpr bool RAW_EARLY = false;
    pg8::TileOrder ord; const char* XC; const char* W; int a_pitch;
    __device__ __forceinline__ bool next(int i, pg8::Unit& u) const { return ord.tile(i, u); }
    __device__ __forceinline__ const char* a_base(const pg8::Unit& u) const { const int d = u.pm >= 72 ? 1 : 0, rt = u.pm - 72 * d; return XC + ((size_t)d * NTOK + (size_t)rt * 256) * 2048 + (u.pn >> 1) * 512; }
    __device__ __forceinline__ const char* b_base(const pg8::Unit& u) const { const int d = u.pm >= 72 ? 1 : 0; return W + (size_t)(d * 8 + u.pn) * 256 * 512; }
    __device__ __forceinline__ unsigned a_rowraw(const pg8::Unit&, int r) const { return (unsigned)((r & ~63) | (4 * (r & 15) + ((r >> 4) & 3))); }
};
template <int CTRL> __device__ __forceinline__ float dppf(float old, float src) { return __int_as_float(__builtin_amdgcn_update_dpp(__float_as_int(old), __float_as_int(src), CTRL, 0xF, 0xF, false)); }
struct EpiGate {
    static constexpr bool PERM = true;
    const bf16* XC; unsigned* AB; const float* gab; const float* gxb; const float* SP;
    __device__ __forceinline__ void operator()(const pg8::f32x4 (&acc)[2][2][4][2], const pg8::Unit& u, int wr, int wc, int fr, int fq) const {
        const int d = u.pm >= 72 ? 1 : 0, rt = u.pm - 72 * d; const int ch0 = (u.pn >> 1) * 256 + (u.pn & 1) * 128 + wc * 32 + 8 * fq;
        pg8::f32x4 ba[2], bx[2], sp[2];
#pragma unroll
        for (int n = 0; n < 2; ++n) { ba[n] = *(const pg8::f32x4*)(gab + d * 1024 + ch0 + 4 * n); bx[n] = *(const pg8::f32x4*)(gxb + d * 1024 + ch0 + 4 * n); sp[n] = *(const pg8::f32x4*)(SP + d * 1024 + ch0 + 4 * n) * (-8.f * 1.4426950408889634f); }
        const size_t rowb = (size_t)d * NTOK + rt * 256 + wr * 64 + 4 * fr;
        v4u xw[4], xn[4];
#pragma unroll
        for (int m = 0; m < 4; ++m) xw[m] = *(const GAS v4u*)(XC + (rowb + m) * D + ch0);
#pragma unroll
        for (int ai = 0; ai < 2; ++ai) {
            if (ai == 0) {
#pragma unroll
                for (int m = 0; m < 4; ++m) xn[m] = *(const GAS v4u*)(XC + (rowb + 128 + m) * D + ch0); }
#pragma unroll
            for (int n = 0; n < 2; ++n) {
                float A[4][4], H[4][4];
#pragma unroll
                for (int m = 0; m < 4; ++m) { const v4u xq = ai == 0 ? xw[m] : xn[m]; const unsigned x01 = n ? xq.z : xq.x, x23 = n ? xq.w : xq.y;
                    const float xc[4] = {bf_lo(x01), bf_hi(x01), bf_lo(x23), bf_hi(x23)};
#pragma unroll
                    for (int i = 0; i < 4; ++i) { const float rp = acc[ai][0][m][n][i] + ba[n][i], ip = acc[ai][1][m][n][i] + bx[n][i];
                        const float rg = __builtin_amdgcn_rcpf(1.f + __builtin_amdgcn_exp2f(-1.4426950408889634f * rp)), ig = __builtin_amdgcn_rcpf(1.f + __builtin_amdgcn_exp2f(-1.4426950408889634f * ip));
                        const float a = __builtin_amdgcn_exp2f(rg * sp[n][i]); A[m][i] = a; H[m][i] = __builtin_amdgcn_sqrtf(fmaxf(1.f - a * a, 0.f)) * ig * xc[i]; } }
                if (d == 0) {
#pragma unroll
                    for (int j = 0; j < 4; ++j) {
#pragma unroll
                        for (int m = 1; m < 4; ++m) { H[m][j] = fmaf(A[m][j], H[m - 1][j], H[m][j]); A[m][j] *= A[m - 1][j]; }
                        float TA = A[3][j], TH = H[3][j];
#define GS_STEP(n_) { const float he_ = dppf<0x110 + n_>(0.f, TH), ae_ = dppf<0x110 + n_>(1.f, TA); TH = fmaf(TA, he_, TH); TA = ae_ * TA; }
                        GS_STEP(1) GS_STEP(2) GS_STEP(4) GS_STEP(8)
#undef GS_STEP
                        const float PA = dppf<0x111>(1.f, TA), PH = dppf<0x111>(0.f, TH);
#pragma unroll
                        for (int m = 0; m < 4; ++m) { H[m][j] = fmaf(A[m][j], PH, H[m][j]); A[m][j] *= PA; } }
                } else {
#pragma unroll
                    for (int j = 0; j < 4; ++j) {
#pragma unroll
                        for (int m = 2; m >= 0; --m) { H[m][j] = fmaf(A[m][j], H[m + 1][j], H[m][j]); A[m][j] *= A[m + 1][j]; }
                        float TA = A[0][j], TH = H[0][j];
#define GS_STEP(n_) { const float he_ = dppf<0x100 + n_>(0.f, TH), ae_ = dppf<0x100 + n_>(1.f, TA); TH = fmaf(TA, he_, TH); TA = ae_ * TA; }
                        GS_STEP(1) GS_STEP(2) GS_STEP(4) GS_STEP(8)
#undef GS_STEP
                        const float PA = dppf<0x101>(1.f, TA), PH = dppf<0x101>(0.f, TH);
#pragma unroll
                        for (int m = 0; m < 4; ++m) { H[m][j] = fmaf(A[m][j], PH, H[m][j]); A[m][j] *= PA; } }
                }
#pragma unroll
                for (int m = 0; m < 4; ++m) *(GAS v4u*)(AB + (rowb + ai * 128 + m) * D + ch0 + 4 * n) = (v4u){pk2(H[m][0], A[m][0]), pk2(H[m][1], A[m][1]), pk2(H[m][2], A[m][2]), pk2(H[m][3], A[m][3])};
            }
        }
    }
};
__device__ __forceinline__ void phase_scan2(Frame& F) {
    const unsigned* AB = (const unsigned*)(F.ws + WS_AB); const bf16* GU = (const bf16*)(F.ws + WS_PROJ); bf16* CAT = (bf16*)(F.ws + WS_CAT);
    int lane_ = lane_now(); asm volatile("" : "+v"(lane_)); const int lane = lane_;
    const int gw = F.vcu * NWAVES + F.wave, NGW = F.G * NWAVES;
    for (int it = gw; it < 8 * 32 * 16; it += NGW) {
        const int cg = it & 15, s = (it >> 4) & 31, b = it >> 9; const int c = cg * 64 + lane;
        float hf = 0.f, hb = 0.f;
        { const int nf = 4 + s, nb = 4 + (31 - s); constexpr unsigned IDW = 0x3F800000u;
            for (int q0 = 0; q0 < nf; q0 += 8) { unsigned v[8];
#pragma unroll
                for (int j = 0; j < 8; ++j) { const int q = q0 + j; const int sc = q < 4 ? b * 4 + q : 32 + b * 32 + (q - 4); v[j] = q < nf ? AB[((size_t)sc * 64 + 63) * D + c] : IDW; }
#pragma unroll
                for (int j = 0; j < 8; ++j) hf = fmaf(bf_hi(v[j]), hf, bf_lo(v[j])); }
            for (int q0 = 0; q0 < nb; q0 += 8) { unsigned v[8];
#pragma unroll
                for (int j = 0; j < 8; ++j) { const int q = q0 + j; const int sc = q < 4 ? b * 4 + (3 - q) : 32 + b * 32 + (31 - (q - 4)); v[j] = q < nb ? AB[((size_t)NTOK + (size_t)sc * 64) * D + c] : IDW; }
#pragma unroll
                for (int j = 0; j < 8; ++j) hb = fmaf(bf_hi(v[j]), hb, bf_lo(v[j])); } }
        const size_t row0 = (size_t)NCTX + (size_t)b * SEQ + s * 64;
#pragma unroll 1
        for (int blk = 0; blk < 4; ++blk) { unsigned wf[16], wb[16]; unsigned short gt[16];
#pragma unroll
            for (int i = 0; i < 16; ++i) { const size_t row = row0 + blk * 16 + i; wf[i] = AB[row * D + c]; wb[i] = AB[((size_t)NTOK + row) * D + c]; gt[i] = GU[row * 2048 + c]; }
#pragma unroll
            for (int i = 0; i < 16; ++i) { const size_t row = row0 + blk * 16 + i;
                const float h = fmaf(bf_hi(wf[i]), hf, bf_lo(wf[i])) + fmaf(bf_hi(wb[i]), hb, bf_lo(wb[i]));
                const float g = bf_lo((unsigned)gt[i]); const float z = 0.7978845608028654f * (g + 0.044715f * g * g * g);
                const float th = 1.f - 2.f * __builtin_amdgcn_rcpf(__builtin_amdgcn_exp2f(2.f * 1.4426950408889634f * z) + 1.f);
                CAT[row * D + c] = (bf16)f2bf(QO(h * (0.5f * g * (1.f + th)))); } }
    }
}
}
#ifndef MK_WGM_GATE
#define MK_WGM_GATE 2
#endif
#ifndef MK_WGM_IN1
#define MK_WGM_IN1 2
#endif
namespace mk {
#define IN(k) (lo <= (k) && (k) < hi)
#define SEAM(k) do { if (IN(k) && IN((k) + 1)) xcd_barrier(bar); } while (0)
template <int LAYER> __device__ __forceinline__ void moe_section(Frame& F, const Args& args, const XcdBarrier& bar, const int lo, const int hi) {
        constexpr int layer = LAYER; constexpr int mb = layer == 0 ? 5 : 15;
        constexpr int row0 = layer == 0 ? 0 : NCTX, nrows = layer == 0 ? NTOK : NLAT;
        if (IN(mb)) { phase_router(F, layer, row0, nrows, args.in[7] + layer * D, args.in[25] + (size_t)layer * D * 32, args.in[26] + layer * 32, args.in[27], args.in[29]);
            if (layer == 1) filler(F, args.in[27], args.in[29], 1 << 20); }
        SEAM(mb);
        if (IN(mb + 1)) {
            moe_table(F, layer);
            LAS const int* tab = (LAS const int*)(F.misc + MISC_TAB); const int T = *(LAS const int*)(F.misc + MISC_NT);
            MoeSched1 S; S.ord.init(T, 8, F.G, (int)blockIdx.x); S.tab = tab; S.cntl = (LAS const int*)(F.misc + MISC_CNT); S.XN = (const char*)(F.ws + WS_XN);
            S.W = (const char*)(F.ws + WS_W1) + (size_t)layer * 32 * 2048 * (size_t)W1_KB; S.list = (const int*)(F.ws + WS_ROUTE + RT_LIST); S.a_pitch = W1_KB; S.wb = W1_KB;
            EpiSwiglu E{(bf16*)(F.ws + WS_HB), args.in[28] + (size_t)layer * 32 * 2048, tab};
            pg8::gemm_phase<EpiSwiglu, MoeSched1, true, FP8_G1, 122>(F.lds + RING_OFF, W1_KB, S, E, F.wave);
            if (layer == 0 && S.ord.early()) filler(F, args.in[27], args.in[29], 2);
        }
        SEAM(mb + 1);
        if (IN(mb + 2)) {
            moe_table(F, layer);
            LAS const int* tab = (LAS const int*)(F.misc + MISC_TAB); const int T = *(LAS const int*)(F.misc + MISC_NT);
            MoeSched2 S; S.ord.init(T, 4, F.G, (int)blockIdx.x); S.tab = tab; S.HB = (const char*)(F.ws + WS_HB); S.W = (const char*)(F.ws + WS_W2) + (size_t)layer * 32 * 1024 * (size_t)W2_KB; S.a_pitch = W2_KB; S.wb = W2_KB;
            EpiBias2 E{(bf16*)(F.ws + WS_Y2), args.in[30] + (size_t)layer * 32 * 1024, tab};
            pg8::gemm_phase<EpiBias2, MoeSched2, false, FP8_G2, 122>(F.lds + RING_OFF, W2_KB, S, E, F.wave);
            if (layer == 0 && S.ord.early()) filler(F, args.in[27], args.in[29], 2);
        }
        SEAM(mb + 2);
        if (IN(mb + 3)) {
            moe_table(F, layer);
            if (layer == 0) phase_combine(F, 0, row0, nrows, 0, args.in[6] + D, (const float*)(F.ws + WS_MOD) + (size_t)9 * 6144, args.out);
            else phase_combine(F, 1, row0, nrows, 1, args.in[31], nullptr, args.out);
        }
        SEAM(mb + 3);
}
#undef IN
#undef SEAM
constexpr int NPHASE = 19;
__global__ void __launch_bounds__(NTHR, 2) mk_fwd(Args args) {
    extern __shared__ __attribute__((aligned(16))) unsigned char lds_raw[];
    Frame F;
    F.lds = (LAS unsigned char*)lds_raw; F.misc = F.lds + MISC_OFF;
    F.wave = __builtin_amdgcn_readfirstlane((int)threadIdx.x >> 6);
    F.G = gridDim.x; { const int bx = blockIdx.x; F.vcu = (F.G % 8 == 0) ? (bx % 8) * (F.G / 8) + bx / 8 : bx; }
    F.ws = args.ws; F.ctl = (gu32*)(args.ws + WS_CTL);
#ifdef MK_RT_SKIP
    F.li = args.li;
#endif
    for (int u = tid_now(F); u < (LDS_BYTES - MISC_OFF) / 4; u += NTHR) ((LAS unsigned*)F.misc)[u] = 0u;
    __syncthreads();
    const int lo = args.ph_lo, hi = args.ph_hi;
    XcdBarrier bar = xcd_barrier_post((unsigned*)(F.ctl + CW_BAR) + args.li * XCD_BAR_WORDS, (volatile LAS unsigned*)(F.misc + MISC_BAR), F.wave);
#define IN(k) (lo <= (k) && (k) < hi)
#define SEAM(k) do { if (IN(k) && IN((k) + 1)) xcd_barrier(bar); } while (0)

    if (IN(0)) {
        p0_adaln(F, args.in[1], args.in[3], args.in[4], args.in[5]);
        p0_tables(F, args.in[10], args.in[11], args.in[12], args.in[13], args.in[24]);
        p0_wr_image(F, args.in[25]);
        __syncthreads();
        p0_dense_weight(F, args.in[8], 1024, 3072, (bf16*)(F.ws + WS_WIN0), 0);
        p0_dense_weight<true>(F, args.in[9], 1024, 1024, (bf16*)(F.ws + WS_WOUT0), 1536);
        p0_dense_weight(F, args.in[16], 1024, 2048, (bf16*)(F.ws + WS_WIN1), 0);
        p0_dense_weight<true>(F, args.in[17], 1024, 1024, (bf16*)(F.ws + WS_WOUT1), 1024);
        p0_gate_weights(F, args.in[20], args.in[22], 1536);
        p0_moe_weights(F, args.in[27], args.in[29], 0);
        if constexpr (!FILLER_ON) p0_moe_weights(F, args.in[27], args.in[29], 1);
    }
    SEAM(0);
    if (IN(1)) phase_norm1_l0(F, args.in[0], args.in[2], args.in[6]);
    SEAM(1);
    if (IN(2)) {
        DenseSched S; S.ord.init(NTOK / 256, 12, F.G, (int)blockIdx.x); S.A = (const char*)(F.ws + WS_XN); S.W = (const char*)(F.ws + WS_WIN0); S.a_pitch = 2048; S.K2 = 2048;
        EpiInProj0 E{(bf16*)(F.ws + WS_PROJ), (const float*)(F.ws + WS_TAB)};
        pg8::gemm_phase<EpiInProj0, DenseSched, false>(F.lds + RING_OFF, 2048, S, E, F.wave);
        tail_fill<2>(F, args.in[27], args.in[29]);
    }
    SEAM(2);
    if (IN(3)) phase_attn(F, args.in[14], args.in[15], args.in[27], args.in[29]);
    SEAM(3);
    if (IN(4)) {
        DenseSched S; S.ord.init(NTOK / 256, 4, F.G, (int)blockIdx.x); S.A = (const char*)(F.ws + WS_CAT); S.W = (const char*)(F.ws + WS_WOUT0); S.a_pitch = 2048; S.K2 = 2048;
        EpiResid E{(bf16*)(F.ws + WS_XS), args.in[0], args.in[2], (const float*)(F.ws + WS_MOD) + 2 * D, 0};
        pg8::gemm_phase<EpiResid, DenseSched, false>(F.lds + RING_OFF, 2048, S, E, F.wave);
        tail_fill<0>(F, args.in[27], args.in[29]);
    }
    SEAM(4);

    moe_section<0>(F, args, bar, lo, hi);
    if (IN(9)) {
        InProj1Sched S; S.ord.init(64, 8, F.G, (int)blockIdx.x, MK_WGM_IN1); S.G = F.G; S.c = (int)blockIdx.x; S.A = (const char*)(F.ws + WS_XN); S.W = (const char*)(F.ws + WS_WIN1); S.a_pitch = 2048;
        EpiBf16 E{(bf16*)(F.ws + WS_PROJ), 2048};
        pg8::gemm_phase<EpiBf16, InProj1Sched, false>(F.lds + RING_OFF, 2048, S, E, F.wave);
        tail_fill<1>(F, args.in[27], args.in[29]);
    }
    SEAM(9);
    if (IN(10)) phase_conv1(F, args.in[18], args.in[19]);
    SEAM(10);
    if (IN(11)) {
        GateSched S; S.ord.init(144, 8, F.G, (int)blockIdx.x, MK_WGM_GATE); S.XC = (const char*)(F.ws + WS_XC); S.W = (const char*)(F.ws + WS_WGATE); S.a_pitch = 2048;
        EpiGate E{(const bf16*)(F.ws + WS_XC), (unsigned*)(F.ws + WS_AB), args.in[21], args.in[23], (const float*)(F.ws + WS_TAB) + TAB_SP};
        pg8::gemm_phase<EpiGate, GateSched, true>(F.lds + RING_OFF, 512, S, E, F.wave);
        tail_fill<3>(F, args.in[27], args.in[29]);
    }
    SEAM(11);
    if (IN(13)) phase_scan2(F);
    SEAM(13);
    if (IN(14)) {
        DenseSched S; S.ord.init(NLAT / 256, 4, F.G, (int)blockIdx.x); S.A = (const char*)(F.ws + WS_CAT) + (size_t)NCTX * 2048; S.W = (const char*)(F.ws + WS_WOUT1); S.a_pitch = 2048; S.K2 = 2048;
        EpiResid E{(bf16*)(F.ws + WS_XS), nullptr, nullptr, (const float*)(F.ws + WS_MOD) + (size_t)9 * 6144 + 2 * D, NCTX};
        pg8::gemm_phase<EpiResid, DenseSched, false>(F.lds + RING_OFF, 2048, S, E, F.wave);
    }
    SEAM(14);
    moe_section<1>(F, args, bar, lo, hi);
#ifdef MK_ABLATION_PHASES
    if (IN(20)) phase_attn<MK_ABLATION_PHASES>(F, args.in[14], args.in[15]);
    if (IN(21)) { for (int i = 0; i < 10; ++i) xcd_barrier(bar); }
#endif
#undef IN
#undef SEAM
}

struct Launcher { int grid; bool ok; };
inline Launcher& launcher() {
    static Launcher L{0, false};
    if (L.grid == 0) {
        int dev = 0, cus = 0, per_cu = 0;
        if (hipGetDevice(&dev) != hipSuccess || hipDeviceGetAttribute(&cus, hipDeviceAttributeMultiprocessorCount, dev) != hipSuccess) { fprintf(stderr, "mk: device query failed\n"); L.grid = -1; return L; }
        if (hipFuncSetAttribute((const void*)mk_fwd, hipFuncAttributeMaxDynamicSharedMemorySize, LDS_BYTES) != hipSuccess) { fprintf(stderr, "mk: hipFuncSetAttribute failed\n"); L.grid = -1; return L; }
        if (hipOccupancyMaxActiveBlocksPerMultiprocessor(&per_cu, (const void*)mk_fwd, NTHR, LDS_BYTES) != hipSuccess || per_cu < 1) fprintf(stderr, "mk: note: occupancy query reports %d\n", per_cu);
        (void)hipGetLastError();
        L.grid = cus; L.ok = true;
    }
    return L;
}
inline void launch(hipStream_t st, void* const* d_in, float* out, unsigned char* ws, int ph_lo, int ph_hi, int li) {
    Launcher& L = launcher(); if (L.grid <= 0) return;
    Args a{}; for (int i = 0; i < 32; ++i) a.in[i] = (const float*)d_in[i];
    a.out = out; a.ws = ws; a.ph_lo = ph_lo; a.ph_hi = ph_hi; a.li = li; a.pad = 0;
    hipLaunchKernelGGL(mk_fwd, dim3(L.grid), dim3(NTHR), LDS_BYTES, st, a);
}
}
extern "C" void kernel_launch(void* const* d_in, const int* in_sizes, int n_in, void* d_out, int out_size, void* d_ws, size_t ws_size, hipStream_t stream) {
    unsigned char* ws = (unsigned char*)d_ws;
    if (mk::WS_END > ws_size) { fprintf(stderr, "kernel_launch: workspace too small: need %zu have %zu\n", (size_t)mk::WS_END, ws_size); return; }
    (void)hipMemsetAsync(ws + mk::WS_CTL, 0, mk::CTL_ZERO_BYTES, stream);
    mk::launch(stream, d_in, (float*)d_out, ws, 0, 19, 0);
}
```
